# Optimizing an MI355X kernel written in HIP

```python
import math
import jax, jax.numpy as jnp
from jax import lax
import numpy as np

D_MODEL = 2048
BATCH = 4
SEQ = 2048
DEPTH = 4

CHUNK = 64
D_MIX = D_MODEL
CONV_W = 4
NORM_EPS = 1e-6
LRU_WIDTH = D_MIX // 4
LRU_BLOCKS = 8
LRU_BLOCK = LRU_WIDTH // LRU_BLOCKS
LRU_C = 8.0
GDN_HEAD = 128
GDN_HEADS = (3 * D_MIX // 8) // GDN_HEAD
GDN_WIDTH = GDN_HEADS * GDN_HEAD
RWKV_HEAD = 64
RWKV_WIDTH = D_MIX - LRU_WIDTH - GDN_WIDTH
RWKV_HEADS = RWKV_WIDTH // RWKV_HEAD
DECAY_LORA = 96
ICLR_LORA = 96
RWKV_SHIFT_WIDTH = 3 * RWKV_WIDTH + DECAY_LORA + ICLR_LORA
RWKV_GN_EPS = 64e-5
IN_SIZES = (LRU_WIDTH, LRU_WIDTH, 3 * GDN_WIDTH, GDN_WIDTH, GDN_HEADS, GDN_HEADS, RWKV_SHIFT_WIDTH, RWKV_WIDTH)
N_IN = 2 * LRU_WIDTH + 4 * GDN_WIDTH + 2 * GDN_HEADS + RWKV_SHIFT_WIDTH + RWKV_WIDTH

kernel_name = 'hybrid_rglru_gdn_rwkv7_trunk'


def rmsnorm(x, g):
    xf = x.astype(jnp.float32)
    y = xf * lax.rsqrt(jnp.mean(xf * xf, axis=-1, keepdims=True) + NORM_EPS) * g.astype(jnp.float32)
    return y.astype(x.dtype)


def split_cols(t, sizes):
    idx = []
    s = 0
    for n in sizes[:-1]:
        s += n
        idx.append(s)
    return jnp.split(t, idx, axis=-1)


def causal_dwconv(x, w):
    c = x.shape[-1]
    k = w.shape[0]
    return lax.conv_general_dilated(x, w[:, None, :], window_strides=(1,), padding=[(k - 1, 0)],
                                    dimension_numbers=('NWC', 'WIO', 'NWC'), feature_group_count=c)


def l2norm(t):
    return t * lax.rsqrt(jnp.sum(t * t, axis=-1, keepdims=True) + 1e-6)


def token_shift(x, mu):
    x_prev = jnp.pad(x, ((0, 0), (1, 0), (0, 0)))[:, :-1]
    return x + (x_prev - x) * mu


def rg_lru(xa, conv_w, conv_b, w_x, b_x, w_a, b_a, lam):
    f32 = jnp.float32
    bsz, seq, _ = xa.shape
    x = causal_dwconv(xa.astype(f32), conv_w.astype(f32)) + conv_b.astype(f32)
    xb = x.reshape(bsz, seq, LRU_BLOCKS, LRU_BLOCK)
    gate_x = jax.nn.sigmoid(jnp.einsum('bsni,nij->bsnj', xb, w_x.astype(f32)).reshape(bsz, seq, LRU_WIDTH) + b_x.astype(f32))
    gate_a = jax.nn.sigmoid(jnp.einsum('bsni,nij->bsnj', xb, w_a.astype(f32)).reshape(bsz, seq, LRU_WIDTH) + b_a.astype(f32))
    log_a = -LRU_C * gate_a * jax.nn.softplus(-lam.astype(f32))
    a = jnp.exp(log_a)
    mult = jnp.sqrt(jnp.maximum(-jnp.expm1(2.0 * log_a), 0.0))
    u = mult * (gate_x * x)

    def combine(left, right):
        a1, b1 = left
        a2, b2 = right
        return a1 * a2, a2 * b1 + b2

    _, h = lax.associative_scan(combine, (a, u), axis=1)
    return h


def chunk_gated_delta_rule(q, k, v, beta, g):
    bsz, seq, h, d = q.shape
    n = seq // CHUNK
    c = CHUNK

    def to_chunks(t):
        return t.reshape(bsz, n, c, h, -1).transpose(0, 3, 1, 2, 4)

    q, k, v = to_chunks(q), to_chunks(k), to_chunks(v)
    beta = beta.reshape(bsz, n, c, h).transpose(0, 3, 1, 2)
    g = g.reshape(bsz, n, c, h).transpose(0, 3, 1, 2)
    decay = jnp.cumsum(g, axis=-1)
    pos = jnp.arange(c)
    incl = pos[:, None] >= pos[None, :]
    strict = pos[:, None] > pos[None, :]
    diff = decay[..., :, None] - decay[..., None, :]
    lmask = jnp.exp(jnp.where(incl, diff, -jnp.inf))
    kb = k * beta[..., None]
    a_mat = jnp.where(strict, jnp.einsum('bhncd,bhnmd->bhncm', kb, k) * lmask, 0.0)
    eye = jnp.broadcast_to(jnp.eye(c, dtype=a_mat.dtype), a_mat.shape)
    t_mat = lax.linalg.triangular_solve(a_mat, eye, left_side=True, lower=True, unit_diagonal=True)
    u = jnp.einsum('bhncm,bhnme->bhnce', t_mat, v * beta[..., None])
    w = jnp.einsum('bhncm,bhnmd->bhncd', t_mat, kb * jnp.exp(decay)[..., None])
    qk = jnp.where(incl, jnp.einsum('bhncd,bhnmd->bhncm', q, k) * lmask, 0.0)
    q_dec = q * jnp.exp(decay)[..., None]
    k_dec = k * jnp.exp(decay[..., -1:] - decay)[..., None]
    g_last = jnp.exp(decay[..., -1])

    def step(state, inp):
        u_i, w_i, qk_i, qd_i, kd_i, gl_i = inp
        v_new = u_i - jnp.einsum('bhcd,bhde->bhce', w_i, state)
        o = jnp.einsum('bhcd,bhde->bhce', qd_i, state) + jnp.einsum('bhcm,bhme->bhce', qk_i, v_new)
        state = state * gl_i[..., None, None] + jnp.einsum('bhcd,bhce->bhde', kd_i, v_new)
        return state, o

    xs = tuple(jnp.moveaxis(t, 2, 0) for t in (u, w, qk, q_dec, k_dec, g_last))
    s0 = jnp.zeros((bsz, h, d, v.shape[-1]), jnp.float32)
    _, o = lax.scan(step, s0, xs)
    return o.transpose(1, 0, 3, 2, 4).reshape(bsz, seq, h, -1)


def gated_deltanet(qkv, beta_logit, a_logit, conv_w, a_log, dt_bias, norm_g):
    f32 = jnp.float32
    bsz, seq, _ = qkv.shape
    qkv = jax.nn.silu(causal_dwconv(qkv.astype(f32), conv_w.astype(f32)))
    q, k, v = jnp.split(qkv, 3, axis=-1)
    q = l2norm(q.reshape(bsz, seq, GDN_HEADS, GDN_HEAD)) * (GDN_HEAD ** -0.5)
    k = l2norm(k.reshape(bsz, seq, GDN_HEADS, GDN_HEAD))
    v = v.reshape(bsz, seq, GDN_HEADS, GDN_HEAD)
    beta = jax.nn.sigmoid(beta_logit.astype(f32))
    g = -jnp.exp(a_log.astype(f32)) * jax.nn.softplus(a_logit.astype(f32) + dt_bias.astype(f32))
    o = chunk_gated_delta_rule(q, k, v, beta, g)
    o = o * lax.rsqrt(jnp.mean(o * o, axis=-1, keepdims=True) + NORM_EPS) * norm_g.astype(f32)
    return o.reshape(bsz, seq, GDN_WIDTH)


def rwkv7_time_mix(c_in, mu, w0, w_up, a0, a_up, k_k, k_a, r_k, gn_w, gn_b):
    f32 = jnp.float32
    bsz, seq, _ = c_in.shape
    xs = token_shift(c_in.astype(f32), mu.astype(f32))
    r, k, v, wl, al = split_cols(xs, (RWKV_WIDTH, RWKV_WIDTH, RWKV_WIDTH, DECAY_LORA, ICLR_LORA))
    w_log = -jax.nn.softplus(-(w0.astype(f32) + jnp.tanh(wl) @ w_up.astype(f32))) - 0.5
    decay = jnp.exp(-jnp.exp(w_log))
    a = jax.nn.sigmoid(a0.astype(f32) + al @ a_up.astype(f32))
    hs = lambda t: t.reshape(bsz, seq, RWKV_HEADS, RWKV_HEAD)
    kk = l2norm(hs(k * k_k.astype(f32)))
    k = k * (1.0 + (a - 1.0) * k_a.astype(f32))
    r, k, v, decay, a = hs(r), hs(k), hs(v), hs(decay), hs(a)

    def step(state, inp):
        r_t, w_t, k_t, v_t, kk_t, a_t = inp
        sa = jnp.einsum('bhij,bhj->bhi', state, -kk_t)
        state = (state * w_t[:, :, None, :] + sa[..., None] * (kk_t * a_t)[:, :, None, :]
                 + v_t[..., None] * k_t[:, :, None, :])
        return state, jnp.einsum('bhij,bhj->bhi', state, r_t)

    seq_in = tuple(jnp.moveaxis(t, 1, 0) for t in (r, decay, k, v, kk, a))
    s0 = jnp.zeros((bsz, RWKV_HEADS, RWKV_HEAD, RWKV_HEAD), jnp.float32)
    _, y = lax.scan(step, s0, seq_in)
    y = jnp.moveaxis(y, 0, 1)
    mean = jnp.mean(y, axis=-1, keepdims=True)
    var = jnp.mean(jnp.square(y - mean), axis=-1, keepdims=True)
    y = ((y - mean) * lax.rsqrt(var + RWKV_GN_EPS)).reshape(bsz, seq, RWKV_WIDTH) * gn_w.astype(f32) + gn_b.astype(f32)
    bonus = jnp.sum(r * k * r_k.astype(f32), axis=-1, keepdims=True) * v
    return y + bonus.reshape(bsz, seq, RWKV_WIDTH)


def setup_inputs(seed: int = 0) -> dict:
    key = jax.random.key(seed)
    ks = iter(jax.random.split(key, 40))
    f32 = jnp.float32
    nrm = lambda shape, s: jax.random.normal(next(ks), shape, f32) * s
    uni = lambda shape, lo, hi: jax.random.uniform(next(ks), shape, f32, lo, hi)
    L = DEPTH
    x = jax.random.normal(next(ks), (BATCH, SEQ, D_MODEL), f32)
    norm_g = 1.0 + nrm((L, D_MODEL), 0.02)
    w_in = nrm((L, D_MODEL, N_IN), D_MODEL ** -0.5)
    w_out = nrm((L, D_MIX, D_MODEL), 0.5 * D_MIX ** -0.5)
    lru_conv_w = nrm((L, CONV_W, LRU_WIDTH), 0.5)
    lru_conv_b = nrm((L, LRU_WIDTH), 0.02)
    lru_wx = nrm((L, LRU_BLOCKS, LRU_BLOCK, LRU_BLOCK), LRU_BLOCK ** -0.5)
    lru_bx = nrm((L, LRU_WIDTH), 0.02)
    lru_wa = nrm((L, LRU_BLOCKS, LRU_BLOCK, LRU_BLOCK), LRU_BLOCK ** -0.5)
    lru_ba = nrm((L, LRU_WIDTH), 0.02)
    a_target = uni((L, LRU_WIDTH), 0.9, 0.999)
    sig = a_target ** (1.0 / LRU_C)
    lru_lambda = jnp.log(sig) - jnp.log1p(-sig)
    gdn_conv_w = nrm((L, CONV_W, 3 * GDN_WIDTH), 0.5)
    gdn_a_log = jnp.log(uni((L, GDN_HEADS), 1.0, 16.0))
    dt = jnp.exp(uni((L, GDN_HEADS), math.log(1e-3), math.log(1e-1)))
    gdn_dt_bias = dt + jnp.log(-jnp.expm1(-dt))
    gdn_norm_g = 1.0 + nrm((L, GDN_HEAD), 0.02)
    rwkv_mu = uni((L, RWKV_SHIFT_WIDTH), 0.1, 0.9)
    rwkv_w0 = uni((L, RWKV_WIDTH), -6.5, -1.5)
    rwkv_w_up = nrm((L, DECAY_LORA, RWKV_WIDTH), 0.1 * DECAY_LORA ** -0.5)
    rwkv_a0 = nrm((L, RWKV_WIDTH), 0.1)
    rwkv_a_up = nrm((L, ICLR_LORA, RWKV_WIDTH), 0.1 * ICLR_LORA ** -0.5)
    rwkv_k_k = 0.85 + nrm((L, RWKV_WIDTH), 0.02)
    rwkv_k_a = 1.0 + nrm((L, RWKV_WIDTH), 0.02)
    rwkv_r_k = nrm((L, RWKV_HEADS, RWKV_HEAD), 0.1)
    rwkv_gn_w = 1.0 + nrm((L, RWKV_WIDTH), 0.02)
    rwkv_gn_b = nrm((L, RWKV_WIDTH), 0.02)
    final_norm_g = 1.0 + nrm((D_MODEL,), 0.02)
    return {'x': x, 'norm_g': norm_g, 'w_in': w_in, 'w_out': w_out,
            'lru_conv_w': lru_conv_w, 'lru_conv_b': lru_conv_b, 'lru_wx': lru_wx, 'lru_bx': lru_bx,
            'lru_wa': lru_wa, 'lru_ba': lru_ba, 'lru_lambda': lru_lambda,
            'gdn_conv_w': gdn_conv_w, 'gdn_a_log': gdn_a_log, 'gdn_dt_bias': gdn_dt_bias, 'gdn_norm_g': gdn_norm_g,
            'rwkv_mu': rwkv_mu, 'rwkv_w0': rwkv_w0, 'rwkv_w_up': rwkv_w_up, 'rwkv_a0': rwkv_a0,
            'rwkv_a_up': rwkv_a_up, 'rwkv_k_k': rwkv_k_k, 'rwkv_k_a': rwkv_k_a, 'rwkv_r_k': rwkv_r_k,
            'rwkv_gn_w': rwkv_gn_w, 'rwkv_gn_b': rwkv_gn_b, 'final_norm_g': final_norm_g}


def reference(x, norm_g, w_in, w_out, lru_conv_w, lru_conv_b, lru_wx, lru_bx, lru_wa, lru_ba, lru_lambda,
              gdn_conv_w, gdn_a_log, gdn_dt_bias, gdn_norm_g, rwkv_mu, rwkv_w0, rwkv_w_up, rwkv_a0,
              rwkv_a_up, rwkv_k_k, rwkv_k_a, rwkv_r_k, rwkv_gn_w, rwkv_gn_b, final_norm_g):
    dt = x.dtype
    for l in range(DEPTH):
        h = rmsnorm(x, norm_g[l])
        proj = h @ w_in[l]
        a_x, a_g, b_qkv, b_g, b_beta, b_a, c_in, c_g = split_cols(proj, IN_SIZES)
        y_a = rg_lru(a_x, lru_conv_w[l], lru_conv_b[l], lru_wx[l], lru_bx[l], lru_wa[l], lru_ba[l], lru_lambda[l])
        y_b = gated_deltanet(b_qkv, b_beta, b_a, gdn_conv_w[l], gdn_a_log[l], gdn_dt_bias[l], gdn_norm_g[l])
        y_c = rwkv7_time_mix(c_in, rwkv_mu[l], rwkv_w0[l], rwkv_w_up[l], rwkv_a0[l], rwkv_a_up[l],
                             rwkv_k_k[l], rwkv_k_a[l], rwkv_r_k[l], rwkv_gn_w[l], rwkv_gn_b[l])
        y = jnp.concatenate([y_a * jax.nn.silu(a_g.astype(jnp.float32)),
                             y_b * jax.nn.silu(b_g.astype(jnp.float32)),
                             y_c * jax.nn.silu(c_g.astype(jnp.float32))], axis=-1).astype(dt)
        x = x + y @ w_out[l]
    return rmsnorm(x, final_norm_g)
```

```cpp
#include <hip/hip_runtime.h>
#include <hip/hip_cooperative_groups.h>
#include <cstdio>
#include <cstdint>
namespace cg = cooperative_groups;
namespace pg8 {
#define PG8_LAS __attribute__((address_space(3)))
typedef unsigned short bf16_t;
typedef short bf16x8 __attribute__((ext_vector_type(8)));
typedef float f32x4 __attribute__((ext_vector_type(4)));
typedef unsigned u32x4 __attribute__((ext_vector_type(4)));
constexpr int BM = 256, BK = 64, HALF = 128, HTB = HALF * BK * 2  , STAGE_BYTES = 8 * HTB, NXCD = 8, WGM = 8;

__host__ __device__ __forceinline__ int lds_byte(int r, int c) { const int st = (r >> 4) * 2 + (c >> 5), rr = r & 15, cc = c & 31, ob = rr * 64 + cc * 2; return st * 1024 + (ob ^ (((ob >> 9) & 1) << 5)); }
__host__ __device__ __forceinline__ void stage_rc(int b, int& R, int& C) { const int st = b / 1024, sb = b % 1024, swz = sb ^ (((sb >> 9) & 1) << 5); R = (st >> 1) * 16 + swz / 64; C = (st & 1) * 32 + (swz % 64) / 2; }
__host__ __device__ __forceinline__ int perm32(int rho) { const int n = rho >> 4, i = rho & 15; return 8 * (i >> 2) + 4 * n + (i & 3); }

struct Unit { int pm, pn; };
struct Gemm { const bf16_t* A; const bf16_t* Bt; int M, N, K; };

struct StaticOrder {
    int nM, nN, nwg, G, c;
    __host__ __device__ void init(int M, int N, int G_, int c_) { nM = M / BM; nN = N / BM; nwg = nM * nN; G = G_; c = c_; }
    __host__ __device__ bool next(int i, Unit& u) const {
        const long L = (long)i * G + c; if (L >= nwg) return false;
        int wgid = (int)L; { const int q = nwg / NXCD, r = nwg % NXCD, xcd = wgid % NXCD, off = wgid / NXCD; wgid = (xcd < r ? xcd * (q + 1) : r * (q + 1) + (xcd - r) * q) + off; }
        const int nig = WGM * nN, gid = wgid / nig, fm = gid * WGM, gsz = (nM - fm) < WGM ? (nM - fm) : WGM;
        u.pm = fm + ((wgid % nig) % gsz); u.pn = (wgid % nig) / gsz; return true;
    }
    __device__ __forceinline__ void a_ready(const Unit&) const {}
    __device__ __forceinline__ void done(const Unit&) const {}
};
struct CountedOrder : StaticOrder {
    const unsigned* ready; unsigned need; unsigned* tmo;
    __device__ __forceinline__ void a_ready(const Unit& u) const {
        if (threadIdx.x < 64) {
            const unsigned long long t0 = __builtin_amdgcn_s_memrealtime(); unsigned polls = 0;
            while ((unsigned)__builtin_amdgcn_readfirstlane(__hip_atomic_load(ready + 64 * u.pm, __ATOMIC_RELAXED, __HIP_MEMORY_SCOPE_AGENT)) < need) {
                if ((++polls & 255u) == 0u && __builtin_amdgcn_readfirstlane(__hip_atomic_load(tmo, __ATOMIC_RELAXED, __HIP_MEMORY_SCOPE_AGENT)) != 0u) break;
                if (__builtin_amdgcn_s_memrealtime() - t0 > 2000000ull) {
                    if (threadIdx.x == 0) { unsigned expect = 0u; __hip_atomic_compare_exchange_strong(tmo + 1, &expect, 0x600u | (unsigned)(u.pm & 0xff), __ATOMIC_RELAXED, __ATOMIC_RELAXED, __HIP_MEMORY_SCOPE_AGENT); __hip_atomic_store(tmo, 1u, __ATOMIC_RELAXED, __HIP_MEMORY_SCOPE_AGENT); }
                    break; }
                __builtin_amdgcn_s_sleep(2); }
            __builtin_amdgcn_fence(__ATOMIC_ACQUIRE, "agent");
            asm volatile("s_waitcnt vmcnt(0)" ::: "memory");
        }
#if !defined(BROKEN_HOOK_NO_BARRIER)
        asm volatile("" ::: "memory"); __builtin_amdgcn_s_barrier(); asm volatile("" ::: "memory");
#endif
    }
};

__device__ __forceinline__ unsigned cvt_pk_bf16(float lo, float hi) { unsigned r; asm volatile("v_cvt_pk_bf16_f32 %0, %1, %2" : "=v"(r) : "v"(lo), "v"(hi)); return r; }
typedef float f32x2 __attribute__((ext_vector_type(2)));
__device__ __forceinline__ f32x2 gelu_pk(f32x2 v) {
    const f32x2 av = __builtin_elementwise_abs(v), d = av * 0.2316418882f + 1.0f;
    f32x2 t; t.x = __builtin_amdgcn_rcpf(d.x); t.y = __builtin_amdgcn_rcpf(d.y);
    f32x2 q = t * 0.5307027145f + (-0.7265760135f); q = q * t + 0.7107068705f; q = q * t + (-0.142248368f); q = q * t + 0.127414796f; q = q * t;
    const f32x2 s = (v * v) * (-0.72134752044f);
    f32x2 e; e.x = __builtin_amdgcn_exp2f(s.x); e.y = __builtin_amdgcn_exp2f(s.y);
    const f32x2 m = v * (q * e), r = v - m;
    f32x2 o; o.x = v.x < 0.f ? m.x : r.x; o.y = v.y < 0.f ? m.y : r.y; return o;
}

struct EpiF32 {
    static constexpr bool PERM = false, AFTER_DRAIN = false;
    float* C; int ldc; const float* bias;
    __device__ __forceinline__ void operator()(const f32x4 (&acc)[2][2][4][2], const Unit& u, int wr, int wc, int fr, int fq) const {
        const int row0 = u.pm * BM + wr * 64 + fr, col0 = u.pn * BM + wc * 32 + 4 * fq;
        f32x4 bv[2][2];
#pragma unroll
        for (int bj = 0; bj < 2; ++bj)
#pragma unroll
            for (int n = 0; n < 2; ++n) bv[bj][n] = bias ? *(const f32x4*)(bias + col0 + bj * HALF + n * 16) : (f32x4){0.f, 0.f, 0.f, 0.f};
#pragma unroll
        for (int ai = 0; ai < 2; ++ai)
#pragma unroll
            for (int m = 0; m < 4; ++m) { float* rowp = C + (size_t)(row0 + ai * HALF + m * 16) * ldc + col0;
#pragma unroll
                for (int bj = 0; bj < 2; ++bj)
#pragma unroll
                    for (int n = 0; n < 2; ++n) *(f32x4*)(rowp + bj * HALF + n * 16) = acc[ai][bj][m][n] + bv[bj][n]; }
    }
};
template <int ACT  > struct EpiBf16 {
    static constexpr bool PERM = true, AFTER_DRAIN = false;
    bf16_t* O; int ldc; const float* bias; int split_cols; size_t split_stride;
    __device__ __forceinline__ void operator()(const f32x4 (&acc)[2][2][4][2], const Unit& u, int wr, int wc, int fr, int fq) const {
        const int row0 = u.pm * BM + wr * 64 + fr; int colt = u.pn * BM; bf16_t* base = O;
        if (split_cols) { const int t = colt / split_cols; base += (size_t)t * split_stride; colt -= t * split_cols; }
        const int col0 = colt + wc * 32 + 8 * fq, bcol0 = u.pn * BM + wc * 32 + 8 * fq;
        f32x4 bv[2][2];
#pragma unroll
        for (int bj = 0; bj < 2; ++bj)
#pragma unroll
            for (int n = 0; n < 2; ++n) bv[bj][n] = bias ? *(const f32x4*)(bias + bcol0 + bj * HALF + 4 * n) : (f32x4){0.f, 0.f, 0.f, 0.f};
#pragma unroll
        for (int ai = 0; ai < 2; ++ai)
#pragma unroll
            for (int m = 0; m < 4; ++m) { bf16_t* rowp = base + (size_t)(row0 + ai * HALF + m * 16) * ldc + col0;
#pragma unroll
                for (int bj = 0; bj < 2; ++bj) { f32x4 v0 = acc[ai][bj][m][0] + bv[bj][0], v1 = acc[ai][bj][m][1] + bv[bj][1];
                    if (ACT == 1) { f32x2 a = gelu_pk((f32x2){v0[0], v0[1]}), b = gelu_pk((f32x2){v0[2], v0[3]}), c = gelu_pk((f32x2){v1[0], v1[1]}), d = gelu_pk((f32x2){v1[2], v1[3]});
                        v0 = (f32x4){a.x, a.y, b.x, b.y}; v1 = (f32x4){c.x, c.y, d.x, d.y}; }
                    if (ACT == 2) {
#pragma unroll
                        for (int j = 0; j < 4; ++j) { v0[j] = 0.5f * v0[j] * (1.0f + erff(v0[j] * 0.70710678f)); v1[j] = 0.5f * v1[j] * (1.0f + erff(v1[j] * 0.70710678f)); } }
                    u32x4 w; w.x = cvt_pk_bf16(v0[0], v0[1]); w.y = cvt_pk_bf16(v0[2], v0[3]); w.z = cvt_pk_bf16(v1[0], v1[1]); w.w = cvt_pk_bf16(v1[2], v1[3]);
                    *(u32x4*)(rowp + bj * HALF) = w; } }
    }
};

struct PanelStats {
    unsigned* xbuf;
    unsigned* cnt;
    unsigned* tmo;
    int ntn; float eps;
    unsigned code;
    __device__ __forceinline__ bool run(const f32x4 (&v)[2][2][4][2], const Unit& u, int wr, int wc, int fr, int fq, PG8_LAS unsigned char* lds, int wid, int lane) const {
        typedef float f32x2v __attribute__((ext_vector_type(2)));
        PG8_LAS f32x2v* P = (PG8_LAS f32x2v*)lds;
        PG8_LAS f32x2v* S = (PG8_LAS f32x2v*)(lds + 8192);
        PG8_LAS unsigned* flag = (PG8_LAS unsigned*)(lds + 8192 + 2048);
#pragma unroll
        for (int ai = 0; ai < 2; ++ai)
#pragma unroll
            for (int m = 0; m < 4; ++m) {
                float s = 0.f;
#pragma unroll
                for (int bj = 0; bj < 2; ++bj)
#pragma unroll
                    for (int n = 0; n < 2; ++n) { const f32x4 x = v[ai][bj][m][n]; s += (x[0] + x[1]) + (x[2] + x[3]); }
                s += __shfl_xor(s, 16); s += __shfl_xor(s, 32);
                const float mw = s * (1.0f / 64.0f); float q = 0.f;
#pragma unroll
                for (int bj = 0; bj < 2; ++bj)
#pragma unroll
                    for (int n = 0; n < 2; ++n) { const f32x4 d = v[ai][bj][m][n] - mw; q += (d[0] * d[0] + d[1] * d[1]) + (d[2] * d[2] + d[3] * d[3]); }
                q += __shfl_xor(q, 16); q += __shfl_xor(q, 32);
                if (fq == 0) P[(ai * HALF + wr * 64 + m * 16 + fr) * 4 + wc] = (f32x2v){mw, q};
            }
        asm volatile("s_waitcnt lgkmcnt(0)" ::: "memory"); __builtin_amdgcn_s_barrier(); asm volatile("" ::: "memory");
#if defined(BROKEN_NO_WAIT)
        if (blockIdx.x >= 64) { const long long t0 = clock64(); while (clock64() - t0 < 60000) __builtin_amdgcn_s_sleep(8); }
#endif
        const int row = wid * 32 + (lane & 31);
        if (lane < 32) {
            const f32x2v a = P[row * 4 + 0], b = P[row * 4 + 1], c = P[row * 4 + 2], d = P[row * 4 + 3];
            const float mt = (a.x + b.x + c.x + d.x) * 0.25f;
            const float da = a.x - mt, db = b.x - mt, dc = c.x - mt, dd = d.x - mt;
            const float m2 = (a.y + b.y) + (c.y + d.y) + 64.0f * ((da * da + db * db) + (dc * dc + dd * dd));
            unsigned long long* slot = (unsigned long long*)xbuf + ((size_t)(u.pm * BM + row) * 4 + u.pn);
            __hip_atomic_store(slot, ((unsigned long long)__float_as_uint(m2) << 32) | __float_as_uint(mt), __ATOMIC_RELAXED, __HIP_MEMORY_SCOPE_AGENT);
        }
        asm volatile("s_waitcnt vmcnt(0)" ::: "memory");
        if (lane == 0) __hip_atomic_fetch_add(cnt + 64 * u.pm, 1u, __ATOMIC_RELAXED, __HIP_MEMORY_SCOPE_AGENT);
        if (wid == 0) {
            bool dead = false; const unsigned long long t0 = __builtin_amdgcn_s_memrealtime(); const unsigned want = 8u * (unsigned)ntn;
            for (;;) {
#if defined(BROKEN_NO_WAIT)
                break;
#endif
                if ((unsigned)__builtin_amdgcn_readfirstlane(__hip_atomic_load(cnt + 64 * u.pm, __ATOMIC_RELAXED, __HIP_MEMORY_SCOPE_AGENT)) >= want) break;
                if (__builtin_amdgcn_s_memrealtime() - t0 > 2000000ull) {
                    if (lane == 0) { unsigned expect = 0u; __hip_atomic_compare_exchange_strong(tmo + 1, &expect, code | (unsigned)(u.pm & 0xff), __ATOMIC_RELAXED, __ATOMIC_RELAXED, __HIP_MEMORY_SCOPE_AGENT);
                                     __hip_atomic_store(tmo, 1u, __ATOMIC_RELAXED, __HIP_MEMORY_SCOPE_AGENT); }
                    dead = true; break; }
                __builtin_amdgcn_s_sleep(2);
            }
            __builtin_amdgcn_fence(__ATOMIC_ACQUIRE, "agent");
            if (lane == 0) flag[0] = dead ? 1u : 0u;
        }
        asm volatile("s_waitcnt vmcnt(0) lgkmcnt(0)" ::: "memory"); __builtin_amdgcn_s_barrier(); asm volatile("" ::: "memory");
        const bool bad = flag[0] != 0u;
        if (lane < 32) {
            const unsigned long long* slot = (const unsigned long long*)xbuf + (size_t)(u.pm * BM + row) * 4; float mt[4], m2[4]; float ms = 0.f;
#pragma unroll
            for (int t = 0; t < 4; ++t) { if (t < ntn) { const unsigned long long w = __hip_atomic_load(slot + t, __ATOMIC_RELAXED, __HIP_MEMORY_SCOPE_AGENT); mt[t] = __uint_as_float((unsigned)w); m2[t] = __uint_as_float((unsigned)(w >> 32)); } else { mt[t] = 0.f; m2[t] = 0.f; } ms += mt[t]; }
            const float mean = ms / (float)ntn; float q = 0.f;
#pragma unroll
            for (int t = 0; t < 4; ++t) if (t < ntn) { const float dm = mt[t] - mean; q += m2[t] + 256.0f * dm * dm; }
            S[row] = (f32x2v){mean, 1.0f / sqrtf(q / (256.0f * (float)ntn) + eps)};
        }
        asm volatile("s_waitcnt lgkmcnt(0)" ::: "memory"); __builtin_amdgcn_s_barrier(); asm volatile("" ::: "memory");
        return bad;
    }
};
struct EpiLnRes {
    static constexpr bool PERM = false, AFTER_DRAIN = true;
    const float* base; float* out; int ldc; const float* bias; PanelStats st; unsigned poison;
    __device__ __forceinline__ void refuse(size_t i0, size_t stride, int M, int N) const { const float q = __builtin_nanf(""); for (size_t i = i0; i < (size_t)M * N; i += stride) out[(i / N) * ldc + i % N] = q;
        if (i0 == 0) { unsigned expect = 0u; __hip_atomic_compare_exchange_strong(st.tmo + 1, &expect, 0x7f0u, __ATOMIC_RELAXED, __ATOMIC_RELAXED, __HIP_MEMORY_SCOPE_AGENT); __hip_atomic_store(st.tmo, 1u, __ATOMIC_RELAXED, __HIP_MEMORY_SCOPE_AGENT); } }
    __device__ __forceinline__ void fused(f32x4 (&acc)[2][2][4][2], const Unit& u, int wr, int wc, int fr, int fq, PG8_LAS unsigned char* lds, int wid, int lane) const {
        typedef float f32x2v __attribute__((ext_vector_type(2)));
        const PG8_LAS f32x2v* S = (const PG8_LAS f32x2v*)(lds + 8192);
        const int col0 = u.pn * BM + wc * 32 + 4 * fq;
#pragma unroll
        for (int bj = 0; bj < 2; ++bj)
#pragma unroll
            for (int n = 0; n < 2; ++n) { const f32x4 bv = bias ? *(const f32x4*)(bias + col0 + bj * HALF + n * 16) : (f32x4){0.f, 0.f, 0.f, 0.f};
#pragma unroll
                for (int ai = 0; ai < 2; ++ai)
#pragma unroll
                    for (int m = 0; m < 4; ++m) acc[ai][bj][m][n] += bv; }
        const bool bad = st.run(acc, u, wr, wc, fr, fq, lds, wid, lane) || poison != 0u;
        const float qnan = __builtin_nanf("");
#pragma unroll
        for (int ai = 0; ai < 2; ++ai)
#pragma unroll
            for (int m = 0; m < 4; ++m) { const int r = ai * HALF + wr * 64 + m * 16 + fr; const f32x2v sr = S[r]; const size_t off = (size_t)(u.pm * BM + r) * ldc + col0;
#pragma unroll
                for (int bj = 0; bj < 2; ++bj)
#pragma unroll
                    for (int n = 0; n < 2; ++n) { const f32x4 bs = *(const f32x4*)(base + off + bj * HALF + n * 16); f32x4 o = bs + (acc[ai][bj][m][n] - sr.x) * sr.y;
                        if (bad) o = (f32x4){qnan, qnan, qnan, qnan}; *(f32x4*)(out + off + bj * HALF + n * 16) = o; }
                asm volatile("" ::: "memory"); }
    }
};
struct EpiLnResLn {
    static constexpr bool PERM = false, AFTER_DRAIN = true;
    const float* base; float* out; bf16_t* xn; int ldc; const float* bias; PanelStats st1, st2; unsigned poison;
    __device__ __forceinline__ void refuse(size_t i0, size_t stride, int M, int N) const { const float q = __builtin_nanf(""); for (size_t i = i0; i < (size_t)M * N; i += stride) { const size_t o = (i / N) * ldc + i % N; out[o] = q; xn[o] = (bf16_t)0x7fc0u; }
        if (i0 == 0) { unsigned expect = 0u; __hip_atomic_compare_exchange_strong(st1.tmo + 1, &expect, 0x7f0u, __ATOMIC_RELAXED, __ATOMIC_RELAXED, __HIP_MEMORY_SCOPE_AGENT); __hip_atomic_store(st1.tmo, 1u, __ATOMIC_RELAXED, __HIP_MEMORY_SCOPE_AGENT); } }
    __device__ __forceinline__ void fused(f32x4 (&acc)[2][2][4][2], const Unit& u, int wr, int wc, int fr, int fq, PG8_LAS unsigned char* lds, int wid, int lane) const {
        typedef float f32x2v __attribute__((ext_vector_type(2))); typedef unsigned u32x2v __attribute__((ext_vector_type(2)));
        const PG8_LAS f32x2v* S = (const PG8_LAS f32x2v*)(lds + 8192);
        const int col0 = u.pn * BM + wc * 32 + 4 * fq;
#pragma unroll
        for (int bj = 0; bj < 2; ++bj)
#pragma unroll
            for (int n = 0; n < 2; ++n) { const f32x4 bv = bias ? *(const f32x4*)(bias + col0 + bj * HALF + n * 16) : (f32x4){0.f, 0.f, 0.f, 0.f};
#pragma unroll
                for (int ai = 0; ai < 2; ++ai)
#pragma unroll
                    for (int m = 0; m < 4; ++m) acc[ai][bj][m][n] += bv; }
        bool bad = st1.run(acc, u, wr, wc, fr, fq, lds, wid, lane) || poison != 0u;
        const float qnan = __builtin_nanf("");
#pragma unroll
        for (int ai = 0; ai < 2; ++ai)
#pragma unroll
            for (int m = 0; m < 4; ++m) { const int r = ai * HALF + wr * 64 + m * 16 + fr; const f32x2v sr = S[r]; const size_t off = (size_t)(u.pm * BM + r) * ldc + col0;
#pragma unroll
                for (int bj = 0; bj < 2; ++bj)
#pragma unroll
                    for (int n = 0; n < 2; ++n) { const f32x4 bs = *(const f32x4*)(base + off + bj * HALF + n * 16); acc[ai][bj][m][n] = bs + (acc[ai][bj][m][n] - sr.x) * sr.y; }
                asm volatile("" : "+v"(acc[ai][0][m][0]), "+v"(acc[ai][0][m][1]), "+v"(acc[ai][1][m][0]), "+v"(acc[ai][1][m][1]));
                if (m & 1) asm volatile("" ::: "memory"); }
        const bool bad1 = bad;
        bad = st2.run(acc, u, wr, wc, fr, fq, lds, wid, lane) || bad;
#pragma unroll
        for (int ai = 0; ai < 2; ++ai)
#pragma unroll
            for (int m = 0; m < 4; ++m) { const int r = ai * HALF + wr * 64 + m * 16 + fr; const f32x2v sr = S[r]; const size_t off = (size_t)(u.pm * BM + r) * ldc + col0;
#pragma unroll
                for (int bj = 0; bj < 2; ++bj)
#pragma unroll
                    for (int n = 0; n < 2; ++n) { const f32x4 x1 = acc[ai][bj][m][n]; *(f32x4*)(out + off + bj * HALF + n * 16) = bad1 ? (f32x4){qnan, qnan, qnan, qnan} : x1;
                        const f32x4 o = (x1 - sr.x) * sr.y; u32x2v w; w.x = cvt_pk_bf16(o[0], o[1]); w.y = cvt_pk_bf16(o[2], o[3]);
                        if (bad) { w.x = 0x7fc07fc0u; w.y = 0x7fc07fc0u; } *(u32x2v*)(xn + off + bj * HALF + n * 16) = w; }
                asm volatile("" ::: "memory"); }
    }
};

template <class Epi, class Sched, bool STAMP = false>
__device__ __forceinline__ void gemm_phase(PG8_LAS unsigned char* lds, const Gemm g, const Sched& S, const Epi& E, unsigned long long* stamps) {
    int tid_ = threadIdx.x; asm volatile("" : "+v"(tid_)); const int tid = tid_, wid = __builtin_amdgcn_readfirstlane(tid >> 6), lane = tid & 63, wr = wid >> 2, wc = wid & 3, fr = lane & 15, fq = lane >> 4;
    const int K = g.K, nt = K / BK;
    int ts_lo = 0, ts_hi = 0, nts = 0; const unsigned long long rt_entry = STAMP ? (unsigned long long)wall_clock64() : 0ull;
#define PG8_STAMP() do { if (STAMP && wid == 0 && nts < 64) { const unsigned long long _c = (unsigned long long)clock64(); \
        ts_lo = (lane == nts) ? (int)(unsigned)_c : ts_lo; ts_hi = (lane == nts) ? (int)(unsigned)(_c >> 32) : ts_hi; ++nts; } } while (0)
    PG8_STAMP();
    unsigned voffA[2], voffB[2];
#pragma unroll
    for (int i = 0; i < 2; ++i) { int R, C; stage_rc(tid * 16 + i * 8192, R, C); const int Rb = Epi::PERM ? ((R & ~31) + perm32(R & 31)) : R;
        voffA[i] = (unsigned)(R * K + C) * 2u; voffB[i] = (unsigned)(Rb * K + C) * 2u; }
    const size_t kstep = (size_t)(BK * 2);
    const size_t hstep = (size_t)HALF * K * 2;
    const size_t tstep = 2 * hstep;
    const unsigned ldsw = (unsigned)wid * 1024u;
    const int aoff = lds_byte(wr * 64 + fr, fq * 8), boff = lds_byte(wc * 32 + fr, fq * 8);
#define PG8_SA(b, h) (((b) * 2 + (h)) * HTB)
#define PG8_SB(b, h) ((4 + (b) * 2 + (h)) * HTB)
#define PG8_STAGE(bufoff, gbase, voff) do { _Pragma("unroll") for (int _i = 0; _i < 2; ++_i) \
        __builtin_amdgcn_global_load_lds((const unsigned*)((const char*)(gbase) + (voff)[_i]), (PG8_LAS unsigned*)(lds + (bufoff) + ldsw + _i * 8192), 16, 0, 0); } while (0)
#define PG8_LDA(dst, b, h) do { _Pragma("unroll") for (int m = 0; m < 4; ++m) _Pragma("unroll") for (int k = 0; k < 2; ++k) dst[m][k] = *(const PG8_LAS bf16x8*)(lds + PG8_SA(b, h) + aoff + m * 2048 + k * 1024); } while (0)
#define PG8_LDB(dst, b, h) do { _Pragma("unroll") for (int n = 0; n < 2; ++n) _Pragma("unroll") for (int k = 0; k < 2; ++k) dst[n][k] = *(const PG8_LAS bf16x8*)(lds + PG8_SB(b, h) + boff + n * 2048 + k * 1024); } while (0)
#define PG8_MMA(ai, bj, At, Bt) do { __builtin_amdgcn_s_setprio(1); _Pragma("unroll") for (int m = 0; m < 4; ++m) _Pragma("unroll") for (int n = 0; n < 2; ++n) _Pragma("unroll") for (int k = 0; k < 2; ++k) \
        acc[ai][bj][m][n] = __builtin_amdgcn_mfma_f32_16x16x32_bf16(Bt[n][k], At[m][k], acc[ai][bj][m][n], 0, 0, 0); __builtin_amdgcn_s_setprio(0); } while (0)
#define PG8_WAIT_V(n) asm volatile("s_waitcnt vmcnt(" #n ")" ::: "memory")
#define PG8_WAIT_L(n) asm volatile("s_waitcnt lgkmcnt(" #n ")" ::: "memory")
#define PG8_BAR __builtin_amdgcn_s_barrier()
#define PG8_SCHED __builtin_amdgcn_sched_barrier(0)
    Unit cur, nxt; int ui = 0;
    if (!S.next(0, cur)) return;
    f32x4 acc[2][2][4][2];
#pragma unroll
    for (int a = 0; a < 2; ++a)
#pragma unroll
        for (int b = 0; b < 2; ++b)
#pragma unroll
            for (int m = 0; m < 4; ++m)
#pragma unroll
                for (int n = 0; n < 2; ++n) acc[a][b][m][n] = (f32x4){0.f, 0.f, 0.f, 0.f};
    bf16x8 At[4][2], B0[2][2], B1[2][2];
    const char* cA = (const char*)g.A + (size_t)cur.pm * tstep; const char* cB = (const char*)g.Bt + (size_t)cur.pn * tstep;
    S.a_ready(cur);
    PG8_STAGE(PG8_SB(0, 0), cB, voffB); PG8_STAGE(PG8_SA(0, 0), cA, voffA); PG8_STAGE(PG8_SB(0, 1), cB + hstep, voffB); PG8_STAGE(PG8_SA(0, 1), cA + hstep, voffA);
    if (wr == 1) PG8_BAR;
    PG8_WAIT_V(4); PG8_BAR;
    PG8_STAGE(PG8_SB(1, 0), cB + kstep, voffB); PG8_STAGE(PG8_SA(1, 0), cA + kstep, voffA); PG8_STAGE(PG8_SB(1, 1), cB + hstep + kstep, voffB);
    PG8_WAIT_V(6); PG8_BAR;
    PG8_STAMP();
    for (;;) {
        const bool has_next = S.next(ui + 1, nxt);
        const char* nA = has_next ? (const char*)g.A + (size_t)nxt.pm * tstep : cA; const char* nB = has_next ? (const char*)g.Bt + (size_t)nxt.pn * tstep : cB;
        for (int t = 0; t < nt; t += 2) {
            const bool last = (t == nt - 2);
            const char* a1 = cA + (size_t)(t + 1) * kstep;
            const char* a2 = last ? nA : cA + (size_t)(t + 2) * kstep; const char* b2 = last ? nB : cB + (size_t)(t + 2) * kstep;
            const char* a3 = a2 + kstep; const char* b3 = b2 + kstep;
            if (last && has_next) S.a_ready(nxt);
            PG8_LDB(B0, 0, 0); PG8_SCHED; PG8_LDA(At, 0, 0); PG8_STAGE(PG8_SA(1, 1), a1 + hstep, voffA);
            PG8_WAIT_L(8); PG8_BAR; PG8_WAIT_L(0); PG8_MMA(0, 0, At, B0); PG8_BAR; PG8_SCHED;
            PG8_LDB(B1, 0, 1); PG8_STAGE(PG8_SB(0, 0), b2, voffB);
            PG8_BAR; PG8_WAIT_L(0); PG8_MMA(0, 1, At, B1); PG8_BAR;
            PG8_LDA(At, 0, 1); PG8_STAGE(PG8_SA(0, 0), a2, voffA);
            PG8_BAR; PG8_WAIT_L(0); PG8_MMA(1, 0, At, B0); PG8_BAR; PG8_SCHED;
            PG8_STAGE(PG8_SB(0, 1), b2 + hstep, voffB);
            PG8_WAIT_V(6); PG8_BAR; PG8_MMA(1, 1, At, B1); PG8_BAR;
            PG8_LDB(B0, 1, 0); PG8_SCHED; PG8_LDA(At, 1, 0); PG8_STAGE(PG8_SA(0, 1), a2 + hstep, voffA);
            PG8_WAIT_L(8); PG8_BAR; PG8_WAIT_L(0); PG8_MMA(0, 0, At, B0); PG8_BAR; PG8_SCHED;
            PG8_LDB(B1, 1, 1); PG8_STAGE(PG8_SB(1, 0), b3, voffB);
            PG8_BAR; PG8_WAIT_L(0); PG8_MMA(0, 1, At, B1); PG8_BAR;
            PG8_LDA(At, 1, 1); PG8_STAGE(PG8_SA(1, 0), a3, voffA);
            PG8_BAR; PG8_WAIT_L(0); PG8_MMA(1, 0, At, B0); PG8_BAR; PG8_SCHED;
            PG8_STAGE(PG8_SB(1, 1), b3 + hstep, voffB);
            PG8_WAIT_V(6); PG8_BAR; PG8_MMA(1, 1, At, B1); PG8_BAR;
        }
        PG8_STAMP();
        if constexpr (!Epi::AFTER_DRAIN) { E(acc, cur, wr, wc, fr, fq); S.done(cur); }
        PG8_STAMP();
        if (!has_next) break;
#pragma unroll
        for (int a = 0; a < 2; ++a)
#pragma unroll
            for (int b = 0; b < 2; ++b)
#pragma unroll
                for (int m = 0; m < 4; ++m)
#pragma unroll
                    for (int n = 0; n < 2; ++n) acc[a][b][m][n] = (f32x4){0.f, 0.f, 0.f, 0.f};
        cur = nxt; cA = nA; cB = nB; ++ui;
    }
    PG8_WAIT_V(0);
    if (wr == 0) PG8_BAR;
    PG8_BAR;
    if constexpr (Epi::AFTER_DRAIN) { E.fused(acc, cur, wr, wc, fr, fq, lds, wid, lane); S.done(cur); }
    PG8_STAMP();
    if (STAMP && wid == 0) { stamps[lane] = lane < nts ? (((unsigned long long)(unsigned)ts_hi << 32) | (unsigned)ts_lo) : 0ull;
        if (lane == 62) stamps[62] = rt_entry; if (lane == 63) stamps[63] = (unsigned long long)wall_clock64(); }
#undef PG8_STAMP
#undef PG8_SA
#undef PG8_SB
#undef PG8_STAGE
#undef PG8_LDA
#undef PG8_LDB
#undef PG8_MMA
#undef PG8_WAIT_V
#undef PG8_WAIT_L
#undef PG8_BAR
#undef PG8_SCHED
}
}
#define LAS __attribute__((address_space(3)))
typedef unsigned short bf16_t;
typedef float f32x4 __attribute__((ext_vector_type(4)));
typedef float f32x2 __attribute__((ext_vector_type(2)));
typedef unsigned u32x4 __attribute__((ext_vector_type(4)));
typedef unsigned u32x2 __attribute__((ext_vector_type(2)));
constexpr int NTOK = 8192, SEQ = 2048, DM = 2048, NIN = 7372, NP = 7424, NL = 4;
constexpr int LRUW = 512, GW = 768, RW_ = 768;
constexpr int PC_AX = 0, PC_AG = 512, PC_BQKV = 1024, PC_BG = 3328, PC_CIN = 4096, PC_CG = 6592, PC_BETA = 7360, PC_BA = 7366;
constexpr int LDS_BYTES = 131072 + 512;
#ifndef SKIPMASK
#define SKIPMASK 0
#endif
#ifndef N_LAUNCH_MODE
#define N_LAUNCH_MODE 0
#endif
constexpr int NPHASE = 2 + 6 * NL;
constexpr size_t WS_WIN = 0;
constexpr size_t WS_WOUT = WS_WIN + (size_t)NL * NP * DM * 2;
constexpr size_t WS_XB = WS_WOUT + (size_t)NL * DM * DM * 2;
constexpr size_t WS_XR = WS_XB + (size_t)NTOK * DM * 2;
constexpr size_t WS_PROJ = WS_XR + (size_t)NTOK * DM * 4;
constexpr size_t WS_Y = WS_PROJ + (size_t)NTOK * NP * 2;
constexpr size_t SZ768 = (size_t)NTOK * 768 * 4;
constexpr size_t WS_GQ = WS_Y + (size_t)NTOK * DM * 2;
constexpr size_t WS_GK = WS_GQ + SZ768;
constexpr size_t WS_GV = WS_GK + SZ768;
constexpr size_t WS_GO = WS_GV + SZ768;
constexpr size_t WS_RR = WS_GO + SZ768;
constexpr size_t WS_RW = WS_RR + SZ768;
constexpr size_t WS_RK = WS_RW + SZ768;
constexpr size_t WS_RV = WS_RK + SZ768;
constexpr size_t WS_RKK = WS_RV + SZ768;
constexpr size_t WS_RB = WS_RKK + SZ768;
constexpr size_t WS_RY = WS_RB + SZ768;
constexpr size_t WS_GB = WS_RY + SZ768;
constexpr size_t WS_GG = WS_GB + (size_t)NTOK * 8 * 4;
constexpr size_t WS_LA = WS_GG + (size_t)NTOK * 8 * 4;
constexpr size_t WS_LU = WS_LA + (size_t)NTOK * 512 * 4;
constexpr size_t WS_END = WS_LU + (size_t)NTOK * 512 * 4;

struct Args {
    const float* in[26];
    float* out; unsigned char* ws;
    int ph_lo, ph_hi;
};
enum { I_X = 0, I_NORMG, I_WIN, I_WOUT, I_LCW, I_LCB, I_LWX, I_LBX, I_LWA, I_LBA, I_LLAM, I_GCW, I_GALOG, I_GDT, I_GNG,
       I_RMU, I_RW0, I_RWUP, I_RA0, I_RAUP, I_RKK, I_RKA, I_RRK, I_RGNW, I_RGNB, I_FNG };

__device__ __forceinline__ int tid_l() { int t = threadIdx.x; asm volatile("" : "+v"(t)); return t; }
__device__ __forceinline__ int bid_l() { int b = blockIdx.x; asm volatile("" : "+s"(b)); return b; }
__device__ __forceinline__ int gdim_l() { int b = gridDim.x; asm volatile("" : "+s"(b)); return b; }
__device__ __forceinline__ const float* inp(LAS unsigned char* lds, int i) {
    const LAS unsigned* t = (const LAS unsigned*)(lds + 131072) + 2 * i;
    const unsigned lo = __builtin_amdgcn_readfirstlane(t[0]), hi = __builtin_amdgcn_readfirstlane(t[1]);
    return (const float*)(((unsigned long long)hi << 32) | lo);
}
__device__ __forceinline__ float bf2f(bf16_t b) { return __uint_as_float(((unsigned)b) << 16); }
__device__ __forceinline__ bf16_t f2bf(float f) { unsigned u = __float_as_uint(f); u += 0x7FFFu + ((u >> 16) & 1u); return (bf16_t)(u >> 16); }
__device__ __forceinline__ unsigned pk2(float lo, float hi) { return (unsigned)f2bf(lo) | ((unsigned)f2bf(hi) << 16); }
__device__ __forceinline__ float wave_sum(float v) {
#pragma unroll
    for (int o = 1; o < 64; o <<= 1) v += __shfl_xor(v, o);
    return v;
}
__device__ __forceinline__ float sigmoidf_(float x) { return 1.0f / (1.0f + __expf(-x)); }
__device__ __forceinline__ float siluf_(float x) { return x / (1.0f + __expf(-x)); }
__device__ __forceinline__ float softplusf_(float x) { return fmaxf(x, 0.f) + log1pf(__expf(-fabsf(x))); }

__device__ __forceinline__ void transpose_item(const float* W, int K, int N, bf16_t* WT, const float* scale, bool remap, LAS float* scr, int item, int nblk, int lane) {
    const int kb = item / nblk, nb = item % nblk, k0 = 64 * kb, n0 = 32 * nb;
    int np = n0 + (lane & 31), oc;
    if (!remap) oc = np;
    else if (np < 4096) oc = np;
    else if (np < 7360) oc = np + 12;
    else if (np < 7372) oc = np - 7360 + 4096;
    else oc = -1;
#pragma unroll 8
    for (int i = 0; i < 32; ++i) { const int kk = 2 * i + (lane >> 5);
        float v = 0.f; if (oc >= 0) { v = W[(size_t)(k0 + kk) * N + oc]; if (scale) v *= scale[k0 + kk]; }
        scr[kk * 33 + (lane & 31)] = v; }
    __builtin_amdgcn_s_waitcnt(0xc07f); asm volatile("s_waitcnt lgkmcnt(0)" ::: "memory");
    const int c = lane & 7;
#pragma unroll
    for (int j = 0; j < 4; ++j) { const int n = (lane >> 3) + 8 * j; const LAS float* s = scr + (8 * c) * 33 + n;
        u32x4 o; o.x = pk2(s[0 * 33], s[1 * 33]); o.y = pk2(s[2 * 33], s[3 * 33]); o.z = pk2(s[4 * 33], s[5 * 33]); o.w = pk2(s[6 * 33], s[7 * 33]);
        *(u32x4*)(WT + (size_t)(n0 + n) * K + k0 + 8 * c) = o; }
    asm volatile("s_waitcnt lgkmcnt(0)" ::: "memory");
}
__device__ __forceinline__ void phase_convert(const Args& a, LAS unsigned char* lds) {
    unsigned char* ws = a.ws; asm volatile("" : "+s"(ws));
    const int tid = tid_l(), wave = __builtin_amdgcn_readfirstlane(tid >> 6), lane = tid & 63;
    LAS float* scr = (LAS float*)(lds + wave * 8448);
    const int gw = bid_l() * 8 + wave, NGW = gdim_l() * 8;
    constexpr int I_IN = (DM / 64) * (NP / 32), I_OUT = (DM / 64) * (DM / 32), PER_L = I_IN + I_OUT;
    for (int it = gw; it < NL * PER_L; it += NGW) {
        const int l = it / PER_L; int r = it % PER_L;
        if (r < I_IN) transpose_item(inp(lds, I_WIN) + (size_t)l * DM * NIN, DM, NIN, (bf16_t*)(ws + WS_WIN) + (size_t)l * NP * DM, inp(lds, I_NORMG) + l * DM, true, scr, r, NP / 32, lane);
        else transpose_item(inp(lds, I_WOUT) + (size_t)l * DM * DM, DM, DM, (bf16_t*)(ws + WS_WOUT) + (size_t)l * DM * DM, nullptr, false, scr, r - I_IN, DM / 32, lane);
    }
}
__device__ __forceinline__ void phase_rms(const float* xin, bf16_t* xb) {
    const int tid = tid_l(), wave = tid >> 6, lane = tid & 63;
    const int gw = bid_l() * 8 + wave, NGW = gdim_l() * 8;
    for (int m = gw; m < NTOK; m += NGW) {
        const f32x4* xr = (const f32x4*)(xin + (size_t)m * DM) + lane;
        f32x4 v[8]; float s = 0.f;
#pragma unroll
        for (int j = 0; j < 8; ++j) { v[j] = xr[64 * j]; s += (v[j].x * v[j].x + v[j].y * v[j].y) + (v[j].z * v[j].z + v[j].w * v[j].w); }
        const float rstd = 1.0f / sqrtf(wave_sum(s) * (1.0f / DM) + 1e-6f);
        u32x2* o = (u32x2*)(xb + (size_t)m * DM) + lane;
#pragma unroll
        for (int j = 0; j < 8; ++j) { u32x2 w; w.x = pk2(v[j].x * rstd, v[j].y * rstd); w.y = pk2(v[j].z * rstd, v[j].w * rstd); o[64 * j] = w; }
    }
}
__device__ __forceinline__ void phase_final(const float* xin, const float* g, float* out) {
    const int tid = tid_l(), wave = tid >> 6, lane = tid & 63;
    const int gw = bid_l() * 8 + wave, NGW = gdim_l() * 8;
    for (int m = gw; m < NTOK; m += NGW) {
        const f32x4* xr = (const f32x4*)(xin + (size_t)m * DM) + lane;
        f32x4 v[8]; float s = 0.f;
#pragma unroll
        for (int j = 0; j < 8; ++j) { v[j] = xr[64 * j]; s += (v[j].x * v[j].x + v[j].y * v[j].y) + (v[j].z * v[j].z + v[j].w * v[j].w); }
        const float rstd = 1.0f / sqrtf(wave_sum(s) * (1.0f / DM) + 1e-6f);
        f32x4* o = (f32x4*)(out + (size_t)m * DM) + lane; const f32x4* gg = (const f32x4*)g + lane;
#pragma unroll
        for (int j = 0; j < 8; ++j) o[64 * j] = v[j] * rstd * gg[64 * j];
    }
}
struct EpiDual {
    static constexpr bool PERM = true, AFTER_DRAIN = false;
    int mode; bf16_t* O; int ldo; const float* base; float* C; int ldc;
    __device__ __forceinline__ void operator()(const pg8::f32x4 (&acc)[2][2][4][2], const pg8::Unit& u, int wr, int wc, int fr, int fq) const {
        const int row0 = u.pm * 256 + wr * 64 + fr, col0 = u.pn * 256 + wc * 32 + 8 * fq;
        if (mode == 0) {
#pragma unroll
            for (int ai = 0; ai < 2; ++ai)
#pragma unroll
                for (int m = 0; m < 4; ++m) { bf16_t* rowp = O + (size_t)(row0 + ai * 128 + m * 16) * ldo + col0;
#pragma unroll
                    for (int bj = 0; bj < 2; ++bj) { const pg8::f32x4 v0 = acc[ai][bj][m][0], v1 = acc[ai][bj][m][1];
                        pg8::u32x4 w; w.x = pg8::cvt_pk_bf16(v0[0], v0[1]); w.y = pg8::cvt_pk_bf16(v0[2], v0[3]); w.z = pg8::cvt_pk_bf16(v1[0], v1[1]); w.w = pg8::cvt_pk_bf16(v1[2], v1[3]);
                        *(pg8::u32x4*)(rowp + bj * 128) = w; } }
        } else {
#pragma unroll
            for (int ai = 0; ai < 2; ++ai)
#pragma unroll
                for (int m = 0; m < 4; ++m) { const size_t off = (size_t)(row0 + ai * 128 + m * 16) * ldc + col0;
#pragma unroll
                    for (int bj = 0; bj < 2; ++bj)
#pragma unroll
                        for (int n = 0; n < 2; ++n) { const pg8::f32x4 b = *(const pg8::f32x4*)(base + off + bj * 128 + n * 4); *(pg8::f32x4*)(C + off + bj * 128 + n * 4) = acc[ai][bj][m][n] + b; }
                    asm volatile("" ::: "memory"); }
        }
    }
};
constexpr int TT = 8;
__device__ __forceinline__ void phase_prep(const Args& a, int l, LAS unsigned char* lds) {
    unsigned char* ws = a.ws; asm volatile("" : "+s"(ws));
    const int tid = tid_l(), wave = __builtin_amdgcn_readfirstlane(tid >> 6), lane = tid & 63;
    const bf16_t* PROJ = (const bf16_t*)(ws + WS_PROJ);
    LAS float* xsl = (LAS float*)lds;
    LAS float* xl = (LAS float*)(lds + 8192);
    float* GQ = (float*)(ws + WS_GQ); float* GK = (float*)(ws + WS_GK); float* GV = (float*)(ws + WS_GV);
    float* GB = (float*)(ws + WS_GB); float* GG = (float*)(ws + WS_GG);
    float* RR = (float*)(ws + WS_RR); float* RWd = (float*)(ws + WS_RW); float* RK = (float*)(ws + WS_RK); float* RV = (float*)(ws + WS_RV);
    float* RKK = (float*)(ws + WS_RKK); float* RB = (float*)(ws + WS_RB);
    float* LA = (float*)(ws + WS_LA); float* LU = (float*)(ws + WS_LU);
    const float* mu = inp(lds, I_RMU) + l * 2496;
    for (int tile = bid_l(); tile < NTOK / TT; tile += gdim_l()) {
        const int t0 = tile * TT, sp = t0 % SEQ;
        for (int idx = tid; idx < TT * 192; idx += 512) { const int tt = idx / 192, i = idx % 192; const int col = PC_CIN + 2304 + i;
            const float cur = bf2f(PROJ[(size_t)(t0 + tt) * NP + col]); const float prev = (sp + tt > 0) ? bf2f(PROJ[(size_t)(t0 + tt - 1) * NP + col]) : 0.f;
            float xs = cur + (prev - cur) * mu[2304 + i]; if (i < 96) xs = tanhf(xs); xsl[tt * 192 + i] = xs; }
        float xv[TT];
        { const int j = tid; const float* cw = inp(lds, I_LCW) + l * 4 * LRUW; const float w0 = cw[j], w1 = cw[LRUW + j], w2 = cw[2 * LRUW + j], w3 = cw[3 * LRUW + j], cb = inp(lds, I_LCB)[l * LRUW + j];
            float xm3 = (sp >= 3) ? bf2f(PROJ[(size_t)(t0 - 3) * NP + PC_AX + j]) : 0.f, xm2 = (sp >= 2) ? bf2f(PROJ[(size_t)(t0 - 2) * NP + PC_AX + j]) : 0.f, xm1 = (sp >= 1) ? bf2f(PROJ[(size_t)(t0 - 1) * NP + PC_AX + j]) : 0.f;
#pragma unroll
            for (int tt = 0; tt < TT; ++tt) { const float cur = bf2f(PROJ[(size_t)(t0 + tt) * NP + PC_AX + j]); const float x = w0 * xm3 + w1 * xm2 + w2 * xm1 + w3 * cur + cb; xv[tt] = x; xl[tt * 512 + j] = x; xm3 = xm2; xm2 = xm1; xm1 = cur; } }
        __syncthreads();
        for (int pass = 0; pass < 2; ++pass) { const int j = tid + 512 * pass; if (j >= 768) break;
            float accw[TT], acca[TT];
#pragma unroll
            for (int tt = 0; tt < TT; ++tt) { accw[tt] = 0.f; acca[tt] = 0.f; }
            const float* wup = inp(lds, I_RWUP) + (size_t)l * 96 * 768 + j; const float* aup = inp(lds, I_RAUP) + (size_t)l * 96 * 768 + j;
#pragma unroll 4
            for (int i = 0; i < 96; ++i) { const float wu = wup[i * 768], au = aup[i * 768];
#pragma unroll
                for (int tt = 0; tt < TT; ++tt) { accw[tt] += xsl[tt * 192 + i] * wu; acca[tt] += xsl[tt * 192 + 96 + i] * au; } }
            const float w0 = inp(lds, I_RW0)[l * 768 + j], a0 = inp(lds, I_RA0)[l * 768 + j], kkw = inp(lds, I_RKK)[l * 768 + j], kaw = inp(lds, I_RKA)[l * 768 + j];
            const float mur = mu[j], muk = mu[768 + j], muv = mu[1536 + j];
            float pr = 0.f, pk = 0.f, pv = 0.f;
            if (sp > 0) { const bf16_t* p = PROJ + (size_t)(t0 - 1) * NP + PC_CIN + j; pr = bf2f(p[0]); pk = bf2f(p[768]); pv = bf2f(p[1536]); }
#pragma unroll
            for (int tt = 0; tt < TT; ++tt) { const bf16_t* p = PROJ + (size_t)(t0 + tt) * NP + PC_CIN + j; const float cr = bf2f(p[0]), ck = bf2f(p[768]), cv = bf2f(p[1536]);
                const float r = cr + (pr - cr) * mur, k = ck + (pk - ck) * muk, v = cv + (pv - cv) * muv; pr = cr; pk = ck; pv = cv;
                const float wlog = -softplusf_(-(w0 + accw[tt])) - 0.5f; const float dec = __expf(-__expf(wlog));
                const float av = sigmoidf_(a0 + acca[tt]);
                const float kr = k * kkw; const float ss = wave_sum(kr * kr); const float kk = kr * (1.0f / sqrtf(ss + 1e-6f));
                const float k2 = k * (1.0f + (av - 1.0f) * kaw);
                const size_t o = (size_t)(t0 + tt) * 768 + j;
                RR[o] = r; RWd[o] = dec; RK[o] = k2; RV[o] = v; RKK[o] = kk; RB[o] = kk * av; }
        }
        { const int j = tid, n = j >> 6, jj = j & 63; float accx[TT], acca[TT];
#pragma unroll
            for (int tt = 0; tt < TT; ++tt) { accx[tt] = 0.f; acca[tt] = 0.f; }
            const float* wx = inp(lds, I_LWX) + (size_t)l * 8 * 64 * 64 + n * 4096 + jj; const float* wa = inp(lds, I_LWA) + (size_t)l * 8 * 64 * 64 + n * 4096 + jj;
#pragma unroll 4
            for (int i = 0; i < 64; ++i) { const float vx = wx[i * 64], va = wa[i * 64];
#pragma unroll
                for (int tt = 0; tt < TT; ++tt) { const float xi = xl[tt * 512 + n * 64 + i]; accx[tt] += xi * vx; acca[tt] += xi * va; } }
            const float bx = inp(lds, I_LBX)[l * 512 + j], ba = inp(lds, I_LBA)[l * 512 + j]; const float spl = softplusf_(-inp(lds, I_LLAM)[l * 512 + j]);
#pragma unroll
            for (int tt = 0; tt < TT; ++tt) { const float gx = sigmoidf_(accx[tt] + bx), ga = sigmoidf_(acca[tt] + ba);
                const float loga = -8.0f * ga * spl; const float av = __expf(loga); const float mult = sqrtf(fmaxf(-expm1f(2.0f * loga), 0.f));
                LA[(size_t)(t0 + tt) * 512 + j] = av; LU[(size_t)(t0 + tt) * 512 + j] = mult * gx * xv[tt]; } }
        for (int wt = wave; wt < 18; wt += 8) { const int ch0 = 128 * wt + 2 * lane; const float* cw = inp(lds, I_GCW) + (size_t)l * 4 * 2304 + ch0;
            const f32x2 w0 = *(const f32x2*)(cw), w1 = *(const f32x2*)(cw + 2304), w2 = *(const f32x2*)(cw + 2 * 2304), w3 = *(const f32x2*)(cw + 3 * 2304);
            f32x2 xm3 = {0.f, 0.f}, xm2 = {0.f, 0.f}, xm1 = {0.f, 0.f};
            const bf16_t* pc = PROJ + PC_BQKV + ch0;
            if (sp >= 3) { const unsigned q = *(const unsigned*)(pc + (size_t)(t0 - 3) * NP); xm3.x = __uint_as_float(q << 16); xm3.y = __uint_as_float(q & 0xffff0000u); }
            if (sp >= 2) { const unsigned q = *(const unsigned*)(pc + (size_t)(t0 - 2) * NP); xm2.x = __uint_as_float(q << 16); xm2.y = __uint_as_float(q & 0xffff0000u); }
            if (sp >= 1) { const unsigned q = *(const unsigned*)(pc + (size_t)(t0 - 1) * NP); xm1.x = __uint_as_float(q << 16); xm1.y = __uint_as_float(q & 0xffff0000u); }
            float* dst = (wt < 6) ? GQ : (wt < 12 ? GK : GV); const int dch = ch0 % 768;
#pragma unroll
            for (int tt = 0; tt < TT; ++tt) { const unsigned q = *(const unsigned*)(pc + (size_t)(t0 + tt) * NP); f32x2 cur; cur.x = __uint_as_float(q << 16); cur.y = __uint_as_float(q & 0xffff0000u);
                f32x2 v = w0 * xm3 + w1 * xm2 + w2 * xm1 + w3 * cur; v.x = siluf_(v.x); v.y = siluf_(v.y);
                if (wt < 12) { const float ss = wave_sum(v.x * v.x + v.y * v.y); float sc = 1.0f / sqrtf(ss + 1e-6f); if (wt < 6) sc *= 0.08838834764831845f; v = v * sc; }
                *(f32x2*)(dst + (size_t)(t0 + tt) * 768 + dch) = v; xm3 = xm2; xm2 = xm1; xm1 = cur; } }
        if (tid < TT * 6) { const int tt = tid / 6, h = tid % 6; const float bl = bf2f(PROJ[(size_t)(t0 + tt) * NP + PC_BETA + h]), al = bf2f(PROJ[(size_t)(t0 + tt) * NP + PC_BA + h]);
            GB[(size_t)(t0 + tt) * 8 + h] = sigmoidf_(bl); GG[(size_t)(t0 + tt) * 8 + h] = -__expf(inp(lds, I_GALOG)[l * 6 + h]) * softplusf_(al + inp(lds, I_GDT)[l * 6 + h]); }
        __syncthreads();
    }
}
constexpr int SB = 16;
__device__ __forceinline__ void phase_scan_naive(const Args& a, int l, LAS unsigned char* lds) {
    unsigned char* ws = a.ws; asm volatile("" : "+s"(ws));
    const int tid = tid_l(), wave = __builtin_amdgcn_readfirstlane(tid >> 6), lane = tid & 63;
    const int blk = bid_l();
    if (blk < 24) {
        const int b = blk / 6, h = blk % 6;
        const float* GQ = (const float*)(ws + WS_GQ); const float* GK = (const float*)(ws + WS_GK); const float* GV = (const float*)(ws + WS_GV);
        const float* GB = (const float*)(ws + WS_GB); const float* GG = (const float*)(ws + WS_GG); float* GO = (float*)(ws + WS_GO);
        LAS float* sk = (LAS float*)lds; LAS float* sq = sk + SB * 128; LAS float* sv = sq + SB * 128; LAS float* sbg = sv + SB * 128;
        float S[64];
#pragma unroll
        for (int d = 0; d < 64; ++d) S[d] = 0.f;
        for (int s0 = 0; s0 < SEQ; s0 += SB) {
            __syncthreads();
            for (int idx = tid; idx < SB * 32; idx += 512) { const int st = idx >> 5, c4 = idx & 31; const size_t g = (size_t)(b * SEQ + s0 + st) * 768 + h * 128 + c4 * 4;
                *(LAS f32x4*)(sk + st * 128 + c4 * 4) = *(const f32x4*)(GK + g); *(LAS f32x4*)(sq + st * 128 + c4 * 4) = *(const f32x4*)(GQ + g); *(LAS f32x4*)(sv + st * 128 + c4 * 4) = *(const f32x4*)(GV + g); }
            if (tid < SB) { const size_t g = (size_t)(b * SEQ + s0 + tid) * 8 + h; sbg[tid * 2] = GB[g]; sbg[tid * 2 + 1] = __expf(GG[g]); }
            __syncthreads();
            if (wave < 4) {
                const int e = wave * 32 + (lane & 31), dh = lane >> 5;
                for (int st = 0; st < SB; ++st) {
                    const float beta = sbg[st * 2], eg = sbg[st * 2 + 1]; const float v = sv[st * 128 + e];
                    const LAS float* kp = sk + st * 128 + dh * 64; const LAS float* qp = sq + st * 128 + dh * 64;
                    float dot = 0.f;
#pragma unroll
                    for (int d4 = 0; d4 < 16; ++d4) { const f32x4 k4 = *(const LAS f32x4*)(kp + d4 * 4); dot += k4.x * S[d4 * 4] + k4.y * S[d4 * 4 + 1] + k4.z * S[d4 * 4 + 2] + k4.w * S[d4 * 4 + 3]; }
                    dot += __shfl_xor(dot, 32);
                    const float vn = beta * (v - eg * dot); float o = 0.f;
#pragma unroll
                    for (int d4 = 0; d4 < 16; ++d4) { const f32x4 k4 = *(const LAS f32x4*)(kp + d4 * 4); const f32x4 q4 = *(const LAS f32x4*)(qp + d4 * 4);
                        S[d4 * 4] = eg * S[d4 * 4] + k4.x * vn; S[d4 * 4 + 1] = eg * S[d4 * 4 + 1] + k4.y * vn; S[d4 * 4 + 2] = eg * S[d4 * 4 + 2] + k4.z * vn; S[d4 * 4 + 3] = eg * S[d4 * 4 + 3] + k4.w * vn;
                        o += q4.x * S[d4 * 4] + q4.y * S[d4 * 4 + 1] + q4.z * S[d4 * 4 + 2] + q4.w * S[d4 * 4 + 3]; }
                    o += __shfl_xor(o, 32);
                    if (dh == 0) GO[(size_t)(b * SEQ + s0 + st) * 768 + h * 128 + e] = o;
                }
            }
        }
    } else if (blk < 72) {
        const int it = blk - 24, b = it / 12, h = it % 12;
        const float* RR = (const float*)(ws + WS_RR); const float* RWd = (const float*)(ws + WS_RW); const float* RK = (const float*)(ws + WS_RK); const float* RV = (const float*)(ws + WS_RV);
        const float* RKK = (const float*)(ws + WS_RKK); const float* RB = (const float*)(ws + WS_RB); float* RY = (float*)(ws + WS_RY);
        LAS float* sr = (LAS float*)lds; LAS float* sw = sr + SB * 64; LAS float* skk = sw + SB * 64; LAS float* sv = skk + SB * 64; LAS float* sk2 = sv + SB * 64; LAS float* sb = sk2 + SB * 64;
        float S[64];
#pragma unroll
        for (int j = 0; j < 64; ++j) S[j] = 0.f;
        for (int s0 = 0; s0 < SEQ; s0 += SB) {
            __syncthreads();
            if (tid < SB * 16) { const int st = tid >> 4, c4 = tid & 15; const size_t g = (size_t)(b * SEQ + s0 + st) * 768 + h * 64 + c4 * 4; const int o = st * 64 + c4 * 4;
                *(LAS f32x4*)(sr + o) = *(const f32x4*)(RR + g); *(LAS f32x4*)(sw + o) = *(const f32x4*)(RWd + g); *(LAS f32x4*)(skk + o) = *(const f32x4*)(RKK + g);
                *(LAS f32x4*)(sv + o) = *(const f32x4*)(RV + g); *(LAS f32x4*)(sk2 + o) = *(const f32x4*)(RK + g); *(LAS f32x4*)(sb + o) = *(const f32x4*)(RB + g); }
            __syncthreads();
            if (wave == 0) {
                for (int st = 0; st < SB; ++st) {
                    const float vi = sv[st * 64 + lane]; float sa = 0.f;
#pragma unroll
                    for (int j4 = 0; j4 < 16; ++j4) { const f32x4 k4 = *(const LAS f32x4*)(skk + st * 64 + j4 * 4); sa += k4.x * S[j4 * 4] + k4.y * S[j4 * 4 + 1] + k4.z * S[j4 * 4 + 2] + k4.w * S[j4 * 4 + 3]; }
                    sa = -sa; float y = 0.f;
#pragma unroll
                    for (int j4 = 0; j4 < 16; ++j4) { const f32x4 w4 = *(const LAS f32x4*)(sw + st * 64 + j4 * 4), b4 = *(const LAS f32x4*)(sb + st * 64 + j4 * 4), k4 = *(const LAS f32x4*)(sk2 + st * 64 + j4 * 4), r4 = *(const LAS f32x4*)(sr + st * 64 + j4 * 4);
                        S[j4 * 4] = S[j4 * 4] * w4.x + sa * b4.x + vi * k4.x; S[j4 * 4 + 1] = S[j4 * 4 + 1] * w4.y + sa * b4.y + vi * k4.y; S[j4 * 4 + 2] = S[j4 * 4 + 2] * w4.z + sa * b4.z + vi * k4.z; S[j4 * 4 + 3] = S[j4 * 4 + 3] * w4.w + sa * b4.w + vi * k4.w;
                        y += r4.x * S[j4 * 4] + r4.y * S[j4 * 4 + 1] + r4.z * S[j4 * 4 + 2] + r4.w * S[j4 * 4 + 3]; }
                    RY[(size_t)(b * SEQ + s0 + st) * 768 + h * 64 + lane] = y;
                }
            }
        }
    } else if (blk < 104) {
        if (wave == 0) { const int ch = (blk - 72) * 64 + lane, b = ch >> 9, c = ch & 511;
            const float* LA = (const float*)(ws + WS_LA); const float* LU = (const float*)(ws + WS_LU); const bf16_t* PROJ = (const bf16_t*)(ws + WS_PROJ); bf16_t* Y = (bf16_t*)(ws + WS_Y);
            float hst = 0.f;
            for (int s0 = 0; s0 < SEQ; s0 += 8) { float av[8], uv[8], gv[8];
#pragma unroll
                for (int i = 0; i < 8; ++i) { const size_t t = (size_t)(b * SEQ + s0 + i); av[i] = LA[t * 512 + c]; uv[i] = LU[t * 512 + c]; gv[i] = bf2f(PROJ[t * NP + PC_AG + c]); }
#pragma unroll
                for (int i = 0; i < 8; ++i) { hst = av[i] * hst + uv[i]; Y[(size_t)(b * SEQ + s0 + i) * DM + c] = f2bf(hst * siluf_(gv[i])); } }
        }
    }
}
__device__ __forceinline__ void phase_fin(const Args& a, int l, LAS unsigned char* lds) {
    unsigned char* ws = a.ws; asm volatile("" : "+s"(ws));
    const int tid = tid_l(), wave = tid >> 6, lane = tid & 63;
    const int gw = bid_l() * 8 + wave, NGW = gdim_l() * 8;
    const bf16_t* PROJ = (const bf16_t*)(ws + WS_PROJ); bf16_t* Y = (bf16_t*)(ws + WS_Y);
    const float* GO = (const float*)(ws + WS_GO); const float* RY = (const float*)(ws + WS_RY);
    const float* RR = (const float*)(ws + WS_RR); const float* RK = (const float*)(ws + WS_RK); const float* RV = (const float*)(ws + WS_RV);
    const f32x2 ng = *(const f32x2*)(inp(lds, I_GNG) + l * 128 + 2 * lane);
    for (int t = gw; t < NTOK; t += NGW) {
#pragma unroll
        for (int h = 0; h < 6; ++h) { const f32x2 o = *(const f32x2*)(GO + (size_t)t * 768 + h * 128 + 2 * lane); const float ss = wave_sum(o.x * o.x + o.y * o.y); const float sc = 1.0f / sqrtf(ss * (1.0f / 128.f) + 1e-6f);
            const unsigned q = *(const unsigned*)(PROJ + (size_t)t * NP + PC_BG + h * 128 + 2 * lane); const float g0 = __uint_as_float(q << 16), g1 = __uint_as_float(q & 0xffff0000u);
            *(unsigned*)(Y + (size_t)t * DM + 512 + h * 128 + 2 * lane) = pk2(o.x * sc * ng.x * siluf_(g0), o.y * sc * ng.y * siluf_(g1)); }
#pragma unroll
        for (int h = 0; h < 12; ++h) { const size_t o = (size_t)t * 768 + h * 64 + lane; const float y = RY[o]; const float mean = wave_sum(y) * (1.0f / 64.f); const float d = y - mean; const float var = wave_sum(d * d) * (1.0f / 64.f);
            float yn = d * (1.0f / sqrtf(var + 64e-5f)) * inp(lds, I_RGNW)[l * 768 + h * 64 + lane] + inp(lds, I_RGNB)[l * 768 + h * 64 + lane];
            const float r = RR[o], k = RK[o], v = RV[o]; const float s = wave_sum(r * k * inp(lds, I_RRK)[l * 768 + h * 64 + lane]); yn += s * v;
            const float g = bf2f(PROJ[(size_t)t * NP + PC_CG + h * 64 + lane]); Y[(size_t)t * DM + 1280 + h * 64 + lane] = f2bf(yn * siluf_(g)); }
    }
}
__global__ void __launch_bounds__(512) mk_fwd(Args a) {
    extern __shared__ __attribute__((aligned(16))) unsigned char lds_raw[];
    LAS unsigned char* lds = (LAS unsigned char*)lds_raw;
    cg::grid_group grid = cg::this_grid();
    const int lo = a.ph_lo, hi = a.ph_hi;
    if (threadIdx.x < 26) { const unsigned long long p = (unsigned long long)a.in[threadIdx.x]; LAS unsigned* t = (LAS unsigned*)(lds + 131072) + 2 * threadIdx.x; t[0] = (unsigned)p; t[1] = (unsigned)(p >> 32); }
    __syncthreads();
    float* XR = (float*)(a.ws + WS_XR); bf16_t* XB = (bf16_t*)(a.ws + WS_XB); bf16_t* PROJ = (bf16_t*)(a.ws + WS_PROJ); bf16_t* Y = (bf16_t*)(a.ws + WS_Y);
    for (int ph = lo; ph < hi; ++ph) {
        if (ph == 0) { if (!(SKIPMASK & 1)) phase_convert(a, lds); }
        else if (ph == NPHASE - 1) phase_final(XR, inp(lds, I_FNG), a.out);
        else { const int l = (ph - 1) / 6, s = (ph - 1) % 6; const float* xin = (l == 0) ? inp(lds, I_X) : XR;
            if (s == 0) { if (!(SKIPMASK & 2)) phase_rms(xin, XB); }
            else if (s == 1 || s == 5) { if (!(SKIPMASK & 4)) {
                pg8::Gemm g; EpiDual E;
                if (s == 1) { g = pg8::Gemm{XB, (const bf16_t*)(a.ws + WS_WIN) + (size_t)l * NP * DM, NTOK, NP, DM}; E = EpiDual{0, PROJ, NP, nullptr, nullptr, 0}; }
                else { g = pg8::Gemm{Y, (const bf16_t*)(a.ws + WS_WOUT) + (size_t)l * DM * DM, NTOK, DM, DM}; E = EpiDual{1, nullptr, 0, xin, XR, DM}; }
                pg8::StaticOrder S; S.init(NTOK, g.N, gdim_l(), bid_l());
                pg8::gemm_phase<EpiDual, pg8::StaticOrder>(lds, g, S, E, nullptr); } }
            else if (s == 2) { if (!(SKIPMASK & 8)) phase_prep(a, l, lds); }
            else if (s == 3) { if (!(SKIPMASK & 16)) phase_scan_naive(a, l, lds); }
            else if (s == 4) { if (!(SKIPMASK & 32)) phase_fin(a, l, lds); }
        }
        if (ph + 1 < hi) grid.sync();
    }
}

extern "C" void kernel_launch(void* const* d_in, const int* in_sizes, int n_in, void* d_out, int out_size, void* d_ws, size_t ws_size, hipStream_t stream) {
    static int grid = 0;
    if (grid == 0) {
        if (n_in != 26 || ws_size < WS_END) { fprintf(stderr, "kernel_launch: unexpected n_in %d or ws_size %zu < %zu\n", n_in, ws_size, (size_t)WS_END); grid = -1; return; }
        int dev = 0, cus = 0, per_cu = 0;
        hipGetDevice(&dev); hipDeviceGetAttribute(&cus, hipDeviceAttributeMultiprocessorCount, dev);
        if (hipFuncSetAttribute((const void*)mk_fwd, hipFuncAttributeMaxDynamicSharedMemorySize, LDS_BYTES) != hipSuccess) { fprintf(stderr, "hipFuncSetAttribute failed\n"); grid = -1; return; }
        if (hipOccupancyMaxActiveBlocksPerMultiprocessor(&per_cu, (const void*)mk_fwd, 512, LDS_BYTES) != hipSuccess || per_cu < 1) { fprintf(stderr, "occupancy query failed / 0\n"); grid = -1; return; }
        grid = cus;
    }
    if (grid < 0) return;
    Args a{};
    for (int i = 0; i < 26; ++i) a.in[i] = (const float*)d_in[i];
    a.out = (float*)d_out; a.ws = (unsigned char*)d_ws;
#if N_LAUNCH_MODE == 1
    a.ph_lo = 0; a.ph_hi = NPHASE;
    void* args[] = {&a};
    hipError_t e = hipLaunchCooperativeKernel((const void*)mk_fwd, dim3(grid), dim3(512), args, LDS_BYTES, stream);
    if (e != hipSuccess) fprintf(stderr, "cooperative launch failed: %s (grid %d)\n", hipGetErrorString(e), grid);
#else
    for (int ph = 0; ph < NPHASE; ++ph) { a.ph_lo = ph; a.ph_hi = ph + 1; hipLaunchKernelGGL(mk_fwd, dim3(grid), dim3(512), LDS_BYTES, stream, a); }
#endif
}
```

```cpp
#include <hip/hip_runtime.h>
#include <hip/hip_cooperative_groups.h>
#include <cstdio>
#include <cstdint>
namespace cg = cooperative_groups;
namespace pg8 {
#define PG8_LAS __attribute__((address_space(3)))
typedef unsigned short bf16_t;
typedef short bf16x8 __attribute__((ext_vector_type(8)));
typedef float f32x4 __attribute__((ext_vector_type(4)));
typedef unsigned u32x4 __attribute__((ext_vector_type(4)));
constexpr int BM = 256, BK = 64, HALF = 128, HTB = HALF * BK * 2  , STAGE_BYTES = 8 * HTB, NXCD = 8, WGM = 8;

__host__ __device__ __forceinline__ int lds_byte(int r, int c) { const int st = (r >> 4) * 2 + (c >> 5), rr = r & 15, cc = c & 31, ob = rr * 64 + cc * 2; return st * 1024 + (ob ^ (((ob >> 9) & 1) << 5)); }
__host__ __device__ __forceinline__ void stage_rc(int b, int& R, int& C) { const int st = b / 1024, sb = b % 1024, swz = sb ^ (((sb >> 9) & 1) << 5); R = (st >> 1) * 16 + swz / 64; C = (st & 1) * 32 + (swz % 64) / 2; }
__host__ __device__ __forceinline__ int perm32(int rho) { const int n = rho >> 4, i = rho & 15; return 8 * (i >> 2) + 4 * n + (i & 3); }

struct Unit { int pm, pn; };
struct Gemm { const bf16_t* A; const bf16_t* Bt; int M, N, K; };

struct StaticOrder {
    int nM, nN, nwg, G, c;
    __host__ __device__ void init(int M, int N, int G_, int c_) { nM = M / BM; nN = N / BM; nwg = nM * nN; G = G_; c = c_; }
    __host__ __device__ bool next(int i, Unit& u) const {
        const long L = (long)i * G + c; if (L >= nwg) return false;
        int wgid = (int)L; { const int q = nwg / NXCD, r = nwg % NXCD, xcd = wgid % NXCD, off = wgid / NXCD; wgid = (xcd < r ? xcd * (q + 1) : r * (q + 1) + (xcd - r) * q) + off; }
        const int nig = WGM * nN, gid = wgid / nig, fm = gid * WGM, gsz = (nM - fm) < WGM ? (nM - fm) : WGM;
        u.pm = fm + ((wgid % nig) % gsz); u.pn = (wgid % nig) / gsz; return true;
    }
    __device__ __forceinline__ void a_ready(const Unit&) const {}
    __device__ __forceinline__ void done(const Unit&) const {}
};
struct CountedOrder : StaticOrder {
    const unsigned* ready; unsigned need; unsigned* tmo;
    __device__ __forceinline__ void a_ready(const Unit& u) const {
        if (threadIdx.x < 64) {
            const unsigned long long t0 = __builtin_amdgcn_s_memrealtime(); unsigned polls = 0;
            while ((unsigned)__builtin_amdgcn_readfirstlane(__hip_atomic_load(ready + 64 * u.pm, __ATOMIC_RELAXED, __HIP_MEMORY_SCOPE_AGENT)) < need) {
                if ((++polls & 255u) == 0u && __builtin_amdgcn_readfirstlane(__hip_atomic_load(tmo, __ATOMIC_RELAXED, __HIP_MEMORY_SCOPE_AGENT)) != 0u) break;
                if (__builtin_amdgcn_s_memrealtime() - t0 > 2000000ull) {
                    if (threadIdx.x == 0) { unsigned expect = 0u; __hip_atomic_compare_exchange_strong(tmo + 1, &expect, 0x600u | (unsigned)(u.pm & 0xff), __ATOMIC_RELAXED, __ATOMIC_RELAXED, __HIP_MEMORY_SCOPE_AGENT); __hip_atomic_store(tmo, 1u, __ATOMIC_RELAXED, __HIP_MEMORY_SCOPE_AGENT); }
                    break; }
                __builtin_amdgcn_s_sleep(2); }
            __builtin_amdgcn_fence(__ATOMIC_ACQUIRE, "agent");
            asm volatile("s_waitcnt vmcnt(0)" ::: "memory");
        }
#if !defined(BROKEN_HOOK_NO_BARRIER)
        asm volatile("" ::: "memory"); __builtin_amdgcn_s_barrier(); asm volatile("" ::: "memory");
#endif
    }
};

__device__ __forceinline__ unsigned cvt_pk_bf16(float lo, float hi) { unsigned r; asm volatile("v_cvt_pk_bf16_f32 %0, %1, %2" : "=v"(r) : "v"(lo), "v"(hi)); return r; }
typedef float f32x2 __attribute__((ext_vector_type(2)));
__device__ __forceinline__ f32x2 gelu_pk(f32x2 v) {
    const f32x2 av = __builtin_elementwise_abs(v), d = av * 0.2316418882f + 1.0f;
    f32x2 t; t.x = __builtin_amdgcn_rcpf(d.x); t.y = __builtin_amdgcn_rcpf(d.y);
    f32x2 q = t * 0.5307027145f + (-0.7265760135f); q = q * t + 0.7107068705f; q = q * t + (-0.142248368f); q = q * t + 0.127414796f; q = q * t;
    const f32x2 s = (v * v) * (-0.72134752044f);
    f32x2 e; e.x = __builtin_amdgcn_exp2f(s.x); e.y = __builtin_amdgcn_exp2f(s.y);
    const f32x2 m = v * (q * e), r = v - m;
    f32x2 o; o.x = v.x < 0.f ? m.x : r.x; o.y = v.y < 0.f ? m.y : r.y; return o;
}

struct EpiF32 {
    static constexpr bool PERM = false, AFTER_DRAIN = false;
    float* C; int ldc; const float* bias;
    __device__ __forceinline__ void operator()(const f32x4 (&acc)[2][2][4][2], const Unit& u, int wr, int wc, int fr, int fq) const {
        const int row0 = u.pm * BM + wr * 64 + fr, col0 = u.pn * BM + wc * 32 + 4 * fq;
        f32x4 bv[2][2];
#pragma unroll
        for (int bj = 0; bj < 2; ++bj)
#pragma unroll
            for (int n = 0; n < 2; ++n) bv[bj][n] = bias ? *(const f32x4*)(bias + col0 + bj * HALF + n * 16) : (f32x4){0.f, 0.f, 0.f, 0.f};
#pragma unroll
        for (int ai = 0; ai < 2; ++ai)
#pragma unroll
            for (int m = 0; m < 4; ++m) { float* rowp = C + (size_t)(row0 + ai * HALF + m * 16) * ldc + col0;
#pragma unroll
                for (int bj = 0; bj < 2; ++bj)
#pragma unroll
                    for (int n = 0; n < 2; ++n) *(f32x4*)(rowp + bj * HALF + n * 16) = acc[ai][bj][m][n] + bv[bj][n]; }
    }
};
template <int ACT  > struct EpiBf16 {
    static constexpr bool PERM = true, AFTER_DRAIN = false;
    bf16_t* O; int ldc; const float* bias; int split_cols; size_t split_stride;
    __device__ __forceinline__ void operator()(const f32x4 (&acc)[2][2][4][2], const Unit& u, int wr, int wc, int fr, int fq) const {
        const int row0 = u.pm * BM + wr * 64 + fr; int colt = u.pn * BM; bf16_t* base = O;
        if (split_cols) { const int t = colt / split_cols; base += (size_t)t * split_stride; colt -= t * split_cols; }
        const int col0 = colt + wc * 32 + 8 * fq, bcol0 = u.pn * BM + wc * 32 + 8 * fq;
        f32x4 bv[2][2];
#pragma unroll
        for (int bj = 0; bj < 2; ++bj)
#pragma unroll
            for (int n = 0; n < 2; ++n) bv[bj][n] = bias ? *(const f32x4*)(bias + bcol0 + bj * HALF + 4 * n) : (f32x4){0.f, 0.f, 0.f, 0.f};
#pragma unroll
        for (int ai = 0; ai < 2; ++ai)
#pragma unroll
            for (int m = 0; m < 4; ++m) { bf16_t* rowp = base + (size_t)(row0 + ai * HALF + m * 16) * ldc + col0;
#pragma unroll
                for (int bj = 0; bj < 2; ++bj) { f32x4 v0 = acc[ai][bj][m][0] + bv[bj][0], v1 = acc[ai][bj][m][1] + bv[bj][1];
                    if (ACT == 1) { f32x2 a = gelu_pk((f32x2){v0[0], v0[1]}), b = gelu_pk((f32x2){v0[2], v0[3]}), c = gelu_pk((f32x2){v1[0], v1[1]}), d = gelu_pk((f32x2){v1[2], v1[3]});
                        v0 = (f32x4){a.x, a.y, b.x, b.y}; v1 = (f32x4){c.x, c.y, d.x, d.y}; }
                    if (ACT == 2) {
#pragma unroll
                        for (int j = 0; j < 4; ++j) { v0[j] = 0.5f * v0[j] * (1.0f + erff(v0[j] * 0.70710678f)); v1[j] = 0.5f * v1[j] * (1.0f + erff(v1[j] * 0.70710678f)); } }
                    u32x4 w; w.x = cvt_pk_bf16(v0[0], v0[1]); w.y = cvt_pk_bf16(v0[2], v0[3]); w.z = cvt_pk_bf16(v1[0], v1[1]); w.w = cvt_pk_bf16(v1[2], v1[3]);
                    *(u32x4*)(rowp + bj * HALF) = w; } }
    }
};

struct PanelStats {
    unsigned* xbuf;
    unsigned* cnt;
    unsigned* tmo;
    int ntn; float eps;
    unsigned code;
    __device__ __forceinline__ bool run(const f32x4 (&v)[2][2][4][2], const Unit& u, int wr, int wc, int fr, int fq, PG8_LAS unsigned char* lds, int wid, int lane) const {
        typedef float f32x2v __attribute__((ext_vector_type(2)));
        PG8_LAS f32x2v* P = (PG8_LAS f32x2v*)lds;
        PG8_LAS f32x2v* S = (PG8_LAS f32x2v*)(lds + 8192);
        PG8_LAS unsigned* flag = (PG8_LAS unsigned*)(lds + 8192 + 2048);
#pragma unroll
        for (int ai = 0; ai < 2; ++ai)
#pragma unroll
            for (int m = 0; m < 4; ++m) {
                float s = 0.f;
#pragma unroll
                for (int bj = 0; bj < 2; ++bj)
#pragma unroll
                    for (int n = 0; n < 2; ++n) { const f32x4 x = v[ai][bj][m][n]; s += (x[0] + x[1]) + (x[2] + x[3]); }
                s += __shfl_xor(s, 16); s += __shfl_xor(s, 32);
                const float mw = s * (1.0f / 64.0f); float q = 0.f;
#pragma unroll
                for (int bj = 0; bj < 2; ++bj)
#pragma unroll
                    for (int n = 0; n < 2; ++n) { const f32x4 d = v[ai][bj][m][n] - mw; q += (d[0] * d[0] + d[1] * d[1]) + (d[2] * d[2] + d[3] * d[3]); }
                q += __shfl_xor(q, 16); q += __shfl_xor(q, 32);
                if (fq == 0) P[(ai * HALF + wr * 64 + m * 16 + fr) * 4 + wc] = (f32x2v){mw, q};
            }
        asm volatile("s_waitcnt lgkmcnt(0)" ::: "memory"); __builtin_amdgcn_s_barrier(); asm volatile("" ::: "memory");
#if defined(BROKEN_NO_WAIT)
        if (blockIdx.x >= 64) { const long long t0 = clock64(); while (clock64() - t0 < 60000) __builtin_amdgcn_s_sleep(8); }
#endif
        const int row = wid * 32 + (lane & 31);
        if (lane < 32) {
            const f32x2v a = P[row * 4 + 0], b = P[row * 4 + 1], c = P[row * 4 + 2], d = P[row * 4 + 3];
            const float mt = (a.x + b.x + c.x + d.x) * 0.25f;
            const float da = a.x - mt, db = b.x - mt, dc = c.x - mt, dd = d.x - mt;
            const float m2 = (a.y + b.y) + (c.y + d.y) + 64.0f * ((da * da + db * db) + (dc * dc + dd * dd));
            unsigned long long* slot = (unsigned long long*)xbuf + ((size_t)(u.pm * BM + row) * 4 + u.pn);
            __hip_atomic_store(slot, ((unsigned long long)__float_as_uint(m2) << 32) | __float_as_uint(mt), __ATOMIC_RELAXED, __HIP_MEMORY_SCOPE_AGENT);
        }
        asm volatile("s_waitcnt vmcnt(0)" ::: "memory");
        if (lane == 0) __hip_atomic_fetch_add(cnt + 64 * u.pm, 1u, __ATOMIC_RELAXED, __HIP_MEMORY_SCOPE_AGENT);
        if (wid == 0) {
            bool dead = false; const unsigned long long t0 = __builtin_amdgcn_s_memrealtime(); const unsigned want = 8u * (unsigned)ntn;
            for (;;) {
#if defined(BROKEN_NO_WAIT)
                break;
#endif
                if ((unsigned)__builtin_amdgcn_readfirstlane(__hip_atomic_load(cnt + 64 * u.pm, __ATOMIC_RELAXED, __HIP_MEMORY_SCOPE_AGENT)) >= want) break;
                if (__builtin_amdgcn_s_memrealtime() - t0 > 2000000ull) {
                    if (lane == 0) { unsigned expect = 0u; __hip_atomic_compare_exchange_strong(tmo + 1, &expect, code | (unsigned)(u.pm & 0xff), __ATOMIC_RELAXED, __ATOMIC_RELAXED, __HIP_MEMORY_SCOPE_AGENT);
                                     __hip_atomic_store(tmo, 1u, __ATOMIC_RELAXED, __HIP_MEMORY_SCOPE_AGENT); }
                    dead = true; break; }
                __builtin_amdgcn_s_sleep(2);
            }
            __builtin_amdgcn_fence(__ATOMIC_ACQUIRE, "agent");
            if (lane == 0) flag[0] = dead ? 1u : 0u;
        }
        asm volatile("s_waitcnt vmcnt(0) lgkmcnt(0)" ::: "memory"); __builtin_amdgcn_s_barrier(); asm volatile("" ::: "memory");
        const bool bad = flag[0] != 0u;
        if (lane < 32) {
            const unsigned long long* slot = (const unsigned long long*)xbuf + (size_t)(u.pm * BM + row) * 4; float mt[4], m2[4]; float ms = 0.f;
#pragma unroll
            for (int t = 0; t < 4; ++t) { if (t < ntn) { const unsigned long long w = __hip_atomic_load(slot + t, __ATOMIC_RELAXED, __HIP_MEMORY_SCOPE_AGENT); mt[t] = __uint_as_float((unsigned)w); m2[t] = __uint_as_float((unsigned)(w >> 32)); } else { mt[t] = 0.f; m2[t] = 0.f; } ms += mt[t]; }
            const float mean = ms / (float)ntn; float q = 0.f;
#pragma unroll
            for (int t = 0; t < 4; ++t) if (t < ntn) { const float dm = mt[t] - mean; q += m2[t] + 256.0f * dm * dm; }
            S[row] = (f32x2v){mean, 1.0f / sqrtf(q / (256.0f * (float)ntn) + eps)};
        }
        asm volatile("s_waitcnt lgkmcnt(0)" ::: "memory"); __builtin_amdgcn_s_barrier(); asm volatile("" ::: "memory");
        return bad;
    }
};
struct EpiLnRes {
    static constexpr bool PERM = false, AFTER_DRAIN = true;
    const float* base; float* out; int ldc; const float* bias; PanelStats st; unsigned poison;
    __device__ __forceinline__ void refuse(size_t i0, size_t stride, int M, int N) const { const float q = __builtin_nanf(""); for (size_t i = i0; i < (size_t)M * N; i += stride) out[(i / N) * ldc + i % N] = q;
        if (i0 == 0) { unsigned expect = 0u; __hip_atomic_compare_exchange_strong(st.tmo + 1, &expect, 0x7f0u, __ATOMIC_RELAXED, __ATOMIC_RELAXED, __HIP_MEMORY_SCOPE_AGENT); __hip_atomic_store(st.tmo, 1u, __ATOMIC_RELAXED, __HIP_MEMORY_SCOPE_AGENT); } }
    __device__ __forceinline__ void fused(f32x4 (&acc)[2][2][4][2], const Unit& u, int wr, int wc, int fr, int fq, PG8_LAS unsigned char* lds, int wid, int lane) const {
        typedef float f32x2v __attribute__((ext_vector_type(2)));
        const PG8_LAS f32x2v* S = (const PG8_LAS f32x2v*)(lds + 8192);
        const int col0 = u.pn * BM + wc * 32 + 4 * fq;
#pragma unroll
        for (int bj = 0; bj < 2; ++bj)
#pragma unroll
            for (int n = 0; n < 2; ++n) { const f32x4 bv = bias ? *(const f32x4*)(bias + col0 + bj * HALF + n * 16) : (f32x4){0.f, 0.f, 0.f, 0.f};
#pragma unroll
                for (int ai = 0; ai < 2; ++ai)
#pragma unroll
                    for (int m = 0; m < 4; ++m) acc[ai][bj][m][n] += bv; }
        const bool bad = st.run(acc, u, wr, wc, fr, fq, lds, wid, lane) || poison != 0u;
        const float qnan = __builtin_nanf("");
#pragma unroll
        for (int ai = 0; ai < 2; ++ai)
#pragma unroll
            for (int m = 0; m < 4; ++m) { const int r = ai * HALF + wr * 64 + m * 16 + fr; const f32x2v sr = S[r]; const size_t off = (size_t)(u.pm * BM + r) * ldc + col0;
#pragma unroll
                for (int bj = 0; bj < 2; ++bj)
#pragma unroll
                    for (int n = 0; n < 2; ++n) { const f32x4 bs = *(const f32x4*)(base + off + bj * HALF + n * 16); f32x4 o = bs + (acc[ai][bj][m][n] - sr.x) * sr.y;
                        if (bad) o = (f32x4){qnan, qnan, qnan, qnan}; *(f32x4*)(out + off + bj * HALF + n * 16) = o; }
                asm volatile("" ::: "memory"); }
    }
};
struct EpiLnResLn {
    static constexpr bool PERM = false, AFTER_DRAIN = true;
    const float* base; float* out; bf16_t* xn; int ldc; const float* bias; PanelStats st1, st2; unsigned poison;
    __device__ __forceinline__ void refuse(size_t i0, size_t stride, int M, int N) const { const float q = __builtin_nanf(""); for (size_t i = i0; i < (size_t)M * N; i += stride) { const size_t o = (i / N) * ldc + i % N; out[o] = q; xn[o] = (bf16_t)0x7fc0u; }
        if (i0 == 0) { unsigned expect = 0u; __hip_atomic_compare_exchange_strong(st1.tmo + 1, &expect, 0x7f0u, __ATOMIC_RELAXED, __ATOMIC_RELAXED, __HIP_MEMORY_SCOPE_AGENT); __hip_atomic_store(st1.tmo, 1u, __ATOMIC_RELAXED, __HIP_MEMORY_SCOPE_AGENT); } }
    __device__ __forceinline__ void fused(f32x4 (&acc)[2][2][4][2], const Unit& u, int wr, int wc, int fr, int fq, PG8_LAS unsigned char* lds, int wid, int lane) const {
        typedef float f32x2v __attribute__((ext_vector_type(2))); typedef unsigned u32x2v __attribute__((ext_vector_type(2)));
        const PG8_LAS f32x2v* S = (const PG8_LAS f32x2v*)(lds + 8192);
        const int col0 = u.pn * BM + wc * 32 + 4 * fq;
#pragma unroll
        for (int bj = 0; bj < 2; ++bj)
#pragma unroll
            for (int n = 0; n < 2; ++n) { const f32x4 bv = bias ? *(const f32x4*)(bias + col0 + bj * HALF + n * 16) : (f32x4){0.f, 0.f, 0.f, 0.f};
#pragma unroll
                for (int ai = 0; ai < 2; ++ai)
#pragma unroll
                    for (int m = 0; m < 4; ++m) acc[ai][bj][m][n] += bv; }
        bool bad = st1.run(acc, u, wr, wc, fr, fq, lds, wid, lane) || poison != 0u;
        const float qnan = __builtin_nanf("");
#pragma unroll
        for (int ai = 0; ai < 2; ++ai)
#pragma unroll
            for (int m = 0; m < 4; ++m) { const int r = ai * HALF + wr * 64 + m * 16 + fr; const f32x2v sr = S[r]; const size_t off = (size_t)(u.pm * BM + r) * ldc + col0;
#pragma unroll
                for (int bj = 0; bj < 2; ++bj)
#pragma unroll
                    for (int n = 0; n < 2; ++n) { const f32x4 bs = *(const f32x4*)(base + off + bj * HALF + n * 16); acc[ai][bj][m][n] = bs + (acc[ai][bj][m][n] - sr.x) * sr.y; }
                asm volatile("" : "+v"(acc[ai][0][m][0]), "+v"(acc[ai][0][m][1]), "+v"(acc[ai][1][m][0]), "+v"(acc[ai][1][m][1]));
                if (m & 1) asm volatile("" ::: "memory"); }
        const bool bad1 = bad;
        bad = st2.run(acc, u, wr, wc, fr, fq, lds, wid, lane) || bad;
#pragma unroll
        for (int ai = 0; ai < 2; ++ai)
#pragma unroll
            for (int m = 0; m < 4; ++m) { const int r = ai * HALF + wr * 64 + m * 16 + fr; const f32x2v sr = S[r]; const size_t off = (size_t)(u.pm * BM + r) * ldc + col0;
#pragma unroll
                for (int bj = 0; bj < 2; ++bj)
#pragma unroll
                    for (int n = 0; n < 2; ++n) { const f32x4 x1 = acc[ai][bj][m][n]; *(f32x4*)(out + off + bj * HALF + n * 16) = bad1 ? (f32x4){qnan, qnan, qnan, qnan} : x1;
                        const f32x4 o = (x1 - sr.x) * sr.y; u32x2v w; w.x = cvt_pk_bf16(o[0], o[1]); w.y = cvt_pk_bf16(o[2], o[3]);
                        if (bad) { w.x = 0x7fc07fc0u; w.y = 0x7fc07fc0u; } *(u32x2v*)(xn + off + bj * HALF + n * 16) = w; }
                asm volatile("" ::: "memory"); }
    }
};

template <class Epi, class Sched, bool STAMP = false>
__device__ __forceinline__ void gemm_phase(PG8_LAS unsigned char* lds, const Gemm g, const Sched& S, const Epi& E, unsigned long long* stamps) {
    int tid_ = threadIdx.x; asm volatile("" : "+v"(tid_)); const int tid = tid_, wid = __builtin_amdgcn_readfirstlane(tid >> 6), lane = tid & 63, wr = wid >> 2, wc = wid & 3, fr = lane & 15, fq = lane >> 4;
    const int K = g.K, nt = K / BK;
    int ts_lo = 0, ts_hi = 0, nts = 0; const unsigned long long rt_entry = STAMP ? (unsigned long long)wall_clock64() : 0ull;
#define PG8_STAMP() do { if (STAMP && wid == 0 && nts < 64) { const unsigned long long _c = (unsigned long long)clock64(); \
        ts_lo = (lane == nts) ? (int)(unsigned)_c : ts_lo; ts_hi = (lane == nts) ? (int)(unsigned)(_c >> 32) : ts_hi; ++nts; } } while (0)
    PG8_STAMP();
    unsigned voffA[2], voffB[2];
#pragma unroll
    for (int i = 0; i < 2; ++i) { int R, C; stage_rc(tid * 16 + i * 8192, R, C); const int Rb = Epi::PERM ? ((R & ~31) + perm32(R & 31)) : R;
        voffA[i] = (unsigned)(R * K + C) * 2u; voffB[i] = (unsigned)(Rb * K + C) * 2u; }
    const size_t kstep = (size_t)(BK * 2);
    const size_t hstep = (size_t)HALF * K * 2;
    const size_t tstep = 2 * hstep;
    const unsigned ldsw = (unsigned)wid * 1024u;
    const int aoff = lds_byte(wr * 64 + fr, fq * 8), boff = lds_byte(wc * 32 + fr, fq * 8);
#define PG8_SA(b, h) (((b) * 2 + (h)) * HTB)
#define PG8_SB(b, h) ((4 + (b) * 2 + (h)) * HTB)
#define PG8_STAGE(bufoff, gbase, voff) do { _Pragma("unroll") for (int _i = 0; _i < 2; ++_i) \
        __builtin_amdgcn_global_load_lds((const unsigned*)((const char*)(gbase) + (voff)[_i]), (PG8_LAS unsigned*)(lds + (bufoff) + ldsw + _i * 8192), 16, 0, 0); } while (0)
#define PG8_LDA(dst, b, h) do { _Pragma("unroll") for (int m = 0; m < 4; ++m) _Pragma("unroll") for (int k = 0; k < 2; ++k) dst[m][k] = *(const PG8_LAS bf16x8*)(lds + PG8_SA(b, h) + aoff + m * 2048 + k * 1024); } while (0)
#define PG8_LDB(dst, b, h) do { _Pragma("unroll") for (int n = 0; n < 2; ++n) _Pragma("unroll") for (int k = 0; k < 2; ++k) dst[n][k] = *(const PG8_LAS bf16x8*)(lds + PG8_SB(b, h) + boff + n * 2048 + k * 1024); } while (0)
#define PG8_MMA(ai, bj, At, Bt) do { __builtin_amdgcn_s_setprio(1); _Pragma("unroll") for (int m = 0; m < 4; ++m) _Pragma("unroll") for (int n = 0; n < 2; ++n) _Pragma("unroll") for (int k = 0; k < 2; ++k) \
        acc[ai][bj][m][n] = __builtin_amdgcn_mfma_f32_16x16x32_bf16(Bt[n][k], At[m][k], acc[ai][bj][m][n], 0, 0, 0); __builtin_amdgcn_s_setprio(0); } while (0)
#define PG8_WAIT_V(n) asm volatile("s_waitcnt vmcnt(" #n ")" ::: "memory")
#define PG8_WAIT_L(n) asm volatile("s_waitcnt lgkmcnt(" #n ")" ::: "memory")
#define PG8_BAR __builtin_amdgcn_s_barrier()
#define PG8_SCHED __builtin_amdgcn_sched_barrier(0)
    Unit cur, nxt; int ui = 0;
    if (!S.next(0, cur)) return;
    f32x4 acc[2][2][4][2];
#pragma unroll
    for (int a = 0; a < 2; ++a)
#pragma unroll
        for (int b = 0; b < 2; ++b)
#pragma unroll
            for (int m = 0; m < 4; ++m)
#pragma unroll
                for (int n = 0; n < 2; ++n) acc[a][b][m][n] = (f32x4){0.f, 0.f, 0.f, 0.f};
    bf16x8 At[4][2], B0[2][2], B1[2][2];
    const char* cA = (const char*)g.A + (size_t)cur.pm * tstep; const char* cB = (const char*)g.Bt + (size_t)cur.pn * tstep;
    S.a_ready(cur);
    PG8_STAGE(PG8_SB(0, 0), cB, voffB); PG8_STAGE(PG8_SA(0, 0), cA, voffA); PG8_STAGE(PG8_SB(0, 1), cB + hstep, voffB); PG8_STAGE(PG8_SA(0, 1), cA + hstep, voffA);
    if (wr == 1) PG8_BAR;
    PG8_WAIT_V(4); PG8_BAR;
    PG8_STAGE(PG8_SB(1, 0), cB + kstep, voffB); PG8_STAGE(PG8_SA(1, 0), cA + kstep, voffA); PG8_STAGE(PG8_SB(1, 1), cB + hstep + kstep, voffB);
    PG8_WAIT_V(6); PG8_BAR;
    PG8_STAMP();
    for (;;) {
        const bool has_next = S.next(ui + 1, nxt);
        const char* nA = has_next ? (const char*)g.A + (size_t)nxt.pm * tstep : cA; const char* nB = has_next ? (const char*)g.Bt + (size_t)nxt.pn * tstep : cB;
        for (int t = 0; t < nt; t += 2) {
            const bool last = (t == nt - 2);
            const char* a1 = cA + (size_t)(t + 1) * kstep;
            const char* a2 = last ? nA : cA + (size_t)(t + 2) * kstep; const char* b2 = last ? nB : cB + (size_t)(t + 2) * kstep;
            const char* a3 = a2 + kstep; const char* b3 = b2 + kstep;
            if (last && has_next) S.a_ready(nxt);
            PG8_LDB(B0, 0, 0); PG8_SCHED; PG8_LDA(At, 0, 0); PG8_STAGE(PG8_SA(1, 1), a1 + hstep, voffA);
            PG8_WAIT_L(8); PG8_BAR; PG8_WAIT_L(0); PG8_MMA(0, 0, At, B0); PG8_BAR; PG8_SCHED;
            PG8_LDB(B1, 0, 1); PG8_STAGE(PG8_SB(0, 0), b2, voffB);
            PG8_BAR; PG8_WAIT_L(0); PG8_MMA(0, 1, At, B1); PG8_BAR;
            PG8_LDA(At, 0, 1); PG8_STAGE(PG8_SA(0, 0), a2, voffA);
            PG8_BAR; PG8_WAIT_L(0); PG8_MMA(1, 0, At, B0); PG8_BAR; PG8_SCHED;
            PG8_STAGE(PG8_SB(0, 1), b2 + hstep, voffB);
            PG8_WAIT_V(6); PG8_BAR; PG8_MMA(1, 1, At, B1); PG8_BAR;
            PG8_LDB(B0, 1, 0); PG8_SCHED; PG8_LDA(At, 1, 0); PG8_STAGE(PG8_SA(0, 1), a2 + hstep, voffA);
            PG8_WAIT_L(8); PG8_BAR; PG8_WAIT_L(0); PG8_MMA(0, 0, At, B0); PG8_BAR; PG8_SCHED;
            PG8_LDB(B1, 1, 1); PG8_STAGE(PG8_SB(1, 0), b3, voffB);
            PG8_BAR; PG8_WAIT_L(0); PG8_MMA(0, 1, At, B1); PG8_BAR;
            PG8_LDA(At, 1, 1); PG8_STAGE(PG8_SA(1, 0), a3, voffA);
            PG8_BAR; PG8_WAIT_L(0); PG8_MMA(1, 0, At, B0); PG8_BAR; PG8_SCHED;
            PG8_STAGE(PG8_SB(1, 1), b3 + hstep, voffB);
            PG8_WAIT_V(6); PG8_BAR; PG8_MMA(1, 1, At, B1); PG8_BAR;
        }
        PG8_STAMP();
        if constexpr (!Epi::AFTER_DRAIN) { E(acc, cur, wr, wc, fr, fq); S.done(cur); }
        PG8_STAMP();
        if (!has_next) break;
#pragma unroll
        for (int a = 0; a < 2; ++a)
#pragma unroll
            for (int b = 0; b < 2; ++b)
#pragma unroll
                for (int m = 0; m < 4; ++m)
#pragma unroll
                    for (int n = 0; n < 2; ++n) acc[a][b][m][n] = (f32x4){0.f, 0.f, 0.f, 0.f};
        cur = nxt; cA = nA; cB = nB; ++ui;
    }
    PG8_WAIT_V(0);
    if (wr == 0) PG8_BAR;
    PG8_BAR;
    if constexpr (Epi::AFTER_DRAIN) { E.fused(acc, cur, wr, wc, fr, fq, lds, wid, lane); S.done(cur); }
    PG8_STAMP();
    if (STAMP && wid == 0) { stamps[lane] = lane < nts ? (((unsigned long long)(unsigned)ts_hi << 32) | (unsigned)ts_lo) : 0ull;
        if (lane == 62) stamps[62] = rt_entry; if (lane == 63) stamps[63] = (unsigned long long)wall_clock64(); }
#undef PG8_STAMP
#undef PG8_SA
#undef PG8_SB
#undef PG8_STAGE
#undef PG8_LDA
#undef PG8_LDB
#undef PG8_MMA
#undef PG8_WAIT_V
#undef PG8_WAIT_L
#undef PG8_BAR
#undef PG8_SCHED
}
}
#define LAS __attribute__((address_space(3)))
typedef unsigned short bf16_t;
typedef float f32x4 __attribute__((ext_vector_type(4)));
typedef float f32x2 __attribute__((ext_vector_type(2)));
typedef unsigned u32x4 __attribute__((ext_vector_type(4)));
typedef unsigned u32x2 __attribute__((ext_vector_type(2)));
constexpr int NTOK = 8192, SEQ = 2048, DM = 2048, NIN = 7372, NP = 7424, NL = 4;
constexpr int LRUW = 512, GW = 768, RW_ = 768;
constexpr int PC_AX = 0, PC_AG = 512, PC_BQKV = 1024, PC_BG = 3328, PC_CIN = 4096, PC_CG = 6592, PC_BETA = 7360, PC_BA = 7366;
constexpr int LDS_BYTES = 131072 + 512;
#ifndef CHUNKREP
#define CHUNKREP 0
#endif
#ifndef CONV_SPLIT
#define CONV_SPLIT 40
#endif
#ifndef REPMASK
#define REPMASK 0
#endif
#ifndef SKIPMASK
#define SKIPMASK 0
#endif
#ifndef N_LAUNCH_MODE
#define N_LAUNCH_MODE 1
#endif
constexpr int PPL = 7;
constexpr int NPHASE = 2 + PPL * NL;
constexpr size_t WS_WIN = 0;
constexpr size_t WS_WOUT = WS_WIN + (size_t)NL * NP * DM * 2;
constexpr size_t WS_XB = WS_WOUT + (size_t)NL * DM * DM * 2;
constexpr size_t WS_XR = WS_XB + (size_t)NTOK * DM * 2;
constexpr size_t WS_PROJ = WS_XR + (size_t)NTOK * DM * 4;
constexpr size_t WS_Y = WS_PROJ + (size_t)NTOK * NP * 2;
constexpr size_t SZ768 = (size_t)NTOK * 768 * 4;
constexpr size_t WS_GQ = WS_Y + (size_t)NTOK * DM * 2;
constexpr size_t WS_GK = WS_GQ + SZ768;
constexpr size_t WS_GV = WS_GK + SZ768;
constexpr size_t WS_GO = WS_GV + SZ768;
constexpr size_t WS_RR = WS_GO + SZ768;
constexpr size_t WS_RW = WS_RR + SZ768;
constexpr size_t WS_RK = WS_RW + SZ768;
constexpr size_t WS_RV = WS_RK + SZ768;
constexpr size_t WS_RKK = WS_RV + SZ768;
constexpr size_t WS_RB = WS_RKK + SZ768;
constexpr size_t WS_RY = WS_RB + SZ768;
constexpr size_t WS_GB = WS_RY + SZ768;
constexpr size_t WS_GG = WS_GB + (size_t)NTOK * 8 * 4;
constexpr size_t WS_LA = WS_GG + (size_t)NTOK * 8 * 4;
constexpr size_t WS_LU = WS_LA + (size_t)NTOK * 512 * 4;
constexpr size_t WS_LEND = WS_LU + (size_t)NTOK * 512 * 4;
constexpr int GCH = 768, RCH = 1536;
constexpr size_t WS_G1 = WS_LEND;
constexpr size_t WS_G2 = WS_G1 + (size_t)GCH * 64 * 128 * 2;
constexpr size_t WS_G3 = WS_G2 + (size_t)GCH * 64 * 128 * 2;
constexpr size_t WS_G4 = WS_G3 + (size_t)GCH * 64 * 64 * 2;
constexpr size_t WS_GU = WS_G4 + (size_t)GCH * 128 * 64 * 2;
constexpr size_t WS_GGL = WS_GU + (size_t)GCH * 128 * 64 * 4;
constexpr size_t WS_R1 = WS_GGL + (size_t)GCH * 128 * 4;
constexpr size_t WS_R2 = WS_R1 + (size_t)RCH * 64 * 64 * 2;
constexpr size_t WS_R3 = WS_R2 + (size_t)RCH * 64 * 64 * 2;
constexpr size_t WS_R4 = WS_R3 + (size_t)RCH * 64 * 128 * 2;
constexpr size_t WS_RU = WS_R4 + (size_t)RCH * 64 * 128 * 2;
constexpr size_t WS_RVT = WS_RU + (size_t)RCH * 64 * 64 * 4;
constexpr size_t WS_RGL = WS_RVT + (size_t)RCH * 64 * 64 * 2;
constexpr size_t WS_LH = WS_RGL + (size_t)RCH * 64 * 4;
constexpr size_t WS_LP = WS_LH + (size_t)NTOK * 512 * 4;
constexpr size_t WS_LC = WS_LP + (size_t)NTOK * 512 * 4;
constexpr size_t WS_BAR = WS_LC + (size_t)128 * 512 * 4;
constexpr size_t WS_WUPT = WS_BAR + 16384;
constexpr size_t WS_AUPT = WS_WUPT + (size_t)NL * 768 * 96 * 2;
constexpr size_t WS_WXT = WS_AUPT + (size_t)NL * 768 * 96 * 2;
constexpr size_t WS_WAT = WS_WXT + (size_t)NL * 8 * 64 * 64 * 2;
constexpr size_t WS_END = WS_WAT + (size_t)NL * 8 * 64 * 64 * 2;

struct Args {
    const float* in[26];
    float* out; unsigned char* ws;
    int ph_lo, ph_hi;
};
enum { I_X = 0, I_NORMG, I_WIN, I_WOUT, I_LCW, I_LCB, I_LWX, I_LBX, I_LWA, I_LBA, I_LLAM, I_GCW, I_GALOG, I_GDT, I_GNG,
       I_RMU, I_RW0, I_RWUP, I_RA0, I_RAUP, I_RKK, I_RKA, I_RRK, I_RGNW, I_RGNB, I_FNG };

__device__ __forceinline__ int tid_l() { int t = threadIdx.x; asm volatile("" : "+v"(t)); return t; }
#define LBAR() do { asm volatile("s_waitcnt lgkmcnt(0)" ::: "memory"); __builtin_amdgcn_s_barrier(); asm volatile("" ::: "memory"); } while (0)
__device__ __forceinline__ int bid_l() { int b = blockIdx.x; asm volatile("" : "+s"(b)); return b; }
__device__ __forceinline__ int gdim_l() { int b = gridDim.x; asm volatile("" : "+s"(b)); return b; }
__device__ __forceinline__ const float* inp(LAS unsigned char* lds, int i) {
    const LAS unsigned* t = (const LAS unsigned*)(lds + 131072) + 2 * i;
    const unsigned lo = __builtin_amdgcn_readfirstlane(t[0]), hi = __builtin_amdgcn_readfirstlane(t[1]);
    return (const float*)(const __attribute__((address_space(1))) float*)(((unsigned long long)hi << 32) | lo);
}
__device__ __forceinline__ float bf2f(bf16_t b) { return __uint_as_float(((unsigned)b) << 16); }
__device__ __forceinline__ bf16_t f2bf(float f) { unsigned u = __float_as_uint(f); u += 0x7FFFu + ((u >> 16) & 1u); return (bf16_t)(u >> 16); }
__device__ __forceinline__ unsigned pk2(float lo, float hi) { return (unsigned)f2bf(lo) | ((unsigned)f2bf(hi) << 16); }
__device__ __forceinline__ float wave_sum(float v) {
#pragma unroll
    for (int o = 1; o < 64; o <<= 1) v += __shfl_xor(v, o);
    return v;
}
typedef __bf16 bf2_t __attribute__((ext_vector_type(2)));
__device__ __forceinline__ unsigned cvtpk(float lo, float hi) { const f32x2 v = {lo, hi}; const bf2_t r = __builtin_convertvector(v, bf2_t); return __builtin_bit_cast(unsigned, r); }
__device__ __forceinline__ float sigmoidf_(float x) { return 1.0f / (1.0f + __expf(-x)); }
__device__ __forceinline__ float siluf_(float x) { return x / (1.0f + __expf(-x)); }
__device__ __forceinline__ float softplusf_(float x) { return fmaxf(x, 0.f) + log1pf(__expf(-fabsf(x))); }

__device__ __forceinline__ void transpose_item(const float* W, int K, int N, bf16_t* WT, const float* scale, bool remap, LAS float* scr, int item, int nblk, int lane) {
    const int kb = item / nblk, nb = item % nblk, k0 = 64 * kb, n0 = 32 * nb;
    int np = n0 + (lane & 31), oc;
    if (!remap) oc = np;
    else if (np < 4096) oc = np;
    else if (np < 7360) oc = np + 12;
    else if (np < 7372) oc = np - 7360 + 4096;
    else oc = -1;
    float vbuf[32], sbuf[32];
#pragma unroll
    for (int i = 0; i < 32; ++i) { const int kk = 2 * i + (lane >> 5); vbuf[i] = (oc >= 0) ? W[(size_t)(k0 + kk) * N + oc] : 0.f; sbuf[i] = scale ? scale[k0 + kk] : 1.0f; }
#pragma unroll
    for (int i = 0; i < 32; ++i) { const int kk = 2 * i + (lane >> 5); scr[kk * 33 + (lane & 31)] = vbuf[i] * sbuf[i]; }
    __builtin_amdgcn_s_waitcnt(0xc07f); asm volatile("s_waitcnt lgkmcnt(0)" ::: "memory");
    const int c = lane & 7;
#pragma unroll
    for (int j = 0; j < 4; ++j) { const int n = (lane >> 3) + 8 * j; const LAS float* s = scr + (8 * c) * 33 + n;
        u32x4 o; o.x = pk2(s[0 * 33], s[1 * 33]); o.y = pk2(s[2 * 33], s[3 * 33]); o.z = pk2(s[4 * 33], s[5 * 33]); o.w = pk2(s[6 * 33], s[7 * 33]);
        *(u32x4*)(WT + (size_t)(n0 + n) * K + k0 + 8 * c) = o; }
    asm volatile("s_waitcnt lgkmcnt(0)" ::: "memory");
}
__device__ __forceinline__ void phase_convert(const Args& a, LAS unsigned char* lds, int l_lo, int l_hi, int f_lo, int f_hi, int vb, int nvb, int small) {
    size_t wso_ = 0; asm volatile("" : "+s"(wso_)); unsigned char* ws = a.ws + wso_;
    const int tid = tid_l(), wave = __builtin_amdgcn_readfirstlane(tid >> 6), lane = tid & 63;
    LAS float* scr = (LAS float*)(lds + wave * 8448);
    const int gw = vb * 8 + wave, NGW = nvb * 8;
    constexpr int I_IN = (DM / 64) * (NP / 32), I_OUT = (DM / 64) * (DM / 32), PER_L = I_IN + I_OUT;
    const int i_lo = (PER_L / 64) * f_lo, i_hi = (PER_L / 64) * f_hi, span = i_hi - i_lo;
    for (int it = gw; it < (l_hi - l_lo) * span; it += NGW) {
        const int l = l_lo + it / span; int r = i_lo + it % span;
        if (r < I_IN) transpose_item(inp(lds, I_WIN) + (size_t)l * DM * NIN, DM, NIN, (bf16_t*)(ws + WS_WIN) + (size_t)l * NP * DM, inp(lds, I_NORMG) + l * DM, true, scr, r, NP / 32, lane);
        else transpose_item(inp(lds, I_WOUT) + (size_t)l * DM * DM, DM, DM, (bf16_t*)(ws + WS_WOUT) + (size_t)l * DM * DM, nullptr, false, scr, r - I_IN, DM / 32, lane);
    }
    if (small) {
        const int gt = vb * 512 + tid, NT_ = nvb * 512;
        const float* wup = inp(lds, I_RWUP); const float* aup = inp(lds, I_RAUP); bf16_t* WUPT = (bf16_t*)(ws + WS_WUPT); bf16_t* AUPT = (bf16_t*)(ws + WS_AUPT);
        for (int idx = gt; idx < NL * 768 * 96; idx += NT_) { const int i = idx % 96, j = (idx / 96) % 768, l = idx / (96 * 768); const size_t src = ((size_t)l * 96 + i) * 768 + j; WUPT[idx] = f2bf(wup[src]); AUPT[idx] = f2bf(aup[src]); }
        const float* wx = inp(lds, I_LWX); const float* wa = inp(lds, I_LWA); bf16_t* WXT = (bf16_t*)(ws + WS_WXT); bf16_t* WAT = (bf16_t*)(ws + WS_WAT);
        for (int idx = gt; idx < NL * 8 * 64 * 64; idx += NT_) { const int i = idx & 63, j = (idx >> 6) & 63, ln = idx >> 12; const size_t src = ((size_t)ln * 64 + i) * 64 + j; WXT[idx] = f2bf(wx[src]); WAT[idx] = f2bf(wa[src]); }
    }
}
__device__ __forceinline__ void phase_rms(const float* xin, bf16_t* xb) {
    const int tid = tid_l(), wave = tid >> 6, lane = tid & 63;
    const int gw = bid_l() * 8 + wave, NGW = gdim_l() * 8;
    for (int m = gw; m < NTOK; m += NGW) {
        const f32x4* xr = (const f32x4*)(xin + (size_t)m * DM) + lane;
        f32x4 v[8]; float s = 0.f;
#pragma unroll
        for (int j = 0; j < 8; ++j) { v[j] = xr[64 * j]; s += (v[j].x * v[j].x + v[j].y * v[j].y) + (v[j].z * v[j].z + v[j].w * v[j].w); }
        const float rstd = 1.0f / sqrtf(wave_sum(s) * (1.0f / DM) + 1e-6f);
        u32x2* o = (u32x2*)(xb + (size_t)m * DM) + lane;
#pragma unroll
        for (int j = 0; j < 8; ++j) { u32x2 w; w.x = pk2(v[j].x * rstd, v[j].y * rstd); w.y = pk2(v[j].z * rstd, v[j].w * rstd); o[64 * j] = w; }
    }
}
__device__ __forceinline__ void phase_final(const float* xin, const float* g, float* out) {
    const int tid = tid_l(), wave = tid >> 6, lane = tid & 63;
    const int gw = bid_l() * 8 + wave, NGW = gdim_l() * 8;
    for (int m = gw; m < NTOK; m += NGW) {
        const f32x4* xr = (const f32x4*)(xin + (size_t)m * DM) + lane;
        f32x4 v[8]; float s = 0.f;
#pragma unroll
        for (int j = 0; j < 8; ++j) { v[j] = xr[64 * j]; s += (v[j].x * v[j].x + v[j].y * v[j].y) + (v[j].z * v[j].z + v[j].w * v[j].w); }
        const float rstd = 1.0f / sqrtf(wave_sum(s) * (1.0f / DM) + 1e-6f);
        f32x4* o = (f32x4*)(out + (size_t)m * DM) + lane; const f32x4* gg = (const f32x4*)g + lane;
#pragma unroll
        for (int j = 0; j < 8; ++j) o[64 * j] = v[j] * rstd * gg[64 * j];
    }
}
struct EpiDual {
    static constexpr bool PERM = true, AFTER_DRAIN = false;
    int mode; bf16_t* O; int ldo; const float* base; float* C; int ldc;
    __device__ __forceinline__ void operator()(const pg8::f32x4 (&acc)[2][2][4][2], const pg8::Unit& u, int wr, int wc, int fr, int fq) const {
        const int row0 = u.pm * 256 + wr * 64 + fr, col0 = u.pn * 256 + wc * 32 + 8 * fq;
        if (mode == 0) {
#pragma unroll
            for (int ai = 0; ai < 2; ++ai)
#pragma unroll
                for (int m = 0; m < 4; ++m) { bf16_t* rowp = O + (size_t)(row0 + ai * 128 + m * 16) * ldo + col0;
#pragma unroll
                    for (int bj = 0; bj < 2; ++bj) { const pg8::f32x4 v0 = acc[ai][bj][m][0], v1 = acc[ai][bj][m][1];
                        pg8::u32x4 w; w.x = cvtpk(v0[0], v0[1]); w.y = cvtpk(v0[2], v0[3]); w.z = cvtpk(v1[0], v1[1]); w.w = cvtpk(v1[2], v1[3]);
                        *(pg8::u32x4*)(rowp + bj * 128) = w; } }
        } else {
#pragma unroll
            for (int ai = 0; ai < 2; ++ai)
#pragma unroll
                for (int m = 0; m < 4; ++m) { const size_t off = (size_t)(row0 + ai * 128 + m * 16) * ldc + col0;
#pragma unroll
                    for (int bj = 0; bj < 2; ++bj)
#pragma unroll
                        for (int n = 0; n < 2; ++n) { const pg8::f32x4 b = *(const pg8::f32x4*)(base + off + bj * 128 + n * 4); *(pg8::f32x4*)(C + off + bj * 128 + n * 4) = acc[ai][bj][m][n] + b; }
                    asm volatile("" ::: "memory"); }
        }
    }
};
constexpr int PT = 32;
typedef short bf16x8 __attribute__((ext_vector_type(8)));
__device__ __forceinline__ float sum16(float v) { v += __shfl_xor(v, 1); v += __shfl_xor(v, 2); v += __shfl_xor(v, 4); v += __shfl_xor(v, 8); return v; }
__device__ __forceinline__ void phase_prep(const Args& a, int l, LAS unsigned char* lds) {
    size_t wso_ = 0; asm volatile("" : "+s"(wso_)); unsigned char* ws = a.ws + wso_;
    const int tid0 = tid_l(), wave = __builtin_amdgcn_readfirstlane(tid0 >> 6);
    const bf16_t* PROJ = (const bf16_t*)(ws + WS_PROJ);
    constexpr int XSR = 200, XLR = 520;
    LAS bf16_t* xsb = (LAS bf16_t*)lds;
    LAS bf16_t* xlb = (LAS bf16_t*)(lds + PT * XSR * 2);
    LAS float* xlf = (LAS float*)(lds + PT * XSR * 2 + PT * XLR * 2);
    float* GQ = (float*)(ws + WS_GQ); float* GK = (float*)(ws + WS_GK); float* GV = (float*)(ws + WS_GV);
    float* GB = (float*)(ws + WS_GB); float* GG = (float*)(ws + WS_GG);
    float* RR = (float*)(ws + WS_RR); float* RWd = (float*)(ws + WS_RW); float* RK = (float*)(ws + WS_RK); float* RV = (float*)(ws + WS_RV);
    float* RKK = (float*)(ws + WS_RKK); float* RB = (float*)(ws + WS_RB);
    float* LA = (float*)(ws + WS_LA); float* LU = (float*)(ws + WS_LU);
    const float* mu = inp(lds, I_RMU) + l * 2496;
    for (int tile = bid_l(); tile < NTOK / PT; tile += gdim_l()) {
        int tid = tid0; asm volatile("" : "+v"(tid)); const int lane = tid & 63, lr = lane & 15, lq = lane >> 4;
        const int t0 = tile * PT, sp = t0 % SEQ;
        { bf16_t curv[12], prevv[12];
#pragma unroll
            for (int q = 0; q < 12; ++q) { const int idx = tid + 512 * q, tt = idx / 192, i = idx % 192; const int col = PC_CIN + 2304 + i;
                curv[q] = PROJ[(size_t)(t0 + tt) * NP + col]; prevv[q] = PROJ[(size_t)(t0 + tt - ((sp + tt > 0) ? 1 : 0)) * NP + col]; }
#pragma unroll
            for (int q = 0; q < 12; ++q) { const int idx = tid + 512 * q, tt = idx / 192, i = idx % 192; const float cur = bf2f(curv[q]), prev = (sp + tt > 0) ? bf2f(prevv[q]) : 0.f;
                float xs = cur + (prev - cur) * mu[2304 + i]; if (i < 96) xs = tanhf(xs); xsb[tt * XSR + i] = f2bf(xs); } }
        { const int j = tid; const float* cw = inp(lds, I_LCW) + l * 4 * LRUW; const float w0 = cw[j], w1 = cw[LRUW + j], w2 = cw[2 * LRUW + j], w3 = cw[3 * LRUW + j], cb = inp(lds, I_LCB)[l * LRUW + j];
            float xm3 = (sp >= 3) ? bf2f(PROJ[(size_t)(t0 - 3) * NP + PC_AX + j]) : 0.f, xm2 = (sp >= 2) ? bf2f(PROJ[(size_t)(t0 - 2) * NP + PC_AX + j]) : 0.f, xm1 = (sp >= 1) ? bf2f(PROJ[(size_t)(t0 - 1) * NP + PC_AX + j]) : 0.f;
            bf16_t cv[PT];
#pragma unroll
            for (int tt = 0; tt < PT; ++tt) cv[tt] = PROJ[(size_t)(t0 + tt) * NP + PC_AX + j];
#pragma unroll
            for (int tt = 0; tt < PT; ++tt) { const float cur = bf2f(cv[tt]); const float x = w0 * xm3 + w1 * xm2 + w2 * xm1 + w3 * cur + cb; xlf[tt * 512 + j] = x; xlb[tt * XLR + j] = f2bf(x); xm3 = xm2; xm2 = xm1; xm1 = cur; } }
        LBAR();
        for (int u = wave; u < 24; u += 8) { const int h = u % 12, tb = u / 12;
            bf16x8 xw[3], xa[3];
#pragma unroll
            for (int k = 0; k < 3; ++k) { xw[k] = *(const LAS bf16x8*)(xsb + (tb * 16 + lr) * XSR + 32 * k + 8 * lq); xa[k] = *(const LAS bf16x8*)(xsb + (tb * 16 + lr) * XSR + 96 + 32 * k + 8 * lq); }
            f32x4 aw[4], aa[4];
#pragma unroll
            for (int jq = 0; jq < 4; ++jq) { const int jrow = l * 768 + h * 64 + jq * 16 + lr; const bf16_t* pw = (const bf16_t*)(ws + WS_WUPT) + (size_t)jrow * 96 + 8 * lq; const bf16_t* pa = (const bf16_t*)(ws + WS_AUPT) + (size_t)jrow * 96 + 8 * lq;
                aw[jq] = (f32x4){0.f, 0.f, 0.f, 0.f}; aa[jq] = (f32x4){0.f, 0.f, 0.f, 0.f};
#pragma unroll
                for (int k = 0; k < 3; ++k) { aw[jq] = __builtin_amdgcn_mfma_f32_16x16x32_bf16(xw[k], *(const bf16x8*)(pw + 32 * k), aw[jq], 0, 0, 0); aa[jq] = __builtin_amdgcn_mfma_f32_16x16x32_bf16(xa[k], *(const bf16x8*)(pa + 32 * k), aa[jq], 0, 0, 0); } }
            const int tokb = tb * 16 + 4 * lq;
            bf16_t pr_[5][4], pk_[5][4], pv_[5][4];
#pragma unroll
            for (int rr = 0; rr < 5; ++rr) { const int trow = t0 + tokb + rr - ((rr == 0 && sp + tokb == 0) ? 0 : 1);
#pragma unroll
                for (int jq = 0; jq < 4; ++jq) { const bf16_t* p = PROJ + (size_t)trow * NP + PC_CIN + h * 64 + jq * 16 + lr; pr_[rr][jq] = p[0]; pk_[rr][jq] = p[768]; pv_[rr][jq] = p[1536]; } }
            float w0v[4], a0v[4], kkwv[4], kawv[4], murv[4], mukv[4], muvv[4];
#pragma unroll
            for (int jq = 0; jq < 4; ++jq) { const int j = h * 64 + jq * 16 + lr; w0v[jq] = inp(lds, I_RW0)[l * 768 + j]; a0v[jq] = inp(lds, I_RA0)[l * 768 + j]; kkwv[jq] = inp(lds, I_RKK)[l * 768 + j]; kawv[jq] = inp(lds, I_RKA)[l * 768 + j];
                murv[jq] = mu[j]; mukv[jq] = mu[768 + j]; muvv[jq] = mu[1536 + j]; }
#pragma unroll
            for (int r = 0; r < 4; ++r) { const bool first = (sp + tokb + r == 0);
                float kr[4], kv_[4], rv_[4], vv_[4], av_[4]; float ss = 0.f;
#pragma unroll
                for (int jq = 0; jq < 4; ++jq) { const float cr = bf2f(pr_[r + 1][jq]), ck = bf2f(pk_[r + 1][jq]), cvv = bf2f(pv_[r + 1][jq]);
                    const float qr = first ? 0.f : bf2f(pr_[r][jq]), qk = first ? 0.f : bf2f(pk_[r][jq]), qv = first ? 0.f : bf2f(pv_[r][jq]);
                    rv_[jq] = cr + (qr - cr) * murv[jq]; kv_[jq] = ck + (qk - ck) * mukv[jq]; vv_[jq] = cvv + (qv - cvv) * muvv[jq];
                    av_[jq] = sigmoidf_(a0v[jq] + aa[jq][r]); kr[jq] = kv_[jq] * kkwv[jq]; ss += kr[jq] * kr[jq]; }
                ss = sum16(ss); const float rs = 1.0f / sqrtf(ss + 1e-6f);
#pragma unroll
                for (int jq = 0; jq < 4; ++jq) { const size_t o = (size_t)(t0 + tokb + r) * 768 + h * 64 + jq * 16 + lr;
                    const float wlog = -softplusf_(-(w0v[jq] + aw[jq][r])) - 0.5f; RWd[o] = -__expf(wlog);
                    const float kk = kr[jq] * rs; RR[o] = rv_[jq]; RK[o] = kv_[jq] * (1.0f + (av_[jq] - 1.0f) * kawv[jq]); RV[o] = vv_[jq]; RKK[o] = kk; RB[o] = kk * av_[jq]; } }
        }
        for (int u = wave; u < 16; u += 8) { const int n = u & 7, tb = u >> 3;
            bf16x8 xg[2];
#pragma unroll
            for (int k = 0; k < 2; ++k) xg[k] = *(const LAS bf16x8*)(xlb + (tb * 16 + lr) * XLR + n * 64 + 32 * k + 8 * lq);
            f32x4 ax[4], ag[4];
#pragma unroll
            for (int jq = 0; jq < 4; ++jq) { const size_t jrow = (size_t)(l * 8 + n) * 64 + jq * 16 + lr; const bf16_t* px = (const bf16_t*)(ws + WS_WXT) + jrow * 64 + 8 * lq; const bf16_t* pa = (const bf16_t*)(ws + WS_WAT) + jrow * 64 + 8 * lq;
                ax[jq] = (f32x4){0.f, 0.f, 0.f, 0.f}; ag[jq] = (f32x4){0.f, 0.f, 0.f, 0.f};
#pragma unroll
                for (int k = 0; k < 2; ++k) { ax[jq] = __builtin_amdgcn_mfma_f32_16x16x32_bf16(xg[k], *(const bf16x8*)(px + 32 * k), ax[jq], 0, 0, 0); ag[jq] = __builtin_amdgcn_mfma_f32_16x16x32_bf16(xg[k], *(const bf16x8*)(pa + 32 * k), ag[jq], 0, 0, 0); } }
#pragma unroll
            for (int jq = 0; jq < 4; ++jq) { const int j = n * 64 + jq * 16 + lr; const float bx = inp(lds, I_LBX)[l * 512 + j], ba = inp(lds, I_LBA)[l * 512 + j]; const float spl = softplusf_(-inp(lds, I_LLAM)[l * 512 + j]);
#pragma unroll
                for (int r = 0; r < 4; ++r) { const int tt = tb * 16 + 4 * lq + r; const float gx = sigmoidf_(ax[jq][r] + bx), ga = sigmoidf_(ag[jq][r] + ba);
                    const float loga = -8.0f * ga * spl; const float av = __expf(loga); const float mult = sqrtf(fmaxf(-expm1f(2.0f * loga), 0.f));
                    LA[(size_t)(t0 + tt) * 512 + j] = av; LU[(size_t)(t0 + tt) * 512 + j] = mult * gx * xlf[tt * 512 + j]; } } }
        for (int wt = wave; wt < 18; wt += 8) { const int ch0 = 128 * wt + 2 * lane; const float* cw = inp(lds, I_GCW) + (size_t)l * 4 * 2304 + ch0;
            const f32x2 w0 = *(const f32x2*)(cw), w1 = *(const f32x2*)(cw + 2304), w2 = *(const f32x2*)(cw + 2 * 2304), w3 = *(const f32x2*)(cw + 3 * 2304);
            f32x2 xm3 = {0.f, 0.f}, xm2 = {0.f, 0.f}, xm1 = {0.f, 0.f};
            const bf16_t* pc = PROJ + PC_BQKV + ch0;
            if (sp >= 3) { const unsigned q = *(const unsigned*)(pc + (size_t)(t0 - 3) * NP); xm3.x = __uint_as_float(q << 16); xm3.y = __uint_as_float(q & 0xffff0000u); }
            if (sp >= 2) { const unsigned q = *(const unsigned*)(pc + (size_t)(t0 - 2) * NP); xm2.x = __uint_as_float(q << 16); xm2.y = __uint_as_float(q & 0xffff0000u); }
            if (sp >= 1) { const unsigned q = *(const unsigned*)(pc + (size_t)(t0 - 1) * NP); xm1.x = __uint_as_float(q << 16); xm1.y = __uint_as_float(q & 0xffff0000u); }
            float* dst = (wt < 6) ? GQ : (wt < 12 ? GK : GV); const int dch = ch0 % 768;
            unsigned qv[PT];
#pragma unroll
            for (int tt = 0; tt < PT; ++tt) qv[tt] = *(const unsigned*)(pc + (size_t)(t0 + tt) * NP);
#pragma unroll
            for (int tt = 0; tt < PT; ++tt) { const unsigned q = qv[tt]; f32x2 cur; cur.x = __uint_as_float(q << 16); cur.y = __uint_as_float(q & 0xffff0000u);
                f32x2 v = w0 * xm3 + w1 * xm2 + w2 * xm1 + w3 * cur; v.x = siluf_(v.x); v.y = siluf_(v.y);
                if (wt < 12) { const float ss = wave_sum(v.x * v.x + v.y * v.y); float sc = 1.0f / sqrtf(ss + 1e-6f); if (wt < 6) sc *= 0.08838834764831845f; v = v * sc; }
                *(f32x2*)(dst + (size_t)(t0 + tt) * 768 + dch) = v; xm3 = xm2; xm2 = xm1; xm1 = cur; } }
        if (tid < PT * 6) { const int tt = tid / 6, h = tid % 6; const float bl = bf2f(PROJ[(size_t)(t0 + tt) * NP + PC_BETA + h]), al = bf2f(PROJ[(size_t)(t0 + tt) * NP + PC_BA + h]);
            GB[(size_t)(t0 + tt) * 8 + h] = sigmoidf_(bl); GG[(size_t)(t0 + tt) * 8 + h] = -__expf(inp(lds, I_GALOG)[l * 6 + h]) * softplusf_(al + inp(lds, I_GDT)[l * 6 + h]); }
        LBAR();
    }
}
typedef short bf16x8 __attribute__((ext_vector_type(8)));
struct ScanRec { const bf16_t* M1; const bf16_t* M2; const bf16_t* M3; const bf16_t* M4T; const float* UT; const float* G; const bf16_t* VT; };
template <int D, int KZ, bool EXT>
__device__ __forceinline__ void scan_item(const ScanRec R0, int e0, float* OUT, int out_ld, LAS unsigned char* lds) {
    constexpr int NK1 = D / 32, NK2 = KZ / 32, NT3 = D / 64, SROW = D + 8, ZROW = KZ + 8, HD = EXT ? 64 : 128;
    constexpr bool LATE = true, GS = !EXT;
    const int tid = tid_l(), w = __builtin_amdgcn_readfirstlane(tid >> 6), lane = tid & 63, lr = lane & 15, lq = lane >> 4;
    const int cb = w >> 1, eb = w & 1;
    LAS bf16_t* ST = (LAS bf16_t*)lds;
    LAS bf16_t* ZT = (LAS bf16_t*)(lds + 2 * 32 * SROW * 2);
    constexpr int OSROW = 36;
    LAS float* OS = (LAS float*)(lds + 2 * 32 * SROW * 2 + 32 * ZROW * 2);
    for (int i = tid; i < 2 * 32 * SROW / 2; i += 512) ((LAS unsigned*)ST)[i] = 0u;
    f32x4 accs[NT3];
#pragma unroll
    for (int t = 0; t < NT3; ++t) accs[t] = (f32x4){0.f, 0.f, 0.f, 0.f};
    struct S1 { bf16x8 m1[NK1]; bf16x8 m2[LATE ? 1 : NK1]; f32x4 ut; };
    struct S2 { bf16x8 m3[NK2], m4[NT3][NK2]; f32x4 g[GS ? 1 : NT3]; float gs; u32x4 vt; };
    S1 p0, p1, p2; S2 q0, q1, q2;
    const int erow = e0 + eb * 16 + lr;
#define SCAN_LOAD1(s, n) do { \
        const bf16_t* a1_ = R0.M1 + (size_t)(n) * 64 * D + (cb * 16 + lr) * D + 8 * lq; const bf16_t* a2_ = R0.M2 + (size_t)(n) * 64 * D + (cb * 16 + lr) * D + 8 * lq; \
        _Pragma("unroll") for (int k = 0; k < NK1; ++k) { s.m1[k] = *(const bf16x8*)(a1_ + 32 * k); if (!LATE) s.m2[k] = *(const bf16x8*)(a2_ + 32 * k); } \
        s.ut = *(const f32x4*)(R0.UT + (size_t)(n) * HD * 64 + (size_t)erow * 64 + cb * 16 + 4 * lq); } while (0)
#define SCAN_LOAD2(s, n) do { \
        const bf16_t* a3_ = R0.M3 + (size_t)(n) * 64 * KZ + (cb * 16 + lr) * KZ + 8 * lq; \
        _Pragma("unroll") for (int k = 0; k < NK2; ++k) s.m3[k] = *(const bf16x8*)(a3_ + 32 * k); \
        _Pragma("unroll") for (int t = 0; t < NT3; ++t) { const int db = cb + 4 * t; const bf16_t* a4_ = R0.M4T + (size_t)(n) * D * KZ + (db * 16 + lr) * KZ + 8 * lq; \
            _Pragma("unroll") for (int k = 0; k < NK2; ++k) s.m4[t][k] = *(const bf16x8*)(a4_ + 32 * k); \
            if (!GS) s.g[t] = *(const f32x4*)(R0.G + (size_t)(n) * D + db * 16 + 4 * lq); } \
        if (GS) s.gs = R0.G[(size_t)(n) * D]; \
        if (EXT && tid < 256) s.vt = *(const u32x4*)(R0.VT + (size_t)(n) * 64 * 64 + (size_t)(e0 + (tid >> 3)) * 64 + (tid & 7) * 8); } while (0)
#define SCAN_STEP(n, par, c1, l1, c2, l2) do { \
        LAS bf16_t* STo = ST + (LATE ? (par) * 32 * SROW : 0); LAS bf16_t* STn = ST + (LATE ? (1 - (par)) * 32 * SROW : 0); \
        bf16x8 m2l[NK1]; if (LATE) { const bf16_t* a2_ = R0.M2 + (size_t)(n) * 64 * D + (cb * 16 + lr) * D + 8 * lq; _Pragma("unroll") for (int k = 0; k < NK1; ++k) m2l[k] = *(const bf16x8*)(a2_ + 32 * k); }     \
        if ((n) + 2 < 32) SCAN_LOAD1(l1, (n) + 2); \
        if ((n) + 2 < 32) SCAN_LOAD2(l2, (n) + 2); \
        f32x4 a1 = c1.ut, a2 = (f32x4){0.f, 0.f, 0.f, 0.f}; \
        _Pragma("unroll") for (int k = 0; k < NK1; ++k) { const bf16x8 y = *(const LAS bf16x8*)(STo + (eb * 16 + lr) * SROW + 32 * k + 8 * lq); \
            a1 = __builtin_amdgcn_mfma_f32_16x16x32_bf16(c1.m1[k], y, a1, 0, 0, 0); if (!LATE) a2 = __builtin_amdgcn_mfma_f32_16x16x32_bf16(c1.m2[k], y, a2, 0, 0, 0); } \
        { u32x2 zz; zz.x = cvtpk(a1[0], a1[1]); zz.y = cvtpk(a1[2], a1[3]); *(LAS u32x2*)(ZT + (eb * 16 + lr) * ZROW + cb * 16 + 4 * lq) = zz; } \
        if (EXT && tid < 256) *(LAS u32x4*)(ZT + (tid >> 3) * ZROW + 64 + (tid & 7) * 8) = c2.vt; \
        LBAR(); \
        bf16x8 z[NK2]; \
        _Pragma("unroll") for (int k = 0; k < NK2; ++k) z[k] = *(const LAS bf16x8*)(ZT + (eb * 16 + lr) * ZROW + 32 * k + 8 * lq); \
        _Pragma("unroll") for (int t = 0; t < NT3; ++t) { if (GS) accs[t] = accs[t] * c2.gs; else accs[t] = accs[t] * c2.g[GS ? 0 : t]; } \
        _Pragma("unroll") for (int k = 0; k < NK2; ++k) { a2 = __builtin_amdgcn_mfma_f32_16x16x32_bf16(c2.m3[k], z[k], a2, 0, 0, 0); \
            _Pragma("unroll") for (int t = 0; t < NT3; ++t) accs[t] = __builtin_amdgcn_mfma_f32_16x16x32_bf16(c2.m4[t][k], z[k], accs[t], 0, 0, 0); } \
        _Pragma("unroll") for (int t = 0; t < NT3; ++t) { const int db = cb + 4 * t; u32x2 ss; ss.x = cvtpk(accs[t][0], accs[t][1]); ss.y = cvtpk(accs[t][2], accs[t][3]); *(LAS u32x2*)(STn + (eb * 16 + lr) * SROW + db * 16 + 4 * lq) = ss; } \
        if (LATE) { _Pragma("unroll") for (int k = 0; k < NK1; ++k) { const bf16x8 y = *(const LAS bf16x8*)(STo + (eb * 16 + lr) * SROW + 32 * k + 8 * lq); a2 = __builtin_amdgcn_mfma_f32_16x16x32_bf16(m2l[k], y, a2, 0, 0, 0); } } \
        { _Pragma("unroll") for (int r = 0; r < 4; ++r) OS[(cb * 16 + 4 * lq + r) * OSROW + eb * 16 + lr] = a2[r]; } \
        LBAR(); \
        { const f32x4 ov = *(const LAS f32x4*)(OS + (tid >> 3) * OSROW + (tid & 7) * 4); *(f32x4*)(OUT + (size_t)((n) * 64 + (tid >> 3)) * out_ld + e0 + (tid & 7) * 4) = ov; } \
        } while (0)
    SCAN_LOAD1(p0, 0); SCAN_LOAD2(q0, 0); SCAN_LOAD1(p1, 1); SCAN_LOAD2(q1, 1);
    __builtin_amdgcn_s_waitcnt(0x0F70);
    LBAR();
    for (int n0 = 0; n0 < 30; n0 += 6) {
        SCAN_STEP(n0, 0, p0, p2, q0, q2);
        SCAN_STEP(n0 + 1, 1, p1, p0, q1, q0);
        SCAN_STEP(n0 + 2, 0, p2, p1, q2, q1);
        SCAN_STEP(n0 + 3, 1, p0, p2, q0, q2);
        SCAN_STEP(n0 + 4, 0, p1, p0, q1, q0);
        SCAN_STEP(n0 + 5, 1, p2, p1, q2, q1);
    }
    SCAN_STEP(30, 0, p0, p2, q0, q2);
    SCAN_STEP(31, 1, p1, p0, q1, q0);
#undef SCAN_STEP
#undef SCAN_LOAD1
#undef SCAN_LOAD2
}

__device__ __forceinline__ void phase_gdn_chunk(const Args& a, int l, LAS unsigned char* lds) {
    size_t wso_ = 0; asm volatile("" : "+s"(wso_)); unsigned char* ws = a.ws + wso_;
    const int tid0 = tid_l(), w = __builtin_amdgcn_readfirstlane(tid0 >> 6);
    const float* GQ = (const float*)(ws + WS_GQ); const float* GK = (const float*)(ws + WS_GK); const float* GV = (const float*)(ws + WS_GV);
    const float* GB = (const float*)(ws + WS_GB); const float* GG = (const float*)(ws + WS_GG);
    constexpr int KROW = 136;
    LAS bf16_t* Kb = (LAS bf16_t*)lds;
    LAS bf16_t* Qb = (LAS bf16_t*)(lds + 64 * KROW * 2);
    LAS float* Af = (LAS float*)(lds + 2 * 64 * KROW * 2);
    LAS float* dvb = Af + 64 * 64;
    const int first = bid_l(), gstep = gdim_l();
    const int nmine = (first < GCH) ? (GCH - first + gstep - 1) / gstep : 0;
    for (int k = -1; k < nmine; ++k) {
        int tid = tid0; asm volatile("" : "+v"(tid)); const int lane = tid & 63, lr = lane & 15, lq = lane >> 4;
        LBAR();
        if (w < 4) {
            const bool act = (k >= 0); const int item = first + (act ? k : 0) * gstep;
            const int b = item / 192, h = (item / 32) % 6, n = item % 32; const size_t t0 = (size_t)b * SEQ + n * 64;
            LAS float* dv = dvb + (k & 1) * 128; LAS float* bv = dv + 64;
            const int col = tid; const bool isu = (w < 2); const int cc = col & 127;
            float X[64]; int Arow[63];
            if (act) {
                const float* src = (isu ? GV : GK) + t0 * 768 + h * 128 + cc;
#pragma unroll
                for (int c = 0; c < 64; ++c) X[c] = src[(size_t)c * 768];
#pragma unroll
                for (int m = 0; m < 63; ++m) Arow[m] = __float_as_int(Af[m * 64 + lane]);
                if (isu) {
#pragma unroll
                    for (int c = 0; c < 64; ++c) X[c] *= bv[c]; }
                else {
#pragma unroll
                    for (int c = 0; c < 64; ++c) X[c] *= bv[c] * __expf(dv[c]); }
            }
            LBAR();
            if (act) {
#pragma unroll
                for (int m = 0; m < 63; ++m) { const float xm = X[m];
#pragma unroll
                    for (int c = m + 1; c < 64; ++c) X[c] -= __int_as_float(__builtin_amdgcn_readlane(Arow[m], c)) * xm; }
            }
            LBAR();
            if (act) {
                if (isu) { float* UT = (float*)(ws + WS_GU) + (size_t)item * 128 * 64 + (size_t)cc * 64;
#pragma unroll
                    for (int c4 = 0; c4 < 16; ++c4) *(f32x4*)(UT + 4 * c4) = (f32x4){X[4 * c4], X[4 * c4 + 1], X[4 * c4 + 2], X[4 * c4 + 3]}; }
                else { bf16_t* M1 = (bf16_t*)(ws + WS_G1) + (size_t)item * 64 * 128 + cc;
#pragma unroll
                    for (int c = 0; c < 64; ++c) M1[c * 128] = f2bf(-X[c]); }
            }
        } else {
            const bool act = (k + 1 < nmine); const int item = first + (act ? (k + 1) : 0) * gstep;
            const int b = item / 192, h = (item / 32) % 6, n = item % 32; const size_t t0 = (size_t)b * SEQ + n * 64;
            LAS float* dv = dvb + ((k + 1) & 1) * 128; LAS float* bv = dv + 64;
            const int t = tid - 256, wb = w - 4;
            if (act) {
                float gpre = 0.f, bpre = 0.f; if (wb == 0) { gpre = GG[(t0 + lane) * 8 + h]; bpre = GB[(t0 + lane) * 8 + h]; }
#pragma unroll
                for (int hf = 0; hf < 2; ++hf) { f32x4 kv4[4], qv4[4];
#pragma unroll
                    for (int q = 0; q < 4; ++q) { const int idx = t + 256 * (4 * hf + q), c = idx >> 5, d4 = idx & 31; const size_t g = (t0 + c) * 768 + h * 128 + d4 * 4; kv4[q] = *(const f32x4*)(GK + g); qv4[q] = *(const f32x4*)(GQ + g); }
#pragma unroll
                    for (int q = 0; q < 4; ++q) { const int idx = t + 256 * (4 * hf + q), c = idx >> 5, d4 = idx & 31; const f32x4 kv = kv4[q], qv = qv4[q];
                        u32x2 pk; pk.x = cvtpk(kv[0], kv[1]); pk.y = cvtpk(kv[2], kv[3]); *(LAS u32x2*)(Kb + c * KROW + d4 * 4) = pk;
                        u32x2 pq; pq.x = cvtpk(qv[0], qv[1]); pq.y = cvtpk(qv[2], qv[3]); *(LAS u32x2*)(Qb + c * KROW + d4 * 4) = pq; } }
                if (wb == 0) { float g = gpre;
#pragma unroll
                    for (int o = 1; o < 64; o <<= 1) { const float tt = __shfl_up(g, o); if (lane >= o) g += tt; }
                    dv[lane] = g; bv[lane] = bpre; }
            }
            LBAR();
            if (act) {
                const int which = wb >> 1; const LAS bf16_t* X = which ? Qb : Kb;
                bf16_t* M3 = (bf16_t*)(ws + WS_G3) + (size_t)item * 64 * 64;
#pragma unroll
                for (int ci = 0; ci < 2; ++ci) { const int cb = 2 * (wb & 1) + ci;
                    bf16x8 xf[4];
#pragma unroll
                    for (int kk = 0; kk < 4; ++kk) xf[kk] = *(const LAS bf16x8*)(X + (cb * 16 + lr) * KROW + 32 * kk + 8 * lq);
#pragma unroll
                    for (int mb = 0; mb < 4; ++mb) { f32x4 acc = (f32x4){0.f, 0.f, 0.f, 0.f};
#pragma unroll
                        for (int kk = 0; kk < 4; ++kk) { const bf16x8 yf = *(const LAS bf16x8*)(Kb + (mb * 16 + lr) * KROW + 32 * kk + 8 * lq); acc = __builtin_amdgcn_mfma_f32_16x16x32_bf16(xf[kk], yf, acc, 0, 0, 0); }
                        const int m = mb * 16 + lr; const float dm = dv[m];
                        if (which == 0) { f32x4 o;
#pragma unroll
                            for (int r = 0; r < 4; ++r) { const int c = cb * 16 + 4 * lq + r; o[r] = (c > m) ? bv[c] * acc[r] * __expf(dv[c] - dm) : 0.f; }
                            *(LAS f32x4*)(Af + m * 64 + cb * 16 + 4 * lq) = o; }
                        else {
#pragma unroll
                            for (int r = 0; r < 4; ++r) { const int c = cb * 16 + 4 * lq + r; M3[c * 64 + m] = f2bf((c >= m) ? acc[r] * __expf(dv[c] - dm) : 0.f); } } } }
            }
            LBAR();
            if (act) {
                const float dl = dv[63];
                bf16_t* M2 = (bf16_t*)(ws + WS_G2) + (size_t)item * 64 * 128;
#pragma unroll
                for (int q = 0; q < 8; ++q) { const int idx = t + 256 * q, c = idx >> 5, d4 = idx & 31; const u32x2 qq = *(const LAS u32x2*)(Qb + c * KROW + d4 * 4); const float e = __expf(dv[c]);
                    u32x2 p; p.x = cvtpk(__uint_as_float(qq.x << 16) * e, __uint_as_float(qq.x & 0xffff0000u) * e); p.y = cvtpk(__uint_as_float(qq.y << 16) * e, __uint_as_float(qq.y & 0xffff0000u) * e); *(u32x2*)(M2 + c * 128 + d4 * 4) = p; }
                { const int d = t & 127, ch = t >> 7; bf16_t* M4 = (bf16_t*)(ws + WS_G4) + (size_t)item * 128 * 64 + d * 64 + ch * 32;
#pragma unroll
                    for (int q = 0; q < 4; ++q) { float kv[8];
#pragma unroll
                        for (int j = 0; j < 8; ++j) { const int c = ch * 32 + q * 8 + j; kv[j] = bf2f(Kb[c * KROW + d]) * __expf(dl - dv[c]); }
                        u32x4 p; p.x = cvtpk(kv[0], kv[1]); p.y = cvtpk(kv[2], kv[3]); p.z = cvtpk(kv[4], kv[5]); p.w = cvtpk(kv[6], kv[7]); *(u32x4*)(M4 + q * 8) = p; } }
                if (t < 128) ((float*)(ws + WS_GGL))[(size_t)item * 128 + t] = __expf(dl);
            }
        }
    }
    LBAR();
}

__device__ __forceinline__ void phase_rwkv_chunk(const Args& a, int l, LAS unsigned char* lds) {
    size_t wso_ = 0; asm volatile("" : "+s"(wso_)); unsigned char* ws = a.ws + wso_;
    const int tid0 = tid_l(), w = __builtin_amdgcn_readfirstlane(tid0 >> 6);
    const float* RR = (const float*)(ws + WS_RR); const float* RWl = (const float*)(ws + WS_RW); const float* RK = (const float*)(ws + WS_RK); const float* RV = (const float*)(ws + WS_RV);
    const float* RKK = (const float*)(ws + WS_RKK); const float* RB = (const float*)(ws + WS_RB);
    constexpr int OR_ = 72;
    LAS float* cw = (LAS float*)lds;
    LAS bf16_t* M3s = (LAS bf16_t*)lds;
    LAS bf16_t* Al = (LAS bf16_t*)(lds + 16384); LAS bf16_t* Be = Al + 64 * OR_; LAS bf16_t* Ka = Be + 64 * OR_; LAS bf16_t* Rh = Ka + 64 * OR_;
    LAS float* ABf = (LAS float*)(lds + 53248);
    LAS bf16_t* AKb = (LAS bf16_t*)(lds + 69632);
    LAS bf16_t* VTb = (LAS bf16_t*)(lds + 78848);
    LAS float* RH2 = (LAS float*)(lds + 88064);
    LAS bf16_t* M4s = (LAS bf16_t*)(lds + 104448);
    LAS float* segt = (LAS float*)(lds + 121856);
    const int first = bid_l(), gstep = gdim_l();
    const int nmine = (first < RCH) ? (RCH - first + gstep - 1) / gstep : 0;
    if (w < 2) {
    for (int k = -1; k < nmine; ++k) {
        int tid = tid0; asm volatile("" : "+v"(tid)); const int lane = tid & 63, lr = lane & 15, lq = lane >> 4;
            const bool act = (k >= 0); const int item = first + (act ? k : 0) * gstep;
            const bool isom = (w == 0); const int cc = tid & 63;
            float X[64]; int Arow[63];
            if (act) {
                if (isom) {
#pragma unroll
                    for (int c = 0; c < 64; ++c) X[c] = bf2f(Al[c * OR_ + cc]); }
                else {
#pragma unroll
                    for (int c = 0; c < 64; ++c) X[c] = RH2[c * 64 + cc]; }
#pragma unroll
                for (int m = 0; m < 63; ++m) Arow[m] = __float_as_int(ABf[m * 64 + lane]);
            }
            LBAR();
#define RW_SOLVE(m0, m1) do { if (act) { _Pragma("unroll") for (int m = (m0); m < (m1); ++m) { const float xm = X[m]; \
                _Pragma("unroll") for (int c = m + 1; c < 64; ++c) X[c] -= __int_as_float(__builtin_amdgcn_readlane(Arow[m], c)) * xm; } } } while (0)
            RW_SOLVE(0, 30);
            LBAR();
            RW_SOLVE(30, 63);
            LBAR();
#undef RW_SOLVE
            if (act) {
                if (isom) { bf16_t* M1 = (bf16_t*)(ws + WS_R1) + (size_t)item * 4096 + cc;
#pragma unroll
                    for (int c = 0; c < 64; ++c) M1[c * 64] = f2bf(X[c]); }
                else { float* UT = (float*)(ws + WS_RU) + (size_t)item * 4096 + (size_t)cc * 64;
#pragma unroll
                    for (int c4 = 0; c4 < 16; ++c4) *(f32x4*)(UT + 4 * c4) = (f32x4){X[4 * c4], X[4 * c4 + 1], X[4 * c4 + 2], X[4 * c4 + 3]}; }
            }
            LBAR();
    }
    } else {
    float plw[16], pv[11], pkk[12], pbb[12], pk2[12], pr[12];
#define RWB_ISSUE(it) do { const int b_ = (it) / 384, h_ = ((it) / 32) % 12, n_ = (it) % 32; const size_t gb_ = ((size_t)b_ * SEQ + n_ * 64) * 768 + h_ * 64; const int t_ = tidp - 128, wb_ = w - 2; \
        if (wb_ < 4) { _Pragma("unroll") for (int q = 0; q < 16; ++q) plw[q] = RWl[gb_ + (size_t)(wb_ * 16 + q) * 768 + (tidp & 63)]; } \
        _Pragma("unroll") for (int q = 0; q < 11; ++q) { const int idx = t_ + 384 * q; const int c = (idx >> 6) & 63, i = idx & 63; pv[q] = RV[gb_ + (size_t)c * 768 + i]; } \
        _Pragma("unroll") for (int q = 0; q < 12; ++q) { const int idx = t_ + 384 * q; const int c = (idx >> 6) & 63, j = idx & 63; const size_t g = gb_ + (size_t)c * 768 + j; pkk[q] = RKK[g]; pbb[q] = RB[g]; pk2[q] = RK[g]; pr[q] = RR[g]; } } while (0)
    if (nmine > 0) { int tidp = tid0; asm volatile("" : "+v"(tidp)); RWB_ISSUE(first); }
    for (int k = -1; k < nmine; ++k) {
        int tid = tid0; asm volatile("" : "+v"(tid)); const int lane = tid & 63, lr = lane & 15, lq = lane >> 4;
            const bool act = (k + 1 < nmine); const int item = first + (act ? (k + 1) : 0) * gstep;
            const int b = item / 384, h = (item / 32) % 12, n = item % 32; const size_t gb = ((size_t)b * SEQ + n * 64) * 768 + h * 64;
            const int t = tid - 128, wb = w - 2;
            if (act) {
                if (wb < 4) {
                    float acc = 0.f;
#pragma unroll
                    for (int q = 0; q < 8; ++q) { acc += plw[q]; cw[(wb * 16 + q) * 64 + lane] = acc; }
                    segt[(2 * wb) * 64 + lane] = acc; acc = 0.f;
#pragma unroll
                    for (int q = 8; q < 16; ++q) { acc += plw[q]; cw[(wb * 16 + q) * 64 + lane] = acc; }
                    segt[(2 * wb + 1) * 64 + lane] = acc; }
#pragma unroll
                for (int q = 0; q < 11; ++q) { const int idx = t + 384 * q; const int c = idx >> 6, i = idx & 63; if (idx < 4096) VTb[i * OR_ + c] = f2bf(pv[q]); }
            }
            LBAR();
            if (act) {
#pragma unroll
                for (int hf = 0; hf < 2; ++hf) {
#pragma unroll
                    for (int q = 0; q < 6; ++q) { const int idx = t + 384 * (6 * hf + q); const int c = idx >> 6, j = idx & 63;
                        if (idx < 4096) {
                            float off = 0.f, offm = 0.f, tot = 0.f;
#pragma unroll
                            for (int s2 = 0; s2 < 8; ++s2) { const float st = segt[s2 * 64 + j]; if (s2 < (c >> 3)) off += st; if (c > 0 && s2 < ((c - 1) >> 3)) offm += st; tot += st; }
                            const float cwc = cw[c * 64 + j] + off, cwm = c ? cw[(c - 1) * 64 + j] + offm : 0.f, cwl = tot;
                            const float kk = pkk[6 * hf + q], bb = pbb[6 * hf + q], k2 = pk2[6 * hf + q], r = pr[6 * hf + q];
                            const float en = __expf(-cwc);
                            Al[c * OR_ + j] = f2bf(kk * __expf(cwm)); Be[c * OR_ + j] = f2bf(bb * en); Ka[c * OR_ + j] = f2bf(k2 * en); const bf16_t rh = f2bf(r * __expf(cwc)); Rh[c * OR_ + j] = rh;
                            ((bf16_t*)(ws + WS_R2))[(size_t)item * 4096 + c * 64 + j] = rh;
                            const float ed = __expf(cwl - cwc); M4s[j * 136 + c] = f2bf(-bb * ed); M4s[j * 136 + 64 + c] = f2bf(k2 * ed);
                            if (c == 63) ((float*)(ws + WS_RGL))[(size_t)item * 64 + j] = __expf(cwl); } } }
                if (k + 2 < nmine) { const int tidp = tid; RWB_ISSUE(first + (k + 2) * gstep); }
            }
            LBAR();
            if (act) {
                for (int pc = wb; pc < 16; pc += 6) { const int p = pc >> 2, cb = pc & 3; const LAS bf16_t* X = (p < 2) ? Al : Rh; const LAS bf16_t* Y = (p & 1) ? Ka : Be;
                    const bf16x8 x0 = *(const LAS bf16x8*)(X + (cb * 16 + lr) * OR_ + 8 * lq), x1 = *(const LAS bf16x8*)(X + (cb * 16 + lr) * OR_ + 32 + 8 * lq);
#pragma unroll
                    for (int mb = 0; mb < 4; ++mb) { f32x4 acc = (f32x4){0.f, 0.f, 0.f, 0.f};
                        acc = __builtin_amdgcn_mfma_f32_16x16x32_bf16(x0, *(const LAS bf16x8*)(Y + (mb * 16 + lr) * OR_ + 8 * lq), acc, 0, 0, 0);
                        acc = __builtin_amdgcn_mfma_f32_16x16x32_bf16(x1, *(const LAS bf16x8*)(Y + (mb * 16 + lr) * OR_ + 32 + 8 * lq), acc, 0, 0, 0);
                        const int m = mb * 16 + lr;
                        if (p == 0) { f32x4 o;
#pragma unroll
                            for (int r = 0; r < 4; ++r) { const int c = cb * 16 + 4 * lq + r; o[r] = (c > m) ? acc[r] : 0.f; }
                            *(LAS f32x4*)(ABf + m * 64 + cb * 16 + 4 * lq) = o; }
                        else {
#pragma unroll
                            for (int r = 0; r < 4; ++r) { const int c = cb * 16 + 4 * lq + r;
                                if (p == 1) AKb[c * OR_ + m] = f2bf((c > m) ? acc[r] : 0.f);
                                else if (p == 2) M3s[c * 128 + m] = f2bf((c >= m) ? -acc[r] : 0.f);
                                else M3s[c * 128 + 64 + m] = f2bf((c >= m) ? acc[r] : 0.f); } } } }
            }
            LBAR();
            if (act) {
                for (int tl = wb; tl < 16; tl += 6) { const int cb = tl >> 2, ib = tl & 3;
                    const bf16x8 x0 = *(const LAS bf16x8*)(AKb + (cb * 16 + lr) * OR_ + 8 * lq), x1 = *(const LAS bf16x8*)(AKb + (cb * 16 + lr) * OR_ + 32 + 8 * lq);
                    f32x4 acc = (f32x4){0.f, 0.f, 0.f, 0.f};
                    acc = __builtin_amdgcn_mfma_f32_16x16x32_bf16(x0, *(const LAS bf16x8*)(VTb + (ib * 16 + lr) * OR_ + 8 * lq), acc, 0, 0, 0);
                    acc = __builtin_amdgcn_mfma_f32_16x16x32_bf16(x1, *(const LAS bf16x8*)(VTb + (ib * 16 + lr) * OR_ + 32 + 8 * lq), acc, 0, 0, 0);
#pragma unroll
                    for (int r = 0; r < 4; ++r) RH2[(cb * 16 + 4 * lq + r) * 64 + ib * 16 + lr] = acc[r]; }
                u32x4* g3 = (u32x4*)((bf16_t*)(ws + WS_R3) + (size_t)item * 64 * 128);
                for (int q = t; q < 1024; q += 384) g3[q] = *(const LAS u32x4*)(M3s + q * 8);
                u32x4* g4 = (u32x4*)((bf16_t*)(ws + WS_R4) + (size_t)item * 64 * 128);
                for (int q = t; q < 1024; q += 384) g4[q] = *(const LAS u32x4*)(M4s + (q >> 4) * 136 + (q & 15) * 8);
                u32x4* gv = (u32x4*)((bf16_t*)(ws + WS_RVT) + (size_t)item * 64 * 64);
                for (int q = t; q < 512; q += 384) gv[q] = *(const LAS u32x4*)(VTb + (q >> 3) * OR_ + (q & 7) * 8);
            }
            LBAR();
    }
    }
    LBAR();
#undef RWB_ISSUE
}

__device__ __forceinline__ void phase_lru_chunk(const Args& a) {
    size_t wso_ = 0; asm volatile("" : "+s"(wso_)); unsigned char* ws = a.ws + wso_;
    const int tid = tid_l();
    const float* LA = (const float*)(ws + WS_LA); const float* LU = (const float*)(ws + WS_LU); float* LH = (float*)(ws + WS_LH); float* LP = (float*)(ws + WS_LP);
    for (int p = bid_l() * 512 + tid; p < 128 * 512; p += gdim_l() * 512) { const int chunk = p >> 9, c = p & 511; const size_t base = (size_t)chunk * 64 * 512 + c;
        float h = 0.f, cp = 1.f;
        for (int i0 = 0; i0 < 64; i0 += 16) { float av[16], uv[16];
#pragma unroll
            for (int i = 0; i < 16; ++i) { av[i] = LA[base + (size_t)(i0 + i) * 512]; uv[i] = LU[base + (size_t)(i0 + i) * 512]; }
#pragma unroll
            for (int i = 0; i < 16; ++i) { h = av[i] * h + uv[i]; cp *= av[i]; LH[base + (size_t)(i0 + i) * 512] = h; LP[base + (size_t)(i0 + i) * 512] = cp; } } }
}
constexpr int SB = 16;
__device__ __forceinline__ void phase_scan_naive(const Args& a, int l, LAS unsigned char* lds) {
    size_t wso_ = 0; asm volatile("" : "+s"(wso_)); unsigned char* ws = a.ws + wso_;
    const int tid = tid_l(), wave = __builtin_amdgcn_readfirstlane(tid >> 6), lane = tid & 63;
    const int blk = bid_l();
    if (blk < 96) {
        const int xq = blk >> 3, bh = (blk & 7) * 3 + (xq >> 2), es = xq & 3, b = bh / 6, h = bh % 6; const size_t ci = (size_t)bh * 32;
        ScanRec R{(const bf16_t*)(ws + WS_G1) + ci * 64 * 128, (const bf16_t*)(ws + WS_G2) + ci * 64 * 128, (const bf16_t*)(ws + WS_G3) + ci * 64 * 64, (const bf16_t*)(ws + WS_G4) + ci * 128 * 64,
                  (const float*)(ws + WS_GU) + ci * 128 * 64, (const float*)(ws + WS_GGL) + ci * 128, nullptr};
        scan_item<128, 64, false>(R, es * 32, (float*)(ws + WS_GO) + (size_t)b * SEQ * 768 + h * 128, 768, lds);
    } else if (blk < 192) {
        const int it = blk - 96, xq = it >> 3, bh = (it & 7) * 6 + (xq >> 1), es = xq & 1, b = bh / 12, h = bh % 12; const size_t ci = (size_t)bh * 32;
        ScanRec R{(const bf16_t*)(ws + WS_R1) + ci * 4096, (const bf16_t*)(ws + WS_R2) + ci * 4096, (const bf16_t*)(ws + WS_R3) + ci * 8192, (const bf16_t*)(ws + WS_R4) + ci * 8192,
                  (const float*)(ws + WS_RU) + ci * 4096, (const float*)(ws + WS_RGL) + ci * 64, (const bf16_t*)(ws + WS_RVT) + ci * 4096};
        scan_item<64, 128, true>(R, es * 32, (float*)(ws + WS_RY) + (size_t)b * SEQ * 768 + h * 64, 768, lds);
    } else if (blk < 196) {
        const int gidx = (blk - 192) * 512 + tid, b = gidx >> 9, c = gidx & 511;
        const float* LH = (const float*)(ws + WS_LH); const float* LP = (const float*)(ws + WS_LP); float* LC = (float*)(ws + WS_LC);
        float pe[32], he[32];
#pragma unroll
        for (int n = 0; n < 32; ++n) { const size_t o = ((size_t)b * SEQ + n * 64 + 63) * 512 + c; pe[n] = LP[o]; he[n] = LH[o]; }
        float carry = 0.f;
#pragma unroll
        for (int n = 0; n < 32; ++n) { LC[(size_t)(b * 32 + n) * 512 + c] = carry; carry = pe[n] * carry + he[n]; }
    } else if (l + 1 < NL && CONV_SPLIT > 0) {
        phase_convert(a, lds, l + 1, l + 2, 0, CONV_SPLIT, blk - 196, gdim_l() - 196, 0);
    }
}
__device__ __forceinline__ void phase_fin(const Args& a, int l, LAS unsigned char* lds) {
    size_t wso_ = 0; asm volatile("" : "+s"(wso_)); unsigned char* ws = a.ws + wso_;
    const int tid = tid_l(), wave = tid >> 6, lane = tid & 63;
    const int gw = bid_l() * 8 + wave, NGW = gdim_l() * 8;
    const bf16_t* PROJ = (const bf16_t*)(ws + WS_PROJ); bf16_t* Y = (bf16_t*)(ws + WS_Y);
    const float* GO = (const float*)(ws + WS_GO); const float* RY = (const float*)(ws + WS_RY);
    const float* RR = (const float*)(ws + WS_RR); const float* RK = (const float*)(ws + WS_RK); const float* RV = (const float*)(ws + WS_RV);
    const float* LH = (const float*)(ws + WS_LH); const float* LP = (const float*)(ws + WS_LP); const float* LC = (const float*)(ws + WS_LC);
    const f32x2 ng = *(const f32x2*)(inp(lds, I_GNG) + l * 128 + 2 * lane);
    float gnw[12], gnb[12], rkw[12];
#pragma unroll
    for (int h = 0; h < 12; ++h) { gnw[h] = inp(lds, I_RGNW)[l * 768 + h * 64 + lane]; gnb[h] = inp(lds, I_RGNB)[l * 768 + h * 64 + lane]; rkw[h] = inp(lds, I_RRK)[l * 768 + h * 64 + lane]; }
    for (int t = gw; t < NTOK; t += NGW) {
        const f32x4 h0 = *(const f32x4*)(LH + (size_t)t * 512 + 8 * lane), h1 = *(const f32x4*)(LH + (size_t)t * 512 + 8 * lane + 4);
        const f32x4 p0 = *(const f32x4*)(LP + (size_t)t * 512 + 8 * lane), p1 = *(const f32x4*)(LP + (size_t)t * 512 + 8 * lane + 4);
        const f32x4 c0 = *(const f32x4*)(LC + (size_t)(t >> 6) * 512 + 8 * lane), c1 = *(const f32x4*)(LC + (size_t)(t >> 6) * 512 + 8 * lane + 4);
        const u32x4 gq = *(const u32x4*)(PROJ + (size_t)t * NP + PC_AG + 8 * lane);
        f32x2 go[6]; unsigned gg[6];
#pragma unroll
        for (int h = 0; h < 6; ++h) { go[h] = *(const f32x2*)(GO + (size_t)t * 768 + h * 128 + 2 * lane); gg[h] = *(const unsigned*)(PROJ + (size_t)t * NP + PC_BG + h * 128 + 2 * lane); }
        float ry[12], rr[12], rk[12], rv[12]; bf16_t rg[12];
#pragma unroll
        for (int h = 0; h < 12; ++h) { const size_t o = (size_t)t * 768 + h * 64 + lane; ry[h] = RY[o]; rr[h] = RR[o]; rk[h] = RK[o]; rv[h] = RV[o]; rg[h] = PROJ[(size_t)t * NP + PC_CG + h * 64 + lane]; }
        { const f32x4 v0 = h0 + p0 * c0, v1 = h1 + p1 * c1;
            u32x4 o; o.x = cvtpk(v0[0] * siluf_(__uint_as_float(gq.x << 16)), v0[1] * siluf_(__uint_as_float(gq.x & 0xffff0000u)));
            o.y = cvtpk(v0[2] * siluf_(__uint_as_float(gq.y << 16)), v0[3] * siluf_(__uint_as_float(gq.y & 0xffff0000u)));
            o.z = cvtpk(v1[0] * siluf_(__uint_as_float(gq.z << 16)), v1[1] * siluf_(__uint_as_float(gq.z & 0xffff0000u)));
            o.w = cvtpk(v1[2] * siluf_(__uint_as_float(gq.w << 16)), v1[3] * siluf_(__uint_as_float(gq.w & 0xffff0000u)));
            *(u32x4*)(Y + (size_t)t * DM + 8 * lane) = o; }
#pragma unroll
        for (int h = 0; h < 6; ++h) { const f32x2 o = go[h]; const float ss = wave_sum(o.x * o.x + o.y * o.y); const float sc = 1.0f / sqrtf(ss * (1.0f / 128.f) + 1e-6f);
            const float g0 = __uint_as_float(gg[h] << 16), g1 = __uint_as_float(gg[h] & 0xffff0000u);
            *(unsigned*)(Y + (size_t)t * DM + 512 + h * 128 + 2 * lane) = cvtpk(o.x * sc * ng.x * siluf_(g0), o.y * sc * ng.y * siluf_(g1)); }
#pragma unroll
        for (int h = 0; h < 12; ++h) { const float y = ry[h]; const float mean = wave_sum(y) * (1.0f / 64.f); const float d = y - mean; const float var = wave_sum(d * d) * (1.0f / 64.f);
            float yn = d * (1.0f / sqrtf(var + 64e-5f)) * gnw[h] + gnb[h];
            const float sdot = wave_sum(rr[h] * rk[h] * rkw[h]); yn += sdot * rv[h];
            Y[(size_t)t * DM + 1280 + h * 64 + lane] = f2bf(yn * siluf_(bf2f(rg[h]))); }
    }
}
#define XB_TMO      128
#define XB_XCNT(j)  (256  + 64 * (j))
#define XB_XSUB(j)  (1280 + 64 * (j))
#define XB_XGEN(j)  (2304 + 64 * (j))
#define XB_TOP      3328
#define XB_TOPGEN   3392
#define XCD_BAR_WORDS 3456
#define XB_SPIN_CAP (1u << 18)
__device__ __forceinline__ unsigned xb_ld(unsigned* p)              { return __hip_atomic_load(p, __ATOMIC_RELAXED, __HIP_MEMORY_SCOPE_AGENT); }
__device__ __forceinline__ unsigned xb_add(unsigned* p, unsigned v) { return __hip_atomic_fetch_add(p, v, __ATOMIC_RELAXED, __HIP_MEMORY_SCOPE_AGENT); }
__device__ __forceinline__ unsigned xb_xcc_id() { return (unsigned)__builtin_amdgcn_s_getreg((3 << 11) | 20) & 0xFu; }
#define XB_SPIN(cond, bar) do { unsigned _sp = 0; while (cond) { __builtin_amdgcn_s_sleep(1); \
    if ((++_sp & 255u) == 0u) { if (xb_ld(&(bar)[XB_TMO])) break; if (_sp > XB_SPIN_CAP) { atomicAdd(&(bar)[XB_TMO], 1u); break; } } } } while (0)

struct XcdBarrier {
    unsigned* bar; unsigned x;
    volatile LAS unsigned* st;
};

__device__ __forceinline__ XcdBarrier xcd_barrier_post(unsigned* bar, volatile LAS unsigned* st) {
    XcdBarrier b; b.bar = bar; b.x = xb_xcc_id(); b.st = st;
    if (threadIdx.x == 0) (void)xb_add(&bar[XB_XCNT(b.x)], 1u);
    return b;
}
__device__ __forceinline__ void xcd_barrier_complete(unsigned* bar, unsigned x, unsigned& nloc, unsigned& nx) {
    const unsigned G = gridDim.x * gridDim.y * gridDim.z;
    unsigned sum, cnt, mine, sp = 0u;
    for (;;) {
        sum = 0u; cnt = 0u; mine = 0u;
#pragma unroll
        for (unsigned j = 0; j < 16; ++j) { const unsigned c = xb_ld(&bar[XB_XCNT(j)]); sum += c; cnt += (c > 0u) ? 1u : 0u; mine = (j == x) ? c : mine; }
        if (sum == G) break;
        __builtin_amdgcn_s_sleep(1);
        if ((++sp & 255u) == 0u) { if (xb_ld(&bar[XB_TMO])) break; if (sp > XB_SPIN_CAP) { atomicAdd(&bar[XB_TMO], 1u); break; } }
    }
    nloc = mine > 0u ? mine : 1u; nx = cnt > 0u ? cnt : 1u;
}

__device__ __forceinline__ void xcd_barrier(const XcdBarrier& b) {
    asm volatile("s_waitcnt vmcnt(0)" ::: "memory");
    __syncthreads();
    if (threadIdx.x == 0) {
        unsigned* bar = b.bar;
        __builtin_amdgcn_s_waitcnt(0);
        unsigned nloc = b.st[0], nx = b.st[1];
        if (nloc == 0u) { xcd_barrier_complete(bar, b.x, nloc, nx); b.st[0] = nloc; b.st[1] = nx; }
        const unsigned old = xb_add(&bar[XB_XSUB(b.x)], 1u);
        const unsigned gen = old / nloc;
        if (old + 1u == (gen + 1u) * nloc) {
            __builtin_amdgcn_fence(__ATOMIC_RELEASE, "agent");
            asm volatile("s_waitcnt vmcnt(0)" ::: "memory");
            const unsigned og = xb_add(&bar[XB_TOP], 1u);
            const unsigned tg = og / nx;
            if (og + 1u == (tg + 1u) * nx) xb_add(&bar[XB_TOPGEN], 1u);
            else XB_SPIN(xb_ld(&bar[XB_TOPGEN]) == tg, bar);
            __builtin_amdgcn_fence(__ATOMIC_ACQUIRE, "agent");
            xb_add(&bar[XB_XGEN(b.x)], 1u);
            asm volatile("s_waitcnt vmcnt(0)" ::: "memory");
        } else {
            XB_SPIN(xb_ld(&bar[XB_XGEN(b.x)]) == gen, bar);
            __builtin_amdgcn_fence(__ATOMIC_ACQUIRE, "agent");
            asm volatile("s_waitcnt vmcnt(0)" ::: "memory");
        }
    }
    __syncthreads();
}


__global__ void __launch_bounds__(512) mk_fwd(Args a) {
    extern __shared__ __attribute__((aligned(16))) unsigned char lds_raw[];
    LAS unsigned char* lds = (LAS unsigned char*)lds_raw;
    cg::grid_group grid = cg::this_grid();
    const int lo = a.ph_lo, hi = a.ph_hi;
    if (threadIdx.x < 26) { const unsigned long long p = (unsigned long long)a.in[threadIdx.x]; LAS unsigned* t = (LAS unsigned*)(lds + 131072) + 2 * threadIdx.x; t[0] = (unsigned)p; t[1] = (unsigned)(p >> 32); }
    if (threadIdx.x == 0) { LAS unsigned* z = (LAS unsigned*)(lds + 131072 + 256); z[0] = 0u; z[1] = 0u; z[2] = 0u; z[3] = 0u; }
    __syncthreads();
    XcdBarrier xb = xcd_barrier_post((unsigned*)(a.ws + WS_BAR), (volatile LAS unsigned*)(lds + 131072 + 256));
    float* XR = (float*)(a.ws + WS_XR); bf16_t* XB = (bf16_t*)(a.ws + WS_XB); bf16_t* PROJ = (bf16_t*)(a.ws + WS_PROJ); bf16_t* Y = (bf16_t*)(a.ws + WS_Y);
    for (int ph = lo; ph < hi; ++ph) {
      const int nrep = (REPMASK && ph > 0 && ph < NPHASE - 1 && ((REPMASK >> ((ph - 1) % PPL)) & 1)) ? 2 : 1;
      for (int rep = 0; rep < nrep; ++rep) {
        if (ph == 0) { phase_convert(a, lds, 0, 1, 0, 64, bid_l(), gdim_l(), 1); }
        else if (ph == NPHASE - 1) phase_final(XR, inp(lds, I_FNG), a.out);
        else { const int l = (ph - 1) / PPL, s = (ph - 1) % PPL; const float* xin = (l == 0) ? inp(lds, I_X) : XR;
            if (s == 0) { if (!(SKIPMASK & 2)) phase_rms(xin, XB); }
            else if (s == 1 || s == 6) { if (!(SKIPMASK & 4)) {
                pg8::Gemm g; EpiDual E;
                if (s == 1) { g = pg8::Gemm{XB, (const bf16_t*)(a.ws + WS_WIN) + (size_t)l * NP * DM, NTOK, NP, DM}; E = EpiDual{0, PROJ, NP, nullptr, nullptr, 0}; }
                else { g = pg8::Gemm{Y, (const bf16_t*)(a.ws + WS_WOUT) + (size_t)l * DM * DM, NTOK, DM, DM}; E = EpiDual{1, nullptr, 0, xin, XR, DM}; }
                pg8::StaticOrder S; S.init(NTOK, g.N, gdim_l(), bid_l());
                pg8::gemm_phase<EpiDual, pg8::StaticOrder>(lds, g, S, E, nullptr);
                if (s == 1 && l + 1 < NL) { const int nfull = (NTOK / 256) * (NP / 256) - 3 * gdim_l();
                    if (nfull > 0 && nfull < gdim_l() && bid_l() >= nfull) phase_convert(a, lds, l + 1, l + 2, CONV_SPLIT, 64, bid_l() - nfull, gdim_l() - nfull, 0);
                    else if (nfull <= 0 || nfull >= gdim_l()) phase_convert(a, lds, l + 1, l + 2, CONV_SPLIT, 64, bid_l(), gdim_l(), 0); } } }
            else if (s == 2) { if (!(SKIPMASK & 8)) phase_prep(a, l, lds); }
            else if (s == 3) { phase_gdn_chunk(a, l, lds); if (CHUNKREP & 1) phase_gdn_chunk(a, l, lds); phase_rwkv_chunk(a, l, lds); if (CHUNKREP & 2) phase_rwkv_chunk(a, l, lds); phase_lru_chunk(a); if (CHUNKREP & 4) phase_lru_chunk(a); }
            else if (s == 4) { if (!(SKIPMASK & 16)) phase_scan_naive(a, l, lds); }
            else if (s == 5) { if (!(SKIPMASK & 32)) phase_fin(a, l, lds); }
        }
      }
        if (ph + 1 < hi) { if (ph == 0) grid.sync(); else xcd_barrier(xb); }
    }
}

extern "C" void kernel_launch(void* const* d_in, const int* in_sizes, int n_in, void* d_out, int out_size, void* d_ws, size_t ws_size, hipStream_t stream) {
    static int grid = 0;
    if (grid == 0) {
        if (n_in != 26 || ws_size < WS_END) { fprintf(stderr, "kernel_launch: unexpected n_in %d or ws_size %zu < %zu\n", n_in, ws_size, (size_t)WS_END); grid = -1; return; }
        int dev = 0, cus = 0, per_cu = 0;
        hipGetDevice(&dev); hipDeviceGetAttribute(&cus, hipDeviceAttributeMultiprocessorCount, dev);
        if (hipFuncSetAttribute((const void*)mk_fwd, hipFuncAttributeMaxDynamicSharedMemorySize, LDS_BYTES) != hipSuccess) { fprintf(stderr, "hipFuncSetAttribute failed\n"); grid = -1; return; }
        if (hipOccupancyMaxActiveBlocksPerMultiprocessor(&per_cu, (const void*)mk_fwd, 512, LDS_BYTES) != hipSuccess || per_cu < 1) { fprintf(stderr, "occupancy query failed / 0\n"); grid = -1; return; }
        grid = cus;
    }
    if (grid < 0) return;
    if (hipMemsetAsync((char*)d_ws + WS_BAR, 0, 16384, stream) != hipSuccess) { fprintf(stderr, "memset of barrier words failed\n"); return; }
    Args a{};
    for (int i = 0; i < 26; ++i) a.in[i] = (const float*)d_in[i];
    a.out = (float*)d_out; a.ws = (unsigned char*)d_ws;
#if N_LAUNCH_MODE == 1
    a.ph_lo = 0; a.ph_hi = NPHASE;
    void* args[] = {&a};
    hipError_t e = hipLaunchCooperativeKernel((const void*)mk_fwd, dim3(grid), dim3(512), args, LDS_BYTES, stream);
    if (e != hipSuccess) fprintf(stderr, "cooperative launch failed: %s (grid %d)\n", hipGetErrorString(e), grid);
#else
    for (int ph = 0; ph < NPHASE; ++ph) { a.ph_lo = ph; a.ph_hi = ph + 1; hipLaunchKernelGGL(mk_fwd, dim3(grid), dim3(512), LDS_BYTES, stream, a); }
#endif
}
```

```cpp
#include <hip/hip_runtime.h>
#include <hip/hip_cooperative_groups.h>
#include <cstdio>
#include <cstdint>
namespace cg = cooperative_groups;
namespace pg8 {
#define PG8_LAS __attribute__((address_space(3)))
typedef unsigned short bf16_t;
typedef short bf16x8 __attribute__((ext_vector_type(8)));
typedef float f32x4 __attribute__((ext_vector_type(4)));
typedef unsigned u32x4 __attribute__((ext_vector_type(4)));
constexpr int BM = 256, BK = 64, HALF = 128, HTB = HALF * BK * 2  , STAGE_BYTES = 8 * HTB, NXCD = 8, WGM = 8;

__host__ __device__ __forceinline__ int lds_byte(int r, int c) { const int st = (r >> 4) * 2 + (c >> 5), rr = r & 15, cc = c & 31, ob = rr * 64 + cc * 2; return st * 1024 + (ob ^ (((ob >> 9) & 1) << 5)); }
__host__ __device__ __forceinline__ void stage_rc(int b, int& R, int& C) { const int st = b / 1024, sb = b % 1024, swz = sb ^ (((sb >> 9) & 1) << 5); R = (st >> 1) * 16 + swz / 64; C = (st & 1) * 32 + (swz % 64) / 2; }
__host__ __device__ __forceinline__ int perm32(int rho) { const int n = rho >> 4, i = rho & 15; return 8 * (i >> 2) + 4 * n + (i & 3); }

struct Unit { int pm, pn; };
struct Gemm { const bf16_t* A; const bf16_t* Bt; int M, N, K; };

struct StaticOrder {
    int nM, nN, nwg, G, c;
    __host__ __device__ void init(int M, int N, int G_, int c_) { nM = M / BM; nN = N / BM; nwg = nM * nN; G = G_; c = c_; }
    __host__ __device__ bool next(int i, Unit& u) const {
        const long L = (long)i * G + c; if (L >= nwg) return false;
        int wgid = (int)L; { const int q = nwg / NXCD, r = nwg % NXCD, xcd = wgid % NXCD, off = wgid / NXCD; wgid = (xcd < r ? xcd * (q + 1) : r * (q + 1) + (xcd - r) * q) + off; }
        const int nig = WGM * nN, gid = wgid / nig, fm = gid * WGM, gsz = (nM - fm) < WGM ? (nM - fm) : WGM;
        u.pm = fm + ((wgid % nig) % gsz); u.pn = (wgid % nig) / gsz; return true;
    }
    __device__ __forceinline__ void a_ready(const Unit&) const {}
    __device__ __forceinline__ void done(const Unit&) const {}
};
struct CountedOrder : StaticOrder {
    const unsigned* ready; unsigned need; unsigned* tmo;
    __device__ __forceinline__ void a_ready(const Unit& u) const {
        if (threadIdx.x < 64) {
            const unsigned long long t0 = __builtin_amdgcn_s_memrealtime(); unsigned polls = 0;
            while ((unsigned)__builtin_amdgcn_readfirstlane(__hip_atomic_load(ready + 64 * u.pm, __ATOMIC_RELAXED, __HIP_MEMORY_SCOPE_AGENT)) < need) {
                if ((++polls & 255u) == 0u && __builtin_amdgcn_readfirstlane(__hip_atomic_load(tmo, __ATOMIC_RELAXED, __HIP_MEMORY_SCOPE_AGENT)) != 0u) break;
                if (__builtin_amdgcn_s_memrealtime() - t0 > 2000000ull) {
                    if (threadIdx.x == 0) { unsigned expect = 0u; __hip_atomic_compare_exchange_strong(tmo + 1, &expect, 0x600u | (unsigned)(u.pm & 0xff), __ATOMIC_RELAXED, __ATOMIC_RELAXED, __HIP_MEMORY_SCOPE_AGENT); __hip_atomic_store(tmo, 1u, __ATOMIC_RELAXED, __HIP_MEMORY_SCOPE_AGENT); }
                    break; }
                __builtin_amdgcn_s_sleep(2); }
            __builtin_amdgcn_fence(__ATOMIC_ACQUIRE, "agent");
            asm volatile("s_waitcnt vmcnt(0)" ::: "memory");
        }
#if !defined(BROKEN_HOOK_NO_BARRIER)
        asm volatile("" ::: "memory"); __builtin_amdgcn_s_barrier(); asm volatile("" ::: "memory");
#endif
    }
};

__device__ __forceinline__ unsigned cvt_pk_bf16(float lo, float hi) { unsigned r; asm volatile("v_cvt_pk_bf16_f32 %0, %1, %2" : "=v"(r) : "v"(lo), "v"(hi)); return r; }
typedef float f32x2 __attribute__((ext_vector_type(2)));
__device__ __forceinline__ f32x2 gelu_pk(f32x2 v) {
    const f32x2 av = __builtin_elementwise_abs(v), d = av * 0.2316418882f + 1.0f;
    f32x2 t; t.x = __builtin_amdgcn_rcpf(d.x); t.y = __builtin_amdgcn_rcpf(d.y);
    f32x2 q = t * 0.5307027145f + (-0.7265760135f); q = q * t + 0.7107068705f; q = q * t + (-0.142248368f); q = q * t + 0.127414796f; q = q * t;
    const f32x2 s = (v * v) * (-0.72134752044f);
    f32x2 e; e.x = __builtin_amdgcn_exp2f(s.x); e.y = __builtin_amdgcn_exp2f(s.y);
    const f32x2 m = v * (q * e), r = v - m;
    f32x2 o; o.x = v.x < 0.f ? m.x : r.x; o.y = v.y < 0.f ? m.y : r.y; return o;
}

struct EpiF32 {
    static constexpr bool PERM = false, AFTER_DRAIN = false;
    float* C; int ldc; const float* bias;
    __device__ __forceinline__ void operator()(const f32x4 (&acc)[2][2][4][2], const Unit& u, int wr, int wc, int fr, int fq) const {
        const int row0 = u.pm * BM + wr * 64 + fr, col0 = u.pn * BM + wc * 32 + 4 * fq;
        f32x4 bv[2][2];
#pragma unroll
        for (int bj = 0; bj < 2; ++bj)
#pragma unroll
            for (int n = 0; n < 2; ++n) bv[bj][n] = bias ? *(const f32x4*)(bias + col0 + bj * HALF + n * 16) : (f32x4){0.f, 0.f, 0.f, 0.f};
#pragma unroll
        for (int ai = 0; ai < 2; ++ai)
#pragma unroll
            for (int m = 0; m < 4; ++m) { float* rowp = C + (size_t)(row0 + ai * HALF + m * 16) * ldc + col0;
#pragma unroll
                for (int bj = 0; bj < 2; ++bj)
#pragma unroll
                    for (int n = 0; n < 2; ++n) *(f32x4*)(rowp + bj * HALF + n * 16) = acc[ai][bj][m][n] + bv[bj][n]; }
    }
};
template <int ACT  > struct EpiBf16 {
    static constexpr bool PERM = true, AFTER_DRAIN = false;
    bf16_t* O; int ldc; const float* bias; int split_cols; size_t split_stride;
    __device__ __forceinline__ void operator()(const f32x4 (&acc)[2][2][4][2], const Unit& u, int wr, int wc, int fr, int fq) const {
        const int row0 = u.pm * BM + wr * 64 + fr; int colt = u.pn * BM; bf16_t* base = O;
        if (split_cols) { const int t = colt / split_cols; base += (size_t)t * split_stride; colt -= t * split_cols; }
        const int col0 = colt + wc * 32 + 8 * fq, bcol0 = u.pn * BM + wc * 32 + 8 * fq;
        f32x4 bv[2][2];
#pragma unroll
        for (int bj = 0; bj < 2; ++bj)
#pragma unroll
            for (int n = 0; n < 2; ++n) bv[bj][n] = bias ? *(const f32x4*)(bias + bcol0 + bj * HALF + 4 * n) : (f32x4){0.f, 0.f, 0.f, 0.f};
#pragma unroll
        for (int ai = 0; ai < 2; ++ai)
#pragma unroll
            for (int m = 0; m < 4; ++m) { bf16_t* rowp = base + (size_t)(row0 + ai * HALF + m * 16) * ldc + col0;
#pragma unroll
                for (int bj = 0; bj < 2; ++bj) { f32x4 v0 = acc[ai][bj][m][0] + bv[bj][0], v1 = acc[ai][bj][m][1] + bv[bj][1];
                    if (ACT == 1) { f32x2 a = gelu_pk((f32x2){v0[0], v0[1]}), b = gelu_pk((f32x2){v0[2], v0[3]}), c = gelu_pk((f32x2){v1[0], v1[1]}), d = gelu_pk((f32x2){v1[2], v1[3]});
                        v0 = (f32x4){a.x, a.y, b.x, b.y}; v1 = (f32x4){c.x, c.y, d.x, d.y}; }
                    if (ACT == 2) {
#pragma unroll
                        for (int j = 0; j < 4; ++j) { v0[j] = 0.5f * v0[j] * (1.0f + erff(v0[j] * 0.70710678f)); v1[j] = 0.5f * v1[j] * (1.0f + erff(v1[j] * 0.70710678f)); } }
                    u32x4 w; w.x = cvt_pk_bf16(v0[0], v0[1]); w.y = cvt_pk_bf16(v0[2], v0[3]); w.z = cvt_pk_bf16(v1[0], v1[1]); w.w = cvt_pk_bf16(v1[2], v1[3]);
                    *(u32x4*)(rowp + bj * HALF) = w; } }
    }
};

struct PanelStats {
    unsigned* xbuf;
    unsigned* cnt;
    unsigned* tmo;
    int ntn; float eps;
    unsigned code;
    __device__ __forceinline__ bool run(const f32x4 (&v)[2][2][4][2], const Unit& u, int wr, int wc, int fr, int fq, PG8_LAS unsigned char* lds, int wid, int lane) const {
        typedef float f32x2v __attribute__((ext_vector_type(2)));
        PG8_LAS f32x2v* P = (PG8_LAS f32x2v*)lds;
        PG8_LAS f32x2v* S = (PG8_LAS f32x2v*)(lds + 8192);
        PG8_LAS unsigned* flag = (PG8_LAS unsigned*)(lds + 8192 + 2048);
#pragma unroll
        for (int ai = 0; ai < 2; ++ai)
#pragma unroll
            for (int m = 0; m < 4; ++m) {
                float s = 0.f;
#pragma unroll
                for (int bj = 0; bj < 2; ++bj)
#pragma unroll
                    for (int n = 0; n < 2; ++n) { const f32x4 x = v[ai][bj][m][n]; s += (x[0] + x[1]) + (x[2] + x[3]); }
                s += __shfl_xor(s, 16); s += __shfl_xor(s, 32);
                const float mw = s * (1.0f / 64.0f); float q = 0.f;
#pragma unroll
                for (int bj = 0; bj < 2; ++bj)
#pragma unroll
                    for (int n = 0; n < 2; ++n) { const f32x4 d = v[ai][bj][m][n] - mw; q += (d[0] * d[0] + d[1] * d[1]) + (d[2] * d[2] + d[3] * d[3]); }
                q += __shfl_xor(q, 16); q += __shfl_xor(q, 32);
                if (fq == 0) P[(ai * HALF + wr * 64 + m * 16 + fr) * 4 + wc] = (f32x2v){mw, q};
            }
        asm volatile("s_waitcnt lgkmcnt(0)" ::: "memory"); __builtin_amdgcn_s_barrier(); asm volatile("" ::: "memory");
#if defined(BROKEN_NO_WAIT)
        if (blockIdx.x >= 64) { const long long t0 = clock64(); while (clock64() - t0 < 60000) __builtin_amdgcn_s_sleep(8); }
#endif
        const int row = wid * 32 + (lane & 31);
        if (lane < 32) {
            const f32x2v a = P[row * 4 + 0], b = P[row * 4 + 1], c = P[row * 4 + 2], d = P[row * 4 + 3];
            const float mt = (a.x + b.x + c.x + d.x) * 0.25f;
            const float da = a.x - mt, db = b.x - mt, dc = c.x - mt, dd = d.x - mt;
            const float m2 = (a.y + b.y) + (c.y + d.y) + 64.0f * ((da * da + db * db) + (dc * dc + dd * dd));
            unsigned long long* slot = (unsigned long long*)xbuf + ((size_t)(u.pm * BM + row) * 4 + u.pn);
            __hip_atomic_store(slot, ((unsigned long long)__float_as_uint(m2) << 32) | __float_as_uint(mt), __ATOMIC_RELAXED, __HIP_MEMORY_SCOPE_AGENT);
        }
        asm volatile("s_waitcnt vmcnt(0)" ::: "memory");
        if (lane == 0) __hip_atomic_fetch_add(cnt + 64 * u.pm, 1u, __ATOMIC_RELAXED, __HIP_MEMORY_SCOPE_AGENT);
        if (wid == 0) {
            bool dead = false; const unsigned long long t0 = __builtin_amdgcn_s_memrealtime(); const unsigned want = 8u * (unsigned)ntn;
            for (;;) {
#if defined(BROKEN_NO_WAIT)
                break;
#endif
                if ((unsigned)__builtin_amdgcn_readfirstlane(__hip_atomic_load(cnt + 64 * u.pm, __ATOMIC_RELAXED, __HIP_MEMORY_SCOPE_AGENT)) >= want) break;
                if (__builtin_amdgcn_s_memrealtime() - t0 > 2000000ull) {
                    if (lane == 0) { unsigned expect = 0u; __hip_atomic_compare_exchange_strong(tmo + 1, &expect, code | (unsigned)(u.pm & 0xff), __ATOMIC_RELAXED, __ATOMIC_RELAXED, __HIP_MEMORY_SCOPE_AGENT);
                                     __hip_atomic_store(tmo, 1u, __ATOMIC_RELAXED, __HIP_MEMORY_SCOPE_AGENT); }
                    dead = true; break; }
                __builtin_amdgcn_s_sleep(2);
            }
            __builtin_amdgcn_fence(__ATOMIC_ACQUIRE, "agent");
            if (lane == 0) flag[0] = dead ? 1u : 0u;
        }
        asm volatile("s_waitcnt vmcnt(0) lgkmcnt(0)" ::: "memory"); __builtin_amdgcn_s_barrier(); asm volatile("" ::: "memory");
        const bool bad = flag[0] != 0u;
        if (lane < 32) {
            const unsigned long long* slot = (const unsigned long long*)xbuf + (size_t)(u.pm * BM + row) * 4; float mt[4], m2[4]; float ms = 0.f;
#pragma unroll
            for (int t = 0; t < 4; ++t) { if (t < ntn) { const unsigned long long w = __hip_atomic_load(slot + t, __ATOMIC_RELAXED, __HIP_MEMORY_SCOPE_AGENT); mt[t] = __uint_as_float((unsigned)w); m2[t] = __uint_as_float((unsigned)(w >> 32)); } else { mt[t] = 0.f; m2[t] = 0.f; } ms += mt[t]; }
            const float mean = ms / (float)ntn; float q = 0.f;
#pragma unroll
            for (int t = 0; t < 4; ++t) if (t < ntn) { const float dm = mt[t] - mean; q += m2[t] + 256.0f * dm * dm; }
            S[row] = (f32x2v){mean, 1.0f / sqrtf(q / (256.0f * (float)ntn) + eps)};
        }
        asm volatile("s_waitcnt lgkmcnt(0)" ::: "memory"); __builtin_amdgcn_s_barrier(); asm volatile("" ::: "memory");
        return bad;
    }
};
struct EpiLnRes {
    static constexpr bool PERM = false, AFTER_DRAIN = true;
    const float* base; float* out; int ldc; const float* bias; PanelStats st; unsigned poison;
    __device__ __forceinline__ void refuse(size_t i0, size_t stride, int M, int N) const { const float q = __builtin_nanf(""); for (size_t i = i0; i < (size_t)M * N; i += stride) out[(i / N) * ldc + i % N] = q;
        if (i0 == 0) { unsigned expect = 0u; __hip_atomic_compare_exchange_strong(st.tmo + 1, &expect, 0x7f0u, __ATOMIC_RELAXED, __ATOMIC_RELAXED, __HIP_MEMORY_SCOPE_AGENT); __hip_atomic_store(st.tmo, 1u, __ATOMIC_RELAXED, __HIP_MEMORY_SCOPE_AGENT); } }
    __device__ __forceinline__ void fused(f32x4 (&acc)[2][2][4][2], const Unit& u, int wr, int wc, int fr, int fq, PG8_LAS unsigned char* lds, int wid, int lane) const {
        typedef float f32x2v __attribute__((ext_vector_type(2)));
        const PG8_LAS f32x2v* S = (const PG8_LAS f32x2v*)(lds + 8192);
        const int col0 = u.pn * BM + wc * 32 + 4 * fq;
#pragma unroll
        for (int bj = 0; bj < 2; ++bj)
#pragma unroll
            for (int n = 0; n < 2; ++n) { const f32x4 bv = bias ? *(const f32x4*)(bias + col0 + bj * HALF + n * 16) : (f32x4){0.f, 0.f, 0.f, 0.f};
#pragma unroll
                for (int ai = 0; ai < 2; ++ai)
#pragma unroll
                    for (int m = 0; m < 4; ++m) acc[ai][bj][m][n] += bv; }
        const bool bad = st.run(acc, u, wr, wc, fr, fq, lds, wid, lane) || poison != 0u;
        const float qnan = __builtin_nanf("");
#pragma unroll
        for (int ai = 0; ai < 2; ++ai)
#pragma unroll
            for (int m = 0; m < 4; ++m) { const int r = ai * HALF + wr * 64 + m * 16 + fr; const f32x2v sr = S[r]; const size_t off = (size_t)(u.pm * BM + r) * ldc + col0;
#pragma unroll
                for (int bj = 0; bj < 2; ++bj)
#pragma unroll
                    for (int n = 0; n < 2; ++n) { const f32x4 bs = *(const f32x4*)(base + off + bj * HALF + n * 16); f32x4 o = bs + (acc[ai][bj][m][n] - sr.x) * sr.y;
                        if (bad) o = (f32x4){qnan, qnan, qnan, qnan}; *(f32x4*)(out + off + bj * HALF + n * 16) = o; }
                asm volatile("" ::: "memory"); }
    }
};
struct EpiLnResLn {
    static constexpr bool PERM = false, AFTER_DRAIN = true;
    const float* base; float* out; bf16_t* xn; int ldc; const float* bias; PanelStats st1, st2; unsigned poison;
    __device__ __forceinline__ void refuse(size_t i0, size_t stride, int M, int N) const { const float q = __builtin_nanf(""); for (size_t i = i0; i < (size_t)M * N; i += stride) { const size_t o = (i / N) * ldc + i % N; out[o] = q; xn[o] = (bf16_t)0x7fc0u; }
        if (i0 == 0) { unsigned expect = 0u; __hip_atomic_compare_exchange_strong(st1.tmo + 1, &expect, 0x7f0u, __ATOMIC_RELAXED, __ATOMIC_RELAXED, __HIP_MEMORY_SCOPE_AGENT); __hip_atomic_store(st1.tmo, 1u, __ATOMIC_RELAXED, __HIP_MEMORY_SCOPE_AGENT); } }
    __device__ __forceinline__ void fused(f32x4 (&acc)[2][2][4][2], const Unit& u, int wr, int wc, int fr, int fq, PG8_LAS unsigned char* lds, int wid, int lane) const {
        typedef float f32x2v __attribute__((ext_vector_type(2))); typedef unsigned u32x2v __attribute__((ext_vector_type(2)));
        const PG8_LAS f32x2v* S = (const PG8_LAS f32x2v*)(lds + 8192);
        const int col0 = u.pn * BM + wc * 32 + 4 * fq;
#pragma unroll
        for (int bj = 0; bj < 2; ++bj)
#pragma unroll
            for (int n = 0; n < 2; ++n) { const f32x4 bv = bias ? *(const f32x4*)(bias + col0 + bj * HALF + n * 16) : (f32x4){0.f, 0.f, 0.f, 0.f};
#pragma unroll
                for (int ai = 0; ai < 2; ++ai)
#pragma unroll
                    for (int m = 0; m < 4; ++m) acc[ai][bj][m][n] += bv; }
        bool bad = st1.run(acc, u, wr, wc, fr, fq, lds, wid, lane) || poison != 0u;
        const float qnan = __builtin_nanf("");
#pragma unroll
        for (int ai = 0; ai < 2; ++ai)
#pragma unroll
            for (int m = 0; m < 4; ++m) { const int r = ai * HALF + wr * 64 + m * 16 + fr; const f32x2v sr = S[r]; const size_t off = (size_t)(u.pm * BM + r) * ldc + col0;
#pragma unroll
                for (int bj = 0; bj < 2; ++bj)
#pragma unroll
                    for (int n = 0; n < 2; ++n) { const f32x4 bs = *(const f32x4*)(base + off + bj * HALF + n * 16); acc[ai][bj][m][n] = bs + (acc[ai][bj][m][n] - sr.x) * sr.y; }
                asm volatile("" : "+v"(acc[ai][0][m][0]), "+v"(acc[ai][0][m][1]), "+v"(acc[ai][1][m][0]), "+v"(acc[ai][1][m][1]));
                if (m & 1) asm volatile("" ::: "memory"); }
        const bool bad1 = bad;
        bad = st2.run(acc, u, wr, wc, fr, fq, lds, wid, lane) || bad;
#pragma unroll
        for (int ai = 0; ai < 2; ++ai)
#pragma unroll
            for (int m = 0; m < 4; ++m) { const int r = ai * HALF + wr * 64 + m * 16 + fr; const f32x2v sr = S[r]; const size_t off = (size_t)(u.pm * BM + r) * ldc + col0;
#pragma unroll
                for (int bj = 0; bj < 2; ++bj)
#pragma unroll
                    for (int n = 0; n < 2; ++n) { const f32x4 x1 = acc[ai][bj][m][n]; *(f32x4*)(out + off + bj * HALF + n * 16) = bad1 ? (f32x4){qnan, qnan, qnan, qnan} : x1;
                        const f32x4 o = (x1 - sr.x) * sr.y; u32x2v w; w.x = cvt_pk_bf16(o[0], o[1]); w.y = cvt_pk_bf16(o[2], o[3]);
                        if (bad) { w.x = 0x7fc07fc0u; w.y = 0x7fc07fc0u; } *(u32x2v*)(xn + off + bj * HALF + n * 16) = w; }
                asm volatile("" ::: "memory"); }
    }
};

template <class Epi, class Sched, bool STAMP = false>
__device__ __forceinline__ void gemm_phase(PG8_LAS unsigned char* lds, const Gemm g, const Sched& S, const Epi& E, unsigned long long* stamps) {
    int tid_ = threadIdx.x; asm volatile("" : "+v"(tid_)); const int tid = tid_, wid = __builtin_amdgcn_readfirstlane(tid >> 6), lane = tid & 63, wr = wid >> 2, wc = wid & 3, fr = lane & 15, fq = lane >> 4;
    const int K = g.K, nt = K / BK;
    int ts_lo = 0, ts_hi = 0, nts = 0; const unsigned long long rt_entry = STAMP ? (unsigned long long)wall_clock64() : 0ull;
#define PG8_STAMP() do { if (STAMP && wid == 0 && nts < 64) { const unsigned long long _c = (unsigned long long)clock64(); \
        ts_lo = (lane == nts) ? (int)(unsigned)_c : ts_lo; ts_hi = (lane == nts) ? (int)(unsigned)(_c >> 32) : ts_hi; ++nts; } } while (0)
    PG8_STAMP();
    unsigned voffA[2], voffB[2];
#pragma unroll
    for (int i = 0; i < 2; ++i) { int R, C; stage_rc(tid * 16 + i * 8192, R, C); const int Rb = Epi::PERM ? ((R & ~31) + perm32(R & 31)) : R;
        voffA[i] = (unsigned)(R * K + C) * 2u; voffB[i] = (unsigned)(Rb * K + C) * 2u; }
    const size_t kstep = (size_t)(BK * 2);
    const size_t hstep = (size_t)HALF * K * 2;
    const size_t tstep = 2 * hstep;
    const unsigned ldsw = (unsigned)wid * 1024u;
    const int aoff = lds_byte(wr * 64 + fr, fq * 8), boff = lds_byte(wc * 32 + fr, fq * 8);
#define PG8_SA(b, h) (((b) * 2 + (h)) * HTB)
#define PG8_SB(b, h) ((4 + (b) * 2 + (h)) * HTB)
#define PG8_STAGE(bufoff, gbase, voff) do { _Pragma("unroll") for (int _i = 0; _i < 2; ++_i) \
        __builtin_amdgcn_global_load_lds((const unsigned*)((const char*)(gbase) + (voff)[_i]), (PG8_LAS unsigned*)(lds + (bufoff) + ldsw + _i * 8192), 16, 0, 0); } while (0)
#define PG8_LDA(dst, b, h) do { _Pragma("unroll") for (int m = 0; m < 4; ++m) _Pragma("unroll") for (int k = 0; k < 2; ++k) dst[m][k] = *(const PG8_LAS bf16x8*)(lds + PG8_SA(b, h) + aoff + m * 2048 + k * 1024); } while (0)
#define PG8_LDB(dst, b, h) do { _Pragma("unroll") for (int n = 0; n < 2; ++n) _Pragma("unroll") for (int k = 0; k < 2; ++k) dst[n][k] = *(const PG8_LAS bf16x8*)(lds + PG8_SB(b, h) + boff + n * 2048 + k * 1024); } while (0)
#define PG8_MMA(ai, bj, At, Bt) do { __builtin_amdgcn_s_setprio(1); _Pragma("unroll") for (int m = 0; m < 4; ++m) _Pragma("unroll") for (int n = 0; n < 2; ++n) _Pragma("unroll") for (int k = 0; k < 2; ++k) \
        acc[ai][bj][m][n] = __builtin_amdgcn_mfma_f32_16x16x32_bf16(Bt[n][k], At[m][k], acc[ai][bj][m][n], 0, 0, 0); __builtin_amdgcn_s_setprio(0); } while (0)
#define PG8_WAIT_V(n) asm volatile("s_waitcnt vmcnt(" #n ")" ::: "memory")
#define PG8_WAIT_L(n) asm volatile("s_waitcnt lgkmcnt(" #n ")" ::: "memory")
#define PG8_BAR __builtin_amdgcn_s_barrier()
#define PG8_SCHED __builtin_amdgcn_sched_barrier(0)
    Unit cur, nxt; int ui = 0;
    if (!S.next(0, cur)) return;
    f32x4 acc[2][2][4][2];
#pragma unroll
    for (int a = 0; a < 2; ++a)
#pragma unroll
        for (int b = 0; b < 2; ++b)
#pragma unroll
            for (int m = 0; m < 4; ++m)
#pragma unroll
                for (int n = 0; n < 2; ++n) acc[a][b][m][n] = (f32x4){0.f, 0.f, 0.f, 0.f};
    bf16x8 At[4][2], B0[2][2], B1[2][2];
    const char* cA = (const char*)g.A + (size_t)cur.pm * tstep; const char* cB = (const char*)g.Bt + (size_t)cur.pn * tstep;
    S.a_ready(cur);
    PG8_STAGE(PG8_SB(0, 0), cB, voffB); PG8_STAGE(PG8_SA(0, 0), cA, voffA); PG8_STAGE(PG8_SB(0, 1), cB + hstep, voffB); PG8_STAGE(PG8_SA(0, 1), cA + hstep, voffA);
    if (wr == 1) PG8_BAR;
    PG8_WAIT_V(4); PG8_BAR;
    PG8_STAGE(PG8_SB(1, 0), cB + kstep, voffB); PG8_STAGE(PG8_SA(1, 0), cA + kstep, voffA); PG8_STAGE(PG8_SB(1, 1), cB + hstep + kstep, voffB);
    PG8_WAIT_V(6); PG8_BAR;
    PG8_STAMP();
    for (;;) {
        const bool has_next = S.next(ui + 1, nxt);
        const char* nA = has_next ? (const char*)g.A + (size_t)nxt.pm * tstep : cA; const char* nB = has_next ? (const char*)g.Bt + (size_t)nxt.pn * tstep : cB;
        for (int t = 0; t < nt; t += 2) {
            const bool last = (t == nt - 2);
            const char* a1 = cA + (size_t)(t + 1) * kstep;
            const char* a2 = last ? nA : cA + (size_t)(t + 2) * kstep; const char* b2 = last ? nB : cB + (size_t)(t + 2) * kstep;
            const char* a3 = a2 + kstep; const char* b3 = b2 + kstep;
            if (last && has_next) S.a_ready(nxt);
            PG8_LDB(B0, 0, 0); PG8_SCHED; PG8_LDA(At, 0, 0); PG8_STAGE(PG8_SA(1, 1), a1 + hstep, voffA);
            PG8_WAIT_L(8); PG8_BAR; PG8_WAIT_L(0); PG8_MMA(0, 0, At, B0); PG8_BAR; PG8_SCHED;
            PG8_LDB(B1, 0, 1); PG8_STAGE(PG8_SB(0, 0), b2, voffB);
            PG8_BAR; PG8_WAIT_L(0); PG8_MMA(0, 1, At, B1); PG8_BAR;
            PG8_LDA(At, 0, 1); PG8_STAGE(PG8_SA(0, 0), a2, voffA);
            PG8_BAR; PG8_WAIT_L(0); PG8_MMA(1, 0, At, B0); PG8_BAR; PG8_SCHED;
            PG8_STAGE(PG8_SB(0, 1), b2 + hstep, voffB);
            PG8_WAIT_V(6); PG8_BAR; PG8_MMA(1, 1, At, B1); PG8_BAR;
            PG8_LDB(B0, 1, 0); PG8_SCHED; PG8_LDA(At, 1, 0); PG8_STAGE(PG8_SA(0, 1), a2 + hstep, voffA);
            PG8_WAIT_L(8); PG8_BAR; PG8_WAIT_L(0); PG8_MMA(0, 0, At, B0); PG8_BAR; PG8_SCHED;
            PG8_LDB(B1, 1, 1); PG8_STAGE(PG8_SB(1, 0), b3, voffB);
            PG8_BAR; PG8_WAIT_L(0); PG8_MMA(0, 1, At, B1); PG8_BAR;
            PG8_LDA(At, 1, 1); PG8_STAGE(PG8_SA(1, 0), a3, voffA);
            PG8_BAR; PG8_WAIT_L(0); PG8_MMA(1, 0, At, B0); PG8_BAR; PG8_SCHED;
            PG8_STAGE(PG8_SB(1, 1), b3 + hstep, voffB);
            PG8_WAIT_V(6); PG8_BAR; PG8_MMA(1, 1, At, B1); PG8_BAR;
        }
        PG8_STAMP();
        if constexpr (!Epi::AFTER_DRAIN) { E(acc, cur, wr, wc, fr, fq); S.done(cur); }
        PG8_STAMP();
        if (!has_next) break;
#pragma unroll
        for (int a = 0; a < 2; ++a)
#pragma unroll
            for (int b = 0; b < 2; ++b)
#pragma unroll
                for (int m = 0; m < 4; ++m)
#pragma unroll
                    for (int n = 0; n < 2; ++n) acc[a][b][m][n] = (f32x4){0.f, 0.f, 0.f, 0.f};
        cur = nxt; cA = nA; cB = nB; ++ui;
    }
    PG8_WAIT_V(0);
    if (wr == 0) PG8_BAR;
    PG8_BAR;
    if constexpr (Epi::AFTER_DRAIN) { E.fused(acc, cur, wr, wc, fr, fq, lds, wid, lane); S.done(cur); }
    PG8_STAMP();
    if (STAMP && wid == 0) { stamps[lane] = lane < nts ? (((unsigned long long)(unsigned)ts_hi << 32) | (unsigned)ts_lo) : 0ull;
        if (lane == 62) stamps[62] = rt_entry; if (lane == 63) stamps[63] = (unsigned long long)wall_clock64(); }
#undef PG8_STAMP
#undef PG8_SA
#undef PG8_SB
#undef PG8_STAGE
#undef PG8_LDA
#undef PG8_LDB
#undef PG8_MMA
#undef PG8_WAIT_V
#undef PG8_WAIT_L
#undef PG8_BAR
#undef PG8_SCHED
}
}
#define LAS __attribute__((address_space(3)))
typedef unsigned short bf16_t;
typedef float f32x4 __attribute__((ext_vector_type(4)));
typedef float f32x2 __attribute__((ext_vector_type(2)));
typedef unsigned u32x4 __attribute__((ext_vector_type(4)));
typedef unsigned u32x2 __attribute__((ext_vector_type(2)));
constexpr int NTOK = 8192, SEQ = 2048, DM = 2048, NIN = 7372, NP = 7424, NL = 4;
constexpr int LRUW = 512, GW = 768, RW_ = 768;
constexpr int PC_AX = 0, PC_AG = 512, PC_BQKV = 1024, PC_BG = 3328, PC_CIN = 4096, PC_CG = 6592, PC_BETA = 7360, PC_BA = 7366;
constexpr int LDS_BYTES = 131072 + 512;
#ifndef CHUNKREP
#define CHUNKREP 0
#endif
#ifndef CONV_SPLIT
#define CONV_SPLIT 40
#endif
#ifndef REPMASK
#define REPMASK 0
#endif
#ifndef SKIPMASK
#define SKIPMASK 0
#endif
#ifndef N_LAUNCH_MODE
#define N_LAUNCH_MODE 1
#endif
constexpr int PPL = 7;
constexpr int NPHASE = 2 + PPL * NL;
constexpr size_t WS_WIN = 0;
constexpr size_t WS_WOUT = WS_WIN + (size_t)NL * NP * DM * 2;
constexpr size_t WS_XB = WS_WOUT + (size_t)NL * DM * DM * 2;
constexpr size_t WS_XR = WS_XB + (size_t)NTOK * DM * 2;
constexpr size_t WS_PROJ = WS_XR + (size_t)NTOK * DM * 4;
constexpr size_t WS_Y = WS_PROJ + (size_t)NTOK * NP * 2;
constexpr size_t SZ768 = (size_t)NTOK * 768 * 4;
constexpr size_t WS_GQ = WS_Y + (size_t)NTOK * DM * 2;
constexpr size_t WS_GK = WS_GQ + SZ768;
constexpr size_t WS_GV = WS_GK + SZ768;
constexpr size_t WS_GO = WS_GV + SZ768;
constexpr size_t WS_RR = WS_GO + SZ768;
constexpr size_t WS_RW = WS_RR + SZ768;
constexpr size_t WS_RK = WS_RW + SZ768;
constexpr size_t WS_RV = WS_RK + SZ768;
constexpr size_t WS_RKK = WS_RV + SZ768;
constexpr size_t WS_RB = WS_RKK + SZ768;
constexpr size_t WS_RY = WS_RB + SZ768;
constexpr size_t WS_GB = WS_RY + SZ768;
constexpr size_t WS_GG = WS_GB + (size_t)NTOK * 8 * 4;
constexpr size_t WS_LA = WS_GG + (size_t)NTOK * 8 * 4;
constexpr size_t WS_LU = WS_LA + (size_t)NTOK * 512 * 4;
constexpr size_t WS_LEND = WS_LU + (size_t)NTOK * 512 * 4;
constexpr int GCH = 768, RCH = 1536;
constexpr size_t WS_G1 = WS_LEND;
constexpr size_t WS_G2 = WS_G1 + (size_t)GCH * 64 * 128 * 2;
constexpr size_t WS_G3 = WS_G2 + (size_t)GCH * 64 * 128 * 2;
constexpr size_t WS_G4 = WS_G3 + (size_t)GCH * 64 * 64 * 2;
constexpr size_t WS_GU = WS_G4 + (size_t)GCH * 128 * 64 * 2;
constexpr size_t WS_GGL = WS_GU + (size_t)GCH * 128 * 64 * 4;
constexpr size_t WS_R1 = WS_GGL + (size_t)GCH * 128 * 4;
constexpr size_t WS_R2 = WS_R1 + (size_t)RCH * 64 * 64 * 2;
constexpr size_t WS_R3 = WS_R2 + (size_t)RCH * 64 * 64 * 2;
constexpr size_t WS_R4 = WS_R3 + (size_t)RCH * 64 * 128 * 2;
constexpr size_t WS_RU = WS_R4 + (size_t)RCH * 64 * 128 * 2;
constexpr size_t WS_RVT = WS_RU + (size_t)RCH * 64 * 64 * 4;
constexpr size_t WS_RGL = WS_RVT + (size_t)RCH * 64 * 64 * 2;
constexpr size_t WS_LH = WS_RGL + (size_t)RCH * 64 * 4;
constexpr size_t WS_LP = WS_LH + (size_t)NTOK * 512 * 4;
constexpr size_t WS_LC = WS_LP + (size_t)NTOK * 512 * 4;
constexpr size_t WS_BAR = WS_LC + (size_t)128 * 512 * 4;
constexpr size_t WS_WUPT = WS_BAR + 16384;
constexpr size_t WS_AUPT = WS_WUPT + (size_t)NL * 768 * 96 * 2;
constexpr size_t WS_WXT = WS_AUPT + (size_t)NL * 768 * 96 * 2;
constexpr size_t WS_WAT = WS_WXT + (size_t)NL * 8 * 64 * 64 * 2;
constexpr size_t WS_END = WS_WAT + (size_t)NL * 8 * 64 * 64 * 2;

struct Args {
    const float* in[26];
    float* out; unsigned char* ws;
    int ph_lo, ph_hi;
};
enum { I_X = 0, I_NORMG, I_WIN, I_WOUT, I_LCW, I_LCB, I_LWX, I_LBX, I_LWA, I_LBA, I_LLAM, I_GCW, I_GALOG, I_GDT, I_GNG,
       I_RMU, I_RW0, I_RWUP, I_RA0, I_RAUP, I_RKK, I_RKA, I_RRK, I_RGNW, I_RGNB, I_FNG };

__device__ __forceinline__ int tid_l() { int t = threadIdx.x; asm volatile("" : "+v"(t)); return t; }
#define LBAR() do { asm volatile("s_waitcnt lgkmcnt(0)" ::: "memory"); __builtin_amdgcn_s_barrier(); asm volatile("" ::: "memory"); } while (0)
__device__ __forceinline__ int bid_l() { int b = blockIdx.x; asm volatile("" : "+s"(b)); return b; }
__device__ __forceinline__ int gdim_l() { int b = gridDim.x; asm volatile("" : "+s"(b)); return b; }
__device__ __forceinline__ const float* inp(LAS unsigned char* lds, int i) {
    const LAS unsigned* t = (const LAS unsigned*)(lds + 131072) + 2 * i;
    const unsigned lo = __builtin_amdgcn_readfirstlane(t[0]), hi = __builtin_amdgcn_readfirstlane(t[1]);
    return (const float*)(const __attribute__((address_space(1))) float*)(((unsigned long long)hi << 32) | lo);
}
__device__ __forceinline__ float bf2f(bf16_t b) { return __uint_as_float(((unsigned)b) << 16); }
__device__ __forceinline__ bf16_t f2bf(float f) { unsigned u = __float_as_uint(f); u += 0x7FFFu + ((u >> 16) & 1u); return (bf16_t)(u >> 16); }
__device__ __forceinline__ unsigned pk2(float lo, float hi) { return (unsigned)f2bf(lo) | ((unsigned)f2bf(hi) << 16); }
__device__ __forceinline__ float wave_sum(float v) {
#pragma unroll
    for (int o = 1; o < 64; o <<= 1) v += __shfl_xor(v, o);
    return v;
}
typedef __bf16 bf2_t __attribute__((ext_vector_type(2)));
__device__ __forceinline__ unsigned cvtpk(float lo, float hi) { const f32x2 v = {lo, hi}; const bf2_t r = __builtin_convertvector(v, bf2_t); return __builtin_bit_cast(unsigned, r); }
__device__ __forceinline__ float sigmoidf_(float x) { return 1.0f / (1.0f + __expf(-x)); }
__device__ __forceinline__ float siluf_(float x) { return x / (1.0f + __expf(-x)); }
__device__ __forceinline__ float softplusf_(float x) { return fmaxf(x, 0.f) + log1pf(__expf(-fabsf(x))); }

__device__ __forceinline__ void transpose_item(const float* W, int K, int N, bf16_t* WT, const float* scale, bool remap, LAS float* scr, int item, int nblk, int lane) {
    const int kb = item / nblk, nb = item % nblk, k0 = 64 * kb, n0 = 32 * nb;
    int np = n0 + (lane & 31), oc;
    if (!remap) oc = np;
    else if (np < 4096) oc = np;
    else if (np < 7360) oc = np + 12;
    else if (np < 7372) oc = np - 7360 + 4096;
    else oc = -1;
    float vbuf[32], sbuf[32];
#pragma unroll
    for (int i = 0; i < 32; ++i) { const int kk = 2 * i + (lane >> 5); vbuf[i] = (oc >= 0) ? W[(size_t)(k0 + kk) * N + oc] : 0.f; sbuf[i] = scale ? scale[k0 + kk] : 1.0f; }
#pragma unroll
    for (int i = 0; i < 32; ++i) { const int kk = 2 * i + (lane >> 5); scr[kk * 33 + (lane & 31)] = vbuf[i] * sbuf[i]; }
    __builtin_amdgcn_s_waitcnt(0xc07f); asm volatile("s_waitcnt lgkmcnt(0)" ::: "memory");
    const int c = lane & 7;
#pragma unroll
    for (int j = 0; j < 4; ++j) { const int n = (lane >> 3) + 8 * j; const LAS float* s = scr + (8 * c) * 33 + n;
        u32x4 o; o.x = pk2(s[0 * 33], s[1 * 33]); o.y = pk2(s[2 * 33], s[3 * 33]); o.z = pk2(s[4 * 33], s[5 * 33]); o.w = pk2(s[6 * 33], s[7 * 33]);
        *(u32x4*)(WT + (size_t)(n0 + n) * K + k0 + 8 * c) = o; }
    asm volatile("s_waitcnt lgkmcnt(0)" ::: "memory");
}
__device__ __forceinline__ void phase_convert(const Args& a, LAS unsigned char* lds, int l_lo, int l_hi, int f_lo, int f_hi, int vb, int nvb, int small) {
    size_t wso_ = 0; asm volatile("" : "+s"(wso_)); unsigned char* ws = a.ws + wso_;
    const int tid = tid_l(), wave = __builtin_amdgcn_readfirstlane(tid >> 6), lane = tid & 63;
    LAS float* scr = (LAS float*)(lds + wave * 8448);
    const int gw = vb * 8 + wave, NGW = nvb * 8;
    constexpr int I_IN = (DM / 64) * (NP / 32), I_OUT = (DM / 64) * (DM / 32), PER_L = I_IN + I_OUT;
    const int i_lo = (PER_L / 64) * f_lo, i_hi = (PER_L / 64) * f_hi, span = i_hi - i_lo;
    for (int it = gw; it < (l_hi - l_lo) * span; it += NGW) {
        const int l = l_lo + it / span; int r = i_lo + it % span;
        if (r < I_IN) transpose_item(inp(lds, I_WIN) + (size_t)l * DM * NIN, DM, NIN, (bf16_t*)(ws + WS_WIN) + (size_t)l * NP * DM, inp(lds, I_NORMG) + l * DM, true, scr, r, NP / 32, lane);
        else transpose_item(inp(lds, I_WOUT) + (size_t)l * DM * DM, DM, DM, (bf16_t*)(ws + WS_WOUT) + (size_t)l * DM * DM, nullptr, false, scr, r - I_IN, DM / 32, lane);
    }
    if (small) {
        const int gt = vb * 512 + tid, NT_ = nvb * 512;
        const float* wup = inp(lds, I_RWUP); const float* aup = inp(lds, I_RAUP); bf16_t* WUPT = (bf16_t*)(ws + WS_WUPT); bf16_t* AUPT = (bf16_t*)(ws + WS_AUPT);
        for (int idx = gt; idx < NL * 768 * 96; idx += NT_) { const int i = idx % 96, j = (idx / 96) % 768, l = idx / (96 * 768); const size_t src = ((size_t)l * 96 + i) * 768 + j; WUPT[idx] = f2bf(wup[src]); AUPT[idx] = f2bf(aup[src]); }
        const float* wx = inp(lds, I_LWX); const float* wa = inp(lds, I_LWA); bf16_t* WXT = (bf16_t*)(ws + WS_WXT); bf16_t* WAT = (bf16_t*)(ws + WS_WAT);
        for (int idx = gt; idx < NL * 8 * 64 * 64; idx += NT_) { const int i = idx & 63, j = (idx >> 6) & 63, ln = idx >> 12; const size_t src = ((size_t)ln * 64 + i) * 64 + j; WXT[idx] = f2bf(wx[src]); WAT[idx] = f2bf(wa[src]); }
    }
}
__device__ __forceinline__ void phase_rms(const float* xin, bf16_t* xb) {
    const int tid = tid_l(), wave = tid >> 6, lane = tid & 63;
    const int gw = bid_l() * 8 + wave, NGW = gdim_l() * 8;
    for (int m = gw; m < NTOK; m += NGW) {
        const f32x4* xr = (const f32x4*)(xin + (size_t)m * DM) + lane;
        f32x4 v[8]; float s = 0.f;
#pragma unroll
        for (int j = 0; j < 8; ++j) { v[j] = xr[64 * j]; s += (v[j].x * v[j].x + v[j].y * v[j].y) + (v[j].z * v[j].z + v[j].w * v[j].w); }
        const float rstd = 1.0f / sqrtf(wave_sum(s) * (1.0f / DM) + 1e-6f);
        u32x2* o = (u32x2*)(xb + (size_t)m * DM) + lane;
#pragma unroll
        for (int j = 0; j < 8; ++j) { u32x2 w; w.x = pk2(v[j].x * rstd, v[j].y * rstd); w.y = pk2(v[j].z * rstd, v[j].w * rstd); o[64 * j] = w; }
    }
}
__device__ __forceinline__ void phase_final(const float* xin, const float* g, float* out) {
    const int tid = tid_l(), wave = tid >> 6, lane = tid & 63;
    const int gw = bid_l() * 8 + wave, NGW = gdim_l() * 8;
    for (int m = gw; m < NTOK; m += NGW) {
        const f32x4* xr = (const f32x4*)(xin + (size_t)m * DM) + lane;
        f32x4 v[8]; float s = 0.f;
#pragma unroll
        for (int j = 0; j < 8; ++j) { v[j] = xr[64 * j]; s += (v[j].x * v[j].x + v[j].y * v[j].y) + (v[j].z * v[j].z + v[j].w * v[j].w); }
        const float rstd = 1.0f / sqrtf(wave_sum(s) * (1.0f / DM) + 1e-6f);
        f32x4* o = (f32x4*)(out + (size_t)m * DM) + lane; const f32x4* gg = (const f32x4*)g + lane;
#pragma unroll
        for (int j = 0; j < 8; ++j) o[64 * j] = v[j] * rstd * gg[64 * j];
    }
}
struct EpiDual {
    static constexpr bool PERM = true, AFTER_DRAIN = false;
    int mode; bf16_t* O; int ldo; const float* base; float* C; int ldc;
    __device__ __forceinline__ void operator()(const pg8::f32x4 (&acc)[2][2][4][2], const pg8::Unit& u, int wr, int wc, int fr, int fq) const {
        const int row0 = u.pm * 256 + wr * 64 + fr, col0 = u.pn * 256 + wc * 32 + 8 * fq;
        if (mode == 0) {
#pragma unroll
            for (int ai = 0; ai < 2; ++ai)
#pragma unroll
                for (int m = 0; m < 4; ++m) { bf16_t* rowp = O + (size_t)(row0 + ai * 128 + m * 16) * ldo + col0;
#pragma unroll
                    for (int bj = 0; bj < 2; ++bj) { const pg8::f32x4 v0 = acc[ai][bj][m][0], v1 = acc[ai][bj][m][1];
                        pg8::u32x4 w; w.x = cvtpk(v0[0], v0[1]); w.y = cvtpk(v0[2], v0[3]); w.z = cvtpk(v1[0], v1[1]); w.w = cvtpk(v1[2], v1[3]);
                        *(pg8::u32x4*)(rowp + bj * 128) = w; } }
        } else {
#pragma unroll
            for (int ai = 0; ai < 2; ++ai)
#pragma unroll
                for (int m = 0; m < 4; ++m) { const size_t off = (size_t)(row0 + ai * 128 + m * 16) * ldc + col0;
#pragma unroll
                    for (int bj = 0; bj < 2; ++bj)
#pragma unroll
                        for (int n = 0; n < 2; ++n) { const pg8::f32x4 b = *(const pg8::f32x4*)(base + off + bj * 128 + n * 4); *(pg8::f32x4*)(C + off + bj * 128 + n * 4) = acc[ai][bj][m][n] + b; }
                    asm volatile("" ::: "memory"); }
        }
    }
};
constexpr int PT = 32;
typedef short bf16x8 __attribute__((ext_vector_type(8)));
__device__ __forceinline__ float sum16(float v) { v += __shfl_xor(v, 1); v += __shfl_xor(v, 2); v += __shfl_xor(v, 4); v += __shfl_xor(v, 8); return v; }
__device__ __forceinline__ void phase_prep(const Args& a, int l, LAS unsigned char* lds) {
    size_t wso_ = 0; asm volatile("" : "+s"(wso_)); unsigned char* ws = a.ws + wso_;
    const int tid0 = tid_l(), wave = __builtin_amdgcn_readfirstlane(tid0 >> 6);
    const bf16_t* PROJ = (const bf16_t*)(ws + WS_PROJ);
    constexpr int XSR = 200, XLR = 520;
    LAS bf16_t* xsb = (LAS bf16_t*)lds;
    LAS bf16_t* xlb = (LAS bf16_t*)(lds + PT * XSR * 2);
    LAS float* xlf = (LAS float*)(lds + PT * XSR * 2 + PT * XLR * 2);
    float* GQ = (float*)(ws + WS_GQ); float* GK = (float*)(ws + WS_GK); float* GV = (float*)(ws + WS_GV);
    float* GB = (float*)(ws + WS_GB); float* GG = (float*)(ws + WS_GG);
    float* RR = (float*)(ws + WS_RR); float* RWd = (float*)(ws + WS_RW); float* RK = (float*)(ws + WS_RK); float* RV = (float*)(ws + WS_RV);
    float* RKK = (float*)(ws + WS_RKK); float* RB = (float*)(ws + WS_RB);
    float* LA = (float*)(ws + WS_LA); float* LU = (float*)(ws + WS_LU);
    const float* mu = inp(lds, I_RMU) + l * 2496;
    for (int tile = bid_l(); tile < NTOK / PT; tile += gdim_l()) {
        int tid = tid0; asm volatile("" : "+v"(tid)); const int lane = tid & 63, lr = lane & 15, lq = lane >> 4;
        const int t0 = tile * PT, sp = t0 % SEQ;
        { bf16_t curv[12], prevv[12];
#pragma unroll
            for (int q = 0; q < 12; ++q) { const int idx = tid + 512 * q, tt = idx / 192, i = idx % 192; const int col = PC_CIN + 2304 + i;
                curv[q] = PROJ[(size_t)(t0 + tt) * NP + col]; prevv[q] = PROJ[(size_t)(t0 + tt - ((sp + tt > 0) ? 1 : 0)) * NP + col]; }
#pragma unroll
            for (int q = 0; q < 12; ++q) { const int idx = tid + 512 * q, tt = idx / 192, i = idx % 192; const float cur = bf2f(curv[q]), prev = (sp + tt > 0) ? bf2f(prevv[q]) : 0.f;
                float xs = cur + (prev - cur) * mu[2304 + i]; if (i < 96) xs = tanhf(xs); xsb[tt * XSR + i] = f2bf(xs); } }
        { const int j = tid; const float* cw = inp(lds, I_LCW) + l * 4 * LRUW; const float w0 = cw[j], w1 = cw[LRUW + j], w2 = cw[2 * LRUW + j], w3 = cw[3 * LRUW + j], cb = inp(lds, I_LCB)[l * LRUW + j];
            float xm3 = (sp >= 3) ? bf2f(PROJ[(size_t)(t0 - 3) * NP + PC_AX + j]) : 0.f, xm2 = (sp >= 2) ? bf2f(PROJ[(size_t)(t0 - 2) * NP + PC_AX + j]) : 0.f, xm1 = (sp >= 1) ? bf2f(PROJ[(size_t)(t0 - 1) * NP + PC_AX + j]) : 0.f;
            bf16_t cv[PT];
#pragma unroll
            for (int tt = 0; tt < PT; ++tt) cv[tt] = PROJ[(size_t)(t0 + tt) * NP + PC_AX + j];
#pragma unroll
            for (int tt = 0; tt < PT; ++tt) { const float cur = bf2f(cv[tt]); const float x = w0 * xm3 + w1 * xm2 + w2 * xm1 + w3 * cur + cb; xlf[tt * 512 + j] = x; xlb[tt * XLR + j] = f2bf(x); xm3 = xm2; xm2 = xm1; xm1 = cur; } }
        LBAR();
        for (int u = wave; u < 24; u += 8) { const int h = u % 12, tb = u / 12;
            bf16x8 xw[3], xa[3];
#pragma unroll
            for (int k = 0; k < 3; ++k) { xw[k] = *(const LAS bf16x8*)(xsb + (tb * 16 + lr) * XSR + 32 * k + 8 * lq); xa[k] = *(const LAS bf16x8*)(xsb + (tb * 16 + lr) * XSR + 96 + 32 * k + 8 * lq); }
            f32x4 aw[4], aa[4];
#pragma unroll
            for (int jq = 0; jq < 4; ++jq) { const int jrow = l * 768 + h * 64 + jq * 16 + lr; const bf16_t* pw = (const bf16_t*)(ws + WS_WUPT) + (size_t)jrow * 96 + 8 * lq; const bf16_t* pa = (const bf16_t*)(ws + WS_AUPT) + (size_t)jrow * 96 + 8 * lq;
                aw[jq] = (f32x4){0.f, 0.f, 0.f, 0.f}; aa[jq] = (f32x4){0.f, 0.f, 0.f, 0.f};
#pragma unroll
                for (int k = 0; k < 3; ++k) { aw[jq] = __builtin_amdgcn_mfma_f32_16x16x32_bf16(xw[k], *(const bf16x8*)(pw + 32 * k), aw[jq], 0, 0, 0); aa[jq] = __builtin_amdgcn_mfma_f32_16x16x32_bf16(xa[k], *(const bf16x8*)(pa + 32 * k), aa[jq], 0, 0, 0); } }
            const int tokb = tb * 16 + 4 * lq;
            bf16_t pr_[5][4], pk_[5][4], pv_[5][4];
#pragma unroll
            for (int rr = 0; rr < 5; ++rr) { const int trow = t0 + tokb + rr - ((rr == 0 && sp + tokb == 0) ? 0 : 1);
#pragma unroll
                for (int jq = 0; jq < 4; ++jq) { const bf16_t* p = PROJ + (size_t)trow * NP + PC_CIN + h * 64 + jq * 16 + lr; pr_[rr][jq] = p[0]; pk_[rr][jq] = p[768]; pv_[rr][jq] = p[1536]; } }
            float w0v[4], a0v[4], kkwv[4], kawv[4], murv[4], mukv[4], muvv[4];
#pragma unroll
            for (int jq = 0; jq < 4; ++jq) { const int j = h * 64 + jq * 16 + lr; w0v[jq] = inp(lds, I_RW0)[l * 768 + j]; a0v[jq] = inp(lds, I_RA0)[l * 768 + j]; kkwv[jq] = inp(lds, I_RKK)[l * 768 + j]; kawv[jq] = inp(lds, I_RKA)[l * 768 + j];
                murv[jq] = mu[j]; mukv[jq] = mu[768 + j]; muvv[jq] = mu[1536 + j]; }
#pragma unroll
            for (int r = 0; r < 4; ++r) { const bool first = (sp + tokb + r == 0);
                float kr[4], kv_[4], rv_[4], vv_[4], av_[4]; float ss = 0.f;
#pragma unroll
                for (int jq = 0; jq < 4; ++jq) { const float cr = bf2f(pr_[r + 1][jq]), ck = bf2f(pk_[r + 1][jq]), cvv = bf2f(pv_[r + 1][jq]);
                    const float qr = first ? 0.f : bf2f(pr_[r][jq]), qk = first ? 0.f : bf2f(pk_[r][jq]), qv = first ? 0.f : bf2f(pv_[r][jq]);
                    rv_[jq] = cr + (qr - cr) * murv[jq]; kv_[jq] = ck + (qk - ck) * mukv[jq]; vv_[jq] = cvv + (qv - cvv) * muvv[jq];
                    av_[jq] = sigmoidf_(a0v[jq] + aa[jq][r]); kr[jq] = kv_[jq] * kkwv[jq]; ss += kr[jq] * kr[jq]; }
                ss = sum16(ss); const float rs = 1.0f / sqrtf(ss + 1e-6f);
#pragma unroll
                for (int jq = 0; jq < 4; ++jq) { const size_t o = (size_t)(t0 + tokb + r) * 768 + h * 64 + jq * 16 + lr;
                    const float wlog = -softplusf_(-(w0v[jq] + aw[jq][r])) - 0.5f; RWd[o] = -__expf(wlog);
                    const float kk = kr[jq] * rs; RR[o] = rv_[jq]; RK[o] = kv_[jq] * (1.0f + (av_[jq] - 1.0f) * kawv[jq]); RV[o] = vv_[jq]; RKK[o] = kk; RB[o] = kk * av_[jq]; } }
        }
        for (int u = wave; u < 16; u += 8) { const int n = u & 7, tb = u >> 3;
            bf16x8 xg[2];
#pragma unroll
            for (int k = 0; k < 2; ++k) xg[k] = *(const LAS bf16x8*)(xlb + (tb * 16 + lr) * XLR + n * 64 + 32 * k + 8 * lq);
            f32x4 ax[4], ag[4];
#pragma unroll
            for (int jq = 0; jq < 4; ++jq) { const size_t jrow = (size_t)(l * 8 + n) * 64 + jq * 16 + lr; const bf16_t* px = (const bf16_t*)(ws + WS_WXT) + jrow * 64 + 8 * lq; const bf16_t* pa = (const bf16_t*)(ws + WS_WAT) + jrow * 64 + 8 * lq;
                ax[jq] = (f32x4){0.f, 0.f, 0.f, 0.f}; ag[jq] = (f32x4){0.f, 0.f, 0.f, 0.f};
#pragma unroll
                for (int k = 0; k < 2; ++k) { ax[jq] = __builtin_amdgcn_mfma_f32_16x16x32_bf16(xg[k], *(const bf16x8*)(px + 32 * k), ax[jq], 0, 0, 0); ag[jq] = __builtin_amdgcn_mfma_f32_16x16x32_bf16(xg[k], *(const bf16x8*)(pa + 32 * k), ag[jq], 0, 0, 0); } }
#pragma unroll
            for (int jq = 0; jq < 4; ++jq) { const int j = n * 64 + jq * 16 + lr; const float bx = inp(lds, I_LBX)[l * 512 + j], ba = inp(lds, I_LBA)[l * 512 + j]; const float spl = softplusf_(-inp(lds, I_LLAM)[l * 512 + j]);
#pragma unroll
                for (int r = 0; r < 4; ++r) { const int tt = tb * 16 + 4 * lq + r; const float gx = sigmoidf_(ax[jq][r] + bx), ga = sigmoidf_(ag[jq][r] + ba);
                    const float loga = -8.0f * ga * spl; const float av = __expf(loga); const float mult = sqrtf(fmaxf(-expm1f(2.0f * loga), 0.f));
                    LA[(size_t)(t0 + tt) * 512 + j] = av; LU[(size_t)(t0 + tt) * 512 + j] = mult * gx * xlf[tt * 512 + j]; } } }
        for (int wt = wave; wt < 18; wt += 8) { const int ch0 = 128 * wt + 2 * lane; const float* cw = inp(lds, I_GCW) + (size_t)l * 4 * 2304 + ch0;
            const f32x2 w0 = *(const f32x2*)(cw), w1 = *(const f32x2*)(cw + 2304), w2 = *(const f32x2*)(cw + 2 * 2304), w3 = *(const f32x2*)(cw + 3 * 2304);
            f32x2 xm3 = {0.f, 0.f}, xm2 = {0.f, 0.f}, xm1 = {0.f, 0.f};
            const bf16_t* pc = PROJ + PC_BQKV + ch0;
            if (sp >= 3) { const unsigned q = *(const unsigned*)(pc + (size_t)(t0 - 3) * NP); xm3.x = __uint_as_float(q << 16); xm3.y = __uint_as_float(q & 0xffff0000u); }
            if (sp >= 2) { const unsigned q = *(const unsigned*)(pc + (size_t)(t0 - 2) * NP); xm2.x = __uint_as_float(q << 16); xm2.y = __uint_as_float(q & 0xffff0000u); }
            if (sp >= 1) { const unsigned q = *(const unsigned*)(pc + (size_t)(t0 - 1) * NP); xm1.x = __uint_as_float(q << 16); xm1.y = __uint_as_float(q & 0xffff0000u); }
            float* dst = (wt < 6) ? GQ : (wt < 12 ? GK : GV); const int dch = ch0 % 768;
            unsigned qv[PT];
#pragma unroll
            for (int tt = 0; tt < PT; ++tt) qv[tt] = *(const unsigned*)(pc + (size_t)(t0 + tt) * NP);
#pragma unroll
            for (int tt = 0; tt < PT; ++tt) { const unsigned q = qv[tt]; f32x2 cur; cur.x = __uint_as_float(q << 16); cur.y = __uint_as_float(q & 0xffff0000u);
                f32x2 v = w0 * xm3 + w1 * xm2 + w2 * xm1 + w3 * cur; v.x = siluf_(v.x); v.y = siluf_(v.y);
                if (wt < 12) { const float ss = wave_sum(v.x * v.x + v.y * v.y); float sc = 1.0f / sqrtf(ss + 1e-6f); if (wt < 6) sc *= 0.08838834764831845f; v = v * sc; }
                *(f32x2*)(dst + (size_t)(t0 + tt) * 768 + dch) = v; xm3 = xm2; xm2 = xm1; xm1 = cur; } }
        if (tid < PT * 6) { const int tt = tid / 6, h = tid % 6; const float bl = bf2f(PROJ[(size_t)(t0 + tt) * NP + PC_BETA + h]), al = bf2f(PROJ[(size_t)(t0 + tt) * NP + PC_BA + h]);
            GB[(size_t)(t0 + tt) * 8 + h] = sigmoidf_(bl); GG[(size_t)(t0 + tt) * 8 + h] = -__expf(inp(lds, I_GALOG)[l * 6 + h]) * softplusf_(al + inp(lds, I_GDT)[l * 6 + h]); }
        LBAR();
    }
}
typedef short bf16x8 __attribute__((ext_vector_type(8)));
struct ScanRec { const bf16_t* M1; const bf16_t* M2; const bf16_t* M3; const bf16_t* M4T; const float* UT; const float* G; const bf16_t* VT; };
template <int D, int KZ, bool EXT>
__device__ __forceinline__ void scan_item(const ScanRec R0, int e0, float* OUT, int out_ld, LAS unsigned char* lds) {
    constexpr int NK1 = D / 32, NK2 = KZ / 32, NT3 = D / 64, SROW = D + 8, ZROW = KZ + 8, HD = EXT ? 64 : 128;
    constexpr bool GS = !EXT;
    const int tid = tid_l(), w = __builtin_amdgcn_readfirstlane(tid >> 6), lane = tid & 63, lr = lane & 15, lq = lane >> 4;
    const bool front = (w < 4); const int cb = w & 3;
    LAS bf16_t* ST = (LAS bf16_t*)lds;
    LAS bf16_t* ZT = (LAS bf16_t*)(lds + 2 * 32 * SROW * 2);
    constexpr int OSROW = 36;
    LAS float* OS = (LAS float*)(lds + 2 * 32 * SROW * 2 + 32 * ZROW * 2);
    for (int i = tid; i < 2 * 32 * SROW / 2; i += 512) ((LAS unsigned*)ST)[i] = 0u;
    struct FS { bf16x8 m1[NK1], m3[NK2]; f32x4 ut[2]; u32x4 vt; };
    struct BS { bf16x8 m4[NT3][NK2]; f32x4 g[GS ? 1 : NT3]; float gs; };
#define SCAN_LOADF(s, n) do { \
        const bf16_t* a1_ = R0.M1 + (size_t)(n) * 64 * D + (cb * 16 + lr) * D + 8 * lq; \
        _Pragma("unroll") for (int k = 0; k < NK1; ++k) s.m1[k] = *(const bf16x8*)(a1_ + 32 * k); \
        const bf16_t* a3_ = R0.M3 + (size_t)(n) * 64 * KZ + (cb * 16 + lr) * KZ + 8 * lq; \
        _Pragma("unroll") for (int k = 0; k < NK2; ++k) s.m3[k] = *(const bf16x8*)(a3_ + 32 * k); \
        _Pragma("unroll") for (int j = 0; j < 2; ++j) s.ut[j] = *(const f32x4*)(R0.UT + (size_t)(n) * HD * 64 + (size_t)(e0 + j * 16 + lr) * 64 + cb * 16 + 4 * lq); \
        if (EXT) s.vt = *(const u32x4*)(R0.VT + (size_t)(n) * 64 * 64 + (size_t)(e0 + (tid >> 3)) * 64 + (tid & 7) * 8); } while (0)
#define SCAN_LOADB(s, n) do { \
        _Pragma("unroll") for (int t = 0; t < NT3; ++t) { const int db = cb + 4 * t; const bf16_t* a4_ = R0.M4T + (size_t)(n) * D * KZ + (db * 16 + lr) * KZ + 8 * lq; \
            _Pragma("unroll") for (int k = 0; k < NK2; ++k) s.m4[t][k] = *(const bf16x8*)(a4_ + 32 * k); \
            if (!GS) s.g[t] = *(const f32x4*)(R0.G + (size_t)(n) * D + db * 16 + 4 * lq); } \
        if (GS) s.gs = R0.G[(size_t)(n) * D]; } while (0)
#define SCAN_OUT(n) do { const f32x4 ov = *(const LAS f32x4*)(OS + (tid >> 3) * OSROW + (tid & 7) * 4); *(f32x4*)(OUT + (size_t)((n) * 64 + (tid >> 3)) * out_ld + e0 + (tid & 7) * 4) = ov; } while (0)
#define SCAN_STEP_F(n, par, fc, fl) do { \
        LAS bf16_t* STo = ST + (par) * 32 * SROW; \
        bf16x8 m2l[NK1]; \
        { const bf16_t* a2_ = R0.M2 + (size_t)(n) * 64 * D + (cb * 16 + lr) * D + 8 * lq; _Pragma("unroll") for (int k = 0; k < NK1; ++k) m2l[k] = *(const bf16x8*)(a2_ + 32 * k); }     \
        if ((n) + 2 < 32) SCAN_LOADF(fl, (n) + 2); \
        _Pragma("unroll") for (int j = 0; j < 2; ++j) { f32x4 a1 = fc.ut[j]; \
            _Pragma("unroll") for (int k = 0; k < NK1; ++k) { const bf16x8 y = *(const LAS bf16x8*)(STo + (j * 16 + lr) * SROW + 32 * k + 8 * lq); a1 = __builtin_amdgcn_mfma_f32_16x16x32_bf16(fc.m1[k], y, a1, 0, 0, 0); } \
            u32x2 zz; zz.x = cvtpk(a1[0], a1[1]); zz.y = cvtpk(a1[2], a1[3]); *(LAS u32x2*)(ZT + (j * 16 + lr) * ZROW + cb * 16 + 4 * lq) = zz; } \
        if (EXT) *(LAS u32x4*)(ZT + (tid >> 3) * ZROW + 64 + (tid & 7) * 8) = fc.vt; \
        LBAR(); \
        _Pragma("unroll") for (int j = 0; j < 2; ++j) { f32x4 a2 = (f32x4){0.f, 0.f, 0.f, 0.f}; \
            _Pragma("unroll") for (int k = 0; k < NK2; ++k) { const bf16x8 z = *(const LAS bf16x8*)(ZT + (j * 16 + lr) * ZROW + 32 * k + 8 * lq); a2 = __builtin_amdgcn_mfma_f32_16x16x32_bf16(fc.m3[k], z, a2, 0, 0, 0); } \
            _Pragma("unroll") for (int k = 0; k < NK1; ++k) { const bf16x8 y = *(const LAS bf16x8*)(STo + (j * 16 + lr) * SROW + 32 * k + 8 * lq); a2 = __builtin_amdgcn_mfma_f32_16x16x32_bf16(m2l[k], y, a2, 0, 0, 0); } \
            _Pragma("unroll") for (int r = 0; r < 4; ++r) OS[(cb * 16 + 4 * lq + r) * OSROW + j * 16 + lr] = a2[r]; } \
        LBAR(); \
        SCAN_OUT(n); } while (0)
#define SCAN_STEP_B(n, par, bc, bl) do { \
        LAS bf16_t* STn = ST + (1 - (par)) * 32 * SROW; \
        if ((n) + 2 < 32) SCAN_LOADB(bl, (n) + 2); \
        LBAR(); \
        _Pragma("unroll") for (int j = 0; j < 2; ++j) { \
            _Pragma("unroll") for (int t = 0; t < NT3; ++t) { if (GS) accs[t][j] = accs[t][j] * bc.gs; else accs[t][j] = accs[t][j] * bc.g[GS ? 0 : t]; } \
            _Pragma("unroll") for (int k = 0; k < NK2; ++k) { const bf16x8 z = *(const LAS bf16x8*)(ZT + (j * 16 + lr) * ZROW + 32 * k + 8 * lq); \
                _Pragma("unroll") for (int t = 0; t < NT3; ++t) accs[t][j] = __builtin_amdgcn_mfma_f32_16x16x32_bf16(bc.m4[t][k], z, accs[t][j], 0, 0, 0); } \
            _Pragma("unroll") for (int t = 0; t < NT3; ++t) { const int db = cb + 4 * t; u32x2 ss; ss.x = cvtpk(accs[t][j][0], accs[t][j][1]); ss.y = cvtpk(accs[t][j][2], accs[t][j][3]); *(LAS u32x2*)(STn + (j * 16 + lr) * SROW + db * 16 + 4 * lq) = ss; } } \
        LBAR(); \
        SCAN_OUT(n); } while (0)
    if (front) {
        FS f0, f1, f2;
        SCAN_LOADF(f0, 0); SCAN_LOADF(f1, 1);
        __builtin_amdgcn_s_waitcnt(0x0F70);
        LBAR();
        for (int n0 = 0; n0 < 30; n0 += 6) {
            SCAN_STEP_F(n0, 0, f0, f2); SCAN_STEP_F(n0 + 1, 1, f1, f0); SCAN_STEP_F(n0 + 2, 0, f2, f1);
            SCAN_STEP_F(n0 + 3, 1, f0, f2); SCAN_STEP_F(n0 + 4, 0, f1, f0); SCAN_STEP_F(n0 + 5, 1, f2, f1);
        }
        SCAN_STEP_F(30, 0, f0, f2); SCAN_STEP_F(31, 1, f1, f0);
    } else {
        BS b0, b1, b2;
        f32x4 accs[NT3][2];
#pragma unroll
        for (int t = 0; t < NT3; ++t) { accs[t][0] = (f32x4){0.f, 0.f, 0.f, 0.f}; accs[t][1] = (f32x4){0.f, 0.f, 0.f, 0.f}; }
        SCAN_LOADB(b0, 0); SCAN_LOADB(b1, 1);
        __builtin_amdgcn_s_waitcnt(0x0F70);
        LBAR();
        for (int n0 = 0; n0 < 30; n0 += 6) {
            SCAN_STEP_B(n0, 0, b0, b2); SCAN_STEP_B(n0 + 1, 1, b1, b0); SCAN_STEP_B(n0 + 2, 0, b2, b1);
            SCAN_STEP_B(n0 + 3, 1, b0, b2); SCAN_STEP_B(n0 + 4, 0, b1, b0); SCAN_STEP_B(n0 + 5, 1, b2, b1);
        }
        SCAN_STEP_B(30, 0, b0, b2); SCAN_STEP_B(31, 1, b1, b0);
    }
#undef SCAN_STEP_F
#undef SCAN_STEP_B
#undef SCAN_OUT
#undef SCAN_LOADF
#undef SCAN_LOADB
}

__device__ __forceinline__ void phase_gdn_chunk(const Args& a, int l, LAS unsigned char* lds) {
    size_t wso_ = 0; asm volatile("" : "+s"(wso_)); unsigned char* ws = a.ws + wso_;
    const int tid0 = tid_l(), w = __builtin_amdgcn_readfirstlane(tid0 >> 6);
    const float* GQ = (const float*)(ws + WS_GQ); const float* GK = (const float*)(ws + WS_GK); const float* GV = (const float*)(ws + WS_GV);
    const float* GB = (const float*)(ws + WS_GB); const float* GG = (const float*)(ws + WS_GG);
    constexpr int KROW = 136;
    LAS bf16_t* Kb = (LAS bf16_t*)lds;
    LAS bf16_t* Qb = (LAS bf16_t*)(lds + 64 * KROW * 2);
    LAS float* Af = (LAS float*)(lds + 2 * 64 * KROW * 2);
    LAS float* dvb = Af + 64 * 64;
    const int first = bid_l(), gstep = gdim_l();
    const int nmine = (first < GCH) ? (GCH - first + gstep - 1) / gstep : 0;
    for (int k = -1; k < nmine; ++k) {
        int tid = tid0; asm volatile("" : "+v"(tid)); const int lane = tid & 63, lr = lane & 15, lq = lane >> 4;
        LBAR();
        if (w < 4) {
            const bool act = (k >= 0); const int item = first + (act ? k : 0) * gstep;
            const int b = item / 192, h = (item / 32) % 6, n = item % 32; const size_t t0 = (size_t)b * SEQ + n * 64;
            LAS float* dv = dvb + (k & 1) * 128; LAS float* bv = dv + 64;
            const int col = tid; const bool isu = (w < 2); const int cc = col & 127;
            float X[64]; int Arow[63];
            if (act) {
                const float* src = (isu ? GV : GK) + t0 * 768 + h * 128 + cc;
#pragma unroll
                for (int c = 0; c < 64; ++c) X[c] = src[(size_t)c * 768];
#pragma unroll
                for (int m = 0; m < 63; ++m) Arow[m] = __float_as_int(Af[m * 64 + lane]);
                if (isu) {
#pragma unroll
                    for (int c = 0; c < 64; ++c) X[c] *= bv[c]; }
                else {
#pragma unroll
                    for (int c = 0; c < 64; ++c) X[c] *= bv[c] * __expf(dv[c]); }
            }
            LBAR();
            if (act) {
#pragma unroll
                for (int m = 0; m < 63; ++m) { const float xm = X[m];
#pragma unroll
                    for (int c = m + 1; c < 64; ++c) X[c] -= __int_as_float(__builtin_amdgcn_readlane(Arow[m], c)) * xm; }
            }
            LBAR();
            if (act) {
                if (isu) { float* UT = (float*)(ws + WS_GU) + (size_t)item * 128 * 64 + (size_t)cc * 64;
#pragma unroll
                    for (int c4 = 0; c4 < 16; ++c4) *(f32x4*)(UT + 4 * c4) = (f32x4){X[4 * c4], X[4 * c4 + 1], X[4 * c4 + 2], X[4 * c4 + 3]}; }
                else { bf16_t* M1 = (bf16_t*)(ws + WS_G1) + (size_t)item * 64 * 128 + cc;
#pragma unroll
                    for (int c = 0; c < 64; ++c) M1[c * 128] = f2bf(-X[c]); }
            }
        } else {
            const bool act = (k + 1 < nmine); const int item = first + (act ? (k + 1) : 0) * gstep;
            const int b = item / 192, h = (item / 32) % 6, n = item % 32; const size_t t0 = (size_t)b * SEQ + n * 64;
            LAS float* dv = dvb + ((k + 1) & 1) * 128; LAS float* bv = dv + 64;
            const int t = tid - 256, wb = w - 4;
            if (act) {
                float gpre = 0.f, bpre = 0.f; if (wb == 0) { gpre = GG[(t0 + lane) * 8 + h]; bpre = GB[(t0 + lane) * 8 + h]; }
#pragma unroll
                for (int hf = 0; hf < 2; ++hf) { f32x4 kv4[4], qv4[4];
#pragma unroll
                    for (int q = 0; q < 4; ++q) { const int idx = t + 256 * (4 * hf + q), c = idx >> 5, d4 = idx & 31; const size_t g = (t0 + c) * 768 + h * 128 + d4 * 4; kv4[q] = *(const f32x4*)(GK + g); qv4[q] = *(const f32x4*)(GQ + g); }
#pragma unroll
                    for (int q = 0; q < 4; ++q) { const int idx = t + 256 * (4 * hf + q), c = idx >> 5, d4 = idx & 31; const f32x4 kv = kv4[q], qv = qv4[q];
                        u32x2 pk; pk.x = cvtpk(kv[0], kv[1]); pk.y = cvtpk(kv[2], kv[3]); *(LAS u32x2*)(Kb + c * KROW + d4 * 4) = pk;
                        u32x2 pq; pq.x = cvtpk(qv[0], qv[1]); pq.y = cvtpk(qv[2], qv[3]); *(LAS u32x2*)(Qb + c * KROW + d4 * 4) = pq; } }
                if (wb == 0) { float g = gpre;
#pragma unroll
                    for (int o = 1; o < 64; o <<= 1) { const float tt = __shfl_up(g, o); if (lane >= o) g += tt; }
                    dv[lane] = g; bv[lane] = bpre; }
            }
            LBAR();
            if (act) {
                const int which = wb >> 1; const LAS bf16_t* X = which ? Qb : Kb;
                bf16_t* M3 = (bf16_t*)(ws + WS_G3) + (size_t)item * 64 * 64;
#pragma unroll
                for (int ci = 0; ci < 2; ++ci) { const int cb = 2 * (wb & 1) + ci;
                    bf16x8 xf[4];
#pragma unroll
                    for (int kk = 0; kk < 4; ++kk) xf[kk] = *(const LAS bf16x8*)(X + (cb * 16 + lr) * KROW + 32 * kk + 8 * lq);
#pragma unroll
                    for (int mb = 0; mb < 4; ++mb) { f32x4 acc = (f32x4){0.f, 0.f, 0.f, 0.f};
#pragma unroll
                        for (int kk = 0; kk < 4; ++kk) { const bf16x8 yf = *(const LAS bf16x8*)(Kb + (mb * 16 + lr) * KROW + 32 * kk + 8 * lq); acc = __builtin_amdgcn_mfma_f32_16x16x32_bf16(xf[kk], yf, acc, 0, 0, 0); }
                        const int m = mb * 16 + lr; const float dm = dv[m];
                        if (which == 0) { f32x4 o;
#pragma unroll
                            for (int r = 0; r < 4; ++r) { const int c = cb * 16 + 4 * lq + r; o[r] = (c > m) ? bv[c] * acc[r] * __expf(dv[c] - dm) : 0.f; }
                            *(LAS f32x4*)(Af + m * 64 + cb * 16 + 4 * lq) = o; }
                        else {
#pragma unroll
                            for (int r = 0; r < 4; ++r) { const int c = cb * 16 + 4 * lq + r; M3[c * 64 + m] = f2bf((c >= m) ? acc[r] * __expf(dv[c] - dm) : 0.f); } } } }
            }
            LBAR();
            if (act) {
                const float dl = dv[63];
                bf16_t* M2 = (bf16_t*)(ws + WS_G2) + (size_t)item * 64 * 128;
#pragma unroll
                for (int q = 0; q < 8; ++q) { const int idx = t + 256 * q, c = idx >> 5, d4 = idx & 31; const u32x2 qq = *(const LAS u32x2*)(Qb + c * KROW + d4 * 4); const float e = __expf(dv[c]);
                    u32x2 p; p.x = cvtpk(__uint_as_float(qq.x << 16) * e, __uint_as_float(qq.x & 0xffff0000u) * e); p.y = cvtpk(__uint_as_float(qq.y << 16) * e, __uint_as_float(qq.y & 0xffff0000u) * e); *(u32x2*)(M2 + c * 128 + d4 * 4) = p; }
                { const int d = t & 127, ch = t >> 7; bf16_t* M4 = (bf16_t*)(ws + WS_G4) + (size_t)item * 128 * 64 + d * 64 + ch * 32;
#pragma unroll
                    for (int q = 0; q < 4; ++q) { float kv[8];
#pragma unroll
                        for (int j = 0; j < 8; ++j) { const int c = ch * 32 + q * 8 + j; kv[j] = bf2f(Kb[c * KROW + d]) * __expf(dl - dv[c]); }
                        u32x4 p; p.x = cvtpk(kv[0], kv[1]); p.y = cvtpk(kv[2], kv[3]); p.z = cvtpk(kv[4], kv[5]); p.w = cvtpk(kv[6], kv[7]); *(u32x4*)(M4 + q * 8) = p; } }
                if (t < 128) ((float*)(ws + WS_GGL))[(size_t)item * 128 + t] = __expf(dl);
            }
        }
    }
    LBAR();
}

__device__ __forceinline__ void phase_rwkv_chunk(const Args& a, int l, LAS unsigned char* lds) {
    size_t wso_ = 0; asm volatile("" : "+s"(wso_)); unsigned char* ws = a.ws + wso_;
    const int tid0 = tid_l(), w = __builtin_amdgcn_readfirstlane(tid0 >> 6);
    const float* RR = (const float*)(ws + WS_RR); const float* RWl = (const float*)(ws + WS_RW); const float* RK = (const float*)(ws + WS_RK); const float* RV = (const float*)(ws + WS_RV);
    const float* RKK = (const float*)(ws + WS_RKK); const float* RB = (const float*)(ws + WS_RB);
    constexpr int OR_ = 72;
    LAS float* cw = (LAS float*)lds;
    LAS bf16_t* M3s = (LAS bf16_t*)lds;
    LAS bf16_t* Al = (LAS bf16_t*)(lds + 16384); LAS bf16_t* Be = Al + 64 * OR_; LAS bf16_t* Ka = Be + 64 * OR_; LAS bf16_t* Rh = Ka + 64 * OR_;
    LAS float* ABf = (LAS float*)(lds + 53248);
    LAS bf16_t* AKb = (LAS bf16_t*)(lds + 69632);
    LAS bf16_t* VTb = (LAS bf16_t*)(lds + 78848);
    LAS float* RH2 = (LAS float*)(lds + 88064);
    LAS bf16_t* M4s = (LAS bf16_t*)(lds + 104448);
    LAS float* segt = (LAS float*)(lds + 121856);
    const int first = bid_l(), gstep = gdim_l();
    const int nmine = (first < RCH) ? (RCH - first + gstep - 1) / gstep : 0;
    if (w < 2) {
    for (int k = -1; k < nmine; ++k) {
        int tid = tid0; asm volatile("" : "+v"(tid)); const int lane = tid & 63, lr = lane & 15, lq = lane >> 4;
            const bool act = (k >= 0); const int item = first + (act ? k : 0) * gstep;
            const bool isom = (w == 0); const int cc = tid & 63;
            float X[64]; int Arow[63];
            if (act) {
                if (isom) {
#pragma unroll
                    for (int c = 0; c < 64; ++c) X[c] = bf2f(Al[c * OR_ + cc]); }
                else {
#pragma unroll
                    for (int c = 0; c < 64; ++c) X[c] = RH2[c * 64 + cc]; }
#pragma unroll
                for (int m = 0; m < 63; ++m) Arow[m] = __float_as_int(ABf[m * 64 + lane]);
            }
            LBAR();
#define RW_SOLVE(m0, m1) do { if (act) { _Pragma("unroll") for (int m = (m0); m < (m1); ++m) { const float xm = X[m]; \
                _Pragma("unroll") for (int c = m + 1; c < 64; ++c) X[c] -= __int_as_float(__builtin_amdgcn_readlane(Arow[m], c)) * xm; } } } while (0)
            RW_SOLVE(0, 30);
            LBAR();
            RW_SOLVE(30, 63);
            LBAR();
#undef RW_SOLVE
            if (act) {
                if (isom) { bf16_t* M1 = (bf16_t*)(ws + WS_R1) + (size_t)item * 4096 + cc;
#pragma unroll
                    for (int c = 0; c < 64; ++c) M1[c * 64] = f2bf(X[c]); }
                else { float* UT = (float*)(ws + WS_RU) + (size_t)item * 4096 + (size_t)cc * 64;
#pragma unroll
                    for (int c4 = 0; c4 < 16; ++c4) *(f32x4*)(UT + 4 * c4) = (f32x4){X[4 * c4], X[4 * c4 + 1], X[4 * c4 + 2], X[4 * c4 + 3]}; }
            }
            LBAR();
    }
    } else {
    float plw[16], pv[11], pkk[12], pbb[12], pk2[12], pr[12];
#define RWB_ISSUE(it) do { const int b_ = (it) / 384, h_ = ((it) / 32) % 12, n_ = (it) % 32; const size_t gb_ = ((size_t)b_ * SEQ + n_ * 64) * 768 + h_ * 64; const int t_ = tidp - 128, wb_ = w - 2; \
        if (wb_ < 4) { _Pragma("unroll") for (int q = 0; q < 16; ++q) plw[q] = RWl[gb_ + (size_t)(wb_ * 16 + q) * 768 + (tidp & 63)]; } \
        _Pragma("unroll") for (int q = 0; q < 11; ++q) { const int idx = t_ + 384 * q; const int c = (idx >> 6) & 63, i = idx & 63; pv[q] = RV[gb_ + (size_t)c * 768 + i]; } \
        _Pragma("unroll") for (int q = 0; q < 12; ++q) { const int idx = t_ + 384 * q; const int c = (idx >> 6) & 63, j = idx & 63; const size_t g = gb_ + (size_t)c * 768 + j; pkk[q] = RKK[g]; pbb[q] = RB[g]; pk2[q] = RK[g]; pr[q] = RR[g]; } } while (0)
    if (nmine > 0) { int tidp = tid0; asm volatile("" : "+v"(tidp)); RWB_ISSUE(first); }
    for (int k = -1; k < nmine; ++k) {
        int tid = tid0; asm volatile("" : "+v"(tid)); const int lane = tid & 63, lr = lane & 15, lq = lane >> 4;
            const bool act = (k + 1 < nmine); const int item = first + (act ? (k + 1) : 0) * gstep;
            const int b = item / 384, h = (item / 32) % 12, n = item % 32; const size_t gb = ((size_t)b * SEQ + n * 64) * 768 + h * 64;
            const int t = tid - 128, wb = w - 2;
            if (act) {
                if (wb < 4) {
                    float acc = 0.f;
#pragma unroll
                    for (int q = 0; q < 8; ++q) { acc += plw[q]; cw[(wb * 16 + q) * 64 + lane] = acc; }
                    segt[(2 * wb) * 64 + lane] = acc; acc = 0.f;
#pragma unroll
                    for (int q = 8; q < 16; ++q) { acc += plw[q]; cw[(wb * 16 + q) * 64 + lane] = acc; }
                    segt[(2 * wb + 1) * 64 + lane] = acc; }
#pragma unroll
                for (int q = 0; q < 11; ++q) { const int idx = t + 384 * q; const int c = idx >> 6, i = idx & 63; if (idx < 4096) VTb[i * OR_ + c] = f2bf(pv[q]); }
            }
            LBAR();
            if (act) {
#pragma unroll
                for (int hf = 0; hf < 2; ++hf) {
#pragma unroll
                    for (int q = 0; q < 6; ++q) { const int idx = t + 384 * (6 * hf + q); const int c = idx >> 6, j = idx & 63;
                        if (idx < 4096) {
                            float off = 0.f, offm = 0.f, tot = 0.f;
#pragma unroll
                            for (int s2 = 0; s2 < 8; ++s2) { const float st = segt[s2 * 64 + j]; if (s2 < (c >> 3)) off += st; if (c > 0 && s2 < ((c - 1) >> 3)) offm += st; tot += st; }
                            const float cwc = cw[c * 64 + j] + off, cwm = c ? cw[(c - 1) * 64 + j] + offm : 0.f, cwl = tot;
                            const float kk = pkk[6 * hf + q], bb = pbb[6 * hf + q], k2 = pk2[6 * hf + q], r = pr[6 * hf + q];
                            const float en = __expf(-cwc);
                            Al[c * OR_ + j] = f2bf(kk * __expf(cwm)); Be[c * OR_ + j] = f2bf(bb * en); Ka[c * OR_ + j] = f2bf(k2 * en); const bf16_t rh = f2bf(r * __expf(cwc)); Rh[c * OR_ + j] = rh;
                            ((bf16_t*)(ws + WS_R2))[(size_t)item * 4096 + c * 64 + j] = rh;
                            const float ed = __expf(cwl - cwc); M4s[j * 136 + c] = f2bf(-bb * ed); M4s[j * 136 + 64 + c] = f2bf(k2 * ed);
                            if (c == 63) ((float*)(ws + WS_RGL))[(size_t)item * 64 + j] = __expf(cwl); } } }
                if (k + 2 < nmine) { const int tidp = tid; RWB_ISSUE(first + (k + 2) * gstep); }
            }
            LBAR();
            if (act) {
                for (int pc = wb; pc < 16; pc += 6) { const int p = pc >> 2, cb = pc & 3; const LAS bf16_t* X = (p < 2) ? Al : Rh; const LAS bf16_t* Y = (p & 1) ? Ka : Be;
                    const bf16x8 x0 = *(const LAS bf16x8*)(X + (cb * 16 + lr) * OR_ + 8 * lq), x1 = *(const LAS bf16x8*)(X + (cb * 16 + lr) * OR_ + 32 + 8 * lq);
#pragma unroll
                    for (int mb = 0; mb < 4; ++mb) { f32x4 acc = (f32x4){0.f, 0.f, 0.f, 0.f};
                        acc = __builtin_amdgcn_mfma_f32_16x16x32_bf16(x0, *(const LAS bf16x8*)(Y + (mb * 16 + lr) * OR_ + 8 * lq), acc, 0, 0, 0);
                        acc = __builtin_amdgcn_mfma_f32_16x16x32_bf16(x1, *(const LAS bf16x8*)(Y + (mb * 16 + lr) * OR_ + 32 + 8 * lq), acc, 0, 0, 0);
                        const int m = mb * 16 + lr;
                        if (p == 0) { f32x4 o;
#pragma unroll
                            for (int r = 0; r < 4; ++r) { const int c = cb * 16 + 4 * lq + r; o[r] = (c > m) ? acc[r] : 0.f; }
                            *(LAS f32x4*)(ABf + m * 64 + cb * 16 + 4 * lq) = o; }
                        else {
#pragma unroll
                            for (int r = 0; r < 4; ++r) { const int c = cb * 16 + 4 * lq + r;
                                if (p == 1) AKb[c * OR_ + m] = f2bf((c > m) ? acc[r] : 0.f);
                                else if (p == 2) M3s[c * 128 + m] = f2bf((c >= m) ? -acc[r] : 0.f);
                                else M3s[c * 128 + 64 + m] = f2bf((c >= m) ? acc[r] : 0.f); } } } }
            }
            LBAR();
            if (act) {
                for (int tl = wb; tl < 16; tl += 6) { const int cb = tl >> 2, ib = tl & 3;
                    const bf16x8 x0 = *(const LAS bf16x8*)(AKb + (cb * 16 + lr) * OR_ + 8 * lq), x1 = *(const LAS bf16x8*)(AKb + (cb * 16 + lr) * OR_ + 32 + 8 * lq);
                    f32x4 acc = (f32x4){0.f, 0.f, 0.f, 0.f};
                    acc = __builtin_amdgcn_mfma_f32_16x16x32_bf16(x0, *(const LAS bf16x8*)(VTb + (ib * 16 + lr) * OR_ + 8 * lq), acc, 0, 0, 0);
                    acc = __builtin_amdgcn_mfma_f32_16x16x32_bf16(x1, *(const LAS bf16x8*)(VTb + (ib * 16 + lr) * OR_ + 32 + 8 * lq), acc, 0, 0, 0);
#pragma unroll
                    for (int r = 0; r < 4; ++r) RH2[(cb * 16 + 4 * lq + r) * 64 + ib * 16 + lr] = acc[r]; }
                u32x4* g3 = (u32x4*)((bf16_t*)(ws + WS_R3) + (size_t)item * 64 * 128);
                for (int q = t; q < 1024; q += 384) g3[q] = *(const LAS u32x4*)(M3s + q * 8);
                u32x4* g4 = (u32x4*)((bf16_t*)(ws + WS_R4) + (size_t)item * 64 * 128);
                for (int q = t; q < 1024; q += 384) g4[q] = *(const LAS u32x4*)(M4s + (q >> 4) * 136 + (q & 15) * 8);
                u32x4* gv = (u32x4*)((bf16_t*)(ws + WS_RVT) + (size_t)item * 64 * 64);
                for (int q = t; q < 512; q += 384) gv[q] = *(const LAS u32x4*)(VTb + (q >> 3) * OR_ + (q & 7) * 8);
            }
            LBAR();
    }
    }
    LBAR();
#undef RWB_ISSUE
}

__device__ __forceinline__ void phase_lru_chunk(const Args& a) {
    size_t wso_ = 0; asm volatile("" : "+s"(wso_)); unsigned char* ws = a.ws + wso_;
    const int tid = tid_l();
    const float* LA = (const float*)(ws + WS_LA); const float* LU = (const float*)(ws + WS_LU); float* LH = (float*)(ws + WS_LH); float* LP = (float*)(ws + WS_LP);
    for (int p = bid_l() * 512 + tid; p < 128 * 512; p += gdim_l() * 512) { const int chunk = p >> 9, c = p & 511; const size_t base = (size_t)chunk * 64 * 512 + c;
        float h = 0.f, cp = 1.f;
        for (int i0 = 0; i0 < 64; i0 += 16) { float av[16], uv[16];
#pragma unroll
            for (int i = 0; i < 16; ++i) { av[i] = LA[base + (size_t)(i0 + i) * 512]; uv[i] = LU[base + (size_t)(i0 + i) * 512]; }
#pragma unroll
            for (int i = 0; i < 16; ++i) { h = av[i] * h + uv[i]; cp *= av[i]; LH[base + (size_t)(i0 + i) * 512] = h; LP[base + (size_t)(i0 + i) * 512] = cp; } } }
}
constexpr int SB = 16;
__device__ __forceinline__ void phase_scan_naive(const Args& a, int l, LAS unsigned char* lds) {
    size_t wso_ = 0; asm volatile("" : "+s"(wso_)); unsigned char* ws = a.ws + wso_;
    const int tid = tid_l(), wave = __builtin_amdgcn_readfirstlane(tid >> 6), lane = tid & 63;
    const int blk = bid_l();
    if (blk < 96) {
        const int xq = blk >> 3, bh = (blk & 7) * 3 + (xq >> 2), es = xq & 3, b = bh / 6, h = bh % 6; const size_t ci = (size_t)bh * 32;
        ScanRec R{(const bf16_t*)(ws + WS_G1) + ci * 64 * 128, (const bf16_t*)(ws + WS_G2) + ci * 64 * 128, (const bf16_t*)(ws + WS_G3) + ci * 64 * 64, (const bf16_t*)(ws + WS_G4) + ci * 128 * 64,
                  (const float*)(ws + WS_GU) + ci * 128 * 64, (const float*)(ws + WS_GGL) + ci * 128, nullptr};
        scan_item<128, 64, false>(R, es * 32, (float*)(ws + WS_GO) + (size_t)b * SEQ * 768 + h * 128, 768, lds);
    } else if (blk < 192) {
        const int it = blk - 96, xq = it >> 3, bh = (it & 7) * 6 + (xq >> 1), es = xq & 1, b = bh / 12, h = bh % 12; const size_t ci = (size_t)bh * 32;
        ScanRec R{(const bf16_t*)(ws + WS_R1) + ci * 4096, (const bf16_t*)(ws + WS_R2) + ci * 4096, (const bf16_t*)(ws + WS_R3) + ci * 8192, (const bf16_t*)(ws + WS_R4) + ci * 8192,
                  (const float*)(ws + WS_RU) + ci * 4096, (const float*)(ws + WS_RGL) + ci * 64, (const bf16_t*)(ws + WS_RVT) + ci * 4096};
        scan_item<64, 128, true>(R, es * 32, (float*)(ws + WS_RY) + (size_t)b * SEQ * 768 + h * 64, 768, lds);
    } else if (blk < 196) {
        const int gidx = (blk - 192) * 512 + tid, b = gidx >> 9, c = gidx & 511;
        const float* LH = (const float*)(ws + WS_LH); const float* LP = (const float*)(ws + WS_LP); float* LC = (float*)(ws + WS_LC);
        float pe[32], he[32];
#pragma unroll
        for (int n = 0; n < 32; ++n) { const size_t o = ((size_t)b * SEQ + n * 64 + 63) * 512 + c; pe[n] = LP[o]; he[n] = LH[o]; }
        float carry = 0.f;
#pragma unroll
        for (int n = 0; n < 32; ++n) { LC[(size_t)(b * 32 + n) * 512 + c] = carry; carry = pe[n] * carry + he[n]; }
    } else if (l + 1 < NL && CONV_SPLIT > 0) {
        phase_convert(a, lds, l + 1, l + 2, 0, CONV_SPLIT, blk - 196, gdim_l() - 196, 0);
    }
}
__device__ __forceinline__ void phase_fin(const Args& a, int l, LAS unsigned char* lds) {
    size_t wso_ = 0; asm volatile("" : "+s"(wso_)); unsigned char* ws = a.ws + wso_;
    const int tid = tid_l(), wave = tid >> 6, lane = tid & 63;
    const int gw = bid_l() * 8 + wave, NGW = gdim_l() * 8;
    const bf16_t* PROJ = (const bf16_t*)(ws + WS_PROJ); bf16_t* Y = (bf16_t*)(ws + WS_Y);
    const float* GO = (const float*)(ws + WS_GO); const float* RY = (const float*)(ws + WS_RY);
    const float* RR = (const float*)(ws + WS_RR); const float* RK = (const float*)(ws + WS_RK); const float* RV = (const float*)(ws + WS_RV);
    const float* LH = (const float*)(ws + WS_LH); const float* LP = (const float*)(ws + WS_LP); const float* LC = (const float*)(ws + WS_LC);
    const f32x2 ng = *(const f32x2*)(inp(lds, I_GNG) + l * 128 + 2 * lane);
    float gnw[12], gnb[12], rkw[12];
#pragma unroll
    for (int h = 0; h < 12; ++h) { gnw[h] = inp(lds, I_RGNW)[l * 768 + h * 64 + lane]; gnb[h] = inp(lds, I_RGNB)[l * 768 + h * 64 + lane]; rkw[h] = inp(lds, I_RRK)[l * 768 + h * 64 + lane]; }
    for (int t = gw; t < NTOK; t += NGW) {
        const f32x4 h0 = *(const f32x4*)(LH + (size_t)t * 512 + 8 * lane), h1 = *(const f32x4*)(LH + (size_t)t * 512 + 8 * lane + 4);
        const f32x4 p0 = *(const f32x4*)(LP + (size_t)t * 512 + 8 * lane), p1 = *(const f32x4*)(LP + (size_t)t * 512 + 8 * lane + 4);
        const f32x4 c0 = *(const f32x4*)(LC + (size_t)(t >> 6) * 512 + 8 * lane), c1 = *(const f32x4*)(LC + (size_t)(t >> 6) * 512 + 8 * lane + 4);
        const u32x4 gq = *(const u32x4*)(PROJ + (size_t)t * NP + PC_AG + 8 * lane);
        f32x2 go[6]; unsigned gg[6];
#pragma unroll
        for (int h = 0; h < 6; ++h) { go[h] = *(const f32x2*)(GO + (size_t)t * 768 + h * 128 + 2 * lane); gg[h] = *(const unsigned*)(PROJ + (size_t)t * NP + PC_BG + h * 128 + 2 * lane); }
        float ry[12], rr[12], rk[12], rv[12]; bf16_t rg[12];
#pragma unroll
        for (int h = 0; h < 12; ++h) { const size_t o = (size_t)t * 768 + h * 64 + lane; ry[h] = RY[o]; rr[h] = RR[o]; rk[h] = RK[o]; rv[h] = RV[o]; rg[h] = PROJ[(size_t)t * NP + PC_CG + h * 64 + lane]; }
        { const f32x4 v0 = h0 + p0 * c0, v1 = h1 + p1 * c1;
            u32x4 o; o.x = cvtpk(v0[0] * siluf_(__uint_as_float(gq.x << 16)), v0[1] * siluf_(__uint_as_float(gq.x & 0xffff0000u)));
            o.y = cvtpk(v0[2] * siluf_(__uint_as_float(gq.y << 16)), v0[3] * siluf_(__uint_as_float(gq.y & 0xffff0000u)));
            o.z = cvtpk(v1[0] * siluf_(__uint_as_float(gq.z << 16)), v1[1] * siluf_(__uint_as_float(gq.z & 0xffff0000u)));
            o.w = cvtpk(v1[2] * siluf_(__uint_as_float(gq.w << 16)), v1[3] * siluf_(__uint_as_float(gq.w & 0xffff0000u)));
            *(u32x4*)(Y + (size_t)t * DM + 8 * lane) = o; }
#pragma unroll
        for (int h = 0; h < 6; ++h) { const f32x2 o = go[h]; const float ss = wave_sum(o.x * o.x + o.y * o.y); const float sc = 1.0f / sqrtf(ss * (1.0f / 128.f) + 1e-6f);
            const float g0 = __uint_as_float(gg[h] << 16), g1 = __uint_as_float(gg[h] & 0xffff0000u);
            *(unsigned*)(Y + (size_t)t * DM + 512 + h * 128 + 2 * lane) = cvtpk(o.x * sc * ng.x * siluf_(g0), o.y * sc * ng.y * siluf_(g1)); }
#pragma unroll
        for (int h = 0; h < 12; ++h) { const float y = ry[h]; const float mean = wave_sum(y) * (1.0f / 64.f); const float d = y - mean; const float var = wave_sum(d * d) * (1.0f / 64.f);
            float yn = d * (1.0f / sqrtf(var + 64e-5f)) * gnw[h] + gnb[h];
            const float sdot = wave_sum(rr[h] * rk[h] * rkw[h]); yn += sdot * rv[h];
            Y[(size_t)t * DM + 1280 + h * 64 + lane] = f2bf(yn * siluf_(bf2f(rg[h]))); }
    }
}
#define XB_TMO      128
#define XB_XCNT(j)  (256  + 64 * (j))
#define XB_XSUB(j)  (1280 + 64 * (j))
#define XB_XGEN(j)  (2304 + 64 * (j))
#define XB_TOP      3328
#define XB_TOPGEN   3392
#define XCD_BAR_WORDS 3456
#define XB_SPIN_CAP (1u << 18)
__device__ __forceinline__ unsigned xb_ld(unsigned* p)              { return __hip_atomic_load(p, __ATOMIC_RELAXED, __HIP_MEMORY_SCOPE_AGENT); }
__device__ __forceinline__ unsigned xb_add(unsigned* p, unsigned v) { return __hip_atomic_fetch_add(p, v, __ATOMIC_RELAXED, __HIP_MEMORY_SCOPE_AGENT); }
__device__ __forceinline__ unsigned xb_xcc_id() { return (unsigned)__builtin_amdgcn_s_getreg((3 << 11) | 20) & 0xFu; }
#define XB_SPIN(cond, bar) do { unsigned _sp = 0; while (cond) { __builtin_amdgcn_s_sleep(1); \
    if ((++_sp & 255u) == 0u) { if (xb_ld(&(bar)[XB_TMO])) break; if (_sp > XB_SPIN_CAP) { atomicAdd(&(bar)[XB_TMO], 1u); break; } } } } while (0)

struct XcdBarrier {
    unsigned* bar; unsigned x;
    volatile LAS unsigned* st;
};

__device__ __forceinline__ XcdBarrier xcd_barrier_post(unsigned* bar, volatile LAS unsigned* st) {
    XcdBarrier b; b.bar = bar; b.x = xb_xcc_id(); b.st = st;
    if (threadIdx.x == 0) (void)xb_add(&bar[XB_XCNT(b.x)], 1u);
    return b;
}
__device__ __forceinline__ void xcd_barrier_complete(unsigned* bar, unsigned x, unsigned& nloc, unsigned& nx) {
    const unsigned G = gridDim.x * gridDim.y * gridDim.z;
    unsigned sum, cnt, mine, sp = 0u;
    for (;;) {
        sum = 0u; cnt = 0u; mine = 0u;
#pragma unroll
        for (unsigned j = 0; j < 16; ++j) { const unsigned c = xb_ld(&bar[XB_XCNT(j)]); sum += c; cnt += (c > 0u) ? 1u : 0u; mine = (j == x) ? c : mine; }
        if (sum == G) break;
        __builtin_amdgcn_s_sleep(1);
        if ((++sp & 255u) == 0u) { if (xb_ld(&bar[XB_TMO])) break; if (sp > XB_SPIN_CAP) { atomicAdd(&bar[XB_TMO], 1u); break; } }
    }
    nloc = mine > 0u ? mine : 1u; nx = cnt > 0u ? cnt : 1u;
}

__device__ __forceinline__ void xcd_barrier(const XcdBarrier& b) {
    asm volatile("s_waitcnt vmcnt(0)" ::: "memory");
    __syncthreads();
    if (threadIdx.x == 0) {
        unsigned* bar = b.bar;
        __builtin_amdgcn_s_waitcnt(0);
        unsigned nloc = b.st[0], nx = b.st[1];
        if (nloc == 0u) { xcd_barrier_complete(bar, b.x, nloc, nx); b.st[0] = nloc; b.st[1] = nx; }
        const unsigned old = xb_add(&bar[XB_XSUB(b.x)], 1u);
        const unsigned gen = old / nloc;
        if (old + 1u == (gen + 1u) * nloc) {
            __builtin_amdgcn_fence(__ATOMIC_RELEASE, "agent");
            asm volatile("s_waitcnt vmcnt(0)" ::: "memory");
            const unsigned og = xb_add(&bar[XB_TOP], 1u);
            const unsigned tg = og / nx;
            if (og + 1u == (tg + 1u) * nx) xb_add(&bar[XB_TOPGEN], 1u);
            else XB_SPIN(xb_ld(&bar[XB_TOPGEN]) == tg, bar);
            __builtin_amdgcn_fence(__ATOMIC_ACQUIRE, "agent");
            xb_add(&bar[XB_XGEN(b.x)], 1u);
            asm volatile("s_waitcnt vmcnt(0)" ::: "memory");
        } else {
            XB_SPIN(xb_ld(&bar[XB_XGEN(b.x)]) == gen, bar);
            __builtin_amdgcn_fence(__ATOMIC_ACQUIRE, "agent");
            asm volatile("s_waitcnt vmcnt(0)" ::: "memory");
        }
    }
    __syncthreads();
}


__global__ void __launch_bounds__(512) mk_fwd(Args a) {
    extern __shared__ __attribute__((aligned(16))) unsigned char lds_raw[];
    LAS unsigned char* lds = (LAS unsigned char*)lds_raw;
    cg::grid_group grid = cg::this_grid();
    const int lo = a.ph_lo, hi = a.ph_hi;
    if (threadIdx.x < 26) { const unsigned long long p = (unsigned long long)a.in[threadIdx.x]; LAS unsigned* t = (LAS unsigned*)(lds + 131072) + 2 * threadIdx.x; t[0] = (unsigned)p; t[1] = (unsigned)(p >> 32); }
    if (threadIdx.x == 0) { LAS unsigned* z = (LAS unsigned*)(lds + 131072 + 256); z[0] = 0u; z[1] = 0u; z[2] = 0u; z[3] = 0u; }
    __syncthreads();
    XcdBarrier xb = xcd_barrier_post((unsigned*)(a.ws + WS_BAR), (volatile LAS unsigned*)(lds + 131072 + 256));
    float* XR = (float*)(a.ws + WS_XR); bf16_t* XB = (bf16_t*)(a.ws + WS_XB); bf16_t* PROJ = (bf16_t*)(a.ws + WS_PROJ); bf16_t* Y = (bf16_t*)(a.ws + WS_Y);
    for (int ph = lo; ph < hi; ++ph) {
      const int nrep = (REPMASK && ph > 0 && ph < NPHASE - 1 && ((REPMASK >> ((ph - 1) % PPL)) & 1)) ? 2 : 1;
      for (int rep = 0; rep < nrep; ++rep) {
        if (ph == 0) { phase_convert(a, lds, 0, 1, 0, 64, bid_l(), gdim_l(), 1); }
        else if (ph == NPHASE - 1) phase_final(XR, inp(lds, I_FNG), a.out);
        else { const int l = (ph - 1) / PPL, s = (ph - 1) % PPL; const float* xin = (l == 0) ? inp(lds, I_X) : XR;
            if (s == 0) { if (!(SKIPMASK & 2)) phase_rms(xin, XB); }
            else if (s == 1 || s == 6) { if (!(SKIPMASK & 4)) {
                pg8::Gemm g; EpiDual E;
                if (s == 1) { g = pg8::Gemm{XB, (const bf16_t*)(a.ws + WS_WIN) + (size_t)l * NP * DM, NTOK, NP, DM}; E = EpiDual{0, PROJ, NP, nullptr, nullptr, 0}; }
                else { g = pg8::Gemm{Y, (const bf16_t*)(a.ws + WS_WOUT) + (size_t)l * DM * DM, NTOK, DM, DM}; E = EpiDual{1, nullptr, 0, xin, XR, DM}; }
                pg8::StaticOrder S; S.init(NTOK, g.N, gdim_l(), bid_l());
                pg8::gemm_phase<EpiDual, pg8::StaticOrder>(lds, g, S, E, nullptr);
                if (s == 1 && l + 1 < NL) { const int nfull = (NTOK / 256) * (NP / 256) - 3 * gdim_l();
                    if (nfull > 0 && nfull < gdim_l() && bid_l() >= nfull) phase_convert(a, lds, l + 1, l + 2, CONV_SPLIT, 64, bid_l() - nfull, gdim_l() - nfull, 0);
                    else if (nfull <= 0 || nfull >= gdim_l()) phase_convert(a, lds, l + 1, l + 2, CONV_SPLIT, 64, bid_l(), gdim_l(), 0); } } }
            else if (s == 2) { if (!(SKIPMASK & 8)) phase_prep(a, l, lds); }
            else if (s == 3) { phase_gdn_chunk(a, l, lds); if (CHUNKREP & 1) phase_gdn_chunk(a, l, lds); phase_rwkv_chunk(a, l, lds); if (CHUNKREP & 2) phase_rwkv_chunk(a, l, lds); phase_lru_chunk(a); if (CHUNKREP & 4) phase_lru_chunk(a); }
            else if (s == 4) { if (!(SKIPMASK & 16)) phase_scan_naive(a, l, lds); }
            else if (s == 5) { if (!(SKIPMASK & 32)) phase_fin(a, l, lds); }
        }
      }
        if (ph + 1 < hi) { if (ph == 0) grid.sync(); else xcd_barrier(xb); }
    }
}

extern "C" void kernel_launch(void* const* d_in, const int* in_sizes, int n_in, void* d_out, int out_size, void* d_ws, size_t ws_size, hipStream_t stream) {
    static int grid = 0;
    if (grid == 0) {
        if (n_in != 26 || ws_size < WS_END) { fprintf(stderr, "kernel_launch: unexpected n_in %d or ws_size %zu < %zu\n", n_in, ws_size, (size_t)WS_END); grid = -1; return; }
        int dev = 0, cus = 0, per_cu = 0;
        hipGetDevice(&dev); hipDeviceGetAttribute(&cus, hipDeviceAttributeMultiprocessorCount, dev);
        if (hipFuncSetAttribute((const void*)mk_fwd, hipFuncAttributeMaxDynamicSharedMemorySize, LDS_BYTES) != hipSuccess) { fprintf(stderr, "hipFuncSetAttribute failed\n"); grid = -1; return; }
        if (hipOccupancyMaxActiveBlocksPerMultiprocessor(&per_cu, (const void*)mk_fwd, 512, LDS_BYTES) != hipSuccess || per_cu < 1) { fprintf(stderr, "occupancy query failed / 0\n"); grid = -1; return; }
        grid = cus;
    }
    if (grid < 0) return;
    if (hipMemsetAsync((char*)d_ws + WS_BAR, 0, 16384, stream) != hipSuccess) { fprintf(stderr, "memset of barrier words failed\n"); return; }
    Args a{};
    for (int i = 0; i < 26; ++i) a.in[i] = (const float*)d_in[i];
    a.out = (float*)d_out; a.ws = (unsigned char*)d_ws;
#if N_LAUNCH_MODE == 1
    a.ph_lo = 0; a.ph_hi = NPHASE;
    void* args[] = {&a};
    hipError_t e = hipLaunchCooperativeKernel((const void*)mk_fwd, dim3(grid), dim3(512), args, LDS_BYTES, stream);
    if (e != hipSuccess) fprintf(stderr, "cooperative launch failed: %s (grid %d)\n", hipGetErrorString(e), grid);
#else
    for (int ph = 0; ph < NPHASE; ++ph) { a.ph_lo = ph; a.ph_hi = ph + 1; hipLaunchKernelGGL(mk_fwd, dim3(grid), dim3(512), LDS_BYTES, stream, a); }
#endif
}
```

```cpp
#include <hip/hip_runtime.h>
#include <hip/hip_cooperative_groups.h>
#include <cstdio>
#include <cstdint>
namespace cg = cooperative_groups;
namespace pg8 {
#define PG8_LAS __attribute__((address_space(3)))
typedef unsigned short bf16_t;
typedef short bf16x8 __attribute__((ext_vector_type(8)));
typedef float f32x4 __attribute__((ext_vector_type(4)));
typedef unsigned u32x4 __attribute__((ext_vector_type(4)));
constexpr int BM = 256, BK = 64, HALF = 128, HTB = HALF * BK * 2  , STAGE_BYTES = 8 * HTB, NXCD = 8, WGM = 8;

__host__ __device__ __forceinline__ int lds_byte(int r, int c) { const int st = (r >> 4) * 2 + (c >> 5), rr = r & 15, cc = c & 31, ob = rr * 64 + cc * 2; return st * 1024 + (ob ^ (((ob >> 9) & 1) << 5)); }
__host__ __device__ __forceinline__ void stage_rc(int b, int& R, int& C) { const int st = b / 1024, sb = b % 1024, swz = sb ^ (((sb >> 9) & 1) << 5); R = (st >> 1) * 16 + swz / 64; C = (st & 1) * 32 + (swz % 64) / 2; }
__host__ __device__ __forceinline__ int perm32(int rho) { const int n = rho >> 4, i = rho & 15; return 8 * (i >> 2) + 4 * n + (i & 3); }

struct Unit { int pm, pn; };
struct Gemm { const bf16_t* A; const bf16_t* Bt; int M, N, K; };

struct StaticOrder {
    int nM, nN, nwg, G, c;
    __host__ __device__ void init(int M, int N, int G_, int c_) { nM = M / BM; nN = N / BM; nwg = nM * nN; G = G_; c = c_; }
    __host__ __device__ bool next(int i, Unit& u) const {
        const long L = (long)i * G + c; if (L >= nwg) return false;
        int wgid = (int)L; { const int q = nwg / NXCD, r = nwg % NXCD, xcd = wgid % NXCD, off = wgid / NXCD; wgid = (xcd < r ? xcd * (q + 1) : r * (q + 1) + (xcd - r) * q) + off; }
        const int nig = WGM * nN, gid = wgid / nig, fm = gid * WGM, gsz = (nM - fm) < WGM ? (nM - fm) : WGM;
        u.pm = fm + ((wgid % nig) % gsz); u.pn = (wgid % nig) / gsz; return true;
    }
    __device__ __forceinline__ void a_ready(const Unit&) const {}
    __device__ __forceinline__ void done(const Unit&) const {}
};
struct CountedOrder : StaticOrder {
    const unsigned* ready; unsigned need; unsigned* tmo;
    __device__ __forceinline__ void a_ready(const Unit& u) const {
        if (threadIdx.x < 64) {
            const unsigned long long t0 = __builtin_amdgcn_s_memrealtime(); unsigned polls = 0;
            while ((unsigned)__builtin_amdgcn_readfirstlane(__hip_atomic_load(ready + 64 * u.pm, __ATOMIC_RELAXED, __HIP_MEMORY_SCOPE_AGENT)) < need) {
                if ((++polls & 255u) == 0u && __builtin_amdgcn_readfirstlane(__hip_atomic_load(tmo, __ATOMIC_RELAXED, __HIP_MEMORY_SCOPE_AGENT)) != 0u) break;
                if (__builtin_amdgcn_s_memrealtime() - t0 > 2000000ull) {
                    if (threadIdx.x == 0) { unsigned expect = 0u; __hip_atomic_compare_exchange_strong(tmo + 1, &expect, 0x600u | (unsigned)(u.pm & 0xff), __ATOMIC_RELAXED, __ATOMIC_RELAXED, __HIP_MEMORY_SCOPE_AGENT); __hip_atomic_store(tmo, 1u, __ATOMIC_RELAXED, __HIP_MEMORY_SCOPE_AGENT); }
                    break; }
                __builtin_amdgcn_s_sleep(2); }
            __builtin_amdgcn_fence(__ATOMIC_ACQUIRE, "agent");
            asm volatile("s_waitcnt vmcnt(0)" ::: "memory");
        }
#if !defined(BROKEN_HOOK_NO_BARRIER)
        asm volatile("" ::: "memory"); __builtin_amdgcn_s_barrier(); asm volatile("" ::: "memory");
#endif
    }
};

__device__ __forceinline__ unsigned cvt_pk_bf16(float lo, float hi) { unsigned r; asm volatile("v_cvt_pk_bf16_f32 %0, %1, %2" : "=v"(r) : "v"(lo), "v"(hi)); return r; }
typedef float f32x2 __attribute__((ext_vector_type(2)));
__device__ __forceinline__ f32x2 gelu_pk(f32x2 v) {
    const f32x2 av = __builtin_elementwise_abs(v), d = av * 0.2316418882f + 1.0f;
    f32x2 t; t.x = __builtin_amdgcn_rcpf(d.x); t.y = __builtin_amdgcn_rcpf(d.y);
    f32x2 q = t * 0.5307027145f + (-0.7265760135f); q = q * t + 0.7107068705f; q = q * t + (-0.142248368f); q = q * t + 0.127414796f; q = q * t;
    const f32x2 s = (v * v) * (-0.72134752044f);
    f32x2 e; e.x = __builtin_amdgcn_exp2f(s.x); e.y = __builtin_amdgcn_exp2f(s.y);
    const f32x2 m = v * (q * e), r = v - m;
    f32x2 o; o.x = v.x < 0.f ? m.x : r.x; o.y = v.y < 0.f ? m.y : r.y; return o;
}

struct EpiF32 {
    static constexpr bool PERM = false, AFTER_DRAIN = false;
    float* C; int ldc; const float* bias;
    __device__ __forceinline__ void operator()(const f32x4 (&acc)[2][2][4][2], const Unit& u, int wr, int wc, int fr, int fq) const {
        const int row0 = u.pm * BM + wr * 64 + fr, col0 = u.pn * BM + wc * 32 + 4 * fq;
        f32x4 bv[2][2];
#pragma unroll
        for (int bj = 0; bj < 2; ++bj)
#pragma unroll
            for (int n = 0; n < 2; ++n) bv[bj][n] = bias ? *(const f32x4*)(bias + col0 + bj * HALF + n * 16) : (f32x4){0.f, 0.f, 0.f, 0.f};
#pragma unroll
        for (int ai = 0; ai < 2; ++ai)
#pragma unroll
            for (int m = 0; m < 4; ++m) { float* rowp = C + (size_t)(row0 + ai * HALF + m * 16) * ldc + col0;
#pragma unroll
                for (int bj = 0; bj < 2; ++bj)
#pragma unroll
                    for (int n = 0; n < 2; ++n) *(f32x4*)(rowp + bj * HALF + n * 16) = acc[ai][bj][m][n] + bv[bj][n]; }
    }
};
template <int ACT  > struct EpiBf16 {
    static constexpr bool PERM = true, AFTER_DRAIN = false;
    bf16_t* O; int ldc; const float* bias; int split_cols; size_t split_stride;
    __device__ __forceinline__ void operator()(const f32x4 (&acc)[2][2][4][2], const Unit& u, int wr, int wc, int fr, int fq) const {
        const int row0 = u.pm * BM + wr * 64 + fr; int colt = u.pn * BM; bf16_t* base = O;
        if (split_cols) { const int t = colt / split_cols; base += (size_t)t * split_stride; colt -= t * split_cols; }
        const int col0 = colt + wc * 32 + 8 * fq, bcol0 = u.pn * BM + wc * 32 + 8 * fq;
        f32x4 bv[2][2];
#pragma unroll
        for (int bj = 0; bj < 2; ++bj)
#pragma unroll
            for (int n = 0; n < 2; ++n) bv[bj][n] = bias ? *(const f32x4*)(bias + bcol0 + bj * HALF + 4 * n) : (f32x4){0.f, 0.f, 0.f, 0.f};
#pragma unroll
        for (int ai = 0; ai < 2; ++ai)
#pragma unroll
            for (int m = 0; m < 4; ++m) { bf16_t* rowp = base + (size_t)(row0 + ai * HALF + m * 16) * ldc + col0;
#pragma unroll
                for (int bj = 0; bj < 2; ++bj) { f32x4 v0 = acc[ai][bj][m][0] + bv[bj][0], v1 = acc[ai][bj][m][1] + bv[bj][1];
                    if (ACT == 1) { f32x2 a = gelu_pk((f32x2){v0[0], v0[1]}), b = gelu_pk((f32x2){v0[2], v0[3]}), c = gelu_pk((f32x2){v1[0], v1[1]}), d = gelu_pk((f32x2){v1[2], v1[3]});
                        v0 = (f32x4){a.x, a.y, b.x, b.y}; v1 = (f32x4){c.x, c.y, d.x, d.y}; }
                    if (ACT == 2) {
#pragma unroll
                        for (int j = 0; j < 4; ++j) { v0[j] = 0.5f * v0[j] * (1.0f + erff(v0[j] * 0.70710678f)); v1[j] = 0.5f * v1[j] * (1.0f + erff(v1[j] * 0.70710678f)); } }
                    u32x4 w; w.x = cvt_pk_bf16(v0[0], v0[1]); w.y = cvt_pk_bf16(v0[2], v0[3]); w.z = cvt_pk_bf16(v1[0], v1[1]); w.w = cvt_pk_bf16(v1[2], v1[3]);
                    *(u32x4*)(rowp + bj * HALF) = w; } }
    }
};

struct PanelStats {
    unsigned* xbuf;
    unsigned* cnt;
    unsigned* tmo;
    int ntn; float eps;
    unsigned code;
    __device__ __forceinline__ bool run(const f32x4 (&v)[2][2][4][2], const Unit& u, int wr, int wc, int fr, int fq, PG8_LAS unsigned char* lds, int wid, int lane) const {
        typedef float f32x2v __attribute__((ext_vector_type(2)));
        PG8_LAS f32x2v* P = (PG8_LAS f32x2v*)lds;
        PG8_LAS f32x2v* S = (PG8_LAS f32x2v*)(lds + 8192);
        PG8_LAS unsigned* flag = (PG8_LAS unsigned*)(lds + 8192 + 2048);
#pragma unroll
        for (int ai = 0; ai < 2; ++ai)
#pragma unroll
            for (int m = 0; m < 4; ++m) {
                float s = 0.f;
#pragma unroll
                for (int bj = 0; bj < 2; ++bj)
#pragma unroll
                    for (int n = 0; n < 2; ++n) { const f32x4 x = v[ai][bj][m][n]; s += (x[0] + x[1]) + (x[2] + x[3]); }
                s += __shfl_xor(s, 16); s += __shfl_xor(s, 32);
                const float mw = s * (1.0f / 64.0f); float q = 0.f;
#pragma unroll
                for (int bj = 0; bj < 2; ++bj)
#pragma unroll
                    for (int n = 0; n < 2; ++n) { const f32x4 d = v[ai][bj][m][n] - mw; q += (d[0] * d[0] + d[1] * d[1]) + (d[2] * d[2] + d[3] * d[3]); }
                q += __shfl_xor(q, 16); q += __shfl_xor(q, 32);
                if (fq == 0) P[(ai * HALF + wr * 64 + m * 16 + fr) * 4 + wc] = (f32x2v){mw, q};
            }
        asm volatile("s_waitcnt lgkmcnt(0)" ::: "memory"); __builtin_amdgcn_s_barrier(); asm volatile("" ::: "memory");
#if defined(BROKEN_NO_WAIT)
        if (blockIdx.x >= 64) { const long long t0 = clock64(); while (clock64() - t0 < 60000) __builtin_amdgcn_s_sleep(8); }
#endif
        const int row = wid * 32 + (lane & 31);
        if (lane < 32) {
            const f32x2v a = P[row * 4 + 0], b = P[row * 4 + 1], c = P[row * 4 + 2], d = P[row * 4 + 3];
            const float mt = (a.x + b.x + c.x + d.x) * 0.25f;
            const float da = a.x - mt, db = b.x - mt, dc = c.x - mt, dd = d.x - mt;
            const float m2 = (a.y + b.y) + (c.y + d.y) + 64.0f * ((da * da + db * db) + (dc * dc + dd * dd));
            unsigned long long* slot = (unsigned long long*)xbuf + ((size_t)(u.pm * BM + row) * 4 + u.pn);
            __hip_atomic_store(slot, ((unsigned long long)__float_as_uint(m2) << 32) | __float_as_uint(mt), __ATOMIC_RELAXED, __HIP_MEMORY_SCOPE_AGENT);
        }
        asm volatile("s_waitcnt vmcnt(0)" ::: "memory");
        if (lane == 0) __hip_atomic_fetch_add(cnt + 64 * u.pm, 1u, __ATOMIC_RELAXED, __HIP_MEMORY_SCOPE_AGENT);
        if (wid == 0) {
            bool dead = false; const unsigned long long t0 = __builtin_amdgcn_s_memrealtime(); const unsigned want = 8u * (unsigned)ntn;
            for (;;) {
#if defined(BROKEN_NO_WAIT)
                break;
#endif
                if ((unsigned)__builtin_amdgcn_readfirstlane(__hip_atomic_load(cnt + 64 * u.pm, __ATOMIC_RELAXED, __HIP_MEMORY_SCOPE_AGENT)) >= want) break;
                if (__builtin_amdgcn_s_memrealtime() - t0 > 2000000ull) {
                    if (lane == 0) { unsigned expect = 0u; __hip_atomic_compare_exchange_strong(tmo + 1, &expect, code | (unsigned)(u.pm & 0xff), __ATOMIC_RELAXED, __ATOMIC_RELAXED, __HIP_MEMORY_SCOPE_AGENT);
                                     __hip_atomic_store(tmo, 1u, __ATOMIC_RELAXED, __HIP_MEMORY_SCOPE_AGENT); }
                    dead = true; break; }
                __builtin_amdgcn_s_sleep(2);
            }
            __builtin_amdgcn_fence(__ATOMIC_ACQUIRE, "agent");
            if (lane == 0) flag[0] = dead ? 1u : 0u;
        }
        asm volatile("s_waitcnt vmcnt(0) lgkmcnt(0)" ::: "memory"); __builtin_amdgcn_s_barrier(); asm volatile("" ::: "memory");
        const bool bad = flag[0] != 0u;
        if (lane < 32) {
            const unsigned long long* slot = (const unsigned long long*)xbuf + (size_t)(u.pm * BM + row) * 4; float mt[4], m2[4]; float ms = 0.f;
#pragma unroll
            for (int t = 0; t < 4; ++t) { if (t < ntn) { const unsigned long long w = __hip_atomic_load(slot + t, __ATOMIC_RELAXED, __HIP_MEMORY_SCOPE_AGENT); mt[t] = __uint_as_float((unsigned)w); m2[t] = __uint_as_float((unsigned)(w >> 32)); } else { mt[t] = 0.f; m2[t] = 0.f; } ms += mt[t]; }
            const float mean = ms / (float)ntn; float q = 0.f;
#pragma unroll
            for (int t = 0; t < 4; ++t) if (t < ntn) { const float dm = mt[t] - mean; q += m2[t] + 256.0f * dm * dm; }
            S[row] = (f32x2v){mean, 1.0f / sqrtf(q / (256.0f * (float)ntn) + eps)};
        }
        asm volatile("s_waitcnt lgkmcnt(0)" ::: "memory"); __builtin_amdgcn_s_barrier(); asm volatile("" ::: "memory");
        return bad;
    }
};
struct EpiLnRes {
    static constexpr bool PERM = false, AFTER_DRAIN = true;
    const float* base; float* out; int ldc; const float* bias; PanelStats st; unsigned poison;
    __device__ __forceinline__ void refuse(size_t i0, size_t stride, int M, int N) const { const float q = __builtin_nanf(""); for (size_t i = i0; i < (size_t)M * N; i += stride) out[(i / N) * ldc + i % N] = q;
        if (i0 == 0) { unsigned expect = 0u; __hip_atomic_compare_exchange_strong(st.tmo + 1, &expect, 0x7f0u, __ATOMIC_RELAXED, __ATOMIC_RELAXED, __HIP_MEMORY_SCOPE_AGENT); __hip_atomic_store(st.tmo, 1u, __ATOMIC_RELAXED, __HIP_MEMORY_SCOPE_AGENT); } }
    __device__ __forceinline__ void fused(f32x4 (&acc)[2][2][4][2], const Unit& u, int wr, int wc, int fr, int fq, PG8_LAS unsigned char* lds, int wid, int lane) const {
        typedef float f32x2v __attribute__((ext_vector_type(2)));
        const PG8_LAS f32x2v* S = (const PG8_LAS f32x2v*)(lds + 8192);
        const int col0 = u.pn * BM + wc * 32 + 4 * fq;
#pragma unroll
        for (int bj = 0; bj < 2; ++bj)
#pragma unroll
            for (int n = 0; n < 2; ++n) { const f32x4 bv = bias ? *(const f32x4*)(bias + col0 + bj * HALF + n * 16) : (f32x4){0.f, 0.f, 0.f, 0.f};
#pragma unroll
                for (int ai = 0; ai < 2; ++ai)
#pragma unroll
                    for (int m = 0; m < 4; ++m) acc[ai][bj][m][n] += bv; }
        const bool bad = st.run(acc, u, wr, wc, fr, fq, lds, wid, lane) || poison != 0u;
        const float qnan = __builtin_nanf("");
#pragma unroll
        for (int ai = 0; ai < 2; ++ai)
#pragma unroll
            for (int m = 0; m < 4; ++m) { const int r = ai * HALF + wr * 64 + m * 16 + fr; const f32x2v sr = S[r]; const size_t off = (size_t)(u.pm * BM + r) * ldc + col0;
#pragma unroll
                for (int bj = 0; bj < 2; ++bj)
#pragma unroll
                    for (int n = 0; n < 2; ++n) { const f32x4 bs = *(const f32x4*)(base + off + bj * HALF + n * 16); f32x4 o = bs + (acc[ai][bj][m][n] - sr.x) * sr.y;
                        if (bad) o = (f32x4){qnan, qnan, qnan, qnan}; *(f32x4*)(out + off + bj * HALF + n * 16) = o; }
                asm volatile("" ::: "memory"); }
    }
};
struct EpiLnResLn {
    static constexpr bool PERM = false, AFTER_DRAIN = true;
    const float* base; float* out; bf16_t* xn; int ldc; const float* bias; PanelStats st1, st2; unsigned poison;
    __device__ __forceinline__ void refuse(size_t i0, size_t stride, int M, int N) const { const float q = __builtin_nanf(""); for (size_t i = i0; i < (size_t)M * N; i += stride) { const size_t o = (i / N) * ldc + i % N; out[o] = q; xn[o] = (bf16_t)0x7fc0u; }
        if (i0 == 0) { unsigned expect = 0u; __hip_atomic_compare_exchange_strong(st1.tmo + 1, &expect, 0x7f0u, __ATOMIC_RELAXED, __ATOMIC_RELAXED, __HIP_MEMORY_SCOPE_AGENT); __hip_atomic_store(st1.tmo, 1u, __ATOMIC_RELAXED, __HIP_MEMORY_SCOPE_AGENT); } }
    __device__ __forceinline__ void fused(f32x4 (&acc)[2][2][4][2], const Unit& u, int wr, int wc, int fr, int fq, PG8_LAS unsigned char* lds, int wid, int lane) const {
        typedef float f32x2v __attribute__((ext_vector_type(2))); typedef unsigned u32x2v __attribute__((ext_vector_type(2)));
        const PG8_LAS f32x2v* S = (const PG8_LAS f32x2v*)(lds + 8192);
        const int col0 = u.pn * BM + wc * 32 + 4 * fq;
#pragma unroll
        for (int bj = 0; bj < 2; ++bj)
#pragma unroll
            for (int n = 0; n < 2; ++n) { const f32x4 bv = bias ? *(const f32x4*)(bias + col0 + bj * HALF + n * 16) : (f32x4){0.f, 0.f, 0.f, 0.f};
#pragma unroll
                for (int ai = 0; ai < 2; ++ai)
#pragma unroll
                    for (int m = 0; m < 4; ++m) acc[ai][bj][m][n] += bv; }
        bool bad = st1.run(acc, u, wr, wc, fr, fq, lds, wid, lane) || poison != 0u;
        const float qnan = __builtin_nanf("");
#pragma unroll
        for (int ai = 0; ai < 2; ++ai)
#pragma unroll
            for (int m = 0; m < 4; ++m) { const int r = ai * HALF + wr * 64 + m * 16 + fr; const f32x2v sr = S[r]; const size_t off = (size_t)(u.pm * BM + r) * ldc + col0;
#pragma unroll
                for (int bj = 0; bj < 2; ++bj)
#pragma unroll
                    for (int n = 0; n < 2; ++n) { const f32x4 bs = *(const f32x4*)(base + off + bj * HALF + n * 16); acc[ai][bj][m][n] = bs + (acc[ai][bj][m][n] - sr.x) * sr.y; }
                asm volatile("" : "+v"(acc[ai][0][m][0]), "+v"(acc[ai][0][m][1]), "+v"(acc[ai][1][m][0]), "+v"(acc[ai][1][m][1]));
                if (m & 1) asm volatile("" ::: "memory"); }
        const bool bad1 = bad;
        bad = st2.run(acc, u, wr, wc, fr, fq, lds, wid, lane) || bad;
#pragma unroll
        for (int ai = 0; ai < 2; ++ai)
#pragma unroll
            for (int m = 0; m < 4; ++m) { const int r = ai * HALF + wr * 64 + m * 16 + fr; const f32x2v sr = S[r]; const size_t off = (size_t)(u.pm * BM + r) * ldc + col0;
#pragma unroll
                for (int bj = 0; bj < 2; ++bj)
#pragma unroll
                    for (int n = 0; n < 2; ++n) { const f32x4 x1 = acc[ai][bj][m][n]; *(f32x4*)(out + off + bj * HALF + n * 16) = bad1 ? (f32x4){qnan, qnan, qnan, qnan} : x1;
                        const f32x4 o = (x1 - sr.x) * sr.y; u32x2v w; w.x = cvt_pk_bf16(o[0], o[1]); w.y = cvt_pk_bf16(o[2], o[3]);
                        if (bad) { w.x = 0x7fc07fc0u; w.y = 0x7fc07fc0u; } *(u32x2v*)(xn + off + bj * HALF + n * 16) = w; }
                asm volatile("" ::: "memory"); }
    }
};

template <class Epi, class Sched, bool STAMP = false>
__device__ __forceinline__ void gemm_phase(PG8_LAS unsigned char* lds, const Gemm g, const Sched& S, const Epi& E, unsigned long long* stamps) {
    int tid_ = threadIdx.x; asm volatile("" : "+v"(tid_)); const int tid = tid_, wid = __builtin_amdgcn_readfirstlane(tid >> 6), lane = tid & 63, wr = wid >> 2, wc = wid & 3, fr = lane & 15, fq = lane >> 4;
    const int K = g.K, nt = K / BK;
    int ts_lo = 0, ts_hi = 0, nts = 0; const unsigned long long rt_entry = STAMP ? (unsigned long long)wall_clock64() : 0ull;
#define PG8_STAMP() do { if (STAMP && wid == 0 && nts < 64) { const unsigned long long _c = (unsigned long long)clock64(); \
        ts_lo = (lane == nts) ? (int)(unsigned)_c : ts_lo; ts_hi = (lane == nts) ? (int)(unsigned)(_c >> 32) : ts_hi; ++nts; } } while (0)
    PG8_STAMP();
    unsigned voffA[2], voffB[2];
#pragma unroll
    for (int i = 0; i < 2; ++i) { int R, C; stage_rc(tid * 16 + i * 8192, R, C); const int Rb = Epi::PERM ? ((R & ~31) + perm32(R & 31)) : R;
        voffA[i] = (unsigned)(R * K + C) * 2u; voffB[i] = (unsigned)(Rb * K + C) * 2u; }
    const size_t kstep = (size_t)(BK * 2);
    const size_t hstep = (size_t)HALF * K * 2;
    const size_t tstep = 2 * hstep;
    const unsigned ldsw = (unsigned)wid * 1024u;
    const int aoff = lds_byte(wr * 64 + fr, fq * 8), boff = lds_byte(wc * 32 + fr, fq * 8);
#define PG8_SA(b, h) (((b) * 2 + (h)) * HTB)
#define PG8_SB(b, h) ((4 + (b) * 2 + (h)) * HTB)
#define PG8_STAGE(bufoff, gbase, voff) do { _Pragma("unroll") for (int _i = 0; _i < 2; ++_i) \
        __builtin_amdgcn_global_load_lds((const unsigned*)((const char*)(gbase) + (voff)[_i]), (PG8_LAS unsigned*)(lds + (bufoff) + ldsw + _i * 8192), 16, 0, 0); } while (0)
#define PG8_LDA(dst, b, h) do { _Pragma("unroll") for (int m = 0; m < 4; ++m) _Pragma("unroll") for (int k = 0; k < 2; ++k) dst[m][k] = *(const PG8_LAS bf16x8*)(lds + PG8_SA(b, h) + aoff + m * 2048 + k * 1024); } while (0)
#define PG8_LDB(dst, b, h) do { _Pragma("unroll") for (int n = 0; n < 2; ++n) _Pragma("unroll") for (int k = 0; k < 2; ++k) dst[n][k] = *(const PG8_LAS bf16x8*)(lds + PG8_SB(b, h) + boff + n * 2048 + k * 1024); } while (0)
#define PG8_MMA(ai, bj, At, Bt) do { __builtin_amdgcn_s_setprio(1); _Pragma("unroll") for (int m = 0; m < 4; ++m) _Pragma("unroll") for (int n = 0; n < 2; ++n) _Pragma("unroll") for (int k = 0; k < 2; ++k) \
        acc[ai][bj][m][n] = __builtin_amdgcn_mfma_f32_16x16x32_bf16(Bt[n][k], At[m][k], acc[ai][bj][m][n], 0, 0, 0); __builtin_amdgcn_s_setprio(0); } while (0)
#define PG8_WAIT_V(n) asm volatile("s_waitcnt vmcnt(" #n ")" ::: "memory")
#define PG8_WAIT_L(n) asm volatile("s_waitcnt lgkmcnt(" #n ")" ::: "memory")
#define PG8_BAR __builtin_amdgcn_s_barrier()
#define PG8_SCHED __builtin_amdgcn_sched_barrier(0)
    Unit cur, nxt; int ui = 0;
    if (!S.next(0, cur)) return;
    f32x4 acc[2][2][4][2];
#pragma unroll
    for (int a = 0; a < 2; ++a)
#pragma unroll
        for (int b = 0; b < 2; ++b)
#pragma unroll
            for (int m = 0; m < 4; ++m)
#pragma unroll
                for (int n = 0; n < 2; ++n) acc[a][b][m][n] = (f32x4){0.f, 0.f, 0.f, 0.f};
    bf16x8 At[4][2], B0[2][2], B1[2][2];
    const char* cA = (const char*)g.A + (size_t)cur.pm * tstep; const char* cB = (const char*)g.Bt + (size_t)cur.pn * tstep;
    S.a_ready(cur);
    PG8_STAGE(PG8_SB(0, 0), cB, voffB); PG8_STAGE(PG8_SA(0, 0), cA, voffA); PG8_STAGE(PG8_SB(0, 1), cB + hstep, voffB); PG8_STAGE(PG8_SA(0, 1), cA + hstep, voffA);
    if (wr == 1) PG8_BAR;
    PG8_WAIT_V(4); PG8_BAR;
    PG8_STAGE(PG8_SB(1, 0), cB + kstep, voffB); PG8_STAGE(PG8_SA(1, 0), cA + kstep, voffA); PG8_STAGE(PG8_SB(1, 1), cB + hstep + kstep, voffB);
    PG8_WAIT_V(6); PG8_BAR;
    PG8_STAMP();
    for (;;) {
        const bool has_next = S.next(ui + 1, nxt);
        const char* nA = has_next ? (const char*)g.A + (size_t)nxt.pm * tstep : cA; const char* nB = has_next ? (const char*)g.Bt + (size_t)nxt.pn * tstep : cB;
        for (int t = 0; t < nt; t += 2) {
            const bool last = (t == nt - 2);
            const char* a1 = cA + (size_t)(t + 1) * kstep;
            const char* a2 = last ? nA : cA + (size_t)(t + 2) * kstep; const char* b2 = last ? nB : cB + (size_t)(t + 2) * kstep;
            const char* a3 = a2 + kstep; const char* b3 = b2 + kstep;
            if (last && has_next) S.a_ready(nxt);
            PG8_LDB(B0, 0, 0); PG8_SCHED; PG8_LDA(At, 0, 0); PG8_STAGE(PG8_SA(1, 1), a1 + hstep, voffA);
            PG8_WAIT_L(8); PG8_BAR; PG8_WAIT_L(0); PG8_MMA(0, 0, At, B0); PG8_BAR; PG8_SCHED;
            PG8_LDB(B1, 0, 1); PG8_STAGE(PG8_SB(0, 0), b2, voffB);
            PG8_BAR; PG8_WAIT_L(0); PG8_MMA(0, 1, At, B1); PG8_BAR;
            PG8_LDA(At, 0, 1); PG8_STAGE(PG8_SA(0, 0), a2, voffA);
            PG8_BAR; PG8_WAIT_L(0); PG8_MMA(1, 0, At, B0); PG8_BAR; PG8_SCHED;
            PG8_STAGE(PG8_SB(0, 1), b2 + hstep, voffB);
            PG8_WAIT_V(6); PG8_BAR; PG8_MMA(1, 1, At, B1); PG8_BAR;
            PG8_LDB(B0, 1, 0); PG8_SCHED; PG8_LDA(At, 1, 0); PG8_STAGE(PG8_SA(0, 1), a2 + hstep, voffA);
            PG8_WAIT_L(8); PG8_BAR; PG8_WAIT_L(0); PG8_MMA(0, 0, At, B0); PG8_BAR; PG8_SCHED;
            PG8_LDB(B1, 1, 1); PG8_STAGE(PG8_SB(1, 0), b3, voffB);
            PG8_BAR; PG8_WAIT_L(0); PG8_MMA(0, 1, At, B1); PG8_BAR;
            PG8_LDA(At, 1, 1); PG8_STAGE(PG8_SA(1, 0), a3, voffA);
            PG8_BAR; PG8_WAIT_L(0); PG8_MMA(1, 0, At, B0); PG8_BAR; PG8_SCHED;
            PG8_STAGE(PG8_SB(1, 1), b3 + hstep, voffB);
            PG8_WAIT_V(6); PG8_BAR; PG8_MMA(1, 1, At, B1); PG8_BAR;
        }
        PG8_STAMP();
        if constexpr (!Epi::AFTER_DRAIN) { E(acc, cur, wr, wc, fr, fq); S.done(cur); }
        PG8_STAMP();
        if (!has_next) break;
#pragma unroll
        for (int a = 0; a < 2; ++a)
#pragma unroll
            for (int b = 0; b < 2; ++b)
#pragma unroll
                for (int m = 0; m < 4; ++m)
#pragma unroll
                    for (int n = 0; n < 2; ++n) acc[a][b][m][n] = (f32x4){0.f, 0.f, 0.f, 0.f};
        cur = nxt; cA = nA; cB = nB; ++ui;
    }
    PG8_WAIT_V(0);
    if (wr == 0) PG8_BAR;
    PG8_BAR;
    if constexpr (Epi::AFTER_DRAIN) { E.fused(acc, cur, wr, wc, fr, fq, lds, wid, lane); S.done(cur); }
    PG8_STAMP();
    if (STAMP && wid == 0) { stamps[lane] = lane < nts ? (((unsigned long long)(unsigned)ts_hi << 32) | (unsigned)ts_lo) : 0ull;
        if (lane == 62) stamps[62] = rt_entry; if (lane == 63) stamps[63] = (unsigned long long)wall_clock64(); }
#undef PG8_STAMP
#undef PG8_SA
#undef PG8_SB
#undef PG8_STAGE
#undef PG8_LDA
#undef PG8_LDB
#undef PG8_MMA
#undef PG8_WAIT_V
#undef PG8_WAIT_L
#undef PG8_BAR
#undef PG8_SCHED
}
}
#define LAS __attribute__((address_space(3)))
typedef unsigned short bf16_t;
typedef float f32x4 __attribute__((ext_vector_type(4)));
typedef float f32x2 __attribute__((ext_vector_type(2)));
typedef unsigned u32x4 __attribute__((ext_vector_type(4)));
typedef unsigned u32x2 __attribute__((ext_vector_type(2)));
constexpr int NTOK = 8192, SEQ = 2048, DM = 2048, NIN = 7372, NP = 7424, NL = 4;
constexpr int LRUW = 512, GW = 768, RW_ = 768;
constexpr int PC_AX = 0, PC_AG = 512, PC_BQKV = 1024, PC_BG = 3328, PC_CIN = 4096, PC_CG = 6592, PC_BETA = 7360, PC_BA = 7366;
constexpr int LDS_BYTES = 131072 + 512;
#ifndef CHUNKREP
#define CHUNKREP 0
#endif
#ifndef CONV_SPLIT2
#define CONV_SPLIT2 52
#endif
#ifndef CONV_SPLIT
#define CONV_SPLIT 24
#endif
#ifndef REPMASK
#define REPMASK 0
#endif
#ifndef SKIPMASK
#define SKIPMASK 0
#endif
#ifndef N_LAUNCH_MODE
#define N_LAUNCH_MODE 1
#endif
constexpr int PPL = 7;
constexpr int NPHASE = 2 + PPL * NL;
constexpr size_t WS_WIN = 0;
constexpr size_t WS_WOUT = WS_WIN + (size_t)NL * NP * DM * 2;
constexpr size_t WS_XB = WS_WOUT + (size_t)NL * DM * DM * 2;
constexpr size_t WS_XR = WS_XB + (size_t)NTOK * DM * 2;
constexpr size_t WS_PROJ = WS_XR + (size_t)NTOK * DM * 4;
constexpr size_t WS_Y = WS_PROJ + (size_t)NTOK * NP * 2;
constexpr size_t SZ768 = (size_t)NTOK * 768 * 4;
constexpr size_t WS_GQ = WS_Y + (size_t)NTOK * DM * 2;
constexpr size_t WS_GK = WS_GQ + SZ768;
constexpr size_t WS_GV = WS_GK + SZ768;
constexpr size_t WS_GO = WS_GV + SZ768;
constexpr size_t WS_RR = WS_GO + SZ768;
constexpr size_t WS_RW = WS_RR + SZ768;
constexpr size_t WS_RK = WS_RW + SZ768;
constexpr size_t WS_RV = WS_RK + SZ768;
constexpr size_t WS_RKK = WS_RV + SZ768;
constexpr size_t WS_RB = WS_RKK + SZ768;
constexpr size_t WS_RY = WS_RB + SZ768;
constexpr size_t WS_GB = WS_RY + SZ768;
constexpr size_t WS_GG = WS_GB + (size_t)NTOK * 8 * 4;
constexpr size_t WS_LA = WS_GG + (size_t)NTOK * 8 * 4;
constexpr size_t WS_LU = WS_LA + (size_t)NTOK * 512 * 4;
constexpr size_t WS_LEND = WS_LU + (size_t)NTOK * 512 * 4;
constexpr int GCH = 768, RCH = 1536;
constexpr size_t WS_G1 = WS_LEND;
constexpr size_t WS_G2 = WS_G1 + (size_t)GCH * 64 * 128 * 2;
constexpr size_t WS_G3 = WS_G2 + (size_t)GCH * 64 * 128 * 2;
constexpr size_t WS_G4 = WS_G3 + (size_t)GCH * 64 * 64 * 2;
constexpr size_t WS_GU = WS_G4 + (size_t)GCH * 128 * 64 * 2;
constexpr size_t WS_GGL = WS_GU + (size_t)GCH * 128 * 64 * 4;
constexpr size_t WS_R1 = WS_GGL + (size_t)GCH * 128 * 4;
constexpr size_t WS_R2 = WS_R1 + (size_t)RCH * 64 * 64 * 2;
constexpr size_t WS_R3 = WS_R2 + (size_t)RCH * 64 * 64 * 2;
constexpr size_t WS_R4 = WS_R3 + (size_t)RCH * 64 * 128 * 2;
constexpr size_t WS_RU = WS_R4 + (size_t)RCH * 64 * 128 * 2;
constexpr size_t WS_RVT = WS_RU + (size_t)RCH * 64 * 64 * 4;
constexpr size_t WS_RGL = WS_RVT + (size_t)RCH * 64 * 64 * 2;
constexpr size_t WS_LH = WS_RGL + (size_t)RCH * 64 * 4;
constexpr size_t WS_LP = WS_LH + (size_t)NTOK * 512 * 4;
constexpr size_t WS_LC = WS_LP + (size_t)NTOK * 512 * 4;
constexpr size_t WS_BAR = WS_LC + (size_t)128 * 512 * 4;
constexpr size_t WS_WUPT = WS_BAR + 16384;
constexpr size_t WS_AUPT = WS_WUPT + (size_t)NL * 768 * 96 * 2;
constexpr size_t WS_WXT = WS_AUPT + (size_t)NL * 768 * 96 * 2;
constexpr size_t WS_WAT = WS_WXT + (size_t)NL * 8 * 64 * 64 * 2;
constexpr size_t WS_END = WS_WAT + (size_t)NL * 8 * 64 * 64 * 2;

struct Args {
    const float* in[26];
    float* out; unsigned char* ws;
    int ph_lo, ph_hi;
};
enum { I_X = 0, I_NORMG, I_WIN, I_WOUT, I_LCW, I_LCB, I_LWX, I_LBX, I_LWA, I_LBA, I_LLAM, I_GCW, I_GALOG, I_GDT, I_GNG,
       I_RMU, I_RW0, I_RWUP, I_RA0, I_RAUP, I_RKK, I_RKA, I_RRK, I_RGNW, I_RGNB, I_FNG };

__device__ __forceinline__ int tid_l() { int t = threadIdx.x; asm volatile("" : "+v"(t)); return t; }
#define LBAR() do { asm volatile("s_waitcnt lgkmcnt(0)" ::: "memory"); __builtin_amdgcn_s_barrier(); asm volatile("" ::: "memory"); } while (0)
__device__ __forceinline__ int bid_l() { int b = blockIdx.x; asm volatile("" : "+s"(b)); return b; }
__device__ __forceinline__ int gdim_l() { int b = gridDim.x; asm volatile("" : "+s"(b)); return b; }
__device__ __forceinline__ const float* inp(LAS unsigned char* lds, int i) {
    const LAS unsigned* t = (const LAS unsigned*)(lds + 131072) + 2 * i;
    const unsigned lo = __builtin_amdgcn_readfirstlane(t[0]), hi = __builtin_amdgcn_readfirstlane(t[1]);
    return (const float*)(const __attribute__((address_space(1))) float*)(((unsigned long long)hi << 32) | lo);
}
__device__ __forceinline__ float bf2f(bf16_t b) { return __uint_as_float(((unsigned)b) << 16); }
__device__ __forceinline__ bf16_t f2bf(float f) { unsigned u = __float_as_uint(f); u += 0x7FFFu + ((u >> 16) & 1u); return (bf16_t)(u >> 16); }
__device__ __forceinline__ unsigned pk2(float lo, float hi) { return (unsigned)f2bf(lo) | ((unsigned)f2bf(hi) << 16); }
__device__ __forceinline__ float wave_sum(float v) {
#pragma unroll
    for (int o = 1; o < 64; o <<= 1) v += __shfl_xor(v, o);
    return v;
}
typedef __bf16 bf2_t __attribute__((ext_vector_type(2)));
__device__ __forceinline__ unsigned cvtpk(float lo, float hi) { const f32x2 v = {lo, hi}; const bf2_t r = __builtin_convertvector(v, bf2_t); return __builtin_bit_cast(unsigned, r); }
__device__ __forceinline__ float sigmoidf_(float x) { return 1.0f / (1.0f + __expf(-x)); }
__device__ __forceinline__ float siluf_(float x) { return x / (1.0f + __expf(-x)); }
__device__ __forceinline__ float softplusf_(float x) { return fmaxf(x, 0.f) + log1pf(__expf(-fabsf(x))); }

__device__ __forceinline__ void transpose_item(const float* W, int K, int N, bf16_t* WT, const float* scale, bool remap, LAS float* scr, int item, int nblk, int lane) {
    const int kb = item / nblk, nb = item % nblk, k0 = 64 * kb, n0 = 32 * nb;
    int np = n0 + (lane & 31), oc;
    if (!remap) oc = np;
    else if (np < 4096) oc = np;
    else if (np < 7360) oc = np + 12;
    else if (np < 7372) oc = np - 7360 + 4096;
    else oc = -1;
    float vbuf[32], sbuf[32];
#pragma unroll
    for (int i = 0; i < 32; ++i) { const int kk = 2 * i + (lane >> 5); vbuf[i] = (oc >= 0) ? W[(size_t)(k0 + kk) * N + oc] : 0.f; sbuf[i] = scale ? scale[k0 + kk] : 1.0f; }
#pragma unroll
    for (int i = 0; i < 32; ++i) { const int kk = 2 * i + (lane >> 5); scr[kk * 33 + (lane & 31)] = vbuf[i] * sbuf[i]; }
    __builtin_amdgcn_s_waitcnt(0xc07f); asm volatile("s_waitcnt lgkmcnt(0)" ::: "memory");
    const int c = lane & 7;
#pragma unroll
    for (int j = 0; j < 4; ++j) { const int n = (lane >> 3) + 8 * j; const LAS float* s = scr + (8 * c) * 33 + n;
        u32x4 o; o.x = pk2(s[0 * 33], s[1 * 33]); o.y = pk2(s[2 * 33], s[3 * 33]); o.z = pk2(s[4 * 33], s[5 * 33]); o.w = pk2(s[6 * 33], s[7 * 33]);
        *(u32x4*)(WT + (size_t)(n0 + n) * K + k0 + 8 * c) = o; }
    asm volatile("s_waitcnt lgkmcnt(0)" ::: "memory");
}
__device__ __forceinline__ void phase_convert(const Args& a, LAS unsigned char* lds, int l_lo, int l_hi, int f_lo, int f_hi, int vb, int nvb, int small) {
    size_t wso_ = 0; asm volatile("" : "+s"(wso_)); unsigned char* ws = a.ws + wso_;
    const int tid = tid_l(), wave = __builtin_amdgcn_readfirstlane(tid >> 6), lane = tid & 63;
    LAS float* scr = (LAS float*)(lds + wave * 8448);
    const int gw = vb * 8 + wave, NGW = nvb * 8;
    constexpr int I_IN = (DM / 64) * (NP / 32), I_OUT = (DM / 64) * (DM / 32), PER_L = I_IN + I_OUT;
    const int i_lo = (PER_L / 64) * f_lo, i_hi = (PER_L / 64) * f_hi, span = i_hi - i_lo;
    for (int it = gw; it < (l_hi - l_lo) * span; it += NGW) {
        const int l = l_lo + it / span; int r = i_lo + it % span;
        if (r < I_IN) transpose_item(inp(lds, I_WIN) + (size_t)l * DM * NIN, DM, NIN, (bf16_t*)(ws + WS_WIN) + (size_t)l * NP * DM, inp(lds, I_NORMG) + l * DM, true, scr, r, NP / 32, lane);
        else transpose_item(inp(lds, I_WOUT) + (size_t)l * DM * DM, DM, DM, (bf16_t*)(ws + WS_WOUT) + (size_t)l * DM * DM, nullptr, false, scr, r - I_IN, DM / 32, lane);
    }
    if (small) {
        const int gt = vb * 512 + tid, NT_ = nvb * 512;
        const float* wup = inp(lds, I_RWUP); const float* aup = inp(lds, I_RAUP); bf16_t* WUPT = (bf16_t*)(ws + WS_WUPT); bf16_t* AUPT = (bf16_t*)(ws + WS_AUPT);
        for (int idx = gt; idx < NL * 768 * 96; idx += NT_) { const int i = idx % 96, j = (idx / 96) % 768, l = idx / (96 * 768); const size_t src = ((size_t)l * 96 + i) * 768 + j; WUPT[idx] = f2bf(wup[src]); AUPT[idx] = f2bf(aup[src]); }
        const float* wx = inp(lds, I_LWX); const float* wa = inp(lds, I_LWA); bf16_t* WXT = (bf16_t*)(ws + WS_WXT); bf16_t* WAT = (bf16_t*)(ws + WS_WAT);
        for (int idx = gt; idx < NL * 8 * 64 * 64; idx += NT_) { const int i = idx & 63, j = (idx >> 6) & 63, ln = idx >> 12; const size_t src = ((size_t)ln * 64 + i) * 64 + j; WXT[idx] = f2bf(wx[src]); WAT[idx] = f2bf(wa[src]); }
    }
}
__device__ __forceinline__ void phase_rms(const float* xin, bf16_t* xb) {
    const int tid = tid_l(), wave = tid >> 6, lane = tid & 63;
    const int gw = bid_l() * 8 + wave, NGW = gdim_l() * 8;
    for (int m = gw; m < NTOK; m += NGW) {
        const f32x4* xr = (const f32x4*)(xin + (size_t)m * DM) + lane;
        f32x4 v[8]; float s = 0.f;
#pragma unroll
        for (int j = 0; j < 8; ++j) { v[j] = xr[64 * j]; s += (v[j].x * v[j].x + v[j].y * v[j].y) + (v[j].z * v[j].z + v[j].w * v[j].w); }
        const float rstd = 1.0f / sqrtf(wave_sum(s) * (1.0f / DM) + 1e-6f);
        u32x2* o = (u32x2*)(xb + (size_t)m * DM) + lane;
#pragma unroll
        for (int j = 0; j < 8; ++j) { u32x2 w; w.x = pk2(v[j].x * rstd, v[j].y * rstd); w.y = pk2(v[j].z * rstd, v[j].w * rstd); o[64 * j] = w; }
    }
}
__device__ __forceinline__ void phase_final(const float* xin, const float* g, float* out) {
    const int tid = tid_l(), wave = tid >> 6, lane = tid & 63;
    const int gw = bid_l() * 8 + wave, NGW = gdim_l() * 8;
    for (int m = gw; m < NTOK; m += NGW) {
        const f32x4* xr = (const f32x4*)(xin + (size_t)m * DM) + lane;
        f32x4 v[8]; float s = 0.f;
#pragma unroll
        for (int j = 0; j < 8; ++j) { v[j] = xr[64 * j]; s += (v[j].x * v[j].x + v[j].y * v[j].y) + (v[j].z * v[j].z + v[j].w * v[j].w); }
        const float rstd = 1.0f / sqrtf(wave_sum(s) * (1.0f / DM) + 1e-6f);
        f32x4* o = (f32x4*)(out + (size_t)m * DM) + lane; const f32x4* gg = (const f32x4*)g + lane;
#pragma unroll
        for (int j = 0; j < 8; ++j) o[64 * j] = v[j] * rstd * gg[64 * j];
    }
}
struct EpiDual {
    static constexpr bool PERM = true, AFTER_DRAIN = false;
    int mode; bf16_t* O; int ldo; const float* base; float* C; int ldc;
    __device__ __forceinline__ void operator()(const pg8::f32x4 (&acc)[2][2][4][2], const pg8::Unit& u, int wr, int wc, int fr, int fq) const {
        const int row0 = u.pm * 256 + wr * 64 + fr, col0 = u.pn * 256 + wc * 32 + 8 * fq;
        if (mode == 0) {
#pragma unroll
            for (int ai = 0; ai < 2; ++ai)
#pragma unroll
                for (int m = 0; m < 4; ++m) { bf16_t* rowp = O + (size_t)(row0 + ai * 128 + m * 16) * ldo + col0;
#pragma unroll
                    for (int bj = 0; bj < 2; ++bj) { const pg8::f32x4 v0 = acc[ai][bj][m][0], v1 = acc[ai][bj][m][1];
                        pg8::u32x4 w; w.x = cvtpk(v0[0], v0[1]); w.y = cvtpk(v0[2], v0[3]); w.z = cvtpk(v1[0], v1[1]); w.w = cvtpk(v1[2], v1[3]);
                        *(pg8::u32x4*)(rowp + bj * 128) = w; } }
        } else {
#pragma unroll
            for (int ai = 0; ai < 2; ++ai)
#pragma unroll
                for (int m = 0; m < 4; ++m) { const size_t off = (size_t)(row0 + ai * 128 + m * 16) * ldc + col0;
#pragma unroll
                    for (int bj = 0; bj < 2; ++bj)
#pragma unroll
                        for (int n = 0; n < 2; ++n) { const pg8::f32x4 b = *(const pg8::f32x4*)(base + off + bj * 128 + n * 4); *(pg8::f32x4*)(C + off + bj * 128 + n * 4) = acc[ai][bj][m][n] + b; }
                    asm volatile("" ::: "memory"); }
        }
    }
};
constexpr int PT = 32;
typedef short bf16x8 __attribute__((ext_vector_type(8)));
__device__ __forceinline__ float sum16(float v) { v += __shfl_xor(v, 1); v += __shfl_xor(v, 2); v += __shfl_xor(v, 4); v += __shfl_xor(v, 8); return v; }
__device__ __forceinline__ void phase_prep(const Args& a, int l, LAS unsigned char* lds) {
    size_t wso_ = 0; asm volatile("" : "+s"(wso_)); unsigned char* ws = a.ws + wso_;
    const int tid0 = tid_l(), wave = __builtin_amdgcn_readfirstlane(tid0 >> 6);
    const bf16_t* PROJ = (const bf16_t*)(ws + WS_PROJ);
    constexpr int XSR = 200, XLR = 520;
    LAS bf16_t* xsb = (LAS bf16_t*)lds;
    LAS bf16_t* xlb = (LAS bf16_t*)(lds + PT * XSR * 2);
    LAS float* xlf = (LAS float*)(lds + PT * XSR * 2 + PT * XLR * 2);
    float* GQ = (float*)(ws + WS_GQ); float* GK = (float*)(ws + WS_GK); float* GV = (float*)(ws + WS_GV);
    float* GB = (float*)(ws + WS_GB); float* GG = (float*)(ws + WS_GG);
    float* RR = (float*)(ws + WS_RR); float* RWd = (float*)(ws + WS_RW); float* RK = (float*)(ws + WS_RK); float* RV = (float*)(ws + WS_RV);
    float* RKK = (float*)(ws + WS_RKK); float* RB = (float*)(ws + WS_RB);
    float* LA = (float*)(ws + WS_LA); float* LU = (float*)(ws + WS_LU);
    const float* mu = inp(lds, I_RMU) + l * 2496;
    for (int tile = bid_l(); tile < NTOK / PT; tile += gdim_l()) {
        int tid = tid0; asm volatile("" : "+v"(tid)); const int lane = tid & 63, lr = lane & 15, lq = lane >> 4;
        const int t0 = tile * PT, sp = t0 % SEQ;
        { bf16_t curv[12], prevv[12];
#pragma unroll
            for (int q = 0; q < 12; ++q) { const int idx = tid + 512 * q, tt = idx / 192, i = idx % 192; const int col = PC_CIN + 2304 + i;
                curv[q] = PROJ[(size_t)(t0 + tt) * NP + col]; prevv[q] = PROJ[(size_t)(t0 + tt - ((sp + tt > 0) ? 1 : 0)) * NP + col]; }
#pragma unroll
            for (int q = 0; q < 12; ++q) { const int idx = tid + 512 * q, tt = idx / 192, i = idx % 192; const float cur = bf2f(curv[q]), prev = (sp + tt > 0) ? bf2f(prevv[q]) : 0.f;
                float xs = cur + (prev - cur) * mu[2304 + i]; if (i < 96) xs = tanhf(xs); xsb[tt * XSR + i] = f2bf(xs); } }
        { const int j = tid; const float* cw = inp(lds, I_LCW) + l * 4 * LRUW; const float w0 = cw[j], w1 = cw[LRUW + j], w2 = cw[2 * LRUW + j], w3 = cw[3 * LRUW + j], cb = inp(lds, I_LCB)[l * LRUW + j];
            float xm3 = (sp >= 3) ? bf2f(PROJ[(size_t)(t0 - 3) * NP + PC_AX + j]) : 0.f, xm2 = (sp >= 2) ? bf2f(PROJ[(size_t)(t0 - 2) * NP + PC_AX + j]) : 0.f, xm1 = (sp >= 1) ? bf2f(PROJ[(size_t)(t0 - 1) * NP + PC_AX + j]) : 0.f;
            bf16_t cv[PT];
#pragma unroll
            for (int tt = 0; tt < PT; ++tt) cv[tt] = PROJ[(size_t)(t0 + tt) * NP + PC_AX + j];
#pragma unroll
            for (int tt = 0; tt < PT; ++tt) { const float cur = bf2f(cv[tt]); const float x = w0 * xm3 + w1 * xm2 + w2 * xm1 + w3 * cur + cb; xlf[tt * 512 + j] = x; xlb[tt * XLR + j] = f2bf(x); xm3 = xm2; xm2 = xm1; xm1 = cur; } }
        LBAR();
        for (int u = wave; u < 24; u += 8) { const int h = u % 12, tb = u / 12;
            bf16x8 xw[3], xa[3];
#pragma unroll
            for (int k = 0; k < 3; ++k) { xw[k] = *(const LAS bf16x8*)(xsb + (tb * 16 + lr) * XSR + 32 * k + 8 * lq); xa[k] = *(const LAS bf16x8*)(xsb + (tb * 16 + lr) * XSR + 96 + 32 * k + 8 * lq); }
            f32x4 aw[4], aa[4];
#pragma unroll
            for (int jq = 0; jq < 4; ++jq) { const int jrow = l * 768 + h * 64 + jq * 16 + lr; const bf16_t* pw = (const bf16_t*)(ws + WS_WUPT) + (size_t)jrow * 96 + 8 * lq; const bf16_t* pa = (const bf16_t*)(ws + WS_AUPT) + (size_t)jrow * 96 + 8 * lq;
                aw[jq] = (f32x4){0.f, 0.f, 0.f, 0.f}; aa[jq] = (f32x4){0.f, 0.f, 0.f, 0.f};
#pragma unroll
                for (int k = 0; k < 3; ++k) { aw[jq] = __builtin_amdgcn_mfma_f32_16x16x32_bf16(xw[k], *(const bf16x8*)(pw + 32 * k), aw[jq], 0, 0, 0); aa[jq] = __builtin_amdgcn_mfma_f32_16x16x32_bf16(xa[k], *(const bf16x8*)(pa + 32 * k), aa[jq], 0, 0, 0); } }
            const int tokb = tb * 16 + 4 * lq;
            bf16_t pr_[5][4], pk_[5][4], pv_[5][4];
#pragma unroll
            for (int rr = 0; rr < 5; ++rr) { const int trow = t0 + tokb + rr - ((rr == 0 && sp + tokb == 0) ? 0 : 1);
#pragma unroll
                for (int jq = 0; jq < 4; ++jq) { const bf16_t* p = PROJ + (size_t)trow * NP + PC_CIN + h * 64 + jq * 16 + lr; pr_[rr][jq] = p[0]; pk_[rr][jq] = p[768]; pv_[rr][jq] = p[1536]; } }
            float w0v[4], a0v[4], kkwv[4], kawv[4], murv[4], mukv[4], muvv[4];
#pragma unroll
            for (int jq = 0; jq < 4; ++jq) { const int j = h * 64 + jq * 16 + lr; w0v[jq] = inp(lds, I_RW0)[l * 768 + j]; a0v[jq] = inp(lds, I_RA0)[l * 768 + j]; kkwv[jq] = inp(lds, I_RKK)[l * 768 + j]; kawv[jq] = inp(lds, I_RKA)[l * 768 + j];
                murv[jq] = mu[j]; mukv[jq] = mu[768 + j]; muvv[jq] = mu[1536 + j]; }
#pragma unroll
            for (int r = 0; r < 4; ++r) { const bool first = (sp + tokb + r == 0);
                float kr[4], kv_[4], rv_[4], vv_[4], av_[4]; float ss = 0.f;
#pragma unroll
                for (int jq = 0; jq < 4; ++jq) { const float cr = bf2f(pr_[r + 1][jq]), ck = bf2f(pk_[r + 1][jq]), cvv = bf2f(pv_[r + 1][jq]);
                    const float qr = first ? 0.f : bf2f(pr_[r][jq]), qk = first ? 0.f : bf2f(pk_[r][jq]), qv = first ? 0.f : bf2f(pv_[r][jq]);
                    rv_[jq] = cr + (qr - cr) * murv[jq]; kv_[jq] = ck + (qk - ck) * mukv[jq]; vv_[jq] = cvv + (qv - cvv) * muvv[jq];
                    av_[jq] = sigmoidf_(a0v[jq] + aa[jq][r]); kr[jq] = kv_[jq] * kkwv[jq]; ss += kr[jq] * kr[jq]; }
                ss = sum16(ss); const float rs = 1.0f / sqrtf(ss + 1e-6f);
#pragma unroll
                for (int jq = 0; jq < 4; ++jq) { const size_t o = (size_t)(t0 + tokb + r) * 768 + h * 64 + jq * 16 + lr;
                    const float wlog = -softplusf_(-(w0v[jq] + aw[jq][r])) - 0.5f; RWd[o] = -__expf(wlog);
                    const float kk = kr[jq] * rs; RR[o] = rv_[jq]; RK[o] = kv_[jq] * (1.0f + (av_[jq] - 1.0f) * kawv[jq]); RV[o] = vv_[jq]; RKK[o] = kk; RB[o] = kk * av_[jq]; } }
        }
        for (int u = wave; u < 16; u += 8) { const int n = u & 7, tb = u >> 3;
            bf16x8 xg[2];
#pragma unroll
            for (int k = 0; k < 2; ++k) xg[k] = *(const LAS bf16x8*)(xlb + (tb * 16 + lr) * XLR + n * 64 + 32 * k + 8 * lq);
            f32x4 ax[4], ag[4];
#pragma unroll
            for (int jq = 0; jq < 4; ++jq) { const size_t jrow = (size_t)(l * 8 + n) * 64 + jq * 16 + lr; const bf16_t* px = (const bf16_t*)(ws + WS_WXT) + jrow * 64 + 8 * lq; const bf16_t* pa = (const bf16_t*)(ws + WS_WAT) + jrow * 64 + 8 * lq;
                ax[jq] = (f32x4){0.f, 0.f, 0.f, 0.f}; ag[jq] = (f32x4){0.f, 0.f, 0.f, 0.f};
#pragma unroll
                for (int k = 0; k < 2; ++k) { ax[jq] = __builtin_amdgcn_mfma_f32_16x16x32_bf16(xg[k], *(const bf16x8*)(px + 32 * k), ax[jq], 0, 0, 0); ag[jq] = __builtin_amdgcn_mfma_f32_16x16x32_bf16(xg[k], *(const bf16x8*)(pa + 32 * k), ag[jq], 0, 0, 0); } }
#pragma unroll
            for (int jq = 0; jq < 4; ++jq) { const int j = n * 64 + jq * 16 + lr; const float bx = inp(lds, I_LBX)[l * 512 + j], ba = inp(lds, I_LBA)[l * 512 + j]; const float spl = softplusf_(-inp(lds, I_LLAM)[l * 512 + j]);
#pragma unroll
                for (int r = 0; r < 4; ++r) { const int tt = tb * 16 + 4 * lq + r; const float gx = sigmoidf_(ax[jq][r] + bx), ga = sigmoidf_(ag[jq][r] + ba);
                    const float loga = -8.0f * ga * spl; const float av = __expf(loga); const float mult = sqrtf(fmaxf(-expm1f(2.0f * loga), 0.f));
                    LA[(size_t)(t0 + tt) * 512 + j] = av; LU[(size_t)(t0 + tt) * 512 + j] = mult * gx * xlf[tt * 512 + j]; } } }
        for (int wt = wave; wt < 18; wt += 8) { const int ch0 = 128 * wt + 2 * lane; const float* cw = inp(lds, I_GCW) + (size_t)l * 4 * 2304 + ch0;
            const f32x2 w0 = *(const f32x2*)(cw), w1 = *(const f32x2*)(cw + 2304), w2 = *(const f32x2*)(cw + 2 * 2304), w3 = *(const f32x2*)(cw + 3 * 2304);
            f32x2 xm3 = {0.f, 0.f}, xm2 = {0.f, 0.f}, xm1 = {0.f, 0.f};
            const bf16_t* pc = PROJ + PC_BQKV + ch0;
            if (sp >= 3) { const unsigned q = *(const unsigned*)(pc + (size_t)(t0 - 3) * NP); xm3.x = __uint_as_float(q << 16); xm3.y = __uint_as_float(q & 0xffff0000u); }
            if (sp >= 2) { const unsigned q = *(const unsigned*)(pc + (size_t)(t0 - 2) * NP); xm2.x = __uint_as_float(q << 16); xm2.y = __uint_as_float(q & 0xffff0000u); }
            if (sp >= 1) { const unsigned q = *(const unsigned*)(pc + (size_t)(t0 - 1) * NP); xm1.x = __uint_as_float(q << 16); xm1.y = __uint_as_float(q & 0xffff0000u); }
            float* dst = (wt < 6) ? GQ : (wt < 12 ? GK : GV); const int dch = ch0 % 768;
            unsigned qv[PT];
#pragma unroll
            for (int tt = 0; tt < PT; ++tt) qv[tt] = *(const unsigned*)(pc + (size_t)(t0 + tt) * NP);
#pragma unroll
            for (int tt = 0; tt < PT; ++tt) { const unsigned q = qv[tt]; f32x2 cur; cur.x = __uint_as_float(q << 16); cur.y = __uint_as_float(q & 0xffff0000u);
                f32x2 v = w0 * xm3 + w1 * xm2 + w2 * xm1 + w3 * cur; v.x = siluf_(v.x); v.y = siluf_(v.y);
                if (wt < 12) { const float ss = wave_sum(v.x * v.x + v.y * v.y); float sc = 1.0f / sqrtf(ss + 1e-6f); if (wt < 6) sc *= 0.08838834764831845f; v = v * sc; }
                *(f32x2*)(dst + (size_t)(t0 + tt) * 768 + dch) = v; xm3 = xm2; xm2 = xm1; xm1 = cur; } }
        if (tid < PT * 6) { const int tt = tid / 6, h = tid % 6; const float bl = bf2f(PROJ[(size_t)(t0 + tt) * NP + PC_BETA + h]), al = bf2f(PROJ[(size_t)(t0 + tt) * NP + PC_BA + h]);
            GB[(size_t)(t0 + tt) * 8 + h] = sigmoidf_(bl); GG[(size_t)(t0 + tt) * 8 + h] = -__expf(inp(lds, I_GALOG)[l * 6 + h]) * softplusf_(al + inp(lds, I_GDT)[l * 6 + h]); }
        LBAR();
    }
}
typedef short bf16x8 __attribute__((ext_vector_type(8)));
struct ScanRec { const bf16_t* M1; const bf16_t* M2; const bf16_t* M3; const bf16_t* M4T; const float* UT; const float* G; const bf16_t* VT; };
template <int D, int KZ, bool EXT>
__device__ __forceinline__ void scan_item(const ScanRec R0, int e0, float* OUT, int out_ld, LAS unsigned char* lds) {
    constexpr int NK1 = D / 32, NK2 = KZ / 32, NT3 = D / 64, SROW = D + 8, ZROW = KZ + 8, HD = EXT ? 64 : 128;
    constexpr bool GS = !EXT;
    const int tid = tid_l(), w = __builtin_amdgcn_readfirstlane(tid >> 6), lane = tid & 63, lr = lane & 15, lq = lane >> 4;
    const bool front = (w < 4); const int cb = w & 3;
    LAS bf16_t* ST = (LAS bf16_t*)lds;
    LAS bf16_t* ZT = (LAS bf16_t*)(lds + 2 * 32 * SROW * 2);
    constexpr int OSROW = 36;
    LAS float* OS = (LAS float*)(lds + 2 * 32 * SROW * 2 + 32 * ZROW * 2);
    for (int i = tid; i < 2 * 32 * SROW / 2; i += 512) ((LAS unsigned*)ST)[i] = 0u;
    struct FS { bf16x8 m1[NK1], m3[NK2]; f32x4 ut[2]; u32x4 vt; };
    struct BS { bf16x8 m4[NT3][NK2]; f32x4 g[GS ? 1 : NT3]; float gs; };
#define SCAN_LOADF(s, n) do { \
        const bf16_t* a1_ = R0.M1 + (size_t)(n) * 64 * D + (cb * 16 + lr) * D + 8 * lq; \
        _Pragma("unroll") for (int k = 0; k < NK1; ++k) s.m1[k] = *(const bf16x8*)(a1_ + 32 * k); \
        const bf16_t* a3_ = R0.M3 + (size_t)(n) * 64 * KZ + (cb * 16 + lr) * KZ + 8 * lq; \
        _Pragma("unroll") for (int k = 0; k < NK2; ++k) s.m3[k] = *(const bf16x8*)(a3_ + 32 * k); \
        _Pragma("unroll") for (int j = 0; j < 2; ++j) s.ut[j] = *(const f32x4*)(R0.UT + (size_t)(n) * HD * 64 + (size_t)(e0 + j * 16 + lr) * 64 + cb * 16 + 4 * lq); \
        if (EXT) s.vt = *(const u32x4*)(R0.VT + (size_t)(n) * 64 * 64 + (size_t)(e0 + (tid >> 3)) * 64 + (tid & 7) * 8); } while (0)
#define SCAN_LOADB(s, n) do { \
        _Pragma("unroll") for (int t = 0; t < NT3; ++t) { const int db = cb + 4 * t; const bf16_t* a4_ = R0.M4T + (size_t)(n) * D * KZ + (db * 16 + lr) * KZ + 8 * lq; \
            _Pragma("unroll") for (int k = 0; k < NK2; ++k) s.m4[t][k] = *(const bf16x8*)(a4_ + 32 * k); \
            if (!GS) s.g[t] = *(const f32x4*)(R0.G + (size_t)(n) * D + db * 16 + 4 * lq); } \
        if (GS) s.gs = R0.G[(size_t)(n) * D]; } while (0)
#define SCAN_OUT(n) do { const f32x4 ov = *(const LAS f32x4*)(OS + (tid >> 3) * OSROW + (tid & 7) * 4); *(f32x4*)(OUT + (size_t)((n) * 64 + (tid >> 3)) * out_ld + e0 + (tid & 7) * 4) = ov; } while (0)
#define SCAN_STEP_F(n, par, fc, fl) do { \
        LAS bf16_t* STo = ST + (par) * 32 * SROW; \
        bf16x8 m2l[NK1]; \
        { const bf16_t* a2_ = R0.M2 + (size_t)(n) * 64 * D + (cb * 16 + lr) * D + 8 * lq; _Pragma("unroll") for (int k = 0; k < NK1; ++k) m2l[k] = *(const bf16x8*)(a2_ + 32 * k); }     \
        if ((n) + 2 < 32) SCAN_LOADF(fl, (n) + 2); \
        _Pragma("unroll") for (int j = 0; j < 2; ++j) { f32x4 a1 = fc.ut[j]; \
            _Pragma("unroll") for (int k = 0; k < NK1; ++k) { const bf16x8 y = *(const LAS bf16x8*)(STo + (j * 16 + lr) * SROW + 32 * k + 8 * lq); a1 = __builtin_amdgcn_mfma_f32_16x16x32_bf16(fc.m1[k], y, a1, 0, 0, 0); } \
            u32x2 zz; zz.x = cvtpk(a1[0], a1[1]); zz.y = cvtpk(a1[2], a1[3]); *(LAS u32x2*)(ZT + (j * 16 + lr) * ZROW + cb * 16 + 4 * lq) = zz; } \
        if (EXT) *(LAS u32x4*)(ZT + (tid >> 3) * ZROW + 64 + (tid & 7) * 8) = fc.vt; \
        LBAR(); \
        _Pragma("unroll") for (int j = 0; j < 2; ++j) { f32x4 a2 = (f32x4){0.f, 0.f, 0.f, 0.f}; \
            _Pragma("unroll") for (int k = 0; k < NK2; ++k) { const bf16x8 z = *(const LAS bf16x8*)(ZT + (j * 16 + lr) * ZROW + 32 * k + 8 * lq); a2 = __builtin_amdgcn_mfma_f32_16x16x32_bf16(fc.m3[k], z, a2, 0, 0, 0); } \
            _Pragma("unroll") for (int k = 0; k < NK1; ++k) { const bf16x8 y = *(const LAS bf16x8*)(STo + (j * 16 + lr) * SROW + 32 * k + 8 * lq); a2 = __builtin_amdgcn_mfma_f32_16x16x32_bf16(m2l[k], y, a2, 0, 0, 0); } \
            _Pragma("unroll") for (int r = 0; r < 4; ++r) OS[(cb * 16 + 4 * lq + r) * OSROW + j * 16 + lr] = a2[r]; } \
        LBAR(); \
        SCAN_OUT(n); } while (0)
#define SCAN_STEP_B(n, par, bc, bl) do { \
        LAS bf16_t* STn = ST + (1 - (par)) * 32 * SROW; \
        if ((n) + 2 < 32) SCAN_LOADB(bl, (n) + 2); \
        LBAR(); \
        _Pragma("unroll") for (int j = 0; j < 2; ++j) { \
            _Pragma("unroll") for (int t = 0; t < NT3; ++t) { if (GS) accs[t][j] = accs[t][j] * bc.gs; else accs[t][j] = accs[t][j] * bc.g[GS ? 0 : t]; } \
            _Pragma("unroll") for (int k = 0; k < NK2; ++k) { const bf16x8 z = *(const LAS bf16x8*)(ZT + (j * 16 + lr) * ZROW + 32 * k + 8 * lq); \
                _Pragma("unroll") for (int t = 0; t < NT3; ++t) accs[t][j] = __builtin_amdgcn_mfma_f32_16x16x32_bf16(bc.m4[t][k], z, accs[t][j], 0, 0, 0); } \
            _Pragma("unroll") for (int t = 0; t < NT3; ++t) { const int db = cb + 4 * t; u32x2 ss; ss.x = cvtpk(accs[t][j][0], accs[t][j][1]); ss.y = cvtpk(accs[t][j][2], accs[t][j][3]); *(LAS u32x2*)(STn + (j * 16 + lr) * SROW + db * 16 + 4 * lq) = ss; } } \
        LBAR(); \
        SCAN_OUT(n); } while (0)
    if (front) {
        FS f0, f1, f2;
        SCAN_LOADF(f0, 0); SCAN_LOADF(f1, 1);
        __builtin_amdgcn_s_waitcnt(0x0F70);
        LBAR();
        for (int n0 = 0; n0 < 30; n0 += 6) {
            SCAN_STEP_F(n0, 0, f0, f2); SCAN_STEP_F(n0 + 1, 1, f1, f0); SCAN_STEP_F(n0 + 2, 0, f2, f1);
            SCAN_STEP_F(n0 + 3, 1, f0, f2); SCAN_STEP_F(n0 + 4, 0, f1, f0); SCAN_STEP_F(n0 + 5, 1, f2, f1);
        }
        SCAN_STEP_F(30, 0, f0, f2); SCAN_STEP_F(31, 1, f1, f0);
    } else {
        BS b0, b1, b2;
        f32x4 accs[NT3][2];
#pragma unroll
        for (int t = 0; t < NT3; ++t) { accs[t][0] = (f32x4){0.f, 0.f, 0.f, 0.f}; accs[t][1] = (f32x4){0.f, 0.f, 0.f, 0.f}; }
        SCAN_LOADB(b0, 0); SCAN_LOADB(b1, 1);
        __builtin_amdgcn_s_waitcnt(0x0F70);
        LBAR();
        for (int n0 = 0; n0 < 30; n0 += 6) {
            SCAN_STEP_B(n0, 0, b0, b2); SCAN_STEP_B(n0 + 1, 1, b1, b0); SCAN_STEP_B(n0 + 2, 0, b2, b1);
            SCAN_STEP_B(n0 + 3, 1, b0, b2); SCAN_STEP_B(n0 + 4, 0, b1, b0); SCAN_STEP_B(n0 + 5, 1, b2, b1);
        }
        SCAN_STEP_B(30, 0, b0, b2); SCAN_STEP_B(31, 1, b1, b0);
    }
#undef SCAN_STEP_F
#undef SCAN_STEP_B
#undef SCAN_OUT
#undef SCAN_LOADF
#undef SCAN_LOADB
}

__device__ __forceinline__ void phase_gdn_chunk(const Args& a, int l, LAS unsigned char* lds) {
    size_t wso_ = 0; asm volatile("" : "+s"(wso_)); unsigned char* ws = a.ws + wso_;
    const int tid0 = tid_l(), w = __builtin_amdgcn_readfirstlane(tid0 >> 6);
    const float* GQ = (const float*)(ws + WS_GQ); const float* GK = (const float*)(ws + WS_GK); const float* GV = (const float*)(ws + WS_GV);
    const float* GB = (const float*)(ws + WS_GB); const float* GG = (const float*)(ws + WS_GG);
    constexpr int KROW = 136;
    LAS bf16_t* Kb = (LAS bf16_t*)lds;
    LAS bf16_t* Qb = (LAS bf16_t*)(lds + 64 * KROW * 2);
    LAS float* Af = (LAS float*)(lds + 2 * 64 * KROW * 2);
    LAS float* dvb = Af + 64 * 64;
    const int first = bid_l(), gstep = gdim_l();
    const int nmine = (first < GCH) ? (GCH - first + gstep - 1) / gstep : 0;
    for (int k = -1; k < nmine; ++k) {
        int tid = tid0; asm volatile("" : "+v"(tid)); const int lane = tid & 63, lr = lane & 15, lq = lane >> 4;
        LBAR();
        if (w < 4) {
            const bool act = (k >= 0); const int item = first + (act ? k : 0) * gstep;
            const int b = item / 192, h = (item / 32) % 6, n = item % 32; const size_t t0 = (size_t)b * SEQ + n * 64;
            LAS float* dv = dvb + (k & 1) * 128; LAS float* bv = dv + 64;
            const int col = tid; const bool isu = (w < 2); const int cc = col & 127;
            float X[64]; int Arow[63];
            if (act) {
                const float* src = (isu ? GV : GK) + t0 * 768 + h * 128 + cc;
#pragma unroll
                for (int c = 0; c < 64; ++c) X[c] = src[(size_t)c * 768];
#pragma unroll
                for (int m = 0; m < 63; ++m) Arow[m] = __float_as_int(Af[m * 64 + lane]);
                if (isu) {
#pragma unroll
                    for (int c = 0; c < 64; ++c) X[c] *= bv[c]; }
                else {
#pragma unroll
                    for (int c = 0; c < 64; ++c) X[c] *= bv[c] * __expf(dv[c]); }
            }
            LBAR();
            if (act) {
#pragma unroll
                for (int m = 0; m < 63; ++m) { const float xm = X[m];
#pragma unroll
                    for (int c = m + 1; c < 64; ++c) X[c] -= __int_as_float(__builtin_amdgcn_readlane(Arow[m], c)) * xm; }
            }
            LBAR();
            if (act) {
                if (isu) { float* UT = (float*)(ws + WS_GU) + (size_t)item * 128 * 64 + (size_t)cc * 64;
#pragma unroll
                    for (int c4 = 0; c4 < 16; ++c4) *(f32x4*)(UT + 4 * c4) = (f32x4){X[4 * c4], X[4 * c4 + 1], X[4 * c4 + 2], X[4 * c4 + 3]}; }
                else { bf16_t* M1 = (bf16_t*)(ws + WS_G1) + (size_t)item * 64 * 128 + cc;
#pragma unroll
                    for (int c = 0; c < 64; ++c) M1[c * 128] = f2bf(-X[c]); }
            }
        } else {
            const bool act = (k + 1 < nmine); const int item = first + (act ? (k + 1) : 0) * gstep;
            const int b = item / 192, h = (item / 32) % 6, n = item % 32; const size_t t0 = (size_t)b * SEQ + n * 64;
            LAS float* dv = dvb + ((k + 1) & 1) * 128; LAS float* bv = dv + 64;
            const int t = tid - 256, wb = w - 4;
            if (act) {
                float gpre = 0.f, bpre = 0.f; if (wb == 0) { gpre = GG[(t0 + lane) * 8 + h]; bpre = GB[(t0 + lane) * 8 + h]; }
#pragma unroll
                for (int hf = 0; hf < 2; ++hf) { f32x4 kv4[4], qv4[4];
#pragma unroll
                    for (int q = 0; q < 4; ++q) { const int idx = t + 256 * (4 * hf + q), c = idx >> 5, d4 = idx & 31; const size_t g = (t0 + c) * 768 + h * 128 + d4 * 4; kv4[q] = *(const f32x4*)(GK + g); qv4[q] = *(const f32x4*)(GQ + g); }
#pragma unroll
                    for (int q = 0; q < 4; ++q) { const int idx = t + 256 * (4 * hf + q), c = idx >> 5, d4 = idx & 31; const f32x4 kv = kv4[q], qv = qv4[q];
                        u32x2 pk; pk.x = cvtpk(kv[0], kv[1]); pk.y = cvtpk(kv[2], kv[3]); *(LAS u32x2*)(Kb + c * KROW + d4 * 4) = pk;
                        u32x2 pq; pq.x = cvtpk(qv[0], qv[1]); pq.y = cvtpk(qv[2], qv[3]); *(LAS u32x2*)(Qb + c * KROW + d4 * 4) = pq; } }
                if (wb == 0) { float g = gpre;
#pragma unroll
                    for (int o = 1; o < 64; o <<= 1) { const float tt = __shfl_up(g, o); if (lane >= o) g += tt; }
                    dv[lane] = g; bv[lane] = bpre; }
            }
            LBAR();
            if (act) {
                const int which = wb >> 1; const LAS bf16_t* X = which ? Qb : Kb;
                bf16_t* M3 = (bf16_t*)(ws + WS_G3) + (size_t)item * 64 * 64;
#pragma unroll
                for (int ci = 0; ci < 2; ++ci) { const int cb = 2 * (wb & 1) + ci;
                    bf16x8 xf[4];
#pragma unroll
                    for (int kk = 0; kk < 4; ++kk) xf[kk] = *(const LAS bf16x8*)(X + (cb * 16 + lr) * KROW + 32 * kk + 8 * lq);
#pragma unroll
                    for (int mb = 0; mb < 4; ++mb) { f32x4 acc = (f32x4){0.f, 0.f, 0.f, 0.f};
#pragma unroll
                        for (int kk = 0; kk < 4; ++kk) { const bf16x8 yf = *(const LAS bf16x8*)(Kb + (mb * 16 + lr) * KROW + 32 * kk + 8 * lq); acc = __builtin_amdgcn_mfma_f32_16x16x32_bf16(xf[kk], yf, acc, 0, 0, 0); }
                        const int m = mb * 16 + lr; const float dm = dv[m];
                        if (which == 0) { f32x4 o;
#pragma unroll
                            for (int r = 0; r < 4; ++r) { const int c = cb * 16 + 4 * lq + r; o[r] = (c > m) ? bv[c] * acc[r] * __expf(dv[c] - dm) : 0.f; }
                            *(LAS f32x4*)(Af + m * 64 + cb * 16 + 4 * lq) = o; }
                        else {
#pragma unroll
                            for (int r = 0; r < 4; ++r) { const int c = cb * 16 + 4 * lq + r; M3[c * 64 + m] = f2bf((c >= m) ? acc[r] * __expf(dv[c] - dm) : 0.f); } } } }
            }
            LBAR();
            if (act) {
                const float dl = dv[63];
                bf16_t* M2 = (bf16_t*)(ws + WS_G2) + (size_t)item * 64 * 128;
#pragma unroll
                for (int q = 0; q < 8; ++q) { const int idx = t + 256 * q, c = idx >> 5, d4 = idx & 31; const u32x2 qq = *(const LAS u32x2*)(Qb + c * KROW + d4 * 4); const float e = __expf(dv[c]);
                    u32x2 p; p.x = cvtpk(__uint_as_float(qq.x << 16) * e, __uint_as_float(qq.x & 0xffff0000u) * e); p.y = cvtpk(__uint_as_float(qq.y << 16) * e, __uint_as_float(qq.y & 0xffff0000u) * e); *(u32x2*)(M2 + c * 128 + d4 * 4) = p; }
                { const int d = t & 127, ch = t >> 7; bf16_t* M4 = (bf16_t*)(ws + WS_G4) + (size_t)item * 128 * 64 + d * 64 + ch * 32;
#pragma unroll
                    for (int q = 0; q < 4; ++q) { float kv[8];
#pragma unroll
                        for (int j = 0; j < 8; ++j) { const int c = ch * 32 + q * 8 + j; kv[j] = bf2f(Kb[c * KROW + d]) * __expf(dl - dv[c]); }
                        u32x4 p; p.x = cvtpk(kv[0], kv[1]); p.y = cvtpk(kv[2], kv[3]); p.z = cvtpk(kv[4], kv[5]); p.w = cvtpk(kv[6], kv[7]); *(u32x4*)(M4 + q * 8) = p; } }
                if (t < 128) ((float*)(ws + WS_GGL))[(size_t)item * 128 + t] = __expf(dl);
            }
        }
    }
    LBAR();
}

__device__ __forceinline__ void phase_rwkv_chunk(const Args& a, int l, LAS unsigned char* lds) {
    size_t wso_ = 0; asm volatile("" : "+s"(wso_)); unsigned char* ws = a.ws + wso_;
    const int tid0 = tid_l(), w = __builtin_amdgcn_readfirstlane(tid0 >> 6);
    const float* RR = (const float*)(ws + WS_RR); const float* RWl = (const float*)(ws + WS_RW); const float* RK = (const float*)(ws + WS_RK); const float* RV = (const float*)(ws + WS_RV);
    const float* RKK = (const float*)(ws + WS_RKK); const float* RB = (const float*)(ws + WS_RB);
    constexpr int OR_ = 72;
    LAS float* cw = (LAS float*)lds;
    LAS bf16_t* M3s = (LAS bf16_t*)lds;
    LAS bf16_t* Al = (LAS bf16_t*)(lds + 16384); LAS bf16_t* Be = Al + 64 * OR_; LAS bf16_t* Ka = Be + 64 * OR_; LAS bf16_t* Rh = Ka + 64 * OR_;
    LAS float* ABf = (LAS float*)(lds + 53248);
    LAS bf16_t* AKb = (LAS bf16_t*)(lds + 69632);
    LAS bf16_t* VTb = (LAS bf16_t*)(lds + 78848);
    LAS float* RH2 = (LAS float*)(lds + 88064);
    LAS bf16_t* M4s = (LAS bf16_t*)(lds + 104448);
    LAS float* segt = (LAS float*)(lds + 121856);
    const int first = bid_l(), gstep = gdim_l();
    const int nmine = (first < RCH) ? (RCH - first + gstep - 1) / gstep : 0;
    if (w < 2) {
    for (int k = -1; k < nmine; ++k) {
        int tid = tid0; asm volatile("" : "+v"(tid)); const int lane = tid & 63, lr = lane & 15, lq = lane >> 4;
            const bool act = (k >= 0); const int item = first + (act ? k : 0) * gstep;
            const bool isom = (w == 0); const int cc = tid & 63;
            float X[64]; int Arow[63];
            if (act) {
                if (isom) {
#pragma unroll
                    for (int c = 0; c < 64; ++c) X[c] = bf2f(Al[c * OR_ + cc]); }
                else {
#pragma unroll
                    for (int c = 0; c < 64; ++c) X[c] = RH2[c * 64 + cc]; }
#pragma unroll
                for (int m = 0; m < 63; ++m) Arow[m] = __float_as_int(ABf[m * 64 + lane]);
            }
            LBAR();
#define RW_SOLVE(m0, m1) do { if (act) { _Pragma("unroll") for (int m = (m0); m < (m1); ++m) { const float xm = X[m]; \
                _Pragma("unroll") for (int c = m + 1; c < 64; ++c) X[c] -= __int_as_float(__builtin_amdgcn_readlane(Arow[m], c)) * xm; } } } while (0)
            RW_SOLVE(0, 30);
            LBAR();
            RW_SOLVE(30, 63);
            LBAR();
#undef RW_SOLVE
            if (act) {
                if (isom) { bf16_t* M1 = (bf16_t*)(ws + WS_R1) + (size_t)item * 4096 + cc;
#pragma unroll
                    for (int c = 0; c < 64; ++c) M1[c * 64] = f2bf(X[c]); }
                else { float* UT = (float*)(ws + WS_RU) + (size_t)item * 4096 + (size_t)cc * 64;
#pragma unroll
                    for (int c4 = 0; c4 < 16; ++c4) *(f32x4*)(UT + 4 * c4) = (f32x4){X[4 * c4], X[4 * c4 + 1], X[4 * c4 + 2], X[4 * c4 + 3]}; }
            }
            LBAR();
    }
    } else {
    float plw[16], pv[11], pkk[12], pbb[12], pk2[12], pr[12];
#define RWB_ISSUE(it) do { const int b_ = (it) / 384, h_ = ((it) / 32) % 12, n_ = (it) % 32; const size_t gb_ = ((size_t)b_ * SEQ + n_ * 64) * 768 + h_ * 64; const int t_ = tidp - 128, wb_ = w - 2; \
        if (wb_ < 4) { _Pragma("unroll") for (int q = 0; q < 16; ++q) plw[q] = RWl[gb_ + (size_t)(wb_ * 16 + q) * 768 + (tidp & 63)]; } \
        _Pragma("unroll") for (int q = 0; q < 11; ++q) { const int idx = t_ + 384 * q; const int c = (idx >> 6) & 63, i = idx & 63; pv[q] = RV[gb_ + (size_t)c * 768 + i]; } \
        _Pragma("unroll") for (int q = 0; q < 12; ++q) { const int idx = t_ + 384 * q; const int c = (idx >> 6) & 63, j = idx & 63; const size_t g = gb_ + (size_t)c * 768 + j; pkk[q] = RKK[g]; pbb[q] = RB[g]; pk2[q] = RK[g]; pr[q] = RR[g]; } } while (0)
    if (nmine > 0) { int tidp = tid0; asm volatile("" : "+v"(tidp)); RWB_ISSUE(first); }
    for (int k = -1; k < nmine; ++k) {
        int tid = tid0; asm volatile("" : "+v"(tid)); const int lane = tid & 63, lr = lane & 15, lq = lane >> 4;
            const bool act = (k + 1 < nmine); const int item = first + (act ? (k + 1) : 0) * gstep;
            const int b = item / 384, h = (item / 32) % 12, n = item % 32; const size_t gb = ((size_t)b * SEQ + n * 64) * 768 + h * 64;
            const int t = tid - 128, wb = w - 2;
            if (act) {
                if (wb < 4) {
                    float acc = 0.f;
#pragma unroll
                    for (int q = 0; q < 8; ++q) { acc += plw[q]; cw[(wb * 16 + q) * 64 + lane] = acc; }
                    segt[(2 * wb) * 64 + lane] = acc; acc = 0.f;
#pragma unroll
                    for (int q = 8; q < 16; ++q) { acc += plw[q]; cw[(wb * 16 + q) * 64 + lane] = acc; }
                    segt[(2 * wb + 1) * 64 + lane] = acc; }
#pragma unroll
                for (int q = 0; q < 11; ++q) { const int idx = t + 384 * q; const int c = idx >> 6, i = idx & 63; if (idx < 4096) VTb[i * OR_ + c] = f2bf(pv[q]); }
            }
            LBAR();
            if (act) {
#pragma unroll
                for (int hf = 0; hf < 2; ++hf) {
#pragma unroll
                    for (int q = 0; q < 6; ++q) { const int idx = t + 384 * (6 * hf + q); const int c = idx >> 6, j = idx & 63;
                        if (idx < 4096) {
                            float off = 0.f, offm = 0.f, tot = 0.f;
#pragma unroll
                            for (int s2 = 0; s2 < 8; ++s2) { const float st = segt[s2 * 64 + j]; if (s2 < (c >> 3)) off += st; if (c > 0 && s2 < ((c - 1) >> 3)) offm += st; tot += st; }
                            const float cwc = cw[c * 64 + j] + off, cwm = c ? cw[(c - 1) * 64 + j] + offm : 0.f, cwl = tot;
                            const float kk = pkk[6 * hf + q], bb = pbb[6 * hf + q], k2 = pk2[6 * hf + q], r = pr[6 * hf + q];
                            const float en = __expf(-cwc);
                            Al[c * OR_ + j] = f2bf(kk * __expf(cwm)); Be[c * OR_ + j] = f2bf(bb * en); Ka[c * OR_ + j] = f2bf(k2 * en); const bf16_t rh = f2bf(r * __expf(cwc)); Rh[c * OR_ + j] = rh;
                            ((bf16_t*)(ws + WS_R2))[(size_t)item * 4096 + c * 64 + j] = rh;
                            const float ed = __expf(cwl - cwc); M4s[j * 136 + c] = f2bf(-bb * ed); M4s[j * 136 + 64 + c] = f2bf(k2 * ed);
                            if (c == 63) ((float*)(ws + WS_RGL))[(size_t)item * 64 + j] = __expf(cwl); } } }
                if (k + 2 < nmine) { const int tidp = tid; RWB_ISSUE(first + (k + 2) * gstep); }
            }
            LBAR();
            if (act) {
                for (int pc = wb; pc < 16; pc += 6) { const int p = pc >> 2, cb = pc & 3; const LAS bf16_t* X = (p < 2) ? Al : Rh; const LAS bf16_t* Y = (p & 1) ? Ka : Be;
                    const bf16x8 x0 = *(const LAS bf16x8*)(X + (cb * 16 + lr) * OR_ + 8 * lq), x1 = *(const LAS bf16x8*)(X + (cb * 16 + lr) * OR_ + 32 + 8 * lq);
#pragma unroll
                    for (int mb = 0; mb < 4; ++mb) { f32x4 acc = (f32x4){0.f, 0.f, 0.f, 0.f};
                        acc = __builtin_amdgcn_mfma_f32_16x16x32_bf16(x0, *(const LAS bf16x8*)(Y + (mb * 16 + lr) * OR_ + 8 * lq), acc, 0, 0, 0);
                        acc = __builtin_amdgcn_mfma_f32_16x16x32_bf16(x1, *(const LAS bf16x8*)(Y + (mb * 16 + lr) * OR_ + 32 + 8 * lq), acc, 0, 0, 0);
                        const int m = mb * 16 + lr;
                        if (p == 0) { f32x4 o;
#pragma unroll
                            for (int r = 0; r < 4; ++r) { const int c = cb * 16 + 4 * lq + r; o[r] = (c > m) ? acc[r] : 0.f; }
                            *(LAS f32x4*)(ABf + m * 64 + cb * 16 + 4 * lq) = o; }
                        else {
#pragma unroll
                            for (int r = 0; r < 4; ++r) { const int c = cb * 16 + 4 * lq + r;
                                if (p == 1) AKb[c * OR_ + m] = f2bf((c > m) ? acc[r] : 0.f);
                                else if (p == 2) M3s[c * 128 + m] = f2bf((c >= m) ? -acc[r] : 0.f);
                                else M3s[c * 128 + 64 + m] = f2bf((c >= m) ? acc[r] : 0.f); } } } }
            }
            LBAR();
            if (act) {
                for (int tl = wb; tl < 16; tl += 6) { const int cb = tl >> 2, ib = tl & 3;
                    const bf16x8 x0 = *(const LAS bf16x8*)(AKb + (cb * 16 + lr) * OR_ + 8 * lq), x1 = *(const LAS bf16x8*)(AKb + (cb * 16 + lr) * OR_ + 32 + 8 * lq);
                    f32x4 acc = (f32x4){0.f, 0.f, 0.f, 0.f};
                    acc = __builtin_amdgcn_mfma_f32_16x16x32_bf16(x0, *(const LAS bf16x8*)(VTb + (ib * 16 + lr) * OR_ + 8 * lq), acc, 0, 0, 0);
                    acc = __builtin_amdgcn_mfma_f32_16x16x32_bf16(x1, *(const LAS bf16x8*)(VTb + (ib * 16 + lr) * OR_ + 32 + 8 * lq), acc, 0, 0, 0);
#pragma unroll
                    for (int r = 0; r < 4; ++r) RH2[(cb * 16 + 4 * lq + r) * 64 + ib * 16 + lr] = acc[r]; }
                u32x4* g3 = (u32x4*)((bf16_t*)(ws + WS_R3) + (size_t)item * 64 * 128);
                for (int q = t; q < 1024; q += 384) g3[q] = *(const LAS u32x4*)(M3s + q * 8);
                u32x4* g4 = (u32x4*)((bf16_t*)(ws + WS_R4) + (size_t)item * 64 * 128);
                for (int q = t; q < 1024; q += 384) g4[q] = *(const LAS u32x4*)(M4s + (q >> 4) * 136 + (q & 15) * 8);
                u32x4* gv = (u32x4*)((bf16_t*)(ws + WS_RVT) + (size_t)item * 64 * 64);
                for (int q = t; q < 512; q += 384) gv[q] = *(const LAS u32x4*)(VTb + (q >> 3) * OR_ + (q & 7) * 8);
            }
            LBAR();
    }
    }
    LBAR();
#undef RWB_ISSUE
}

__device__ __forceinline__ void phase_lru_chunk(const Args& a) {
    size_t wso_ = 0; asm volatile("" : "+s"(wso_)); unsigned char* ws = a.ws + wso_;
    const int tid = tid_l();
    const float* LA = (const float*)(ws + WS_LA); const float* LU = (const float*)(ws + WS_LU); float* LH = (float*)(ws + WS_LH); float* LP = (float*)(ws + WS_LP);
    for (int p = bid_l() * 512 + tid; p < 128 * 512; p += gdim_l() * 512) { const int chunk = p >> 9, c = p & 511; const size_t base = (size_t)chunk * 64 * 512 + c;
        float h = 0.f, cp = 1.f;
        for (int i0 = 0; i0 < 64; i0 += 16) { float av[16], uv[16];
#pragma unroll
            for (int i = 0; i < 16; ++i) { av[i] = LA[base + (size_t)(i0 + i) * 512]; uv[i] = LU[base + (size_t)(i0 + i) * 512]; }
#pragma unroll
            for (int i = 0; i < 16; ++i) { h = av[i] * h + uv[i]; cp *= av[i]; LH[base + (size_t)(i0 + i) * 512] = h; LP[base + (size_t)(i0 + i) * 512] = cp; } } }
}
constexpr int SB = 16;
__device__ __forceinline__ void phase_scan_naive(const Args& a, int l, LAS unsigned char* lds) {
    size_t wso_ = 0; asm volatile("" : "+s"(wso_)); unsigned char* ws = a.ws + wso_;
    const int tid = tid_l(), wave = __builtin_amdgcn_readfirstlane(tid >> 6), lane = tid & 63;
    const int blk = bid_l();
    if (blk < 96) {
        const int xq = blk >> 3, bh = (blk & 7) * 3 + (xq >> 2), es = xq & 3, b = bh / 6, h = bh % 6; const size_t ci = (size_t)bh * 32;
        ScanRec R{(const bf16_t*)(ws + WS_G1) + ci * 64 * 128, (const bf16_t*)(ws + WS_G2) + ci * 64 * 128, (const bf16_t*)(ws + WS_G3) + ci * 64 * 64, (const bf16_t*)(ws + WS_G4) + ci * 128 * 64,
                  (const float*)(ws + WS_GU) + ci * 128 * 64, (const float*)(ws + WS_GGL) + ci * 128, nullptr};
        scan_item<128, 64, false>(R, es * 32, (float*)(ws + WS_GO) + (size_t)b * SEQ * 768 + h * 128, 768, lds);
    } else if (blk < 192) {
        const int it = blk - 96, xq = it >> 3, bh = (it & 7) * 6 + (xq >> 1), es = xq & 1, b = bh / 12, h = bh % 12; const size_t ci = (size_t)bh * 32;
        ScanRec R{(const bf16_t*)(ws + WS_R1) + ci * 4096, (const bf16_t*)(ws + WS_R2) + ci * 4096, (const bf16_t*)(ws + WS_R3) + ci * 8192, (const bf16_t*)(ws + WS_R4) + ci * 8192,
                  (const float*)(ws + WS_RU) + ci * 4096, (const float*)(ws + WS_RGL) + ci * 64, (const bf16_t*)(ws + WS_RVT) + ci * 4096};
        scan_item<64, 128, true>(R, es * 32, (float*)(ws + WS_RY) + (size_t)b * SEQ * 768 + h * 64, 768, lds);
    } else if (blk < 196) {
        const int gidx = (blk - 192) * 512 + tid, b = gidx >> 9, c = gidx & 511;
        const float* LH = (const float*)(ws + WS_LH); const float* LP = (const float*)(ws + WS_LP); float* LC = (float*)(ws + WS_LC);
        float pe[32], he[32];
#pragma unroll
        for (int n = 0; n < 32; ++n) { const size_t o = ((size_t)b * SEQ + n * 64 + 63) * 512 + c; pe[n] = LP[o]; he[n] = LH[o]; }
        float carry = 0.f;
#pragma unroll
        for (int n = 0; n < 32; ++n) { LC[(size_t)(b * 32 + n) * 512 + c] = carry; carry = pe[n] * carry + he[n]; }
    } else if (l + 1 < NL && CONV_SPLIT > 0) {
        phase_convert(a, lds, l + 1, l + 2, 0, CONV_SPLIT, blk - 196, gdim_l() - 196, 0);
    }
}
__device__ __forceinline__ void phase_fin(const Args& a, int l, LAS unsigned char* lds) {
    size_t wso_ = 0; asm volatile("" : "+s"(wso_)); unsigned char* ws = a.ws + wso_;
    const int tid = tid_l(), wave = tid >> 6, lane = tid & 63;
    const int gw = bid_l() * 8 + wave, NGW = gdim_l() * 8;
    const bf16_t* PROJ = (const bf16_t*)(ws + WS_PROJ); bf16_t* Y = (bf16_t*)(ws + WS_Y);
    const float* GO = (const float*)(ws + WS_GO); const float* RY = (const float*)(ws + WS_RY);
    const float* RR = (const float*)(ws + WS_RR); const float* RK = (const float*)(ws + WS_RK); const float* RV = (const float*)(ws + WS_RV);
    const float* LH = (const float*)(ws + WS_LH); const float* LP = (const float*)(ws + WS_LP); const float* LC = (const float*)(ws + WS_LC);
    const f32x2 ng = *(const f32x2*)(inp(lds, I_GNG) + l * 128 + 2 * lane);
    float gnw[12], gnb[12], rkw[12];
#pragma unroll
    for (int h = 0; h < 12; ++h) { gnw[h] = inp(lds, I_RGNW)[l * 768 + h * 64 + lane]; gnb[h] = inp(lds, I_RGNB)[l * 768 + h * 64 + lane]; rkw[h] = inp(lds, I_RRK)[l * 768 + h * 64 + lane]; }
    for (int t = gw; t < NTOK; t += NGW) {
        const f32x4 h0 = *(const f32x4*)(LH + (size_t)t * 512 + 8 * lane), h1 = *(const f32x4*)(LH + (size_t)t * 512 + 8 * lane + 4);
        const f32x4 p0 = *(const f32x4*)(LP + (size_t)t * 512 + 8 * lane), p1 = *(const f32x4*)(LP + (size_t)t * 512 + 8 * lane + 4);
        const f32x4 c0 = *(const f32x4*)(LC + (size_t)(t >> 6) * 512 + 8 * lane), c1 = *(const f32x4*)(LC + (size_t)(t >> 6) * 512 + 8 * lane + 4);
        const u32x4 gq = *(const u32x4*)(PROJ + (size_t)t * NP + PC_AG + 8 * lane);
        f32x2 go[6]; unsigned gg[6];
#pragma unroll
        for (int h = 0; h < 6; ++h) { go[h] = *(const f32x2*)(GO + (size_t)t * 768 + h * 128 + 2 * lane); gg[h] = *(const unsigned*)(PROJ + (size_t)t * NP + PC_BG + h * 128 + 2 * lane); }
        float ry[12], rr[12], rk[12], rv[12]; bf16_t rg[12];
#pragma unroll
        for (int h = 0; h < 12; ++h) { const size_t o = (size_t)t * 768 + h * 64 + lane; ry[h] = RY[o]; rr[h] = RR[o]; rk[h] = RK[o]; rv[h] = RV[o]; rg[h] = PROJ[(size_t)t * NP + PC_CG + h * 64 + lane]; }
        { const f32x4 v0 = h0 + p0 * c0, v1 = h1 + p1 * c1;
            u32x4 o; o.x = cvtpk(v0[0] * siluf_(__uint_as_float(gq.x << 16)), v0[1] * siluf_(__uint_as_float(gq.x & 0xffff0000u)));
            o.y = cvtpk(v0[2] * siluf_(__uint_as_float(gq.y << 16)), v0[3] * siluf_(__uint_as_float(gq.y & 0xffff0000u)));
            o.z = cvtpk(v1[0] * siluf_(__uint_as_float(gq.z << 16)), v1[1] * siluf_(__uint_as_float(gq.z & 0xffff0000u)));
            o.w = cvtpk(v1[2] * siluf_(__uint_as_float(gq.w << 16)), v1[3] * siluf_(__uint_as_float(gq.w & 0xffff0000u)));
            *(u32x4*)(Y + (size_t)t * DM + 8 * lane) = o; }
#pragma unroll
        for (int h = 0; h < 6; ++h) { const f32x2 o = go[h]; const float ss = wave_sum(o.x * o.x + o.y * o.y); const float sc = 1.0f / sqrtf(ss * (1.0f / 128.f) + 1e-6f);
            const float g0 = __uint_as_float(gg[h] << 16), g1 = __uint_as_float(gg[h] & 0xffff0000u);
            *(unsigned*)(Y + (size_t)t * DM + 512 + h * 128 + 2 * lane) = cvtpk(o.x * sc * ng.x * siluf_(g0), o.y * sc * ng.y * siluf_(g1)); }
#pragma unroll
        for (int h = 0; h < 12; ++h) { const float y = ry[h]; const float mean = wave_sum(y) * (1.0f / 64.f); const float d = y - mean; const float var = wave_sum(d * d) * (1.0f / 64.f);
            float yn = d * (1.0f / sqrtf(var + 64e-5f)) * gnw[h] + gnb[h];
            const float sdot = wave_sum(rr[h] * rk[h] * rkw[h]); yn += sdot * rv[h];
            Y[(size_t)t * DM + 1280 + h * 64 + lane] = f2bf(yn * siluf_(bf2f(rg[h]))); }
    }
}
#define XB_TMO      128
#define XB_XCNT(j)  (256  + 64 * (j))
#define XB_XSUB(j)  (1280 + 64 * (j))
#define XB_XGEN(j)  (2304 + 64 * (j))
#define XB_TOP      3328
#define XB_TOPGEN   3392
#define XCD_BAR_WORDS 3456
#define XB_SPIN_CAP (1u << 18)
__device__ __forceinline__ unsigned xb_ld(unsigned* p)              { return __hip_atomic_load(p, __ATOMIC_RELAXED, __HIP_MEMORY_SCOPE_AGENT); }
__device__ __forceinline__ unsigned xb_add(unsigned* p, unsigned v) { return __hip_atomic_fetch_add(p, v, __ATOMIC_RELAXED, __HIP_MEMORY_SCOPE_AGENT); }
__device__ __forceinline__ unsigned xb_xcc_id() { return (unsigned)__builtin_amdgcn_s_getreg((3 << 11) | 20) & 0xFu; }
#define XB_SPIN(cond, bar) do { unsigned _sp = 0; while (cond) { __builtin_amdgcn_s_sleep(1); \
    if ((++_sp & 255u) == 0u) { if (xb_ld(&(bar)[XB_TMO])) break; if (_sp > XB_SPIN_CAP) { atomicAdd(&(bar)[XB_TMO], 1u); break; } } } } while (0)

struct XcdBarrier {
    unsigned* bar; unsigned x;
    volatile LAS unsigned* st;
};

__device__ __forceinline__ XcdBarrier xcd_barrier_post(unsigned* bar, volatile LAS unsigned* st) {
    XcdBarrier b; b.bar = bar; b.x = xb_xcc_id(); b.st = st;
    if (threadIdx.x == 0) (void)xb_add(&bar[XB_XCNT(b.x)], 1u);
    return b;
}
__device__ __forceinline__ void xcd_barrier_complete(unsigned* bar, unsigned x, unsigned& nloc, unsigned& nx) {
    const unsigned G = gridDim.x * gridDim.y * gridDim.z;
    unsigned sum, cnt, mine, sp = 0u;
    for (;;) {
        sum = 0u; cnt = 0u; mine = 0u;
#pragma unroll
        for (unsigned j = 0; j < 16; ++j) { const unsigned c = xb_ld(&bar[XB_XCNT(j)]); sum += c; cnt += (c > 0u) ? 1u : 0u; mine = (j == x) ? c : mine; }
        if (sum == G) break;
        __builtin_amdgcn_s_sleep(1);
        if ((++sp & 255u) == 0u) { if (xb_ld(&bar[XB_TMO])) break; if (sp > XB_SPIN_CAP) { atomicAdd(&bar[XB_TMO], 1u); break; } }
    }
    nloc = mine > 0u ? mine : 1u; nx = cnt > 0u ? cnt : 1u;
}

__device__ __forceinline__ void xcd_barrier(const XcdBarrier& b) {
    asm volatile("s_waitcnt vmcnt(0)" ::: "memory");
    __syncthreads();
    if (threadIdx.x == 0) {
        unsigned* bar = b.bar;
        __builtin_amdgcn_s_waitcnt(0);
        unsigned nloc = b.st[0], nx = b.st[1];
        if (nloc == 0u) { xcd_barrier_complete(bar, b.x, nloc, nx); b.st[0] = nloc; b.st[1] = nx; }
        const unsigned old = xb_add(&bar[XB_XSUB(b.x)], 1u);
        const unsigned gen = old / nloc;
        if (old + 1u == (gen + 1u) * nloc) {
            __builtin_amdgcn_fence(__ATOMIC_RELEASE, "agent");
            asm volatile("s_waitcnt vmcnt(0)" ::: "memory");
            const unsigned og = xb_add(&bar[XB_TOP], 1u);
            const unsigned tg = og / nx;
            if (og + 1u == (tg + 1u) * nx) xb_add(&bar[XB_TOPGEN], 1u);
            else XB_SPIN(xb_ld(&bar[XB_TOPGEN]) == tg, bar);
            __builtin_amdgcn_fence(__ATOMIC_ACQUIRE, "agent");
            xb_add(&bar[XB_XGEN(b.x)], 1u);
            asm volatile("s_waitcnt vmcnt(0)" ::: "memory");
        } else {
            XB_SPIN(xb_ld(&bar[XB_XGEN(b.x)]) == gen, bar);
            __builtin_amdgcn_fence(__ATOMIC_ACQUIRE, "agent");
            asm volatile("s_waitcnt vmcnt(0)" ::: "memory");
        }
    }
    __syncthreads();
}


__global__ void __launch_bounds__(512) mk_fwd(Args a) {
    extern __shared__ __attribute__((aligned(16))) unsigned char lds_raw[];
    LAS unsigned char* lds = (LAS unsigned char*)lds_raw;
    cg::grid_group grid = cg::this_grid();
    const int lo = a.ph_lo, hi = a.ph_hi;
    if (threadIdx.x < 26) { const unsigned long long p = (unsigned long long)a.in[threadIdx.x]; LAS unsigned* t = (LAS unsigned*)(lds + 131072) + 2 * threadIdx.x; t[0] = (unsigned)p; t[1] = (unsigned)(p >> 32); }
    if (threadIdx.x == 0) { LAS unsigned* z = (LAS unsigned*)(lds + 131072 + 256); z[0] = 0u; z[1] = 0u; z[2] = 0u; z[3] = 0u; }
    __syncthreads();
    XcdBarrier xb = xcd_barrier_post((unsigned*)(a.ws + WS_BAR), (volatile LAS unsigned*)(lds + 131072 + 256));
    float* XR = (float*)(a.ws + WS_XR); bf16_t* XB = (bf16_t*)(a.ws + WS_XB); bf16_t* PROJ = (bf16_t*)(a.ws + WS_PROJ); bf16_t* Y = (bf16_t*)(a.ws + WS_Y);
    for (int ph = lo; ph < hi; ++ph) {
      const int nrep = (REPMASK && ph > 0 && ph < NPHASE - 1 && ((REPMASK >> ((ph - 1) % PPL)) & 1)) ? 2 : 1;
      for (int rep = 0; rep < nrep; ++rep) {
        if (ph == 0) { phase_convert(a, lds, 0, 1, 0, 64, bid_l(), gdim_l(), 1); phase_convert(a, lds, 1, NL, CONV_SPLIT2, 64, bid_l(), gdim_l(), 0); }
        else if (ph == NPHASE - 1) phase_final(XR, inp(lds, I_FNG), a.out);
        else { const int l = (ph - 1) / PPL, s = (ph - 1) % PPL; const float* xin = (l == 0) ? inp(lds, I_X) : XR;
            if (s == 0) { if (!(SKIPMASK & 2)) phase_rms(xin, XB); }
            else if (s == 1 || s == 6) { if (!(SKIPMASK & 4)) {
                pg8::Gemm g; EpiDual E;
                if (s == 1) { g = pg8::Gemm{XB, (const bf16_t*)(a.ws + WS_WIN) + (size_t)l * NP * DM, NTOK, NP, DM}; E = EpiDual{0, PROJ, NP, nullptr, nullptr, 0}; }
                else { g = pg8::Gemm{Y, (const bf16_t*)(a.ws + WS_WOUT) + (size_t)l * DM * DM, NTOK, DM, DM}; E = EpiDual{1, nullptr, 0, xin, XR, DM}; }
                pg8::StaticOrder S; S.init(NTOK, g.N, gdim_l(), bid_l());
                pg8::gemm_phase<EpiDual, pg8::StaticOrder>(lds, g, S, E, nullptr);
                if (s == 1 && l + 1 < NL) { const int nfull = (NTOK / 256) * (NP / 256) - 3 * gdim_l();
                    if (nfull > 0 && nfull < gdim_l() && bid_l() >= nfull) phase_convert(a, lds, l + 1, l + 2, CONV_SPLIT, CONV_SPLIT2, bid_l() - nfull, gdim_l() - nfull, 0);
                    else if (nfull <= 0 || nfull >= gdim_l()) phase_convert(a, lds, l + 1, l + 2, CONV_SPLIT, CONV_SPLIT2, bid_l(), gdim_l(), 0); } } }
            else if (s == 2) { if (!(SKIPMASK & 8)) phase_prep(a, l, lds); }
            else if (s == 3) { phase_gdn_chunk(a, l, lds); if (CHUNKREP & 1) phase_gdn_chunk(a, l, lds); phase_rwkv_chunk(a, l, lds); if (CHUNKREP & 2) phase_rwkv_chunk(a, l, lds); phase_lru_chunk(a); if (CHUNKREP & 4) phase_lru_chunk(a); }
            else if (s == 4) { if (!(SKIPMASK & 16)) phase_scan_naive(a, l, lds); }
            else if (s == 5) { if (!(SKIPMASK & 32)) phase_fin(a, l, lds); }
        }
      }
        if (ph + 1 < hi) { if (ph == 0) grid.sync(); else xcd_barrier(xb); }
    }
}

extern "C" void kernel_launch(void* const* d_in, const int* in_sizes, int n_in, void* d_out, int out_size, void* d_ws, size_t ws_size, hipStream_t stream) {
    static int grid = 0;
    if (grid == 0) {
        if (n_in != 26 || ws_size < WS_END) { fprintf(stderr, "kernel_launch: unexpected n_in %d or ws_size %zu < %zu\n", n_in, ws_size, (size_t)WS_END); grid = -1; return; }
        int dev = 0, cus = 0, per_cu = 0;
        hipGetDevice(&dev); hipDeviceGetAttribute(&cus, hipDeviceAttributeMultiprocessorCount, dev);
        if (hipFuncSetAttribute((const void*)mk_fwd, hipFuncAttributeMaxDynamicSharedMemorySize, LDS_BYTES) != hipSuccess) { fprintf(stderr, "hipFuncSetAttribute failed\n"); grid = -1; return; }
        if (hipOccupancyMaxActiveBlocksPerMultiprocessor(&per_cu, (const void*)mk_fwd, 512, LDS_BYTES) != hipSuccess || per_cu < 1) { fprintf(stderr, "occupancy query failed / 0\n"); grid = -1; return; }
        grid = cus;
    }
    if (grid < 0) return;
    if (hipMemsetAsync((char*)d_ws + WS_BAR, 0, 16384, stream) != hipSuccess) { fprintf(stderr, "memset of barrier words failed\n"); return; }
    Args a{};
    for (int i = 0; i < 26; ++i) a.in[i] = (const float*)d_in[i];
    a.out = (float*)d_out; a.ws = (unsigned char*)d_ws;
#if N_LAUNCH_MODE == 1
    a.ph_lo = 0; a.ph_hi = NPHASE;
    void* args[] = {&a};
    hipError_t e = hipLaunchCooperativeKernel((const void*)mk_fwd, dim3(grid), dim3(512), args, LDS_BYTES, stream);
    if (e != hipSuccess) fprintf(stderr, "cooperative launch failed: %s (grid %d)\n", hipGetErrorString(e), grid);
#else
    for (int ph = 0; ph < NPHASE; ++ph) { a.ph_lo = ph; a.ph_hi = ph + 1; hipLaunchKernelGGL(mk_fwd, dim3(grid), dim3(512), LDS_BYTES, stream, a); }
#endif
}
```

```cpp
#include <hip/hip_runtime.h>
#include <hip/hip_cooperative_groups.h>
#include <cstdio>
#include <cstdint>
namespace cg = cooperative_groups;
namespace pg8 {
#define PG8_LAS __attribute__((address_space(3)))
typedef unsigned short bf16_t;
typedef short bf16x8 __attribute__((ext_vector_type(8)));
typedef float f32x4 __attribute__((ext_vector_type(4)));
typedef unsigned u32x4 __attribute__((ext_vector_type(4)));
constexpr int BM = 256, BK = 64, HALF = 128, HTB = HALF * BK * 2  , STAGE_BYTES = 8 * HTB, NXCD = 8, WGM = 8;

__host__ __device__ __forceinline__ int lds_byte(int r, int c) { const int st = (r >> 4) * 2 + (c >> 5), rr = r & 15, cc = c & 31, ob = rr * 64 + cc * 2; return st * 1024 + (ob ^ (((ob >> 9) & 1) << 5)); }
__host__ __device__ __forceinline__ void stage_rc(int b, int& R, int& C) { const int st = b / 1024, sb = b % 1024, swz = sb ^ (((sb >> 9) & 1) << 5); R = (st >> 1) * 16 + swz / 64; C = (st & 1) * 32 + (swz % 64) / 2; }
__host__ __device__ __forceinline__ int perm32(int rho) { const int n = rho >> 4, i = rho & 15; return 8 * (i >> 2) + 4 * n + (i & 3); }

struct Unit { int pm, pn; };
struct Gemm { const bf16_t* A; const bf16_t* Bt; int M, N, K; };

struct StaticOrder {
    int nM, nN, nwg, G, c;
    __host__ __device__ void init(int M, int N, int G_, int c_) { nM = M / BM; nN = N / BM; nwg = nM * nN; G = G_; c = c_; }
    __host__ __device__ bool next(int i, Unit& u) const {
        const long L = (long)i * G + c; if (L >= nwg) return false;
        int wgid = (int)L; { const int q = nwg / NXCD, r = nwg % NXCD, xcd = wgid % NXCD, off = wgid / NXCD; wgid = (xcd < r ? xcd * (q + 1) : r * (q + 1) + (xcd - r) * q) + off; }
        const int nig = WGM * nN, gid = wgid / nig, fm = gid * WGM, gsz = (nM - fm) < WGM ? (nM - fm) : WGM;
        u.pm = fm + ((wgid % nig) % gsz); u.pn = (wgid % nig) / gsz; return true;
    }
    __device__ __forceinline__ void a_ready(const Unit&) const {}
    __device__ __forceinline__ void done(const Unit&) const {}
};
struct CountedOrder : StaticOrder {
    const unsigned* ready; unsigned need; unsigned* tmo;
    __device__ __forceinline__ void a_ready(const Unit& u) const {
        if (threadIdx.x < 64) {
            const unsigned long long t0 = __builtin_amdgcn_s_memrealtime(); unsigned polls = 0;
            while ((unsigned)__builtin_amdgcn_readfirstlane(__hip_atomic_load(ready + 64 * u.pm, __ATOMIC_RELAXED, __HIP_MEMORY_SCOPE_AGENT)) < need) {
                if ((++polls & 255u) == 0u && __builtin_amdgcn_readfirstlane(__hip_atomic_load(tmo, __ATOMIC_RELAXED, __HIP_MEMORY_SCOPE_AGENT)) != 0u) break;
                if (__builtin_amdgcn_s_memrealtime() - t0 > 2000000ull) {
                    if (threadIdx.x == 0) { unsigned expect = 0u; __hip_atomic_compare_exchange_strong(tmo + 1, &expect, 0x600u | (unsigned)(u.pm & 0xff), __ATOMIC_RELAXED, __ATOMIC_RELAXED, __HIP_MEMORY_SCOPE_AGENT); __hip_atomic_store(tmo, 1u, __ATOMIC_RELAXED, __HIP_MEMORY_SCOPE_AGENT); }
                    break; }
                __builtin_amdgcn_s_sleep(2); }
            __builtin_amdgcn_fence(__ATOMIC_ACQUIRE, "agent");
            asm volatile("s_waitcnt vmcnt(0)" ::: "memory");
        }
#if !defined(BROKEN_HOOK_NO_BARRIER)
        asm volatile("" ::: "memory"); __builtin_amdgcn_s_barrier(); asm volatile("" ::: "memory");
#endif
    }
};

__device__ __forceinline__ unsigned cvt_pk_bf16(float lo, float hi) { unsigned r; asm volatile("v_cvt_pk_bf16_f32 %0, %1, %2" : "=v"(r) : "v"(lo), "v"(hi)); return r; }
typedef float f32x2 __attribute__((ext_vector_type(2)));
__device__ __forceinline__ f32x2 gelu_pk(f32x2 v) {
    const f32x2 av = __builtin_elementwise_abs(v), d = av * 0.2316418882f + 1.0f;
    f32x2 t; t.x = __builtin_amdgcn_rcpf(d.x); t.y = __builtin_amdgcn_rcpf(d.y);
    f32x2 q = t * 0.5307027145f + (-0.7265760135f); q = q * t + 0.7107068705f; q = q * t + (-0.142248368f); q = q * t + 0.127414796f; q = q * t;
    const f32x2 s = (v * v) * (-0.72134752044f);
    f32x2 e; e.x = __builtin_amdgcn_exp2f(s.x); e.y = __builtin_amdgcn_exp2f(s.y);
    const f32x2 m = v * (q * e), r = v - m;
    f32x2 o; o.x = v.x < 0.f ? m.x : r.x; o.y = v.y < 0.f ? m.y : r.y; return o;
}

struct EpiF32 {
    static constexpr bool PERM = false, AFTER_DRAIN = false;
    float* C; int ldc; const float* bias;
    __device__ __forceinline__ void operator()(const f32x4 (&acc)[2][2][4][2], const Unit& u, int wr, int wc, int fr, int fq) const {
        const int row0 = u.pm * BM + wr * 64 + fr, col0 = u.pn * BM + wc * 32 + 4 * fq;
        f32x4 bv[2][2];
#pragma unroll
        for (int bj = 0; bj < 2; ++bj)
#pragma unroll
            for (int n = 0; n < 2; ++n) bv[bj][n] = bias ? *(const f32x4*)(bias + col0 + bj * HALF + n * 16) : (f32x4){0.f, 0.f, 0.f, 0.f};
#pragma unroll
        for (int ai = 0; ai < 2; ++ai)
#pragma unroll
            for (int m = 0; m < 4; ++m) { float* rowp = C + (size_t)(row0 + ai * HALF + m * 16) * ldc + col0;
#pragma unroll
                for (int bj = 0; bj < 2; ++bj)
#pragma unroll
                    for (int n = 0; n < 2; ++n) *(f32x4*)(rowp + bj * HALF + n * 16) = acc[ai][bj][m][n] + bv[bj][n]; }
    }
};
template <int ACT  > struct EpiBf16 {
    static constexpr bool PERM = true, AFTER_DRAIN = false;
    bf16_t* O; int ldc; const float* bias; int split_cols; size_t split_stride;
    __device__ __forceinline__ void operator()(const f32x4 (&acc)[2][2][4][2], const Unit& u, int wr, int wc, int fr, int fq) const {
        const int row0 = u.pm * BM + wr * 64 + fr; int colt = u.pn * BM; bf16_t* base = O;
        if (split_cols) { const int t = colt / split_cols; base += (size_t)t * split_stride; colt -= t * split_cols; }
        const int col0 = colt + wc * 32 + 8 * fq, bcol0 = u.pn * BM + wc * 32 + 8 * fq;
        f32x4 bv[2][2];
#pragma unroll
        for (int bj = 0; bj < 2; ++bj)
#pragma unroll
            for (int n = 0; n < 2; ++n) bv[bj][n] = bias ? *(const f32x4*)(bias + bcol0 + bj * HALF + 4 * n) : (f32x4){0.f, 0.f, 0.f, 0.f};
#pragma unroll
        for (int ai = 0; ai < 2; ++ai)
#pragma unroll
            for (int m = 0; m < 4; ++m) { bf16_t* rowp = base + (size_t)(row0 + ai * HALF + m * 16) * ldc + col0;
#pragma unroll
                for (int bj = 0; bj < 2; ++bj) { f32x4 v0 = acc[ai][bj][m][0] + bv[bj][0], v1 = acc[ai][bj][m][1] + bv[bj][1];
                    if (ACT == 1) { f32x2 a = gelu_pk((f32x2){v0[0], v0[1]}), b = gelu_pk((f32x2){v0[2], v0[3]}), c = gelu_pk((f32x2){v1[0], v1[1]}), d = gelu_pk((f32x2){v1[2], v1[3]});
                        v0 = (f32x4){a.x, a.y, b.x, b.y}; v1 = (f32x4){c.x, c.y, d.x, d.y}; }
                    if (ACT == 2) {
#pragma unroll
                        for (int j = 0; j < 4; ++j) { v0[j] = 0.5f * v0[j] * (1.0f + erff(v0[j] * 0.70710678f)); v1[j] = 0.5f * v1[j] * (1.0f + erff(v1[j] * 0.70710678f)); } }
                    u32x4 w; w.x = cvt_pk_bf16(v0[0], v0[1]); w.y = cvt_pk_bf16(v0[2], v0[3]); w.z = cvt_pk_bf16(v1[0], v1[1]); w.w = cvt_pk_bf16(v1[2], v1[3]);
                    *(u32x4*)(rowp + bj * HALF) = w; } }
    }
};

struct PanelStats {
    unsigned* xbuf;
    unsigned* cnt;
    unsigned* tmo;
    int ntn; float eps;
    unsigned code;
    __device__ __forceinline__ bool run(const f32x4 (&v)[2][2][4][2], const Unit& u, int wr, int wc, int fr, int fq, PG8_LAS unsigned char* lds, int wid, int lane) const {
        typedef float f32x2v __attribute__((ext_vector_type(2)));
        PG8_LAS f32x2v* P = (PG8_LAS f32x2v*)lds;
        PG8_LAS f32x2v* S = (PG8_LAS f32x2v*)(lds + 8192);
        PG8_LAS unsigned* flag = (PG8_LAS unsigned*)(lds + 8192 + 2048);
#pragma unroll
        for (int ai = 0; ai < 2; ++ai)
#pragma unroll
            for (int m = 0; m < 4; ++m) {
                float s = 0.f;
#pragma unroll
                for (int bj = 0; bj < 2; ++bj)
#pragma unroll
                    for (int n = 0; n < 2; ++n) { const f32x4 x = v[ai][bj][m][n]; s += (x[0] + x[1]) + (x[2] + x[3]); }
                s += __shfl_xor(s, 16); s += __shfl_xor(s, 32);
                const float mw = s * (1.0f / 64.0f); float q = 0.f;
#pragma unroll
                for (int bj = 0; bj < 2; ++bj)
#pragma unroll
                    for (int n = 0; n < 2; ++n) { const f32x4 d = v[ai][bj][m][n] - mw; q += (d[0] * d[0] + d[1] * d[1]) + (d[2] * d[2] + d[3] * d[3]); }
                q += __shfl_xor(q, 16); q += __shfl_xor(q, 32);
                if (fq == 0) P[(ai * HALF + wr * 64 + m * 16 + fr) * 4 + wc] = (f32x2v){mw, q};
            }
        asm volatile("s_waitcnt lgkmcnt(0)" ::: "memory"); __builtin_amdgcn_s_barrier(); asm volatile("" ::: "memory");
#if defined(BROKEN_NO_WAIT)
        if (blockIdx.x >= 64) { const long long t0 = clock64(); while (clock64() - t0 < 60000) __builtin_amdgcn_s_sleep(8); }
#endif
        const int row = wid * 32 + (lane & 31);
        if (lane < 32) {
            const f32x2v a = P[row * 4 + 0], b = P[row * 4 + 1], c = P[row * 4 + 2], d = P[row * 4 + 3];
            const float mt = (a.x + b.x + c.x + d.x) * 0.25f;
            const float da = a.x - mt, db = b.x - mt, dc = c.x - mt, dd = d.x - mt;
            const float m2 = (a.y + b.y) + (c.y + d.y) + 64.0f * ((da * da + db * db) + (dc * dc + dd * dd));
            unsigned long long* slot = (unsigned long long*)xbuf + ((size_t)(u.pm * BM + row) * 4 + u.pn);
            __hip_atomic_store(slot, ((unsigned long long)__float_as_uint(m2) << 32) | __float_as_uint(mt), __ATOMIC_RELAXED, __HIP_MEMORY_SCOPE_AGENT);
        }
        asm volatile("s_waitcnt vmcnt(0)" ::: "memory");
        if (lane == 0) __hip_atomic_fetch_add(cnt + 64 * u.pm, 1u, __ATOMIC_RELAXED, __HIP_MEMORY_SCOPE_AGENT);
        if (wid == 0) {
            bool dead = false; const unsigned long long t0 = __builtin_amdgcn_s_memrealtime(); const unsigned want = 8u * (unsigned)ntn;
            for (;;) {
#if defined(BROKEN_NO_WAIT)
                break;
#endif
                if ((unsigned)__builtin_amdgcn_readfirstlane(__hip_atomic_load(cnt + 64 * u.pm, __ATOMIC_RELAXED, __HIP_MEMORY_SCOPE_AGENT)) >= want) break;
                if (__builtin_amdgcn_s_memrealtime() - t0 > 2000000ull) {
                    if (lane == 0) { unsigned expect = 0u; __hip_atomic_compare_exchange_strong(tmo + 1, &expect, code | (unsigned)(u.pm & 0xff), __ATOMIC_RELAXED, __ATOMIC_RELAXED, __HIP_MEMORY_SCOPE_AGENT);
                                     __hip_atomic_store(tmo, 1u, __ATOMIC_RELAXED, __HIP_MEMORY_SCOPE_AGENT); }
                    dead = true; break; }
                __builtin_amdgcn_s_sleep(2);
            }
            __builtin_amdgcn_fence(__ATOMIC_ACQUIRE, "agent");
            if (lane == 0) flag[0] = dead ? 1u : 0u;
        }
        asm volatile("s_waitcnt vmcnt(0) lgkmcnt(0)" ::: "memory"); __builtin_amdgcn_s_barrier(); asm volatile("" ::: "memory");
        const bool bad = flag[0] != 0u;
        if (lane < 32) {
            const unsigned long long* slot = (const unsigned long long*)xbuf + (size_t)(u.pm * BM + row) * 4; float mt[4], m2[4]; float ms = 0.f;
#pragma unroll
            for (int t = 0; t < 4; ++t) { if (t < ntn) { const unsigned long long w = __hip_atomic_load(slot + t, __ATOMIC_RELAXED, __HIP_MEMORY_SCOPE_AGENT); mt[t] = __uint_as_float((unsigned)w); m2[t] = __uint_as_float((unsigned)(w >> 32)); } else { mt[t] = 0.f; m2[t] = 0.f; } ms += mt[t]; }
            const float mean = ms / (float)ntn; float q = 0.f;
#pragma unroll
            for (int t = 0; t < 4; ++t) if (t < ntn) { const float dm = mt[t] - mean; q += m2[t] + 256.0f * dm * dm; }
            S[row] = (f32x2v){mean, 1.0f / sqrtf(q / (256.0f * (float)ntn) + eps)};
        }
        asm volatile("s_waitcnt lgkmcnt(0)" ::: "memory"); __builtin_amdgcn_s_barrier(); asm volatile("" ::: "memory");
        return bad;
    }
};
struct EpiLnRes {
    static constexpr bool PERM = false, AFTER_DRAIN = true;
    const float* base; float* out; int ldc; const float* bias; PanelStats st; unsigned poison;
    __device__ __forceinline__ void refuse(size_t i0, size_t stride, int M, int N) const { const float q = __builtin_nanf(""); for (size_t i = i0; i < (size_t)M * N; i += stride) out[(i / N) * ldc + i % N] = q;
        if (i0 == 0) { unsigned expect = 0u; __hip_atomic_compare_exchange_strong(st.tmo + 1, &expect, 0x7f0u, __ATOMIC_RELAXED, __ATOMIC_RELAXED, __HIP_MEMORY_SCOPE_AGENT); __hip_atomic_store(st.tmo, 1u, __ATOMIC_RELAXED, __HIP_MEMORY_SCOPE_AGENT); } }
    __device__ __forceinline__ void fused(f32x4 (&acc)[2][2][4][2], const Unit& u, int wr, int wc, int fr, int fq, PG8_LAS unsigned char* lds, int wid, int lane) const {
        typedef float f32x2v __attribute__((ext_vector_type(2)));
        const PG8_LAS f32x2v* S = (const PG8_LAS f32x2v*)(lds + 8192);
        const int col0 = u.pn * BM + wc * 32 + 4 * fq;
#pragma unroll
        for (int bj = 0; bj < 2; ++bj)
#pragma unroll
            for (int n = 0; n < 2; ++n) { const f32x4 bv = bias ? *(const f32x4*)(bias + col0 + bj * HALF + n * 16) : (f32x4){0.f, 0.f, 0.f, 0.f};
#pragma unroll
                for (int ai = 0; ai < 2; ++ai)
#pragma unroll
                    for (int m = 0; m < 4; ++m) acc[ai][bj][m][n] += bv; }
        const bool bad = st.run(acc, u, wr, wc, fr, fq, lds, wid, lane) || poison != 0u;
        const float qnan = __builtin_nanf("");
#pragma unroll
        for (int ai = 0; ai < 2; ++ai)
#pragma unroll
            for (int m = 0; m < 4; ++m) { const int r = ai * HALF + wr * 64 + m * 16 + fr; const f32x2v sr = S[r]; const size_t off = (size_t)(u.pm * BM + r) * ldc + col0;
#pragma unroll
                for (int bj = 0; bj < 2; ++bj)
#pragma unroll
                    for (int n = 0; n < 2; ++n) { const f32x4 bs = *(const f32x4*)(base + off + bj * HALF + n * 16); f32x4 o = bs + (acc[ai][bj][m][n] - sr.x) * sr.y;
                        if (bad) o = (f32x4){qnan, qnan, qnan, qnan}; *(f32x4*)(out + off + bj * HALF + n * 16) = o; }
                asm volatile("" ::: "memory"); }
    }
};
struct EpiLnResLn {
    static constexpr bool PERM = false, AFTER_DRAIN = true;
    const float* base; float* out; bf16_t* xn; int ldc; const float* bias; PanelStats st1, st2; unsigned poison;
    __device__ __forceinline__ void refuse(size_t i0, size_t stride, int M, int N) const { const float q = __builtin_nanf(""); for (size_t i = i0; i < (size_t)M * N; i += stride) { const size_t o = (i / N) * ldc + i % N; out[o] = q; xn[o] = (bf16_t)0x7fc0u; }
        if (i0 == 0) { unsigned expect = 0u; __hip_atomic_compare_exchange_strong(st1.tmo + 1, &expect, 0x7f0u, __ATOMIC_RELAXED, __ATOMIC_RELAXED, __HIP_MEMORY_SCOPE_AGENT); __hip_atomic_store(st1.tmo, 1u, __ATOMIC_RELAXED, __HIP_MEMORY_SCOPE_AGENT); } }
    __device__ __forceinline__ void fused(f32x4 (&acc)[2][2][4][2], const Unit& u, int wr, int wc, int fr, int fq, PG8_LAS unsigned char* lds, int wid, int lane) const {
        typedef float f32x2v __attribute__((ext_vector_type(2))); typedef unsigned u32x2v __attribute__((ext_vector_type(2)));
        const PG8_LAS f32x2v* S = (const PG8_LAS f32x2v*)(lds + 8192);
        const int col0 = u.pn * BM + wc * 32 + 4 * fq;
#pragma unroll
        for (int bj = 0; bj < 2; ++bj)
#pragma unroll
            for (int n = 0; n < 2; ++n) { const f32x4 bv = bias ? *(const f32x4*)(bias + col0 + bj * HALF + n * 16) : (f32x4){0.f, 0.f, 0.f, 0.f};
#pragma unroll
                for (int ai = 0; ai < 2; ++ai)
#pragma unroll
                    for (int m = 0; m < 4; ++m) acc[ai][bj][m][n] += bv; }
        bool bad = st1.run(acc, u, wr, wc, fr, fq, lds, wid, lane) || poison != 0u;
        const float qnan = __builtin_nanf("");
#pragma unroll
        for (int ai = 0; ai < 2; ++ai)
#pragma unroll
            for (int m = 0; m < 4; ++m) { const int r = ai * HALF + wr * 64 + m * 16 + fr; const f32x2v sr = S[r]; const size_t off = (size_t)(u.pm * BM + r) * ldc + col0;
#pragma unroll
                for (int bj = 0; bj < 2; ++bj)
#pragma unroll
                    for (int n = 0; n < 2; ++n) { const f32x4 bs = *(const f32x4*)(base + off + bj * HALF + n * 16); acc[ai][bj][m][n] = bs + (acc[ai][bj][m][n] - sr.x) * sr.y; }
                asm volatile("" : "+v"(acc[ai][0][m][0]), "+v"(acc[ai][0][m][1]), "+v"(acc[ai][1][m][0]), "+v"(acc[ai][1][m][1]));
                if (m & 1) asm volatile("" ::: "memory"); }
        const bool bad1 = bad;
        bad = st2.run(acc, u, wr, wc, fr, fq, lds, wid, lane) || bad;
#pragma unroll
        for (int ai = 0; ai < 2; ++ai)
#pragma unroll
            for (int m = 0; m < 4; ++m) { const int r = ai * HALF + wr * 64 + m * 16 + fr; const f32x2v sr = S[r]; const size_t off = (size_t)(u.pm * BM + r) * ldc + col0;
#pragma unroll
                for (int bj = 0; bj < 2; ++bj)
#pragma unroll
                    for (int n = 0; n < 2; ++n) { const f32x4 x1 = acc[ai][bj][m][n]; *(f32x4*)(out + off + bj * HALF + n * 16) = bad1 ? (f32x4){qnan, qnan, qnan, qnan} : x1;
                        const f32x4 o = (x1 - sr.x) * sr.y; u32x2v w; w.x = cvt_pk_bf16(o[0], o[1]); w.y = cvt_pk_bf16(o[2], o[3]);
                        if (bad) { w.x = 0x7fc07fc0u; w.y = 0x7fc07fc0u; } *(u32x2v*)(xn + off + bj * HALF + n * 16) = w; }
                asm volatile("" ::: "memory"); }
    }
};

template <class Epi, class Sched, bool STAMP = false>
__device__ __forceinline__ void gemm_phase(PG8_LAS unsigned char* lds, const Gemm g, const Sched& S, const Epi& E, unsigned long long* stamps) {
    int tid_ = threadIdx.x; asm volatile("" : "+v"(tid_)); const int tid = tid_, wid = __builtin_amdgcn_readfirstlane(tid >> 6), lane = tid & 63, wr = wid >> 2, wc = wid & 3, fr = lane & 15, fq = lane >> 4;
    const int K = g.K, nt = K / BK;
    int ts_lo = 0, ts_hi = 0, nts = 0; const unsigned long long rt_entry = STAMP ? (unsigned long long)wall_clock64() : 0ull;
#define PG8_STAMP() do { if (STAMP && wid == 0 && nts < 64) { const unsigned long long _c = (unsigned long long)clock64(); \
        ts_lo = (lane == nts) ? (int)(unsigned)_c : ts_lo; ts_hi = (lane == nts) ? (int)(unsigned)(_c >> 32) : ts_hi; ++nts; } } while (0)
    PG8_STAMP();
    unsigned voffA[2], voffB[2];
#pragma unroll
    for (int i = 0; i < 2; ++i) { int R, C; stage_rc(tid * 16 + i * 8192, R, C); const int Rb = Epi::PERM ? ((R & ~31) + perm32(R & 31)) : R;
        voffA[i] = (unsigned)(R * K + C) * 2u; voffB[i] = (unsigned)(Rb * K + C) * 2u; }
    const size_t kstep = (size_t)(BK * 2);
    const size_t hstep = (size_t)HALF * K * 2;
    const size_t tstep = 2 * hstep;
    const unsigned ldsw = (unsigned)wid * 1024u;
    const int aoff = lds_byte(wr * 64 + fr, fq * 8), boff = lds_byte(wc * 32 + fr, fq * 8);
#define PG8_SA(b, h) (((b) * 2 + (h)) * HTB)
#define PG8_SB(b, h) ((4 + (b) * 2 + (h)) * HTB)
#define PG8_STAGE(bufoff, gbase, voff) do { _Pragma("unroll") for (int _i = 0; _i < 2; ++_i) \
        __builtin_amdgcn_global_load_lds((const unsigned*)((const char*)(gbase) + (voff)[_i]), (PG8_LAS unsigned*)(lds + (bufoff) + ldsw + _i * 8192), 16, 0, 0); } while (0)
#define PG8_LDA(dst, b, h) do { _Pragma("unroll") for (int m = 0; m < 4; ++m) _Pragma("unroll") for (int k = 0; k < 2; ++k) dst[m][k] = *(const PG8_LAS bf16x8*)(lds + PG8_SA(b, h) + aoff + m * 2048 + k * 1024); } while (0)
#define PG8_LDB(dst, b, h) do { _Pragma("unroll") for (int n = 0; n < 2; ++n) _Pragma("unroll") for (int k = 0; k < 2; ++k) dst[n][k] = *(const PG8_LAS bf16x8*)(lds + PG8_SB(b, h) + boff + n * 2048 + k * 1024); } while (0)
#define PG8_MMA(ai, bj, At, Bt) do { __builtin_amdgcn_s_setprio(1); _Pragma("unroll") for (int m = 0; m < 4; ++m) _Pragma("unroll") for (int n = 0; n < 2; ++n) _Pragma("unroll") for (int k = 0; k < 2; ++k) \
        acc[ai][bj][m][n] = __builtin_amdgcn_mfma_f32_16x16x32_bf16(Bt[n][k], At[m][k], acc[ai][bj][m][n], 0, 0, 0); __builtin_amdgcn_s_setprio(0); } while (0)
#define PG8_WAIT_V(n) asm volatile("s_waitcnt vmcnt(" #n ")" ::: "memory")
#define PG8_WAIT_L(n) asm volatile("s_waitcnt lgkmcnt(" #n ")" ::: "memory")
#define PG8_BAR __builtin_amdgcn_s_barrier()
#define PG8_SCHED __builtin_amdgcn_sched_barrier(0)
    Unit cur, nxt; int ui = 0;
    if (!S.next(0, cur)) return;
    f32x4 acc[2][2][4][2];
#pragma unroll
    for (int a = 0; a < 2; ++a)
#pragma unroll
        for (int b = 0; b < 2; ++b)
#pragma unroll
            for (int m = 0; m < 4; ++m)
#pragma unroll
                for (int n = 0; n < 2; ++n) acc[a][b][m][n] = (f32x4){0.f, 0.f, 0.f, 0.f};
    bf16x8 At[4][2], B0[2][2], B1[2][2];
    const char* cA = (const char*)g.A + (size_t)cur.pm * tstep; const char* cB = (const char*)g.Bt + (size_t)cur.pn * tstep;
    S.a_ready(cur);
    PG8_STAGE(PG8_SB(0, 0), cB, voffB); PG8_STAGE(PG8_SA(0, 0), cA, voffA); PG8_STAGE(PG8_SB(0, 1), cB + hstep, voffB); PG8_STAGE(PG8_SA(0, 1), cA + hstep, voffA);
    if (wr == 1) PG8_BAR;
    PG8_WAIT_V(4); PG8_BAR;
    PG8_STAGE(PG8_SB(1, 0), cB + kstep, voffB); PG8_STAGE(PG8_SA(1, 0), cA + kstep, voffA); PG8_STAGE(PG8_SB(1, 1), cB + hstep + kstep, voffB);
    PG8_WAIT_V(6); PG8_BAR;
    PG8_STAMP();
    for (;;) {
        const bool has_next = S.next(ui + 1, nxt);
        const char* nA = has_next ? (const char*)g.A + (size_t)nxt.pm * tstep : cA; const char* nB = has_next ? (const char*)g.Bt + (size_t)nxt.pn * tstep : cB;
        for (int t = 0; t < nt; t += 2) {
            const bool last = (t == nt - 2);
            const char* a1 = cA + (size_t)(t + 1) * kstep;
            const char* a2 = last ? nA : cA + (size_t)(t + 2) * kstep; const char* b2 = last ? nB : cB + (size_t)(t + 2) * kstep;
            const char* a3 = a2 + kstep; const char* b3 = b2 + kstep;
            if (last && has_next) S.a_ready(nxt);
            PG8_LDB(B0, 0, 0); PG8_SCHED; PG8_LDA(At, 0, 0); PG8_STAGE(PG8_SA(1, 1), a1 + hstep, voffA);
            PG8_WAIT_L(8); PG8_BAR; PG8_WAIT_L(0); PG8_MMA(0, 0, At, B0); PG8_BAR; PG8_SCHED;
            PG8_LDB(B1, 0, 1); PG8_STAGE(PG8_SB(0, 0), b2, voffB);
            PG8_BAR; PG8_WAIT_L(0); PG8_MMA(0, 1, At, B1); PG8_BAR;
            PG8_LDA(At, 0, 1); PG8_STAGE(PG8_SA(0, 0), a2, voffA);
            PG8_BAR; PG8_WAIT_L(0); PG8_MMA(1, 0, At, B0); PG8_BAR; PG8_SCHED;
            PG8_STAGE(PG8_SB(0, 1), b2 + hstep, voffB);
            PG8_WAIT_V(6); PG8_BAR; PG8_MMA(1, 1, At, B1); PG8_BAR;
            PG8_LDB(B0, 1, 0); PG8_SCHED; PG8_LDA(At, 1, 0); PG8_STAGE(PG8_SA(0, 1), a2 + hstep, voffA);
            PG8_WAIT_L(8); PG8_BAR; PG8_WAIT_L(0); PG8_MMA(0, 0, At, B0); PG8_BAR; PG8_SCHED;
            PG8_LDB(B1, 1, 1); PG8_STAGE(PG8_SB(1, 0), b3, voffB);
            PG8_BAR; PG8_WAIT_L(0); PG8_MMA(0, 1, At, B1); PG8_BAR;
            PG8_LDA(At, 1, 1); PG8_STAGE(PG8_SA(1, 0), a3, voffA);
            PG8_BAR; PG8_WAIT_L(0); PG8_MMA(1, 0, At, B0); PG8_BAR; PG8_SCHED;
            PG8_STAGE(PG8_SB(1, 1), b3 + hstep, voffB);
            PG8_WAIT_V(6); PG8_BAR; PG8_MMA(1, 1, At, B1); PG8_BAR;
        }
        PG8_STAMP();
        if constexpr (!Epi::AFTER_DRAIN) { E(acc, cur, wr, wc, fr, fq); S.done(cur); }
        PG8_STAMP();
        if (!has_next) break;
#pragma unroll
        for (int a = 0; a < 2; ++a)
#pragma unroll
            for (int b = 0; b < 2; ++b)
#pragma unroll
                for (int m = 0; m < 4; ++m)
#pragma unroll
                    for (int n = 0; n < 2; ++n) acc[a][b][m][n] = (f32x4){0.f, 0.f, 0.f, 0.f};
        cur = nxt; cA = nA; cB = nB; ++ui;
    }
    PG8_WAIT_V(0);
    if (wr == 0) PG8_BAR;
    PG8_BAR;
    if constexpr (Epi::AFTER_DRAIN) { E.fused(acc, cur, wr, wc, fr, fq, lds, wid, lane); S.done(cur); }
    PG8_STAMP();
    if (STAMP && wid == 0) { stamps[lane] = lane < nts ? (((unsigned long long)(unsigned)ts_hi << 32) | (unsigned)ts_lo) : 0ull;
        if (lane == 62) stamps[62] = rt_entry; if (lane == 63) stamps[63] = (unsigned long long)wall_clock64(); }
#undef PG8_STAMP
#undef PG8_SA
#undef PG8_SB
#undef PG8_STAGE
#undef PG8_LDA
#undef PG8_LDB
#undef PG8_MMA
#undef PG8_WAIT_V
#undef PG8_WAIT_L
#undef PG8_BAR
#undef PG8_SCHED
}
}
#define LAS __attribute__((address_space(3)))
typedef unsigned short bf16_t;
typedef float f32x4 __attribute__((ext_vector_type(4)));
typedef float f32x2 __attribute__((ext_vector_type(2)));
typedef unsigned u32x4 __attribute__((ext_vector_type(4)));
typedef unsigned u32x2 __attribute__((ext_vector_type(2)));
constexpr int NTOK = 8192, SEQ = 2048, DM = 2048, NIN = 7372, NP = 7424, NL = 4;
constexpr int LRUW = 512, GW = 768, RW_ = 768;
constexpr int PC_AX = 0, PC_AG = 512, PC_BQKV = 1024, PC_BG = 3328, PC_CIN = 4096, PC_CG = 6592, PC_BETA = 7360, PC_BA = 7366;
constexpr int LDS_BYTES = 131072 + 512;
#ifndef CHUNKREP
#define CHUNKREP 0
#endif
#ifndef CONV_SPLIT2
#define CONV_SPLIT2 52
#endif
#ifndef CONV_SPLIT
#define CONV_SPLIT 24
#endif
#ifndef REPMASK
#define REPMASK 0
#endif
#ifndef SKIPMASK
#define SKIPMASK 0
#endif
#ifndef N_LAUNCH_MODE
#define N_LAUNCH_MODE 1
#endif
constexpr int PPL = 7;
constexpr int NPHASE = 2 + PPL * NL;
constexpr size_t WS_WIN = 0;
constexpr size_t WS_WOUT = WS_WIN + (size_t)NL * NP * DM * 2;
constexpr size_t WS_XB = WS_WOUT + (size_t)NL * DM * DM * 2;
constexpr size_t WS_XR = WS_XB + (size_t)NTOK * DM * 2;
constexpr size_t WS_PROJ = WS_XR + (size_t)NTOK * DM * 4;
constexpr size_t WS_Y = WS_PROJ + (size_t)NTOK * NP * 2;
constexpr size_t SZ768 = (size_t)NTOK * 768 * 4;
constexpr size_t WS_GQ = WS_Y + (size_t)NTOK * DM * 2;
constexpr size_t WS_GK = WS_GQ + SZ768;
constexpr size_t WS_GV = WS_GK + SZ768;
constexpr size_t WS_GO = WS_GV + SZ768;
constexpr size_t WS_RR = WS_GO + SZ768;
constexpr size_t WS_RW = WS_RR + SZ768;
constexpr size_t WS_RK = WS_RW + SZ768;
constexpr size_t WS_RV = WS_RK + SZ768;
constexpr size_t WS_RKK = WS_RV + SZ768;
constexpr size_t WS_RB = WS_RKK + SZ768;
constexpr size_t WS_RY = WS_RB + SZ768;
constexpr size_t WS_GB = WS_RY + SZ768;
constexpr size_t WS_GG = WS_GB + (size_t)NTOK * 8 * 4;
constexpr size_t WS_LA = WS_GG + (size_t)NTOK * 8 * 4;
constexpr size_t WS_LU = WS_LA + (size_t)NTOK * 512 * 4;
constexpr size_t WS_LEND = WS_LU + (size_t)NTOK * 512 * 4;
constexpr int GCH = 768, RCH = 1536;
constexpr size_t WS_G1 = WS_LEND;
constexpr size_t WS_G2 = WS_G1 + (size_t)GCH * 64 * 128 * 2;
constexpr size_t WS_G3 = WS_G2 + (size_t)GCH * 64 * 128 * 2;
constexpr size_t WS_G4 = WS_G3 + (size_t)GCH * 64 * 64 * 2;
constexpr size_t WS_GU = WS_G4 + (size_t)GCH * 128 * 64 * 2;
constexpr size_t WS_GGL = WS_GU + (size_t)GCH * 128 * 64 * 4;
constexpr size_t WS_R1 = WS_GGL + (size_t)GCH * 128 * 4;
constexpr size_t WS_R2 = WS_R1 + (size_t)RCH * 64 * 64 * 2;
constexpr size_t WS_R3 = WS_R2 + (size_t)RCH * 64 * 64 * 2;
constexpr size_t WS_R4 = WS_R3 + (size_t)RCH * 64 * 128 * 2;
constexpr size_t WS_RU = WS_R4 + (size_t)RCH * 64 * 128 * 2;
constexpr size_t WS_RVT = WS_RU + (size_t)RCH * 64 * 64 * 4;
constexpr size_t WS_RGL = WS_RVT + (size_t)RCH * 64 * 64 * 2;
constexpr size_t WS_LH = WS_RGL + (size_t)RCH * 64 * 4;
constexpr size_t WS_LP = WS_LH + (size_t)NTOK * 512 * 4;
constexpr size_t WS_LC = WS_LP + (size_t)NTOK * 512 * 4;
constexpr size_t WS_BAR = WS_LC + (size_t)128 * 512 * 4;
constexpr size_t WS_WUPT = WS_BAR + 16384;
constexpr size_t WS_AUPT = WS_WUPT + (size_t)NL * 768 * 96 * 2;
constexpr size_t WS_WXT = WS_AUPT + (size_t)NL * 768 * 96 * 2;
constexpr size_t WS_WAT = WS_WXT + (size_t)NL * 8 * 64 * 64 * 2;
constexpr size_t WS_END = WS_WAT + (size_t)NL * 8 * 64 * 64 * 2;

struct Args {
    const float* in[26];
    float* out; unsigned char* ws;
    int ph_lo, ph_hi;
};
enum { I_X = 0, I_NORMG, I_WIN, I_WOUT, I_LCW, I_LCB, I_LWX, I_LBX, I_LWA, I_LBA, I_LLAM, I_GCW, I_GALOG, I_GDT, I_GNG,
       I_RMU, I_RW0, I_RWUP, I_RA0, I_RAUP, I_RKK, I_RKA, I_RRK, I_RGNW, I_RGNB, I_FNG };

__device__ __forceinline__ int tid_l() { int t = threadIdx.x; asm volatile("" : "+v"(t)); return t; }
#define LBAR() do { asm volatile("s_waitcnt lgkmcnt(0)" ::: "memory"); __builtin_amdgcn_s_barrier(); asm volatile("" ::: "memory"); } while (0)
__device__ __forceinline__ int bid_l() { int b = blockIdx.x; asm volatile("" : "+s"(b)); return b; }
__device__ __forceinline__ int gdim_l() { int b = gridDim.x; asm volatile("" : "+s"(b)); return b; }
__device__ __forceinline__ const float* inp(LAS unsigned char* lds, int i) {
    const LAS unsigned* t = (const LAS unsigned*)(lds + 131072) + 2 * i;
    const unsigned lo = __builtin_amdgcn_readfirstlane(t[0]), hi = __builtin_amdgcn_readfirstlane(t[1]);
    return (const float*)(const __attribute__((address_space(1))) float*)(((unsigned long long)hi << 32) | lo);
}
__device__ __forceinline__ float bf2f(bf16_t b) { return __uint_as_float(((unsigned)b) << 16); }
__device__ __forceinline__ bf16_t f2bf(float f) { unsigned u = __float_as_uint(f); u += 0x7FFFu + ((u >> 16) & 1u); return (bf16_t)(u >> 16); }
__device__ __forceinline__ unsigned pk2(float lo, float hi) { return (unsigned)f2bf(lo) | ((unsigned)f2bf(hi) << 16); }
__device__ __forceinline__ float wave_sum(float v) {
#pragma unroll
    for (int o = 1; o < 64; o <<= 1) v += __shfl_xor(v, o);
    return v;
}
typedef __bf16 bf2_t __attribute__((ext_vector_type(2)));
__device__ __forceinline__ unsigned cvtpk(float lo, float hi) { const f32x2 v = {lo, hi}; const bf2_t r = __builtin_convertvector(v, bf2_t); return __builtin_bit_cast(unsigned, r); }
__device__ __forceinline__ float sigmoidf_(float x) { return __builtin_amdgcn_rcpf(1.0f + __expf(-x)); }
__device__ __forceinline__ float siluf_(float x) { return x * __builtin_amdgcn_rcpf(1.0f + __expf(-x)); }
__device__ __forceinline__ float softplusf_(float x) { return fmaxf(x, 0.f) + __logf(1.0f + __expf(-fabsf(x))); }
__device__ __forceinline__ float tanhf_(float x) { const float e = __expf(-2.0f * fabsf(x)); return copysignf((1.0f - e) * __builtin_amdgcn_rcpf(1.0f + e), x); }

__device__ __forceinline__ void transpose_item(const float* W, int K, int N, bf16_t* WT, const float* scale, bool remap, LAS float* scr, int item, int nblk, int lane) {
    const int kb = item / nblk, nb = item % nblk, k0 = 64 * kb, n0 = 32 * nb;
    int np = n0 + (lane & 31), oc;
    if (!remap) oc = np;
    else if (np < 4096) oc = np;
    else if (np < 7360) oc = np + 12;
    else if (np < 7372) oc = np - 7360 + 4096;
    else oc = -1;
    float vbuf[32], sbuf[32];
#pragma unroll
    for (int i = 0; i < 32; ++i) { const int kk = 2 * i + (lane >> 5); vbuf[i] = (oc >= 0) ? W[(size_t)(k0 + kk) * N + oc] : 0.f; sbuf[i] = scale ? scale[k0 + kk] : 1.0f; }
#pragma unroll
    for (int i = 0; i < 32; ++i) { const int kk = 2 * i + (lane >> 5); scr[kk * 33 + (lane & 31)] = vbuf[i] * sbuf[i]; }
    __builtin_amdgcn_s_waitcnt(0xc07f); asm volatile("s_waitcnt lgkmcnt(0)" ::: "memory");
    const int c = lane & 7;
#pragma unroll
    for (int j = 0; j < 4; ++j) { const int n = (lane >> 3) + 8 * j; const LAS float* s = scr + (8 * c) * 33 + n;
        u32x4 o; o.x = pk2(s[0 * 33], s[1 * 33]); o.y = pk2(s[2 * 33], s[3 * 33]); o.z = pk2(s[4 * 33], s[5 * 33]); o.w = pk2(s[6 * 33], s[7 * 33]);
        *(u32x4*)(WT + (size_t)(n0 + n) * K + k0 + 8 * c) = o; }
    asm volatile("s_waitcnt lgkmcnt(0)" ::: "memory");
}
__device__ __forceinline__ void phase_convert(const Args& a, LAS unsigned char* lds, int l_lo, int l_hi, int f_lo, int f_hi, int vb, int nvb, int small) {
    size_t wso_ = 0; asm volatile("" : "+s"(wso_)); unsigned char* ws = a.ws + wso_;
    const int tid = tid_l(), wave = __builtin_amdgcn_readfirstlane(tid >> 6), lane = tid & 63;
    LAS float* scr = (LAS float*)(lds + wave * 8448);
    const int gw = vb * 8 + wave, NGW = nvb * 8;
    constexpr int I_IN = (DM / 64) * (NP / 32), I_OUT = (DM / 64) * (DM / 32), PER_L = I_IN + I_OUT;
    const int i_lo = (PER_L / 64) * f_lo, i_hi = (PER_L / 64) * f_hi, span = i_hi - i_lo;
    for (int it = gw; it < (l_hi - l_lo) * span; it += NGW) {
        const int l = l_lo + it / span; int r = i_lo + it % span;
        if (r < I_IN) transpose_item(inp(lds, I_WIN) + (size_t)l * DM * NIN, DM, NIN, (bf16_t*)(ws + WS_WIN) + (size_t)l * NP * DM, inp(lds, I_NORMG) + l * DM, true, scr, r, NP / 32, lane);
        else transpose_item(inp(lds, I_WOUT) + (size_t)l * DM * DM, DM, DM, (bf16_t*)(ws + WS_WOUT) + (size_t)l * DM * DM, nullptr, false, scr, r - I_IN, DM / 32, lane);
    }
    if (small) {
        const int gt = vb * 512 + tid, NT_ = nvb * 512;
        const float* wup = inp(lds, I_RWUP); const float* aup = inp(lds, I_RAUP); bf16_t* WUPT = (bf16_t*)(ws + WS_WUPT); bf16_t* AUPT = (bf16_t*)(ws + WS_AUPT);
        for (int idx = gt; idx < NL * 768 * 96; idx += NT_) { const int i = idx % 96, j = (idx / 96) % 768, l = idx / (96 * 768); const size_t src = ((size_t)l * 96 + i) * 768 + j; WUPT[idx] = f2bf(wup[src]); AUPT[idx] = f2bf(aup[src]); }
        const float* wx = inp(lds, I_LWX); const float* wa = inp(lds, I_LWA); bf16_t* WXT = (bf16_t*)(ws + WS_WXT); bf16_t* WAT = (bf16_t*)(ws + WS_WAT);
        for (int idx = gt; idx < NL * 8 * 64 * 64; idx += NT_) { const int i = idx & 63, j = (idx >> 6) & 63, ln = idx >> 12; const size_t src = ((size_t)ln * 64 + i) * 64 + j; WXT[idx] = f2bf(wx[src]); WAT[idx] = f2bf(wa[src]); }
    }
}
__device__ __forceinline__ void phase_rms(const float* xin, bf16_t* xb) {
    const int tid = tid_l(), wave = tid >> 6, lane = tid & 63;
    const int gw = bid_l() * 8 + wave, NGW = gdim_l() * 8;
    for (int m = gw; m < NTOK; m += NGW) {
        const f32x4* xr = (const f32x4*)(xin + (size_t)m * DM) + lane;
        f32x4 v[8]; float s = 0.f;
#pragma unroll
        for (int j = 0; j < 8; ++j) { v[j] = xr[64 * j]; s += (v[j].x * v[j].x + v[j].y * v[j].y) + (v[j].z * v[j].z + v[j].w * v[j].w); }
        const float rstd = __builtin_amdgcn_rsqf(wave_sum(s) * (1.0f / DM) + 1e-6f);
        u32x2* o = (u32x2*)(xb + (size_t)m * DM) + lane;
#pragma unroll
        for (int j = 0; j < 8; ++j) { u32x2 w; w.x = pk2(v[j].x * rstd, v[j].y * rstd); w.y = pk2(v[j].z * rstd, v[j].w * rstd); o[64 * j] = w; }
    }
}
__device__ __forceinline__ void phase_final(const float* xin, const float* g, float* out) {
    const int tid = tid_l(), wave = tid >> 6, lane = tid & 63;
    const int gw = bid_l() * 8 + wave, NGW = gdim_l() * 8;
    for (int m = gw; m < NTOK; m += NGW) {
        const f32x4* xr = (const f32x4*)(xin + (size_t)m * DM) + lane;
        f32x4 v[8]; float s = 0.f;
#pragma unroll
        for (int j = 0; j < 8; ++j) { v[j] = xr[64 * j]; s += (v[j].x * v[j].x + v[j].y * v[j].y) + (v[j].z * v[j].z + v[j].w * v[j].w); }
        const float rstd = __builtin_amdgcn_rsqf(wave_sum(s) * (1.0f / DM) + 1e-6f);
        f32x4* o = (f32x4*)(out + (size_t)m * DM) + lane; const f32x4* gg = (const f32x4*)g + lane;
#pragma unroll
        for (int j = 0; j < 8; ++j) o[64 * j] = v[j] * rstd * gg[64 * j];
    }
}
struct EpiDual {
    static constexpr bool PERM = true, AFTER_DRAIN = false;
    int mode; bf16_t* O; int ldo; const float* base; float* C; int ldc;
    __device__ __forceinline__ void operator()(const pg8::f32x4 (&acc)[2][2][4][2], const pg8::Unit& u, int wr, int wc, int fr, int fq) const {
        const int row0 = u.pm * 256 + wr * 64 + fr, col0 = u.pn * 256 + wc * 32 + 8 * fq;
        if (mode == 0) {
#pragma unroll
            for (int ai = 0; ai < 2; ++ai)
#pragma unroll
                for (int m = 0; m < 4; ++m) { bf16_t* rowp = O + (size_t)(row0 + ai * 128 + m * 16) * ldo + col0;
#pragma unroll
                    for (int bj = 0; bj < 2; ++bj) { const pg8::f32x4 v0 = acc[ai][bj][m][0], v1 = acc[ai][bj][m][1];
                        pg8::u32x4 w; w.x = cvtpk(v0[0], v0[1]); w.y = cvtpk(v0[2], v0[3]); w.z = cvtpk(v1[0], v1[1]); w.w = cvtpk(v1[2], v1[3]);
                        *(pg8::u32x4*)(rowp + bj * 128) = w; } }
        } else {
#pragma unroll
            for (int ai = 0; ai < 2; ++ai)
#pragma unroll
                for (int m = 0; m < 4; ++m) { const size_t off = (size_t)(row0 + ai * 128 + m * 16) * ldc + col0;
#pragma unroll
                    for (int bj = 0; bj < 2; ++bj)
#pragma unroll
                        for (int n = 0; n < 2; ++n) { const pg8::f32x4 b = *(const pg8::f32x4*)(base + off + bj * 128 + n * 4); *(pg8::f32x4*)(C + off + bj * 128 + n * 4) = acc[ai][bj][m][n] + b; }
                    asm volatile("" ::: "memory"); }
        }
    }
};
constexpr int PT = 32;
typedef short bf16x8 __attribute__((ext_vector_type(8)));
__device__ __forceinline__ float sum16(float v) { v += __shfl_xor(v, 1); v += __shfl_xor(v, 2); v += __shfl_xor(v, 4); v += __shfl_xor(v, 8); return v; }
__device__ __forceinline__ void phase_prep(const Args& a, int l, LAS unsigned char* lds) {
    size_t wso_ = 0; asm volatile("" : "+s"(wso_)); unsigned char* ws = a.ws + wso_;
    const int tid0 = tid_l(), wave = __builtin_amdgcn_readfirstlane(tid0 >> 6);
    const bf16_t* PROJ = (const bf16_t*)(ws + WS_PROJ);
    constexpr int XSR = 200, XLR = 520;
    LAS bf16_t* xsb = (LAS bf16_t*)lds;
    LAS bf16_t* xlb = (LAS bf16_t*)(lds + PT * XSR * 2);
    LAS float* xlf = (LAS float*)(lds + PT * XSR * 2 + PT * XLR * 2);
    float* GQ = (float*)(ws + WS_GQ); float* GK = (float*)(ws + WS_GK); float* GV = (float*)(ws + WS_GV);
    float* GB = (float*)(ws + WS_GB); float* GG = (float*)(ws + WS_GG);
    float* RR = (float*)(ws + WS_RR); float* RWd = (float*)(ws + WS_RW); float* RK = (float*)(ws + WS_RK); float* RV = (float*)(ws + WS_RV);
    float* RKK = (float*)(ws + WS_RKK); float* RB = (float*)(ws + WS_RB);
    float* LA = (float*)(ws + WS_LA); float* LU = (float*)(ws + WS_LU);
    const float* mu = inp(lds, I_RMU) + l * 2496;
    for (int tile = bid_l(); tile < NTOK / PT; tile += gdim_l()) {
        int tid = tid0; asm volatile("" : "+v"(tid)); const int lane = tid & 63, lr = lane & 15, lq = lane >> 4;
        const int t0 = tile * PT, sp = t0 % SEQ;
        { bf16_t curv[12], prevv[12];
#pragma unroll
            for (int q = 0; q < 12; ++q) { const int idx = tid + 512 * q, tt = idx / 192, i = idx % 192; const int col = PC_CIN + 2304 + i;
                curv[q] = PROJ[(size_t)(t0 + tt) * NP + col]; prevv[q] = PROJ[(size_t)(t0 + tt - ((sp + tt > 0) ? 1 : 0)) * NP + col]; }
#pragma unroll
            for (int q = 0; q < 12; ++q) { const int idx = tid + 512 * q, tt = idx / 192, i = idx % 192; const float cur = bf2f(curv[q]), prev = (sp + tt > 0) ? bf2f(prevv[q]) : 0.f;
                float xs = cur + (prev - cur) * mu[2304 + i]; if (i < 96) xs = tanhf_(xs); xsb[tt * XSR + i] = f2bf(xs); } }
        { const int j = tid; const float* cw = inp(lds, I_LCW) + l * 4 * LRUW; const float w0 = cw[j], w1 = cw[LRUW + j], w2 = cw[2 * LRUW + j], w3 = cw[3 * LRUW + j], cb = inp(lds, I_LCB)[l * LRUW + j];
            float xm3 = (sp >= 3) ? bf2f(PROJ[(size_t)(t0 - 3) * NP + PC_AX + j]) : 0.f, xm2 = (sp >= 2) ? bf2f(PROJ[(size_t)(t0 - 2) * NP + PC_AX + j]) : 0.f, xm1 = (sp >= 1) ? bf2f(PROJ[(size_t)(t0 - 1) * NP + PC_AX + j]) : 0.f;
            bf16_t cv[PT];
#pragma unroll
            for (int tt = 0; tt < PT; ++tt) cv[tt] = PROJ[(size_t)(t0 + tt) * NP + PC_AX + j];
#pragma unroll
            for (int tt = 0; tt < PT; ++tt) { const float cur = bf2f(cv[tt]); const float x = w0 * xm3 + w1 * xm2 + w2 * xm1 + w3 * cur + cb; xlf[tt * 512 + j] = x; xlb[tt * XLR + j] = f2bf(x); xm3 = xm2; xm2 = xm1; xm1 = cur; } }
        LBAR();
        for (int u = wave; u < 24; u += 8) { const int h = u % 12, tb = u / 12;
            bf16x8 xw[3], xa[3];
#pragma unroll
            for (int k = 0; k < 3; ++k) { xw[k] = *(const LAS bf16x8*)(xsb + (tb * 16 + lr) * XSR + 32 * k + 8 * lq); xa[k] = *(const LAS bf16x8*)(xsb + (tb * 16 + lr) * XSR + 96 + 32 * k + 8 * lq); }
            f32x4 aw[4], aa[4];
#pragma unroll
            for (int jq = 0; jq < 4; ++jq) { const int jrow = l * 768 + h * 64 + jq * 16 + lr; const bf16_t* pw = (const bf16_t*)(ws + WS_WUPT) + (size_t)jrow * 96 + 8 * lq; const bf16_t* pa = (const bf16_t*)(ws + WS_AUPT) + (size_t)jrow * 96 + 8 * lq;
                aw[jq] = (f32x4){0.f, 0.f, 0.f, 0.f}; aa[jq] = (f32x4){0.f, 0.f, 0.f, 0.f};
#pragma unroll
                for (int k = 0; k < 3; ++k) { aw[jq] = __builtin_amdgcn_mfma_f32_16x16x32_bf16(xw[k], *(const bf16x8*)(pw + 32 * k), aw[jq], 0, 0, 0); aa[jq] = __builtin_amdgcn_mfma_f32_16x16x32_bf16(xa[k], *(const bf16x8*)(pa + 32 * k), aa[jq], 0, 0, 0); } }
            const int tokb = tb * 16 + 4 * lq;
            bf16_t pr_[5][4], pk_[5][4], pv_[5][4];
#pragma unroll
            for (int rr = 0; rr < 5; ++rr) { const int trow = t0 + tokb + rr - ((rr == 0 && sp + tokb == 0) ? 0 : 1);
#pragma unroll
                for (int jq = 0; jq < 4; ++jq) { const bf16_t* p = PROJ + (size_t)trow * NP + PC_CIN + h * 64 + jq * 16 + lr; pr_[rr][jq] = p[0]; pk_[rr][jq] = p[768]; pv_[rr][jq] = p[1536]; } }
            float w0v[4], a0v[4], kkwv[4], kawv[4], murv[4], mukv[4], muvv[4];
#pragma unroll
            for (int jq = 0; jq < 4; ++jq) { const int j = h * 64 + jq * 16 + lr; w0v[jq] = inp(lds, I_RW0)[l * 768 + j]; a0v[jq] = inp(lds, I_RA0)[l * 768 + j]; kkwv[jq] = inp(lds, I_RKK)[l * 768 + j]; kawv[jq] = inp(lds, I_RKA)[l * 768 + j];
                murv[jq] = mu[j]; mukv[jq] = mu[768 + j]; muvv[jq] = mu[1536 + j]; }
#pragma unroll
            for (int r = 0; r < 4; ++r) { const bool first = (sp + tokb + r == 0);
                float kr[4], kv_[4], rv_[4], vv_[4], av_[4]; float ss = 0.f;
#pragma unroll
                for (int jq = 0; jq < 4; ++jq) { const float cr = bf2f(pr_[r + 1][jq]), ck = bf2f(pk_[r + 1][jq]), cvv = bf2f(pv_[r + 1][jq]);
                    const float qr = first ? 0.f : bf2f(pr_[r][jq]), qk = first ? 0.f : bf2f(pk_[r][jq]), qv = first ? 0.f : bf2f(pv_[r][jq]);
                    rv_[jq] = cr + (qr - cr) * murv[jq]; kv_[jq] = ck + (qk - ck) * mukv[jq]; vv_[jq] = cvv + (qv - cvv) * muvv[jq];
                    av_[jq] = sigmoidf_(a0v[jq] + aa[jq][r]); kr[jq] = kv_[jq] * kkwv[jq]; ss += kr[jq] * kr[jq]; }
                ss = sum16(ss); const float rs = __builtin_amdgcn_rsqf(ss + 1e-6f);
#pragma unroll
                for (int jq = 0; jq < 4; ++jq) { const size_t o = (size_t)(t0 + tokb + r) * 768 + h * 64 + jq * 16 + lr;
                    const float wlog = -softplusf_(-(w0v[jq] + aw[jq][r])) - 0.5f; RWd[o] = -__expf(wlog);
                    const float kk = kr[jq] * rs; RR[o] = rv_[jq]; RK[o] = kv_[jq] * (1.0f + (av_[jq] - 1.0f) * kawv[jq]); RV[o] = vv_[jq]; RKK[o] = kk; RB[o] = kk * av_[jq]; } }
        }
        for (int u = wave; u < 16; u += 8) { const int n = u & 7, tb = u >> 3;
            bf16x8 xg[2];
#pragma unroll
            for (int k = 0; k < 2; ++k) xg[k] = *(const LAS bf16x8*)(xlb + (tb * 16 + lr) * XLR + n * 64 + 32 * k + 8 * lq);
            f32x4 ax[4], ag[4];
#pragma unroll
            for (int jq = 0; jq < 4; ++jq) { const size_t jrow = (size_t)(l * 8 + n) * 64 + jq * 16 + lr; const bf16_t* px = (const bf16_t*)(ws + WS_WXT) + jrow * 64 + 8 * lq; const bf16_t* pa = (const bf16_t*)(ws + WS_WAT) + jrow * 64 + 8 * lq;
                ax[jq] = (f32x4){0.f, 0.f, 0.f, 0.f}; ag[jq] = (f32x4){0.f, 0.f, 0.f, 0.f};
#pragma unroll
                for (int k = 0; k < 2; ++k) { ax[jq] = __builtin_amdgcn_mfma_f32_16x16x32_bf16(xg[k], *(const bf16x8*)(px + 32 * k), ax[jq], 0, 0, 0); ag[jq] = __builtin_amdgcn_mfma_f32_16x16x32_bf16(xg[k], *(const bf16x8*)(pa + 32 * k), ag[jq], 0, 0, 0); } }
#pragma unroll
            for (int jq = 0; jq < 4; ++jq) { const int j = n * 64 + jq * 16 + lr; const float bx = inp(lds, I_LBX)[l * 512 + j], ba = inp(lds, I_LBA)[l * 512 + j]; const float spl = softplusf_(-inp(lds, I_LLAM)[l * 512 + j]);
#pragma unroll
                for (int r = 0; r < 4; ++r) { const int tt = tb * 16 + 4 * lq + r; const float gx = sigmoidf_(ax[jq][r] + bx), ga = sigmoidf_(ag[jq][r] + ba);
                    const float loga = -8.0f * ga * spl; const float av = __expf(loga); const float mult = __builtin_amdgcn_sqrtf(fmaxf(1.0f - __expf(2.0f * loga), 0.f));
                    LA[(size_t)(t0 + tt) * 512 + j] = av; LU[(size_t)(t0 + tt) * 512 + j] = mult * gx * xlf[tt * 512 + j]; } } }
        for (int wt = wave; wt < 18; wt += 8) { const int ch0 = 128 * wt + 2 * lane; const float* cw = inp(lds, I_GCW) + (size_t)l * 4 * 2304 + ch0;
            const f32x2 w0 = *(const f32x2*)(cw), w1 = *(const f32x2*)(cw + 2304), w2 = *(const f32x2*)(cw + 2 * 2304), w3 = *(const f32x2*)(cw + 3 * 2304);
            f32x2 xm3 = {0.f, 0.f}, xm2 = {0.f, 0.f}, xm1 = {0.f, 0.f};
            const bf16_t* pc = PROJ + PC_BQKV + ch0;
            if (sp >= 3) { const unsigned q = *(const unsigned*)(pc + (size_t)(t0 - 3) * NP); xm3.x = __uint_as_float(q << 16); xm3.y = __uint_as_float(q & 0xffff0000u); }
            if (sp >= 2) { const unsigned q = *(const unsigned*)(pc + (size_t)(t0 - 2) * NP); xm2.x = __uint_as_float(q << 16); xm2.y = __uint_as_float(q & 0xffff0000u); }
            if (sp >= 1) { const unsigned q = *(const unsigned*)(pc + (size_t)(t0 - 1) * NP); xm1.x = __uint_as_float(q << 16); xm1.y = __uint_as_float(q & 0xffff0000u); }
            float* dst = (wt < 6) ? GQ : (wt < 12 ? GK : GV); const int dch = ch0 % 768;
            unsigned qv[PT];
#pragma unroll
            for (int tt = 0; tt < PT; ++tt) qv[tt] = *(const unsigned*)(pc + (size_t)(t0 + tt) * NP);
#pragma unroll
            for (int tt = 0; tt < PT; ++tt) { const unsigned q = qv[tt]; f32x2 cur; cur.x = __uint_as_float(q << 16); cur.y = __uint_as_float(q & 0xffff0000u);
                f32x2 v = w0 * xm3 + w1 * xm2 + w2 * xm1 + w3 * cur; v.x = siluf_(v.x); v.y = siluf_(v.y);
                if (wt < 12) { const float ss = wave_sum(v.x * v.x + v.y * v.y); float sc = __builtin_amdgcn_rsqf(ss + 1e-6f); if (wt < 6) sc *= 0.08838834764831845f; v = v * sc; }
                *(f32x2*)(dst + (size_t)(t0 + tt) * 768 + dch) = v; xm3 = xm2; xm2 = xm1; xm1 = cur; } }
        if (tid < PT * 6) { const int tt = tid / 6, h = tid % 6; const float bl = bf2f(PROJ[(size_t)(t0 + tt) * NP + PC_BETA + h]), al = bf2f(PROJ[(size_t)(t0 + tt) * NP + PC_BA + h]);
            GB[(size_t)(t0 + tt) * 8 + h] = sigmoidf_(bl); GG[(size_t)(t0 + tt) * 8 + h] = -__expf(inp(lds, I_GALOG)[l * 6 + h]) * softplusf_(al + inp(lds, I_GDT)[l * 6 + h]); }
        LBAR();
    }
}
typedef short bf16x8 __attribute__((ext_vector_type(8)));
struct ScanRec { const bf16_t* M1; const bf16_t* M2; const bf16_t* M3; const bf16_t* M4T; const float* UT; const float* G; const bf16_t* VT; };
template <int D, int KZ, bool EXT>
__device__ __forceinline__ void scan_item(const ScanRec R0, int e0, float* OUT, int out_ld, LAS unsigned char* lds) {
    constexpr int NK1 = D / 32, NK2 = KZ / 32, NT3 = D / 64, SROW = D + 8, ZROW = KZ + 8, HD = EXT ? 64 : 128;
    constexpr bool GS = !EXT;
    const int tid = tid_l(), w = __builtin_amdgcn_readfirstlane(tid >> 6), lane = tid & 63, lr = lane & 15, lq = lane >> 4;
    const bool front = (w < 4); const int cb = w & 3;
    LAS bf16_t* ST = (LAS bf16_t*)lds;
    LAS bf16_t* ZT = (LAS bf16_t*)(lds + 2 * 32 * SROW * 2);
    constexpr int OSROW = 36;
    LAS float* OS = (LAS float*)(lds + 2 * 32 * SROW * 2 + 32 * ZROW * 2);
    for (int i = tid; i < 2 * 32 * SROW / 2; i += 512) ((LAS unsigned*)ST)[i] = 0u;
    struct FS { bf16x8 m1[NK1], m3[NK2]; f32x4 ut[2]; u32x4 vt; };
    struct BS { bf16x8 m4[NT3][NK2]; f32x4 g[GS ? 1 : NT3]; float gs; };
#define SCAN_LOADF(s, n) do { \
        const bf16_t* a1_ = R0.M1 + (size_t)(n) * 64 * D + (cb * 16 + lr) * D + 8 * lq; \
        _Pragma("unroll") for (int k = 0; k < NK1; ++k) s.m1[k] = *(const bf16x8*)(a1_ + 32 * k); \
        const bf16_t* a3_ = R0.M3 + (size_t)(n) * 64 * KZ + (cb * 16 + lr) * KZ + 8 * lq; \
        _Pragma("unroll") for (int k = 0; k < NK2; ++k) s.m3[k] = *(const bf16x8*)(a3_ + 32 * k); \
        _Pragma("unroll") for (int j = 0; j < 2; ++j) s.ut[j] = *(const f32x4*)(R0.UT + (size_t)(n) * HD * 64 + (size_t)(e0 + j * 16 + lr) * 64 + cb * 16 + 4 * lq); \
        if (EXT) s.vt = *(const u32x4*)(R0.VT + (size_t)(n) * 64 * 64 + (size_t)(e0 + (tid >> 3)) * 64 + (tid & 7) * 8); } while (0)
#define SCAN_LOADB(s, n) do { \
        _Pragma("unroll") for (int t = 0; t < NT3; ++t) { const int db = cb + 4 * t; const bf16_t* a4_ = R0.M4T + (size_t)(n) * D * KZ + (db * 16 + lr) * KZ + 8 * lq; \
            _Pragma("unroll") for (int k = 0; k < NK2; ++k) s.m4[t][k] = *(const bf16x8*)(a4_ + 32 * k); \
            if (!GS) s.g[t] = *(const f32x4*)(R0.G + (size_t)(n) * D + db * 16 + 4 * lq); } \
        if (GS) s.gs = R0.G[(size_t)(n) * D]; } while (0)
#define SCAN_OUT(n) do { const f32x4 ov = *(const LAS f32x4*)(OS + (tid >> 3) * OSROW + (tid & 7) * 4); *(f32x4*)(OUT + (size_t)((n) * 64 + (tid >> 3)) * out_ld + e0 + (tid & 7) * 4) = ov; } while (0)
#define SCAN_STEP_F(n, par, fc, fl) do { \
        LAS bf16_t* STo = ST + (par) * 32 * SROW; \
        bf16x8 m2l[NK1]; \
        { const bf16_t* a2_ = R0.M2 + (size_t)(n) * 64 * D + (cb * 16 + lr) * D + 8 * lq; _Pragma("unroll") for (int k = 0; k < NK1; ++k) m2l[k] = *(const bf16x8*)(a2_ + 32 * k); }     \
        if ((n) + 2 < 32) SCAN_LOADF(fl, (n) + 2); \
        _Pragma("unroll") for (int j = 0; j < 2; ++j) { f32x4 a1 = fc.ut[j]; \
            _Pragma("unroll") for (int k = 0; k < NK1; ++k) { const bf16x8 y = *(const LAS bf16x8*)(STo + (j * 16 + lr) * SROW + 32 * k + 8 * lq); a1 = __builtin_amdgcn_mfma_f32_16x16x32_bf16(fc.m1[k], y, a1, 0, 0, 0); } \
            u32x2 zz; zz.x = cvtpk(a1[0], a1[1]); zz.y = cvtpk(a1[2], a1[3]); *(LAS u32x2*)(ZT + (j * 16 + lr) * ZROW + cb * 16 + 4 * lq) = zz; } \
        if (EXT) *(LAS u32x4*)(ZT + (tid >> 3) * ZROW + 64 + (tid & 7) * 8) = fc.vt; \
        LBAR(); \
        _Pragma("unroll") for (int j = 0; j < 2; ++j) { f32x4 a2 = (f32x4){0.f, 0.f, 0.f, 0.f}; \
            _Pragma("unroll") for (int k = 0; k < NK2; ++k) { const bf16x8 z = *(const LAS bf16x8*)(ZT + (j * 16 + lr) * ZROW + 32 * k + 8 * lq); a2 = __builtin_amdgcn_mfma_f32_16x16x32_bf16(fc.m3[k], z, a2, 0, 0, 0); } \
            _Pragma("unroll") for (int k = 0; k < NK1; ++k) { const bf16x8 y = *(const LAS bf16x8*)(STo + (j * 16 + lr) * SROW + 32 * k + 8 * lq); a2 = __builtin_amdgcn_mfma_f32_16x16x32_bf16(m2l[k], y, a2, 0, 0, 0); } \
            _Pragma("unroll") for (int r = 0; r < 4; ++r) OS[(cb * 16 + 4 * lq + r) * OSROW + j * 16 + lr] = a2[r]; } \
        LBAR(); \
        SCAN_OUT(n); } while (0)
#define SCAN_STEP_B(n, par, bc, bl) do { \
        LAS bf16_t* STn = ST + (1 - (par)) * 32 * SROW; \
        if ((n) + 2 < 32) SCAN_LOADB(bl, (n) + 2); \
        LBAR(); \
        _Pragma("unroll") for (int j = 0; j < 2; ++j) { \
            _Pragma("unroll") for (int t = 0; t < NT3; ++t) { if (GS) accs[t][j] = accs[t][j] * bc.gs; else accs[t][j] = accs[t][j] * bc.g[GS ? 0 : t]; } \
            _Pragma("unroll") for (int k = 0; k < NK2; ++k) { const bf16x8 z = *(const LAS bf16x8*)(ZT + (j * 16 + lr) * ZROW + 32 * k + 8 * lq); \
                _Pragma("unroll") for (int t = 0; t < NT3; ++t) accs[t][j] = __builtin_amdgcn_mfma_f32_16x16x32_bf16(bc.m4[t][k], z, accs[t][j], 0, 0, 0); } \
            _Pragma("unroll") for (int t = 0; t < NT3; ++t) { const int db = cb + 4 * t; u32x2 ss; ss.x = cvtpk(accs[t][j][0], accs[t][j][1]); ss.y = cvtpk(accs[t][j][2], accs[t][j][3]); *(LAS u32x2*)(STn + (j * 16 + lr) * SROW + db * 16 + 4 * lq) = ss; } } \
        LBAR(); \
        SCAN_OUT(n); } while (0)
    if (front) {
        FS f0, f1, f2;
        SCAN_LOADF(f0, 0); SCAN_LOADF(f1, 1);
        __builtin_amdgcn_s_waitcnt(0x0F70);
        LBAR();
        for (int n0 = 0; n0 < 30; n0 += 6) {
            SCAN_STEP_F(n0, 0, f0, f2); SCAN_STEP_F(n0 + 1, 1, f1, f0); SCAN_STEP_F(n0 + 2, 0, f2, f1);
            SCAN_STEP_F(n0 + 3, 1, f0, f2); SCAN_STEP_F(n0 + 4, 0, f1, f0); SCAN_STEP_F(n0 + 5, 1, f2, f1);
        }
        SCAN_STEP_F(30, 0, f0, f2); SCAN_STEP_F(31, 1, f1, f0);
    } else {
        BS b0, b1, b2;
        f32x4 accs[NT3][2];
#pragma unroll
        for (int t = 0; t < NT3; ++t) { accs[t][0] = (f32x4){0.f, 0.f, 0.f, 0.f}; accs[t][1] = (f32x4){0.f, 0.f, 0.f, 0.f}; }
        SCAN_LOADB(b0, 0); SCAN_LOADB(b1, 1);
        __builtin_amdgcn_s_waitcnt(0x0F70);
        LBAR();
        for (int n0 = 0; n0 < 30; n0 += 6) {
            SCAN_STEP_B(n0, 0, b0, b2); SCAN_STEP_B(n0 + 1, 1, b1, b0); SCAN_STEP_B(n0 + 2, 0, b2, b1);
            SCAN_STEP_B(n0 + 3, 1, b0, b2); SCAN_STEP_B(n0 + 4, 0, b1, b0); SCAN_STEP_B(n0 + 5, 1, b2, b1);
        }
        SCAN_STEP_B(30, 0, b0, b2); SCAN_STEP_B(31, 1, b1, b0);
    }
#undef SCAN_STEP_F
#undef SCAN_STEP_B
#undef SCAN_OUT
#undef SCAN_LOADF
#undef SCAN_LOADB
}

__device__ __forceinline__ void phase_gdn_chunk(const Args& a, int l, LAS unsigned char* lds) {
    size_t wso_ = 0; asm volatile("" : "+s"(wso_)); unsigned char* ws = a.ws + wso_;
    const int tid0 = tid_l(), w = __builtin_amdgcn_readfirstlane(tid0 >> 6);
    const float* GQ = (const float*)(ws + WS_GQ); const float* GK = (const float*)(ws + WS_GK); const float* GV = (const float*)(ws + WS_GV);
    const float* GB = (const float*)(ws + WS_GB); const float* GG = (const float*)(ws + WS_GG);
    constexpr int KROW = 136;
    LAS bf16_t* Kb = (LAS bf16_t*)lds;
    LAS bf16_t* Qb = (LAS bf16_t*)(lds + 64 * KROW * 2);
    LAS float* Af = (LAS float*)(lds + 2 * 64 * KROW * 2);
    LAS float* dvb = Af + 64 * 64;
    const int first = bid_l(), gstep = gdim_l();
    const int nmine = (first < GCH) ? (GCH - first + gstep - 1) / gstep : 0;
    for (int k = -1; k < nmine; ++k) {
        int tid = tid0; asm volatile("" : "+v"(tid)); const int lane = tid & 63, lr = lane & 15, lq = lane >> 4;
        LBAR();
        if (w < 4) {
            const bool act = (k >= 0); const int item = first + (act ? k : 0) * gstep;
            const int b = item / 192, h = (item / 32) % 6, n = item % 32; const size_t t0 = (size_t)b * SEQ + n * 64;
            LAS float* dv = dvb + (k & 1) * 128; LAS float* bv = dv + 64;
            const int col = tid; const bool isu = (w < 2); const int cc = col & 127;
            float X[64]; int Arow[63];
            if (act) {
                const float* src = (isu ? GV : GK) + t0 * 768 + h * 128 + cc;
#pragma unroll
                for (int c = 0; c < 64; ++c) X[c] = src[(size_t)c * 768];
#pragma unroll
                for (int m = 0; m < 63; ++m) Arow[m] = __float_as_int(Af[m * 64 + lane]);
                if (isu) {
#pragma unroll
                    for (int c = 0; c < 64; ++c) X[c] *= bv[c]; }
                else {
#pragma unroll
                    for (int c = 0; c < 64; ++c) X[c] *= bv[c] * __expf(dv[c]); }
            }
            LBAR();
            if (act) {
#pragma unroll
                for (int m = 0; m < 63; ++m) { const float xm = X[m];
#pragma unroll
                    for (int c = m + 1; c < 64; ++c) X[c] -= __int_as_float(__builtin_amdgcn_readlane(Arow[m], c)) * xm; }
            }
            LBAR();
            if (act) {
                if (isu) { float* UT = (float*)(ws + WS_GU) + (size_t)item * 128 * 64 + (size_t)cc * 64;
#pragma unroll
                    for (int c4 = 0; c4 < 16; ++c4) *(f32x4*)(UT + 4 * c4) = (f32x4){X[4 * c4], X[4 * c4 + 1], X[4 * c4 + 2], X[4 * c4 + 3]}; }
                else { bf16_t* M1 = (bf16_t*)(ws + WS_G1) + (size_t)item * 64 * 128 + cc;
#pragma unroll
                    for (int c = 0; c < 64; ++c) M1[c * 128] = f2bf(-X[c]); }
            }
        } else {
            const bool act = (k + 1 < nmine); const int item = first + (act ? (k + 1) : 0) * gstep;
            const int b = item / 192, h = (item / 32) % 6, n = item % 32; const size_t t0 = (size_t)b * SEQ + n * 64;
            LAS float* dv = dvb + ((k + 1) & 1) * 128; LAS float* bv = dv + 64;
            const int t = tid - 256, wb = w - 4;
            if (act) {
                float gpre = 0.f, bpre = 0.f; if (wb == 0) { gpre = GG[(t0 + lane) * 8 + h]; bpre = GB[(t0 + lane) * 8 + h]; }
#pragma unroll
                for (int hf = 0; hf < 2; ++hf) { f32x4 kv4[4], qv4[4];
#pragma unroll
                    for (int q = 0; q < 4; ++q) { const int idx = t + 256 * (4 * hf + q), c = idx >> 5, d4 = idx & 31; const size_t g = (t0 + c) * 768 + h * 128 + d4 * 4; kv4[q] = *(const f32x4*)(GK + g); qv4[q] = *(const f32x4*)(GQ + g); }
#pragma unroll
                    for (int q = 0; q < 4; ++q) { const int idx = t + 256 * (4 * hf + q), c = idx >> 5, d4 = idx & 31; const f32x4 kv = kv4[q], qv = qv4[q];
                        u32x2 pk; pk.x = cvtpk(kv[0], kv[1]); pk.y = cvtpk(kv[2], kv[3]); *(LAS u32x2*)(Kb + c * KROW + d4 * 4) = pk;
                        u32x2 pq; pq.x = cvtpk(qv[0], qv[1]); pq.y = cvtpk(qv[2], qv[3]); *(LAS u32x2*)(Qb + c * KROW + d4 * 4) = pq; } }
                if (wb == 0) { float g = gpre;
#pragma unroll
                    for (int o = 1; o < 64; o <<= 1) { const float tt = __shfl_up(g, o); if (lane >= o) g += tt; }
                    dv[lane] = g; bv[lane] = bpre; }
            }
            LBAR();
            if (act) {
                const int which = wb >> 1; const LAS bf16_t* X = which ? Qb : Kb;
                bf16_t* M3 = (bf16_t*)(ws + WS_G3) + (size_t)item * 64 * 64;
#pragma unroll
                for (int ci = 0; ci < 2; ++ci) { const int cb = 2 * (wb & 1) + ci;
                    bf16x8 xf[4];
#pragma unroll
                    for (int kk = 0; kk < 4; ++kk) xf[kk] = *(const LAS bf16x8*)(X + (cb * 16 + lr) * KROW + 32 * kk + 8 * lq);
#pragma unroll
                    for (int mb = 0; mb < 4; ++mb) { f32x4 acc = (f32x4){0.f, 0.f, 0.f, 0.f};
#pragma unroll
                        for (int kk = 0; kk < 4; ++kk) { const bf16x8 yf = *(const LAS bf16x8*)(Kb + (mb * 16 + lr) * KROW + 32 * kk + 8 * lq); acc = __builtin_amdgcn_mfma_f32_16x16x32_bf16(xf[kk], yf, acc, 0, 0, 0); }
                        const int m = mb * 16 + lr; const float dm = dv[m];
                        if (which == 0) { f32x4 o;
#pragma unroll
                            for (int r = 0; r < 4; ++r) { const int c = cb * 16 + 4 * lq + r; o[r] = (c > m) ? bv[c] * acc[r] * __expf(dv[c] - dm) : 0.f; }
                            *(LAS f32x4*)(Af + m * 64 + cb * 16 + 4 * lq) = o; }
                        else {
#pragma unroll
                            for (int r = 0; r < 4; ++r) { const int c = cb * 16 + 4 * lq + r; M3[c * 64 + m] = f2bf((c >= m) ? acc[r] * __expf(dv[c] - dm) : 0.f); } } } }
            }
            LBAR();
            if (act) {
                const float dl = dv[63];
                bf16_t* M2 = (bf16_t*)(ws + WS_G2) + (size_t)item * 64 * 128;
#pragma unroll
                for (int q = 0; q < 8; ++q) { const int idx = t + 256 * q, c = idx >> 5, d4 = idx & 31; const u32x2 qq = *(const LAS u32x2*)(Qb + c * KROW + d4 * 4); const float e = __expf(dv[c]);
                    u32x2 p; p.x = cvtpk(__uint_as_float(qq.x << 16) * e, __uint_as_float(qq.x & 0xffff0000u) * e); p.y = cvtpk(__uint_as_float(qq.y << 16) * e, __uint_as_float(qq.y & 0xffff0000u) * e); *(u32x2*)(M2 + c * 128 + d4 * 4) = p; }
                { const int d = t & 127, ch = t >> 7; bf16_t* M4 = (bf16_t*)(ws + WS_G4) + (size_t)item * 128 * 64 + d * 64 + ch * 32;
#pragma unroll
                    for (int q = 0; q < 4; ++q) { float kv[8];
#pragma unroll
                        for (int j = 0; j < 8; ++j) { const int c = ch * 32 + q * 8 + j; kv[j] = bf2f(Kb[c * KROW + d]) * __expf(dl - dv[c]); }
                        u32x4 p; p.x = cvtpk(kv[0], kv[1]); p.y = cvtpk(kv[2], kv[3]); p.z = cvtpk(kv[4], kv[5]); p.w = cvtpk(kv[6], kv[7]); *(u32x4*)(M4 + q * 8) = p; } }
                if (t < 128) ((float*)(ws + WS_GGL))[(size_t)item * 128 + t] = __expf(dl);
            }
        }
    }
    LBAR();
}

__device__ __forceinline__ void phase_rwkv_chunk(const Args& a, int l, LAS unsigned char* lds) {
    size_t wso_ = 0; asm volatile("" : "+s"(wso_)); unsigned char* ws = a.ws + wso_;
    const int tid0 = tid_l(), w = __builtin_amdgcn_readfirstlane(tid0 >> 6);
    const float* RR = (const float*)(ws + WS_RR); const float* RWl = (const float*)(ws + WS_RW); const float* RK = (const float*)(ws + WS_RK); const float* RV = (const float*)(ws + WS_RV);
    const float* RKK = (const float*)(ws + WS_RKK); const float* RB = (const float*)(ws + WS_RB);
    constexpr int OR_ = 72;
    LAS float* cw = (LAS float*)lds;
    LAS bf16_t* M3s = (LAS bf16_t*)lds;
    LAS bf16_t* Al = (LAS bf16_t*)(lds + 16384); LAS bf16_t* Be = Al + 64 * OR_; LAS bf16_t* Ka = Be + 64 * OR_; LAS bf16_t* Rh = Ka + 64 * OR_;
    LAS float* ABf = (LAS float*)(lds + 53248);
    LAS bf16_t* AKb = (LAS bf16_t*)(lds + 69632);
    LAS bf16_t* VTb = (LAS bf16_t*)(lds + 78848);
    LAS float* RH2 = (LAS float*)(lds + 88064);
    LAS bf16_t* M4s = (LAS bf16_t*)(lds + 104448);
    LAS float* segt = (LAS float*)(lds + 121856);
    const int first = bid_l(), gstep = gdim_l();
    const int nmine = (first < RCH) ? (RCH - first + gstep - 1) / gstep : 0;
    if (w < 2) {
    for (int k = -1; k < nmine; ++k) {
        int tid = tid0; asm volatile("" : "+v"(tid)); const int lane = tid & 63, lr = lane & 15, lq = lane >> 4;
            const bool act = (k >= 0); const int item = first + (act ? k : 0) * gstep;
            const bool isom = (w == 0); const int cc = tid & 63;
            float X[64]; int Arow[63];
            if (act) {
                if (isom) {
#pragma unroll
                    for (int c = 0; c < 64; ++c) X[c] = bf2f(Al[c * OR_ + cc]); }
                else {
#pragma unroll
                    for (int c = 0; c < 64; ++c) X[c] = RH2[c * 64 + cc]; }
#pragma unroll
                for (int m = 0; m < 63; ++m) Arow[m] = __float_as_int(ABf[m * 64 + lane]);
            }
            LBAR();
#define RW_SOLVE(m0, m1) do { if (act) { _Pragma("unroll") for (int m = (m0); m < (m1); ++m) { const float xm = X[m]; \
                _Pragma("unroll") for (int c = m + 1; c < 64; ++c) X[c] -= __int_as_float(__builtin_amdgcn_readlane(Arow[m], c)) * xm; } } } while (0)
            RW_SOLVE(0, 30);
            LBAR();
            RW_SOLVE(30, 63);
            LBAR();
#undef RW_SOLVE
            if (act) {
                if (isom) { bf16_t* M1 = (bf16_t*)(ws + WS_R1) + (size_t)item * 4096 + cc;
#pragma unroll
                    for (int c = 0; c < 64; ++c) M1[c * 64] = f2bf(X[c]); }
                else { float* UT = (float*)(ws + WS_RU) + (size_t)item * 4096 + (size_t)cc * 64;
#pragma unroll
                    for (int c4 = 0; c4 < 16; ++c4) *(f32x4*)(UT + 4 * c4) = (f32x4){X[4 * c4], X[4 * c4 + 1], X[4 * c4 + 2], X[4 * c4 + 3]}; }
            }
            LBAR();
    }
    } else {
    float plw[16], pv[11], pkk[12], pbb[12], pk2[12], pr[12];
#define RWB_ISSUE(it) do { const int b_ = (it) / 384, h_ = ((it) / 32) % 12, n_ = (it) % 32; const size_t gb_ = ((size_t)b_ * SEQ + n_ * 64) * 768 + h_ * 64; const int t_ = tidp - 128, wb_ = w - 2; \
        if (wb_ < 4) { _Pragma("unroll") for (int q = 0; q < 16; ++q) plw[q] = RWl[gb_ + (size_t)(wb_ * 16 + q) * 768 + (tidp & 63)]; } \
        _Pragma("unroll") for (int q = 0; q < 11; ++q) { const int idx = t_ + 384 * q; const int c = (idx >> 6) & 63, i = idx & 63; pv[q] = RV[gb_ + (size_t)c * 768 + i]; } \
        _Pragma("unroll") for (int q = 0; q < 12; ++q) { const int idx = t_ + 384 * q; const int c = (idx >> 6) & 63, j = idx & 63; const size_t g = gb_ + (size_t)c * 768 + j; pkk[q] = RKK[g]; pbb[q] = RB[g]; pk2[q] = RK[g]; pr[q] = RR[g]; } } while (0)
    if (nmine > 0) { int tidp = tid0; asm volatile("" : "+v"(tidp)); RWB_ISSUE(first); }
    for (int k = -1; k < nmine; ++k) {
        int tid = tid0; asm volatile("" : "+v"(tid)); const int lane = tid & 63, lr = lane & 15, lq = lane >> 4;
            const bool act = (k + 1 < nmine); const int item = first + (act ? (k + 1) : 0) * gstep;
            const int b = item / 384, h = (item / 32) % 12, n = item % 32; const size_t gb = ((size_t)b * SEQ + n * 64) * 768 + h * 64;
            const int t = tid - 128, wb = w - 2;
            if (act) {
                if (wb < 4) {
                    float acc = 0.f;
#pragma unroll
                    for (int q = 0; q < 8; ++q) { acc += plw[q]; cw[(wb * 16 + q) * 64 + lane] = acc; }
                    segt[(2 * wb) * 64 + lane] = acc; acc = 0.f;
#pragma unroll
                    for (int q = 8; q < 16; ++q) { acc += plw[q]; cw[(wb * 16 + q) * 64 + lane] = acc; }
                    segt[(2 * wb + 1) * 64 + lane] = acc; }
#pragma unroll
                for (int q = 0; q < 11; ++q) { const int idx = t + 384 * q; const int c = idx >> 6, i = idx & 63; if (idx < 4096) VTb[i * OR_ + c] = f2bf(pv[q]); }
            }
            LBAR();
            if (act) {
#pragma unroll
                for (int hf = 0; hf < 2; ++hf) {
#pragma unroll
                    for (int q = 0; q < 6; ++q) { const int idx = t + 384 * (6 * hf + q); const int c = idx >> 6, j = idx & 63;
                        if (idx < 4096) {
                            float off = 0.f, offm = 0.f, tot = 0.f;
#pragma unroll
                            for (int s2 = 0; s2 < 8; ++s2) { const float st = segt[s2 * 64 + j]; if (s2 < (c >> 3)) off += st; if (c > 0 && s2 < ((c - 1) >> 3)) offm += st; tot += st; }
                            const float cwc = cw[c * 64 + j] + off, cwm = c ? cw[(c - 1) * 64 + j] + offm : 0.f, cwl = tot;
                            const float kk = pkk[6 * hf + q], bb = pbb[6 * hf + q], k2 = pk2[6 * hf + q], r = pr[6 * hf + q];
                            const float en = __expf(-cwc);
                            Al[c * OR_ + j] = f2bf(kk * __expf(cwm)); Be[c * OR_ + j] = f2bf(bb * en); Ka[c * OR_ + j] = f2bf(k2 * en); const bf16_t rh = f2bf(r * __expf(cwc)); Rh[c * OR_ + j] = rh;
                            ((bf16_t*)(ws + WS_R2))[(size_t)item * 4096 + c * 64 + j] = rh;
                            const float ed = __expf(cwl - cwc); M4s[j * 136 + c] = f2bf(-bb * ed); M4s[j * 136 + 64 + c] = f2bf(k2 * ed);
                            if (c == 63) ((float*)(ws + WS_RGL))[(size_t)item * 64 + j] = __expf(cwl); } } }
                if (k + 2 < nmine) { const int tidp = tid; RWB_ISSUE(first + (k + 2) * gstep); }
            }
            LBAR();
            if (act) {
                for (int pc = wb; pc < 16; pc += 6) { const int p = pc >> 2, cb = pc & 3; const LAS bf16_t* X = (p < 2) ? Al : Rh; const LAS bf16_t* Y = (p & 1) ? Ka : Be;
                    const bf16x8 x0 = *(const LAS bf16x8*)(X + (cb * 16 + lr) * OR_ + 8 * lq), x1 = *(const LAS bf16x8*)(X + (cb * 16 + lr) * OR_ + 32 + 8 * lq);
#pragma unroll
                    for (int mb = 0; mb < 4; ++mb) { f32x4 acc = (f32x4){0.f, 0.f, 0.f, 0.f};
                        acc = __builtin_amdgcn_mfma_f32_16x16x32_bf16(x0, *(const LAS bf16x8*)(Y + (mb * 16 + lr) * OR_ + 8 * lq), acc, 0, 0, 0);
                        acc = __builtin_amdgcn_mfma_f32_16x16x32_bf16(x1, *(const LAS bf16x8*)(Y + (mb * 16 + lr) * OR_ + 32 + 8 * lq), acc, 0, 0, 0);
                        const int m = mb * 16 + lr;
                        if (p == 0) { f32x4 o;
#pragma unroll
                            for (int r = 0; r < 4; ++r) { const int c = cb * 16 + 4 * lq + r; o[r] = (c > m) ? acc[r] : 0.f; }
                            *(LAS f32x4*)(ABf + m * 64 + cb * 16 + 4 * lq) = o; }
                        else {
#pragma unroll
                            for (int r = 0; r < 4; ++r) { const int c = cb * 16 + 4 * lq + r;
                                if (p == 1) AKb[c * OR_ + m] = f2bf((c > m) ? acc[r] : 0.f);
                                else if (p == 2) M3s[c * 128 + m] = f2bf((c >= m) ? -acc[r] : 0.f);
                                else M3s[c * 128 + 64 + m] = f2bf((c >= m) ? acc[r] : 0.f); } } } }
            }
            LBAR();
            if (act) {
                for (int tl = wb; tl < 16; tl += 6) { const int cb = tl >> 2, ib = tl & 3;
                    const bf16x8 x0 = *(const LAS bf16x8*)(AKb + (cb * 16 + lr) * OR_ + 8 * lq), x1 = *(const LAS bf16x8*)(AKb + (cb * 16 + lr) * OR_ + 32 + 8 * lq);
                    f32x4 acc = (f32x4){0.f, 0.f, 0.f, 0.f};
                    acc = __builtin_amdgcn_mfma_f32_16x16x32_bf16(x0, *(const LAS bf16x8*)(VTb + (ib * 16 + lr) * OR_ + 8 * lq), acc, 0, 0, 0);
                    acc = __builtin_amdgcn_mfma_f32_16x16x32_bf16(x1, *(const LAS bf16x8*)(VTb + (ib * 16 + lr) * OR_ + 32 + 8 * lq), acc, 0, 0, 0);
#pragma unroll
                    for (int r = 0; r < 4; ++r) RH2[(cb * 16 + 4 * lq + r) * 64 + ib * 16 + lr] = acc[r]; }
                u32x4* g3 = (u32x4*)((bf16_t*)(ws + WS_R3) + (size_t)item * 64 * 128);
                for (int q = t; q < 1024; q += 384) g3[q] = *(const LAS u32x4*)(M3s + q * 8);
                u32x4* g4 = (u32x4*)((bf16_t*)(ws + WS_R4) + (size_t)item * 64 * 128);
                for (int q = t; q < 1024; q += 384) g4[q] = *(const LAS u32x4*)(M4s + (q >> 4) * 136 + (q & 15) * 8);
                u32x4* gv = (u32x4*)((bf16_t*)(ws + WS_RVT) + (size_t)item * 64 * 64);
                for (int q = t; q < 512; q += 384) gv[q] = *(const LAS u32x4*)(VTb + (q >> 3) * OR_ + (q & 7) * 8);
            }
            LBAR();
    }
    }
    LBAR();
#undef RWB_ISSUE
}

__device__ __forceinline__ void phase_lru_chunk(const Args& a) {
    size_t wso_ = 0; asm volatile("" : "+s"(wso_)); unsigned char* ws = a.ws + wso_;
    const int tid = tid_l();
    const float* LA = (const float*)(ws + WS_LA); const float* LU = (const float*)(ws + WS_LU); float* LH = (float*)(ws + WS_LH); float* LP = (float*)(ws + WS_LP);
    for (int p = bid_l() * 512 + tid; p < 128 * 512; p += gdim_l() * 512) { const int chunk = p >> 9, c = p & 511; const size_t base = (size_t)chunk * 64 * 512 + c;
        float h = 0.f, cp = 1.f;
        for (int i0 = 0; i0 < 64; i0 += 16) { float av[16], uv[16];
#pragma unroll
            for (int i = 0; i < 16; ++i) { av[i] = LA[base + (size_t)(i0 + i) * 512]; uv[i] = LU[base + (size_t)(i0 + i) * 512]; }
#pragma unroll
            for (int i = 0; i < 16; ++i) { h = av[i] * h + uv[i]; cp *= av[i]; LH[base + (size_t)(i0 + i) * 512] = h; LP[base + (size_t)(i0 + i) * 512] = cp; } } }
}
constexpr int SB = 16;
__device__ __forceinline__ void phase_scan_naive(const Args& a, int l, LAS unsigned char* lds) {
    size_t wso_ = 0; asm volatile("" : "+s"(wso_)); unsigned char* ws = a.ws + wso_;
    const int tid = tid_l(), wave = __builtin_amdgcn_readfirstlane(tid >> 6), lane = tid & 63;
    const int blk = bid_l();
    if (blk < 96) {
        const int xq = blk >> 3, bh = (blk & 7) * 3 + (xq >> 2), es = xq & 3, b = bh / 6, h = bh % 6; const size_t ci = (size_t)bh * 32;
        ScanRec R{(const bf16_t*)(ws + WS_G1) + ci * 64 * 128, (const bf16_t*)(ws + WS_G2) + ci * 64 * 128, (const bf16_t*)(ws + WS_G3) + ci * 64 * 64, (const bf16_t*)(ws + WS_G4) + ci * 128 * 64,
                  (const float*)(ws + WS_GU) + ci * 128 * 64, (const float*)(ws + WS_GGL) + ci * 128, nullptr};
        scan_item<128, 64, false>(R, es * 32, (float*)(ws + WS_GO) + (size_t)b * SEQ * 768 + h * 128, 768, lds);
    } else if (blk < 192) {
        const int it = blk - 96, xq = it >> 3, bh = (it & 7) * 6 + (xq >> 1), es = xq & 1, b = bh / 12, h = bh % 12; const size_t ci = (size_t)bh * 32;
        ScanRec R{(const bf16_t*)(ws + WS_R1) + ci * 4096, (const bf16_t*)(ws + WS_R2) + ci * 4096, (const bf16_t*)(ws + WS_R3) + ci * 8192, (const bf16_t*)(ws + WS_R4) + ci * 8192,
                  (const float*)(ws + WS_RU) + ci * 4096, (const float*)(ws + WS_RGL) + ci * 64, (const bf16_t*)(ws + WS_RVT) + ci * 4096};
        scan_item<64, 128, true>(R, es * 32, (float*)(ws + WS_RY) + (size_t)b * SEQ * 768 + h * 64, 768, lds);
    } else if (blk < 196) {
        const int gidx = (blk - 192) * 512 + tid, b = gidx >> 9, c = gidx & 511;
        const float* LH = (const float*)(ws + WS_LH); const float* LP = (const float*)(ws + WS_LP); float* LC = (float*)(ws + WS_LC);
        float pe[32], he[32];
#pragma unroll
        for (int n = 0; n < 32; ++n) { const size_t o = ((size_t)b * SEQ + n * 64 + 63) * 512 + c; pe[n] = LP[o]; he[n] = LH[o]; }
        float carry = 0.f;
#pragma unroll
        for (int n = 0; n < 32; ++n) { LC[(size_t)(b * 32 + n) * 512 + c] = carry; carry = pe[n] * carry + he[n]; }
    } else if (l + 1 < NL && CONV_SPLIT > 0) {
        phase_convert(a, lds, l + 1, l + 2, 0, CONV_SPLIT, blk - 196, gdim_l() - 196, 0);
    }
}
__device__ __forceinline__ void phase_fin(const Args& a, int l, LAS unsigned char* lds) {
    size_t wso_ = 0; asm volatile("" : "+s"(wso_)); unsigned char* ws = a.ws + wso_;
    const int tid = tid_l(), wave = tid >> 6, lane = tid & 63;
    const int gw = bid_l() * 8 + wave, NGW = gdim_l() * 8;
    const bf16_t* PROJ = (const bf16_t*)(ws + WS_PROJ); bf16_t* Y = (bf16_t*)(ws + WS_Y);
    const float* GO = (const float*)(ws + WS_GO); const float* RY = (const float*)(ws + WS_RY);
    const float* RR = (const float*)(ws + WS_RR); const float* RK = (const float*)(ws + WS_RK); const float* RV = (const float*)(ws + WS_RV);
    const float* LH = (const float*)(ws + WS_LH); const float* LP = (const float*)(ws + WS_LP); const float* LC = (const float*)(ws + WS_LC);
    const f32x2 ng = *(const f32x2*)(inp(lds, I_GNG) + l * 128 + 2 * lane);
    float gnw[12], gnb[12], rkw[12];
#pragma unroll
    for (int h = 0; h < 12; ++h) { gnw[h] = inp(lds, I_RGNW)[l * 768 + h * 64 + lane]; gnb[h] = inp(lds, I_RGNB)[l * 768 + h * 64 + lane]; rkw[h] = inp(lds, I_RRK)[l * 768 + h * 64 + lane]; }
    for (int t = gw; t < NTOK; t += NGW) {
        const f32x4 h0 = *(const f32x4*)(LH + (size_t)t * 512 + 8 * lane), h1 = *(const f32x4*)(LH + (size_t)t * 512 + 8 * lane + 4);
        const f32x4 p0 = *(const f32x4*)(LP + (size_t)t * 512 + 8 * lane), p1 = *(const f32x4*)(LP + (size_t)t * 512 + 8 * lane + 4);
        const f32x4 c0 = *(const f32x4*)(LC + (size_t)(t >> 6) * 512 + 8 * lane), c1 = *(const f32x4*)(LC + (size_t)(t >> 6) * 512 + 8 * lane + 4);
        const u32x4 gq = *(const u32x4*)(PROJ + (size_t)t * NP + PC_AG + 8 * lane);
        f32x2 go[6]; unsigned gg[6];
#pragma unroll
        for (int h = 0; h < 6; ++h) { go[h] = *(const f32x2*)(GO + (size_t)t * 768 + h * 128 + 2 * lane); gg[h] = *(const unsigned*)(PROJ + (size_t)t * NP + PC_BG + h * 128 + 2 * lane); }
        float ry[12], rr[12], rk[12], rv[12]; bf16_t rg[12];
#pragma unroll
        for (int h = 0; h < 12; ++h) { const size_t o = (size_t)t * 768 + h * 64 + lane; ry[h] = RY[o]; rr[h] = RR[o]; rk[h] = RK[o]; rv[h] = RV[o]; rg[h] = PROJ[(size_t)t * NP + PC_CG + h * 64 + lane]; }
        { const f32x4 v0 = h0 + p0 * c0, v1 = h1 + p1 * c1;
            u32x4 o; o.x = cvtpk(v0[0] * siluf_(__uint_as_float(gq.x << 16)), v0[1] * siluf_(__uint_as_float(gq.x & 0xffff0000u)));
            o.y = cvtpk(v0[2] * siluf_(__uint_as_float(gq.y << 16)), v0[3] * siluf_(__uint_as_float(gq.y & 0xffff0000u)));
            o.z = cvtpk(v1[0] * siluf_(__uint_as_float(gq.z << 16)), v1[1] * siluf_(__uint_as_float(gq.z & 0xffff0000u)));
            o.w = cvtpk(v1[2] * siluf_(__uint_as_float(gq.w << 16)), v1[3] * siluf_(__uint_as_float(gq.w & 0xffff0000u)));
            *(u32x4*)(Y + (size_t)t * DM + 8 * lane) = o; }
#pragma unroll
        for (int h = 0; h < 6; ++h) { const f32x2 o = go[h]; const float ss = wave_sum(o.x * o.x + o.y * o.y); const float sc = __builtin_amdgcn_rsqf(ss * (1.0f / 128.f) + 1e-6f);
            const float g0 = __uint_as_float(gg[h] << 16), g1 = __uint_as_float(gg[h] & 0xffff0000u);
            *(unsigned*)(Y + (size_t)t * DM + 512 + h * 128 + 2 * lane) = cvtpk(o.x * sc * ng.x * siluf_(g0), o.y * sc * ng.y * siluf_(g1)); }
#pragma unroll
        for (int h = 0; h < 12; ++h) { const float y = ry[h]; const float mean = wave_sum(y) * (1.0f / 64.f); const float d = y - mean; const float var = wave_sum(d * d) * (1.0f / 64.f);
            float yn = d * (__builtin_amdgcn_rsqf(var + 64e-5f)) * gnw[h] + gnb[h];
            const float sdot = wave_sum(rr[h] * rk[h] * rkw[h]); yn += sdot * rv[h];
            Y[(size_t)t * DM + 1280 + h * 64 + lane] = f2bf(yn * siluf_(bf2f(rg[h]))); }
    }
}
#define XB_TMO      128
#define XB_XCNT(j)  (256  + 64 * (j))
#define XB_XSUB(j)  (1280 + 64 * (j))
#define XB_XGEN(j)  (2304 + 64 * (j))
#define XB_TOP      3328
#define XB_TOPGEN   3392
#define XCD_BAR_WORDS 3456
#define XB_SPIN_CAP (1u << 18)
__device__ __forceinline__ unsigned xb_ld(unsigned* p)              { return __hip_atomic_load(p, __ATOMIC_RELAXED, __HIP_MEMORY_SCOPE_AGENT); }
__device__ __forceinline__ unsigned xb_add(unsigned* p, unsigned v) { return __hip_atomic_fetch_add(p, v, __ATOMIC_RELAXED, __HIP_MEMORY_SCOPE_AGENT); }
__device__ __forceinline__ unsigned xb_xcc_id() { return (unsigned)__builtin_amdgcn_s_getreg((3 << 11) | 20) & 0xFu; }
#define XB_SPIN(cond, bar) do { unsigned _sp = 0; while (cond) { __builtin_amdgcn_s_sleep(1); \
    if ((++_sp & 255u) == 0u) { if (xb_ld(&(bar)[XB_TMO])) break; if (_sp > XB_SPIN_CAP) { atomicAdd(&(bar)[XB_TMO], 1u); break; } } } } while (0)

struct XcdBarrier {
    unsigned* bar; unsigned x;
    volatile LAS unsigned* st;
};

__device__ __forceinline__ XcdBarrier xcd_barrier_post(unsigned* bar, volatile LAS unsigned* st) {
    XcdBarrier b; b.bar = bar; b.x = xb_xcc_id(); b.st = st;
    if (threadIdx.x == 0) (void)xb_add(&bar[XB_XCNT(b.x)], 1u);
    return b;
}
__device__ __forceinline__ void xcd_barrier_complete(unsigned* bar, unsigned x, unsigned& nloc, unsigned& nx) {
    const unsigned G = gridDim.x * gridDim.y * gridDim.z;
    unsigned sum, cnt, mine, sp = 0u;
    for (;;) {
        sum = 0u; cnt = 0u; mine = 0u;
#pragma unroll
        for (unsigned j = 0; j < 16; ++j) { const unsigned c = xb_ld(&bar[XB_XCNT(j)]); sum += c; cnt += (c > 0u) ? 1u : 0u; mine = (j == x) ? c : mine; }
        if (sum == G) break;
        __builtin_amdgcn_s_sleep(1);
        if ((++sp & 255u) == 0u) { if (xb_ld(&bar[XB_TMO])) break; if (sp > XB_SPIN_CAP) { atomicAdd(&bar[XB_TMO], 1u); break; } }
    }
    nloc = mine > 0u ? mine : 1u; nx = cnt > 0u ? cnt : 1u;
}

__device__ __forceinline__ void xcd_barrier(const XcdBarrier& b) {
    asm volatile("s_waitcnt vmcnt(0)" ::: "memory");
    __syncthreads();
    if (threadIdx.x == 0) {
        unsigned* bar = b.bar;
        __builtin_amdgcn_s_waitcnt(0);
        unsigned nloc = b.st[0], nx = b.st[1];
        if (nloc == 0u) { xcd_barrier_complete(bar, b.x, nloc, nx); b.st[0] = nloc; b.st[1] = nx; }
        const unsigned old = xb_add(&bar[XB_XSUB(b.x)], 1u);
        const unsigned gen = old / nloc;
        if (old + 1u == (gen + 1u) * nloc) {
            __builtin_amdgcn_fence(__ATOMIC_RELEASE, "agent");
            asm volatile("s_waitcnt vmcnt(0)" ::: "memory");
            const unsigned og = xb_add(&bar[XB_TOP], 1u);
            const unsigned tg = og / nx;
            if (og + 1u == (tg + 1u) * nx) xb_add(&bar[XB_TOPGEN], 1u);
            else XB_SPIN(xb_ld(&bar[XB_TOPGEN]) == tg, bar);
            __builtin_amdgcn_fence(__ATOMIC_ACQUIRE, "agent");
            xb_add(&bar[XB_XGEN(b.x)], 1u);
            asm volatile("s_waitcnt vmcnt(0)" ::: "memory");
        } else {
            XB_SPIN(xb_ld(&bar[XB_XGEN(b.x)]) == gen, bar);
            __builtin_amdgcn_fence(__ATOMIC_ACQUIRE, "agent");
            asm volatile("s_waitcnt vmcnt(0)" ::: "memory");
        }
    }
    __syncthreads();
}


__global__ void __launch_bounds__(512) mk_fwd(Args a) {
    extern __shared__ __attribute__((aligned(16))) unsigned char lds_raw[];
    LAS unsigned char* lds = (LAS unsigned char*)lds_raw;
    cg::grid_group grid = cg::this_grid();
    const int lo = a.ph_lo, hi = a.ph_hi;
    if (threadIdx.x < 26) { const unsigned long long p = (unsigned long long)a.in[threadIdx.x]; LAS unsigned* t = (LAS unsigned*)(lds + 131072) + 2 * threadIdx.x; t[0] = (unsigned)p; t[1] = (unsigned)(p >> 32); }
    if (threadIdx.x == 0) { LAS unsigned* z = (LAS unsigned*)(lds + 131072 + 256); z[0] = 0u; z[1] = 0u; z[2] = 0u; z[3] = 0u; }
    __syncthreads();
    XcdBarrier xb = xcd_barrier_post((unsigned*)(a.ws + WS_BAR), (volatile LAS unsigned*)(lds + 131072 + 256));
    float* XR = (float*)(a.ws + WS_XR); bf16_t* XB = (bf16_t*)(a.ws + WS_XB); bf16_t* PROJ = (bf16_t*)(a.ws + WS_PROJ); bf16_t* Y = (bf16_t*)(a.ws + WS_Y);
    for (int ph = lo; ph < hi; ++ph) {
      const int nrep = (REPMASK && ph > 0 && ph < NPHASE - 1 && ((REPMASK >> ((ph - 1) % PPL)) & 1)) ? 2 : 1;
      for (int rep = 0; rep < nrep; ++rep) {
        if (ph == 0) { phase_convert(a, lds, 0, 1, 0, 64, bid_l(), gdim_l(), 1); phase_convert(a, lds, 1, NL, CONV_SPLIT2, 64, bid_l(), gdim_l(), 0); }
        else if (ph == NPHASE - 1) phase_final(XR, inp(lds, I_FNG), a.out);
        else { const int l = (ph - 1) / PPL, s = (ph - 1) % PPL; const float* xin = (l == 0) ? inp(lds, I_X) : XR;
            if (s == 0) { if (!(SKIPMASK & 2)) phase_rms(xin, XB); }
            else if (s == 1 || s == 6) { if (!(SKIPMASK & 4)) {
                pg8::Gemm g; EpiDual E;
                if (s == 1) { g = pg8::Gemm{XB, (const bf16_t*)(a.ws + WS_WIN) + (size_t)l * NP * DM, NTOK, NP, DM}; E = EpiDual{0, PROJ, NP, nullptr, nullptr, 0}; }
                else { g = pg8::Gemm{Y, (const bf16_t*)(a.ws + WS_WOUT) + (size_t)l * DM * DM, NTOK, DM, DM}; E = EpiDual{1, nullptr, 0, xin, XR, DM}; }
                pg8::StaticOrder S; S.init(NTOK, g.N, gdim_l(), bid_l());
                pg8::gemm_phase<EpiDual, pg8::StaticOrder>(lds, g, S, E, nullptr);
                if (s == 1 && l + 1 < NL) { const int nfull = (NTOK / 256) * (NP / 256) - 3 * gdim_l();
                    if (nfull > 0 && nfull < gdim_l() && bid_l() >= nfull) phase_convert(a, lds, l + 1, l + 2, CONV_SPLIT, CONV_SPLIT2, bid_l() - nfull, gdim_l() - nfull, 0);
                    else if (nfull <= 0 || nfull >= gdim_l()) phase_convert(a, lds, l + 1, l + 2, CONV_SPLIT, CONV_SPLIT2, bid_l(), gdim_l(), 0); } } }
            else if (s == 2) { if (!(SKIPMASK & 8)) phase_prep(a, l, lds); }
            else if (s == 3) { phase_gdn_chunk(a, l, lds); if (CHUNKREP & 1) phase_gdn_chunk(a, l, lds); phase_rwkv_chunk(a, l, lds); if (CHUNKREP & 2) phase_rwkv_chunk(a, l, lds); phase_lru_chunk(a); if (CHUNKREP & 4) phase_lru_chunk(a); }
            else if (s == 4) { if (!(SKIPMASK & 16)) phase_scan_naive(a, l, lds); }
            else if (s == 5) { if (!(SKIPMASK & 32)) phase_fin(a, l, lds); }
        }
      }
        if (ph + 1 < hi) { if (ph == 0) grid.sync(); else xcd_barrier(xb); }
    }
}

extern "C" void kernel_launch(void* const* d_in, const int* in_sizes, int n_in, void* d_out, int out_size, void* d_ws, size_t ws_size, hipStream_t stream) {
    static int grid = 0;
    if (grid == 0) {
        if (n_in != 26 || ws_size < WS_END) { fprintf(stderr, "kernel_launch: unexpected n_in %d or ws_size %zu < %zu\n", n_in, ws_size, (size_t)WS_END); grid = -1; return; }
        int dev = 0, cus = 0, per_cu = 0;
        hipGetDevice(&dev); hipDeviceGetAttribute(&cus, hipDeviceAttributeMultiprocessorCount, dev);
        if (hipFuncSetAttribute((const void*)mk_fwd, hipFuncAttributeMaxDynamicSharedMemorySize, LDS_BYTES) != hipSuccess) { fprintf(stderr, "hipFuncSetAttribute failed\n"); grid = -1; return; }
        if (hipOccupancyMaxActiveBlocksPerMultiprocessor(&per_cu, (const void*)mk_fwd, 512, LDS_BYTES) != hipSuccess || per_cu < 1) { fprintf(stderr, "occupancy query failed / 0\n"); grid = -1; return; }
        grid = cus;
    }
    if (grid < 0) return;
    if (hipMemsetAsync((char*)d_ws + WS_BAR, 0, 16384, stream) != hipSuccess) { fprintf(stderr, "memset of barrier words failed\n"); return; }
    Args a{};
    for (int i = 0; i < 26; ++i) a.in[i] = (const float*)d_in[i];
    a.out = (float*)d_out; a.ws = (unsigned char*)d_ws;
#if N_LAUNCH_MODE == 1
    a.ph_lo = 0; a.ph_hi = NPHASE;
    void* args[] = {&a};
    hipError_t e = hipLaunchCooperativeKernel((const void*)mk_fwd, dim3(grid), dim3(512), args, LDS_BYTES, stream);
    if (e != hipSuccess) fprintf(stderr, "cooperative launch failed: %s (grid %d)\n", hipGetErrorString(e), grid);
#else
    for (int ph = 0; ph < NPHASE; ++ph) { a.ph_lo = ph; a.ph_hi = ph + 1; hipLaunchKernelGGL(mk_fwd, dim3(grid), dim3(512), LDS_BYTES, stream, a); }
#endif
}
```

```cpp
#include <hip/hip_runtime.h>
#include <hip/hip_cooperative_groups.h>
#include <cstdio>
#include <cstdint>
namespace cg = cooperative_groups;
namespace pg8 {
#define PG8_LAS __attribute__((address_space(3)))
typedef unsigned short bf16_t;
typedef short bf16x8 __attribute__((ext_vector_type(8)));
typedef float f32x4 __attribute__((ext_vector_type(4)));
typedef unsigned u32x4 __attribute__((ext_vector_type(4)));
constexpr int BM = 256, BK = 64, HALF = 128, HTB = HALF * BK * 2  , STAGE_BYTES = 8 * HTB, NXCD = 8, WGM = 8;

__host__ __device__ __forceinline__ int lds_byte(int r, int c) { const int st = (r >> 4) * 2 + (c >> 5), rr = r & 15, cc = c & 31, ob = rr * 64 + cc * 2; return st * 1024 + (ob ^ (((ob >> 9) & 1) << 5)); }
__host__ __device__ __forceinline__ void stage_rc(int b, int& R, int& C) { const int st = b / 1024, sb = b % 1024, swz = sb ^ (((sb >> 9) & 1) << 5); R = (st >> 1) * 16 + swz / 64; C = (st & 1) * 32 + (swz % 64) / 2; }
__host__ __device__ __forceinline__ int perm32(int rho) { const int n = rho >> 4, i = rho & 15; return 8 * (i >> 2) + 4 * n + (i & 3); }

struct Unit { int pm, pn; };
struct Gemm { const bf16_t* A; const bf16_t* Bt; int M, N, K; };

struct StaticOrder {
    int nM, nN, nwg, G, c;
    __host__ __device__ void init(int M, int N, int G_, int c_) { nM = M / BM; nN = N / BM; nwg = nM * nN; G = G_; c = c_; }
    __host__ __device__ bool next(int i, Unit& u) const {
        const long L = (long)i * G + c; if (L >= nwg) return false;
        int wgid = (int)L; { const int q = nwg / NXCD, r = nwg % NXCD, xcd = wgid % NXCD, off = wgid / NXCD; wgid = (xcd < r ? xcd * (q + 1) : r * (q + 1) + (xcd - r) * q) + off; }
        const int nig = WGM * nN, gid = wgid / nig, fm = gid * WGM, gsz = (nM - fm) < WGM ? (nM - fm) : WGM;
        u.pm = fm + ((wgid % nig) % gsz); u.pn = (wgid % nig) / gsz; return true;
    }
    __device__ __forceinline__ void a_ready(const Unit&) const {}
    __device__ __forceinline__ void done(const Unit&) const {}
};
struct CountedOrder : StaticOrder {
    const unsigned* ready; unsigned need; unsigned* tmo;
    __device__ __forceinline__ void a_ready(const Unit& u) const {
        if (threadIdx.x < 64) {
            const unsigned long long t0 = __builtin_amdgcn_s_memrealtime(); unsigned polls = 0;
            while ((unsigned)__builtin_amdgcn_readfirstlane(__hip_atomic_load(ready + 64 * u.pm, __ATOMIC_RELAXED, __HIP_MEMORY_SCOPE_AGENT)) < need) {
                if ((++polls & 255u) == 0u && __builtin_amdgcn_readfirstlane(__hip_atomic_load(tmo, __ATOMIC_RELAXED, __HIP_MEMORY_SCOPE_AGENT)) != 0u) break;
                if (__builtin_amdgcn_s_memrealtime() - t0 > 2000000ull) {
                    if (threadIdx.x == 0) { unsigned expect = 0u; __hip_atomic_compare_exchange_strong(tmo + 1, &expect, 0x600u | (unsigned)(u.pm & 0xff), __ATOMIC_RELAXED, __ATOMIC_RELAXED, __HIP_MEMORY_SCOPE_AGENT); __hip_atomic_store(tmo, 1u, __ATOMIC_RELAXED, __HIP_MEMORY_SCOPE_AGENT); }
                    break; }
                __builtin_amdgcn_s_sleep(2); }
            __builtin_amdgcn_fence(__ATOMIC_ACQUIRE, "agent");
            asm volatile("s_waitcnt vmcnt(0)" ::: "memory");
        }
#if !defined(BROKEN_HOOK_NO_BARRIER)
        asm volatile("" ::: "memory"); __builtin_amdgcn_s_barrier(); asm volatile("" ::: "memory");
#endif
    }
};

__device__ __forceinline__ unsigned cvt_pk_bf16(float lo, float hi) { unsigned r; asm volatile("v_cvt_pk_bf16_f32 %0, %1, %2" : "=v"(r) : "v"(lo), "v"(hi)); return r; }
typedef float f32x2 __attribute__((ext_vector_type(2)));
__device__ __forceinline__ f32x2 gelu_pk(f32x2 v) {
    const f32x2 av = __builtin_elementwise_abs(v), d = av * 0.2316418882f + 1.0f;
    f32x2 t; t.x = __builtin_amdgcn_rcpf(d.x); t.y = __builtin_amdgcn_rcpf(d.y);
    f32x2 q = t * 0.5307027145f + (-0.7265760135f); q = q * t + 0.7107068705f; q = q * t + (-0.142248368f); q = q * t + 0.127414796f; q = q * t;
    const f32x2 s = (v * v) * (-0.72134752044f);
    f32x2 e; e.x = __builtin_amdgcn_exp2f(s.x); e.y = __builtin_amdgcn_exp2f(s.y);
    const f32x2 m = v * (q * e), r = v - m;
    f32x2 o; o.x = v.x < 0.f ? m.x : r.x; o.y = v.y < 0.f ? m.y : r.y; return o;
}

struct EpiF32 {
    static constexpr bool PERM = false, AFTER_DRAIN = false;
    float* C; int ldc; const float* bias;
    __device__ __forceinline__ void operator()(const f32x4 (&acc)[2][2][4][2], const Unit& u, int wr, int wc, int fr, int fq) const {
        const int row0 = u.pm * BM + wr * 64 + fr, col0 = u.pn * BM + wc * 32 + 4 * fq;
        f32x4 bv[2][2];
#pragma unroll
        for (int bj = 0; bj < 2; ++bj)
#pragma unroll
            for (int n = 0; n < 2; ++n) bv[bj][n] = bias ? *(const f32x4*)(bias + col0 + bj * HALF + n * 16) : (f32x4){0.f, 0.f, 0.f, 0.f};
#pragma unroll
        for (int ai = 0; ai < 2; ++ai)
#pragma unroll
            for (int m = 0; m < 4; ++m) { float* rowp = C + (size_t)(row0 + ai * HALF + m * 16) * ldc + col0;
#pragma unroll
                for (int bj = 0; bj < 2; ++bj)
#pragma unroll
                    for (int n = 0; n < 2; ++n) *(f32x4*)(rowp + bj * HALF + n * 16) = acc[ai][bj][m][n] + bv[bj][n]; }
    }
};
template <int ACT  > struct EpiBf16 {
    static constexpr bool PERM = true, AFTER_DRAIN = false;
    bf16_t* O; int ldc; const float* bias; int split_cols; size_t split_stride;
    __device__ __forceinline__ void operator()(const f32x4 (&acc)[2][2][4][2], const Unit& u, int wr, int wc, int fr, int fq) const {
        const int row0 = u.pm * BM + wr * 64 + fr; int colt = u.pn * BM; bf16_t* base = O;
        if (split_cols) { const int t = colt / split_cols; base += (size_t)t * split_stride; colt -= t * split_cols; }
        const int col0 = colt + wc * 32 + 8 * fq, bcol0 = u.pn * BM + wc * 32 + 8 * fq;
        f32x4 bv[2][2];
#pragma unroll
        for (int bj = 0; bj < 2; ++bj)
#pragma unroll
            for (int n = 0; n < 2; ++n) bv[bj][n] = bias ? *(const f32x4*)(bias + bcol0 + bj * HALF + 4 * n) : (f32x4){0.f, 0.f, 0.f, 0.f};
#pragma unroll
        for (int ai = 0; ai < 2; ++ai)
#pragma unroll
            for (int m = 0; m < 4; ++m) { bf16_t* rowp = base + (size_t)(row0 + ai * HALF + m * 16) * ldc + col0;
#pragma unroll
                for (int bj = 0; bj < 2; ++bj) { f32x4 v0 = acc[ai][bj][m][0] + bv[bj][0], v1 = acc[ai][bj][m][1] + bv[bj][1];
                    if (ACT == 1) { f32x2 a = gelu_pk((f32x2){v0[0], v0[1]}), b = gelu_pk((f32x2){v0[2], v0[3]}), c = gelu_pk((f32x2){v1[0], v1[1]}), d = gelu_pk((f32x2){v1[2], v1[3]});
                        v0 = (f32x4){a.x, a.y, b.x, b.y}; v1 = (f32x4){c.x, c.y, d.x, d.y}; }
                    if (ACT == 2) {
#pragma unroll
                        for (int j = 0; j < 4; ++j) { v0[j] = 0.5f * v0[j] * (1.0f + erff(v0[j] * 0.70710678f)); v1[j] = 0.5f * v1[j] * (1.0f + erff(v1[j] * 0.70710678f)); } }
                    u32x4 w; w.x = cvt_pk_bf16(v0[0], v0[1]); w.y = cvt_pk_bf16(v0[2], v0[3]); w.z = cvt_pk_bf16(v1[0], v1[1]); w.w = cvt_pk_bf16(v1[2], v1[3]);
                    *(u32x4*)(rowp + bj * HALF) = w; } }
    }
};

struct PanelStats {
    unsigned* xbuf;
    unsigned* cnt;
    unsigned* tmo;
    int ntn; float eps;
    unsigned code;
    __device__ __forceinline__ bool run(const f32x4 (&v)[2][2][4][2], const Unit& u, int wr, int wc, int fr, int fq, PG8_LAS unsigned char* lds, int wid, int lane) const {
        typedef float f32x2v __attribute__((ext_vector_type(2)));
        PG8_LAS f32x2v* P = (PG8_LAS f32x2v*)lds;
        PG8_LAS f32x2v* S = (PG8_LAS f32x2v*)(lds + 8192);
        PG8_LAS unsigned* flag = (PG8_LAS unsigned*)(lds + 8192 + 2048);
#pragma unroll
        for (int ai = 0; ai < 2; ++ai)
#pragma unroll
            for (int m = 0; m < 4; ++m) {
                float s = 0.f;
#pragma unroll
                for (int bj = 0; bj < 2; ++bj)
#pragma unroll
                    for (int n = 0; n < 2; ++n) { const f32x4 x = v[ai][bj][m][n]; s += (x[0] + x[1]) + (x[2] + x[3]); }
                s += __shfl_xor(s, 16); s += __shfl_xor(s, 32);
                const float mw = s * (1.0f / 64.0f); float q = 0.f;
#pragma unroll
                for (int bj = 0; bj < 2; ++bj)
#pragma unroll
                    for (int n = 0; n < 2; ++n) { const f32x4 d = v[ai][bj][m][n] - mw; q += (d[0] * d[0] + d[1] * d[1]) + (d[2] * d[2] + d[3] * d[3]); }
                q += __shfl_xor(q, 16); q += __shfl_xor(q, 32);
                if (fq == 0) P[(ai * HALF + wr * 64 + m * 16 + fr) * 4 + wc] = (f32x2v){mw, q};
            }
        asm volatile("s_waitcnt lgkmcnt(0)" ::: "memory"); __builtin_amdgcn_s_barrier(); asm volatile("" ::: "memory");
#if defined(BROKEN_NO_WAIT)
        if (blockIdx.x >= 64) { const long long t0 = clock64(); while (clock64() - t0 < 60000) __builtin_amdgcn_s_sleep(8); }
#endif
        const int row = wid * 32 + (lane & 31);
        if (lane < 32) {
            const f32x2v a = P[row * 4 + 0], b = P[row * 4 + 1], c = P[row * 4 + 2], d = P[row * 4 + 3];
            const float mt = (a.x + b.x + c.x + d.x) * 0.25f;
            const float da = a.x - mt, db = b.x - mt, dc = c.x - mt, dd = d.x - mt;
            const float m2 = (a.y + b.y) + (c.y + d.y) + 64.0f * ((da * da + db * db) + (dc * dc + dd * dd));
            unsigned long long* slot = (unsigned long long*)xbuf + ((size_t)(u.pm * BM + row) * 4 + u.pn);
            __hip_atomic_store(slot, ((unsigned long long)__float_as_uint(m2) << 32) | __float_as_uint(mt), __ATOMIC_RELAXED, __HIP_MEMORY_SCOPE_AGENT);
        }
        asm volatile("s_waitcnt vmcnt(0)" ::: "memory");
        if (lane == 0) __hip_atomic_fetch_add(cnt + 64 * u.pm, 1u, __ATOMIC_RELAXED, __HIP_MEMORY_SCOPE_AGENT);
        if (wid == 0) {
            bool dead = false; const unsigned long long t0 = __builtin_amdgcn_s_memrealtime(); const unsigned want = 8u * (unsigned)ntn;
            for (;;) {
#if defined(BROKEN_NO_WAIT)
                break;
#endif
                if ((unsigned)__builtin_amdgcn_readfirstlane(__hip_atomic_load(cnt + 64 * u.pm, __ATOMIC_RELAXED, __HIP_MEMORY_SCOPE_AGENT)) >= want) break;
                if (__builtin_amdgcn_s_memrealtime() - t0 > 2000000ull) {
                    if (lane == 0) { unsigned expect = 0u; __hip_atomic_compare_exchange_strong(tmo + 1, &expect, code | (unsigned)(u.pm & 0xff), __ATOMIC_RELAXED, __ATOMIC_RELAXED, __HIP_MEMORY_SCOPE_AGENT);
                                     __hip_atomic_store(tmo, 1u, __ATOMIC_RELAXED, __HIP_MEMORY_SCOPE_AGENT); }
                    dead = true; break; }
                __builtin_amdgcn_s_sleep(2);
            }
            __builtin_amdgcn_fence(__ATOMIC_ACQUIRE, "agent");
            if (lane == 0) flag[0] = dead ? 1u : 0u;
        }
        asm volatile("s_waitcnt vmcnt(0) lgkmcnt(0)" ::: "memory"); __builtin_amdgcn_s_barrier(); asm volatile("" ::: "memory");
        const bool bad = flag[0] != 0u;
        if (lane < 32) {
            const unsigned long long* slot = (const unsigned long long*)xbuf + (size_t)(u.pm * BM + row) * 4; float mt[4], m2[4]; float ms = 0.f;
#pragma unroll
            for (int t = 0; t < 4; ++t) { if (t < ntn) { const unsigned long long w = __hip_atomic_load(slot + t, __ATOMIC_RELAXED, __HIP_MEMORY_SCOPE_AGENT); mt[t] = __uint_as_float((unsigned)w); m2[t] = __uint_as_float((unsigned)(w >> 32)); } else { mt[t] = 0.f; m2[t] = 0.f; } ms += mt[t]; }
            const float mean = ms / (float)ntn; float q = 0.f;
#pragma unroll
            for (int t = 0; t < 4; ++t) if (t < ntn) { const float dm = mt[t] - mean; q += m2[t] + 256.0f * dm * dm; }
            S[row] = (f32x2v){mean, 1.0f / sqrtf(q / (256.0f * (float)ntn) + eps)};
        }
        asm volatile("s_waitcnt lgkmcnt(0)" ::: "memory"); __builtin_amdgcn_s_barrier(); asm volatile("" ::: "memory");
        return bad;
    }
};
struct EpiLnRes {
    static constexpr bool PERM = false, AFTER_DRAIN = true;
    const float* base; float* out; int ldc; const float* bias; PanelStats st; unsigned poison;
    __device__ __forceinline__ void refuse(size_t i0, size_t stride, int M, int N) const { const float q = __builtin_nanf(""); for (size_t i = i0; i < (size_t)M * N; i += stride) out[(i / N) * ldc + i % N] = q;
        if (i0 == 0) { unsigned expect = 0u; __hip_atomic_compare_exchange_strong(st.tmo + 1, &expect, 0x7f0u, __ATOMIC_RELAXED, __ATOMIC_RELAXED, __HIP_MEMORY_SCOPE_AGENT); __hip_atomic_store(st.tmo, 1u, __ATOMIC_RELAXED, __HIP_MEMORY_SCOPE_AGENT); } }
    __device__ __forceinline__ void fused(f32x4 (&acc)[2][2][4][2], const Unit& u, int wr, int wc, int fr, int fq, PG8_LAS unsigned char* lds, int wid, int lane) const {
        typedef float f32x2v __attribute__((ext_vector_type(2)));
        const PG8_LAS f32x2v* S = (const PG8_LAS f32x2v*)(lds + 8192);
        const int col0 = u.pn * BM + wc * 32 + 4 * fq;
#pragma unroll
        for (int bj = 0; bj < 2; ++bj)
#pragma unroll
            for (int n = 0; n < 2; ++n) { const f32x4 bv = bias ? *(const f32x4*)(bias + col0 + bj * HALF + n * 16) : (f32x4){0.f, 0.f, 0.f, 0.f};
#pragma unroll
                for (int ai = 0; ai < 2; ++ai)
#pragma unroll
                    for (int m = 0; m < 4; ++m) acc[ai][bj][m][n] += bv; }
        const bool bad = st.run(acc, u, wr, wc, fr, fq, lds, wid, lane) || poison != 0u;
        const float qnan = __builtin_nanf("");
#pragma unroll
        for (int ai = 0; ai < 2; ++ai)
#pragma unroll
            for (int m = 0; m < 4; ++m) { const int r = ai * HALF + wr * 64 + m * 16 + fr; const f32x2v sr = S[r]; const size_t off = (size_t)(u.pm * BM + r) * ldc + col0;
#pragma unroll
                for (int bj = 0; bj < 2; ++bj)
#pragma unroll
                    for (int n = 0; n < 2; ++n) { const f32x4 bs = *(const f32x4*)(base + off + bj * HALF + n * 16); f32x4 o = bs + (acc[ai][bj][m][n] - sr.x) * sr.y;
                        if (bad) o = (f32x4){qnan, qnan, qnan, qnan}; *(f32x4*)(out + off + bj * HALF + n * 16) = o; }
                asm volatile("" ::: "memory"); }
    }
};
struct EpiLnResLn {
    static constexpr bool PERM = false, AFTER_DRAIN = true;
    const float* base; float* out; bf16_t* xn; int ldc; const float* bias; PanelStats st1, st2; unsigned poison;
    __device__ __forceinline__ void refuse(size_t i0, size_t stride, int M, int N) const { const float q = __builtin_nanf(""); for (size_t i = i0; i < (size_t)M * N; i += stride) { const size_t o = (i / N) * ldc + i % N; out[o] = q; xn[o] = (bf16_t)0x7fc0u; }
        if (i0 == 0) { unsigned expect = 0u; __hip_atomic_compare_exchange_strong(st1.tmo + 1, &expect, 0x7f0u, __ATOMIC_RELAXED, __ATOMIC_RELAXED, __HIP_MEMORY_SCOPE_AGENT); __hip_atomic_store(st1.tmo, 1u, __ATOMIC_RELAXED, __HIP_MEMORY_SCOPE_AGENT); } }
    __device__ __forceinline__ void fused(f32x4 (&acc)[2][2][4][2], const Unit& u, int wr, int wc, int fr, int fq, PG8_LAS unsigned char* lds, int wid, int lane) const {
        typedef float f32x2v __attribute__((ext_vector_type(2))); typedef unsigned u32x2v __attribute__((ext_vector_type(2)));
        const PG8_LAS f32x2v* S = (const PG8_LAS f32x2v*)(lds + 8192);
        const int col0 = u.pn * BM + wc * 32 + 4 * fq;
#pragma unroll
        for (int bj = 0; bj < 2; ++bj)
#pragma unroll
            for (int n = 0; n < 2; ++n) { const f32x4 bv = bias ? *(const f32x4*)(bias + col0 + bj * HALF + n * 16) : (f32x4){0.f, 0.f, 0.f, 0.f};
#pragma unroll
                for (int ai = 0; ai < 2; ++ai)
#pragma unroll
                    for (int m = 0; m < 4; ++m) acc[ai][bj][m][n] += bv; }
        bool bad = st1.run(acc, u, wr, wc, fr, fq, lds, wid, lane) || poison != 0u;
        const float qnan = __builtin_nanf("");
#pragma unroll
        for (int ai = 0; ai < 2; ++ai)
#pragma unroll
            for (int m = 0; m < 4; ++m) { const int r = ai * HALF + wr * 64 + m * 16 + fr; const f32x2v sr = S[r]; const size_t off = (size_t)(u.pm * BM + r) * ldc + col0;
#pragma unroll
                for (int bj = 0; bj < 2; ++bj)
#pragma unroll
                    for (int n = 0; n < 2; ++n) { const f32x4 bs = *(const f32x4*)(base + off + bj * HALF + n * 16); acc[ai][bj][m][n] = bs + (acc[ai][bj][m][n] - sr.x) * sr.y; }
                asm volatile("" : "+v"(acc[ai][0][m][0]), "+v"(acc[ai][0][m][1]), "+v"(acc[ai][1][m][0]), "+v"(acc[ai][1][m][1]));
                if (m & 1) asm volatile("" ::: "memory"); }
        const bool bad1 = bad;
        bad = st2.run(acc, u, wr, wc, fr, fq, lds, wid, lane) || bad;
#pragma unroll
        for (int ai = 0; ai < 2; ++ai)
#pragma unroll
            for (int m = 0; m < 4; ++m) { const int r = ai * HALF + wr * 64 + m * 16 + fr; const f32x2v sr = S[r]; const size_t off = (size_t)(u.pm * BM + r) * ldc + col0;
#pragma unroll
                for (int bj = 0; bj < 2; ++bj)
#pragma unroll
                    for (int n = 0; n < 2; ++n) { const f32x4 x1 = acc[ai][bj][m][n]; *(f32x4*)(out + off + bj * HALF + n * 16) = bad1 ? (f32x4){qnan, qnan, qnan, qnan} : x1;
                        const f32x4 o = (x1 - sr.x) * sr.y; u32x2v w; w.x = cvt_pk_bf16(o[0], o[1]); w.y = cvt_pk_bf16(o[2], o[3]);
                        if (bad) { w.x = 0x7fc07fc0u; w.y = 0x7fc07fc0u; } *(u32x2v*)(xn + off + bj * HALF + n * 16) = w; }
                asm volatile("" ::: "memory"); }
    }
};

template <class Epi, class Sched, bool STAMP = false>
__device__ __forceinline__ void gemm_phase(PG8_LAS unsigned char* lds, const Gemm g, const Sched& S, const Epi& E, unsigned long long* stamps) {
    int tid_ = threadIdx.x; asm volatile("" : "+v"(tid_)); const int tid = tid_, wid = __builtin_amdgcn_readfirstlane(tid >> 6), lane = tid & 63, wr = wid >> 2, wc = wid & 3, fr = lane & 15, fq = lane >> 4;
    const int K = g.K, nt = K / BK;
    int ts_lo = 0, ts_hi = 0, nts = 0; const unsigned long long rt_entry = STAMP ? (unsigned long long)wall_clock64() : 0ull;
#define PG8_STAMP() do { if (STAMP && wid == 0 && nts < 64) { const unsigned long long _c = (unsigned long long)clock64(); \
        ts_lo = (lane == nts) ? (int)(unsigned)_c : ts_lo; ts_hi = (lane == nts) ? (int)(unsigned)(_c >> 32) : ts_hi; ++nts; } } while (0)
    PG8_STAMP();
    unsigned voffA[2], voffB[2];
#pragma unroll
    for (int i = 0; i < 2; ++i) { int R, C; stage_rc(tid * 16 + i * 8192, R, C); const int Rb = Epi::PERM ? ((R & ~31) + perm32(R & 31)) : R;
        voffA[i] = (unsigned)(R * K + C) * 2u; voffB[i] = (unsigned)(Rb * K + C) * 2u; }
    const size_t kstep = (size_t)(BK * 2);
    const size_t hstep = (size_t)HALF * K * 2;
    const size_t tstep = 2 * hstep;
    const unsigned ldsw = (unsigned)wid * 1024u;
    const int aoff = lds_byte(wr * 64 + fr, fq * 8), boff = lds_byte(wc * 32 + fr, fq * 8);
#define PG8_SA(b, h) (((b) * 2 + (h)) * HTB)
#define PG8_SB(b, h) ((4 + (b) * 2 + (h)) * HTB)
#define PG8_STAGE(bufoff, gbase, voff) do { _Pragma("unroll") for (int _i = 0; _i < 2; ++_i) \
        __builtin_amdgcn_global_load_lds((const unsigned*)((const char*)(gbase) + (voff)[_i]), (PG8_LAS unsigned*)(lds + (bufoff) + ldsw + _i * 8192), 16, 0, 0); } while (0)
#define PG8_LDA(dst, b, h) do { _Pragma("unroll") for (int m = 0; m < 4; ++m) _Pragma("unroll") for (int k = 0; k < 2; ++k) dst[m][k] = *(const PG8_LAS bf16x8*)(lds + PG8_SA(b, h) + aoff + m * 2048 + k * 1024); } while (0)
#define PG8_LDB(dst, b, h) do { _Pragma("unroll") for (int n = 0; n < 2; ++n) _Pragma("unroll") for (int k = 0; k < 2; ++k) dst[n][k] = *(const PG8_LAS bf16x8*)(lds + PG8_SB(b, h) + boff + n * 2048 + k * 1024); } while (0)
#define PG8_MMA(ai, bj, At, Bt) do { __builtin_amdgcn_s_setprio(1); _Pragma("unroll") for (int m = 0; m < 4; ++m) _Pragma("unroll") for (int n = 0; n < 2; ++n) _Pragma("unroll") for (int k = 0; k < 2; ++k) \
        acc[ai][bj][m][n] = __builtin_amdgcn_mfma_f32_16x16x32_bf16(Bt[n][k], At[m][k], acc[ai][bj][m][n], 0, 0, 0); __builtin_amdgcn_s_setprio(0); } while (0)
#define PG8_WAIT_V(n) asm volatile("s_waitcnt vmcnt(" #n ")" ::: "memory")
#define PG8_WAIT_L(n) asm volatile("s_waitcnt lgkmcnt(" #n ")" ::: "memory")
#define PG8_BAR __builtin_amdgcn_s_barrier()
#define PG8_SCHED __builtin_amdgcn_sched_barrier(0)
    Unit cur, nxt; int ui = 0;
    if (!S.next(0, cur)) return;
    f32x4 acc[2][2][4][2];
#pragma unroll
    for (int a = 0; a < 2; ++a)
#pragma unroll
        for (int b = 0; b < 2; ++b)
#pragma unroll
            for (int m = 0; m < 4; ++m)
#pragma unroll
                for (int n = 0; n < 2; ++n) acc[a][b][m][n] = (f32x4){0.f, 0.f, 0.f, 0.f};
    bf16x8 At[4][2], B0[2][2], B1[2][2];
    const char* cA = (const char*)g.A + (size_t)cur.pm * tstep; const char* cB = (const char*)g.Bt + (size_t)cur.pn * tstep;
    S.a_ready(cur);
    PG8_STAGE(PG8_SB(0, 0), cB, voffB); PG8_STAGE(PG8_SA(0, 0), cA, voffA); PG8_STAGE(PG8_SB(0, 1), cB + hstep, voffB); PG8_STAGE(PG8_SA(0, 1), cA + hstep, voffA);
    if (wr == 1) PG8_BAR;
    PG8_WAIT_V(4); PG8_BAR;
    PG8_STAGE(PG8_SB(1, 0), cB + kstep, voffB); PG8_STAGE(PG8_SA(1, 0), cA + kstep, voffA); PG8_STAGE(PG8_SB(1, 1), cB + hstep + kstep, voffB);
    PG8_WAIT_V(6); PG8_BAR;
    PG8_STAMP();
    for (;;) {
        const bool has_next = S.next(ui + 1, nxt);
        const char* nA = has_next ? (const char*)g.A + (size_t)nxt.pm * tstep : cA; const char* nB = has_next ? (const char*)g.Bt + (size_t)nxt.pn * tstep : cB;
        for (int t = 0; t < nt; t += 2) {
            const bool last = (t == nt - 2);
            const char* a1 = cA + (size_t)(t + 1) * kstep;
            const char* a2 = last ? nA : cA + (size_t)(t + 2) * kstep; const char* b2 = last ? nB : cB + (size_t)(t + 2) * kstep;
            const char* a3 = a2 + kstep; const char* b3 = b2 + kstep;
            if (last && has_next) S.a_ready(nxt);
            PG8_LDB(B0, 0, 0); PG8_SCHED; PG8_LDA(At, 0, 0); PG8_STAGE(PG8_SA(1, 1), a1 + hstep, voffA);
            PG8_WAIT_L(8); PG8_BAR; PG8_WAIT_L(0); PG8_MMA(0, 0, At, B0); PG8_BAR; PG8_SCHED;
            PG8_LDB(B1, 0, 1); PG8_STAGE(PG8_SB(0, 0), b2, voffB);
            PG8_BAR; PG8_WAIT_L(0); PG8_MMA(0, 1, At, B1); PG8_BAR;
            PG8_LDA(At, 0, 1); PG8_STAGE(PG8_SA(0, 0), a2, voffA);
            PG8_BAR; PG8_WAIT_L(0); PG8_MMA(1, 0, At, B0); PG8_BAR; PG8_SCHED;
            PG8_STAGE(PG8_SB(0, 1), b2 + hstep, voffB);
            PG8_WAIT_V(6); PG8_BAR; PG8_MMA(1, 1, At, B1); PG8_BAR;
            PG8_LDB(B0, 1, 0); PG8_SCHED; PG8_LDA(At, 1, 0); PG8_STAGE(PG8_SA(0, 1), a2 + hstep, voffA);
            PG8_WAIT_L(8); PG8_BAR; PG8_WAIT_L(0); PG8_MMA(0, 0, At, B0); PG8_BAR; PG8_SCHED;
            PG8_LDB(B1, 1, 1); PG8_STAGE(PG8_SB(1, 0), b3, voffB);
            PG8_BAR; PG8_WAIT_L(0); PG8_MMA(0, 1, At, B1); PG8_BAR;
            PG8_LDA(At, 1, 1); PG8_STAGE(PG8_SA(1, 0), a3, voffA);
            PG8_BAR; PG8_WAIT_L(0); PG8_MMA(1, 0, At, B0); PG8_BAR; PG8_SCHED;
            PG8_STAGE(PG8_SB(1, 1), b3 + hstep, voffB);
            PG8_WAIT_V(6); PG8_BAR; PG8_MMA(1, 1, At, B1); PG8_BAR;
        }
        PG8_STAMP();
        if constexpr (!Epi::AFTER_DRAIN) { E(acc, cur, wr, wc, fr, fq); S.done(cur); }
        PG8_STAMP();
        if (!has_next) break;
#pragma unroll
        for (int a = 0; a < 2; ++a)
#pragma unroll
            for (int b = 0; b < 2; ++b)
#pragma unroll
                for (int m = 0; m < 4; ++m)
#pragma unroll
                    for (int n = 0; n < 2; ++n) acc[a][b][m][n] = (f32x4){0.f, 0.f, 0.f, 0.f};
        cur = nxt; cA = nA; cB = nB; ++ui;
    }
    PG8_WAIT_V(0);
    if (wr == 0) PG8_BAR;
    PG8_BAR;
    if constexpr (Epi::AFTER_DRAIN) { E.fused(acc, cur, wr, wc, fr, fq, lds, wid, lane); S.done(cur); }
    PG8_STAMP();
    if (STAMP && wid == 0) { stamps[lane] = lane < nts ? (((unsigned long long)(unsigned)ts_hi << 32) | (unsigned)ts_lo) : 0ull;
        if (lane == 62) stamps[62] = rt_entry; if (lane == 63) stamps[63] = (unsigned long long)wall_clock64(); }
#undef PG8_STAMP
#undef PG8_SA
#undef PG8_SB
#undef PG8_STAGE
#undef PG8_LDA
#undef PG8_LDB
#undef PG8_MMA
#undef PG8_WAIT_V
#undef PG8_WAIT_L
#undef PG8_BAR
#undef PG8_SCHED
}
}
#define LAS __attribute__((address_space(3)))
typedef unsigned short bf16_t;
typedef float f32x4 __attribute__((ext_vector_type(4)));
typedef float f32x2 __attribute__((ext_vector_type(2)));
typedef unsigned u32x4 __attribute__((ext_vector_type(4)));
typedef unsigned u32x2 __attribute__((ext_vector_type(2)));
constexpr int NTOK = 8192, SEQ = 2048, DM = 2048, NIN = 7372, NP = 7424, NL = 4;
constexpr int LRUW = 512, GW = 768, RW_ = 768;
constexpr int PC_AX = 0, PC_AG = 512, PC_BQKV = 1024, PC_BG = 3328, PC_CIN = 4096, PC_CG = 6592, PC_BETA = 7360, PC_BA = 7366;
constexpr int LDS_BYTES = 131072 + 512;
#ifndef CHUNKREP
#define CHUNKREP 0
#endif
#ifndef CONV_SPLIT2
#define CONV_SPLIT2 52
#endif
#ifndef CONV_SPLIT
#define CONV_SPLIT 24
#endif
#ifndef REPMASK
#define REPMASK 0
#endif
#ifndef SKIPMASK
#define SKIPMASK 0
#endif
#ifndef N_LAUNCH_MODE
#define N_LAUNCH_MODE 1
#endif
constexpr int PPL = 7;
constexpr int NPHASE = 2 + PPL * NL;
constexpr size_t WS_WIN = 0;
constexpr size_t WS_WOUT = WS_WIN + (size_t)NL * NP * DM * 2;
constexpr size_t WS_XB = WS_WOUT + (size_t)NL * DM * DM * 2;
constexpr size_t WS_XR = WS_XB + (size_t)NTOK * DM * 2;
constexpr size_t WS_PROJ = WS_XR + (size_t)NTOK * DM * 4;
constexpr size_t WS_Y = WS_PROJ + (size_t)NTOK * NP * 2;
constexpr size_t SZ768 = (size_t)NTOK * 768 * 4;
constexpr size_t WS_GQ = WS_Y + (size_t)NTOK * DM * 2;
constexpr size_t WS_GK = WS_GQ + SZ768;
constexpr size_t WS_GV = WS_GK + SZ768;
constexpr size_t WS_GO = WS_GV + SZ768;
constexpr size_t WS_RR = WS_GO + SZ768;
constexpr size_t WS_RW = WS_RR + SZ768;
constexpr size_t WS_RK = WS_RW + SZ768;
constexpr size_t WS_RV = WS_RK + SZ768;
constexpr size_t WS_RKK = WS_RV + SZ768;
constexpr size_t WS_RB = WS_RKK + SZ768;
constexpr size_t WS_RY = WS_RB + SZ768;
constexpr size_t WS_GB = WS_RY + SZ768;
constexpr size_t WS_GG = WS_GB + (size_t)NTOK * 8 * 4;
constexpr size_t WS_LA = WS_GG + (size_t)NTOK * 8 * 4;
constexpr size_t WS_LU = WS_LA + (size_t)NTOK * 512 * 4;
constexpr size_t WS_LEND = WS_LU + (size_t)NTOK * 512 * 4;
constexpr int GCH = 768, RCH = 1536;
constexpr size_t WS_G1 = WS_LEND;
constexpr size_t WS_G2 = WS_G1 + (size_t)GCH * 64 * 128 * 2;
constexpr size_t WS_G3 = WS_G2 + (size_t)GCH * 64 * 128 * 2;
constexpr size_t WS_G4 = WS_G3 + (size_t)GCH * 64 * 64 * 2;
constexpr size_t WS_GU = WS_G4 + (size_t)GCH * 128 * 64 * 2;
constexpr size_t WS_GGL = WS_GU + (size_t)GCH * 128 * 64 * 4;
constexpr size_t WS_R1 = WS_GGL + (size_t)GCH * 128 * 4;
constexpr size_t WS_R2 = WS_R1 + (size_t)RCH * 64 * 64 * 2;
constexpr size_t WS_R3 = WS_R2 + (size_t)RCH * 64 * 64 * 2;
constexpr size_t WS_R4 = WS_R3 + (size_t)RCH * 64 * 128 * 2;
constexpr size_t WS_RU = WS_R4 + (size_t)RCH * 64 * 128 * 2;
constexpr size_t WS_RVT = WS_RU + (size_t)RCH * 64 * 64 * 4;
constexpr size_t WS_RGL = WS_RVT + (size_t)RCH * 64 * 64 * 2;
constexpr size_t WS_LH = WS_RGL + (size_t)RCH * 64 * 4;
constexpr size_t WS_LP = WS_LH + (size_t)NTOK * 512 * 4;
constexpr size_t WS_LC = WS_LP + (size_t)NTOK * 512 * 4;
constexpr size_t WS_BAR = WS_LC + (size_t)128 * 512 * 4;
constexpr size_t WS_WUPT = WS_BAR + 16384;
constexpr size_t WS_AUPT = WS_WUPT + (size_t)NL * 768 * 96 * 2;
constexpr size_t WS_WXT = WS_AUPT + (size_t)NL * 768 * 96 * 2;
constexpr size_t WS_WAT = WS_WXT + (size_t)NL * 8 * 64 * 64 * 2;
constexpr size_t WS_END = WS_WAT + (size_t)NL * 8 * 64 * 64 * 2;

struct Args {
    const float* in[26];
    float* out; unsigned char* ws;
    int ph_lo, ph_hi;
};
enum { I_X = 0, I_NORMG, I_WIN, I_WOUT, I_LCW, I_LCB, I_LWX, I_LBX, I_LWA, I_LBA, I_LLAM, I_GCW, I_GALOG, I_GDT, I_GNG,
       I_RMU, I_RW0, I_RWUP, I_RA0, I_RAUP, I_RKK, I_RKA, I_RRK, I_RGNW, I_RGNB, I_FNG };

__device__ __forceinline__ int tid_l() { int t = threadIdx.x; asm volatile("" : "+v"(t)); return t; }
#define LBAR() do { asm volatile("s_waitcnt lgkmcnt(0)" ::: "memory"); __builtin_amdgcn_s_barrier(); asm volatile("" ::: "memory"); } while (0)
__device__ __forceinline__ int bid_l() { int b = blockIdx.x; asm volatile("" : "+s"(b)); return b; }
__device__ __forceinline__ int gdim_l() { int b = gridDim.x; asm volatile("" : "+s"(b)); return b; }
__device__ __forceinline__ const float* inp(LAS unsigned char* lds, int i) {
    const LAS unsigned* t = (const LAS unsigned*)(lds + 131072) + 2 * i;
    const unsigned lo = __builtin_amdgcn_readfirstlane(t[0]), hi = __builtin_amdgcn_readfirstlane(t[1]);
    return (const float*)(const __attribute__((address_space(1))) float*)(((unsigned long long)hi << 32) | lo);
}
__device__ __forceinline__ float bf2f(bf16_t b) { return __uint_as_float(((unsigned)b) << 16); }
typedef __bf16 bf2n_t __attribute__((ext_vector_type(2)));
__device__ __forceinline__ unsigned pk2(float lo, float hi) { const f32x2 v = {lo, hi}; const bf2n_t r = __builtin_convertvector(v, bf2n_t); return __builtin_bit_cast(unsigned, r); }
__device__ __forceinline__ bf16_t f2bf(float f) { return (bf16_t)(pk2(f, f) & 0xffffu); }
__device__ __forceinline__ float wave_sum(float v) {
#pragma unroll
    for (int o = 1; o < 64; o <<= 1) v += __shfl_xor(v, o);
    return v;
}
typedef __bf16 bf2_t __attribute__((ext_vector_type(2)));
__device__ __forceinline__ unsigned cvtpk(float lo, float hi) { const f32x2 v = {lo, hi}; const bf2_t r = __builtin_convertvector(v, bf2_t); return __builtin_bit_cast(unsigned, r); }
__device__ __forceinline__ float sigmoidf_(float x) { return __builtin_amdgcn_rcpf(1.0f + __expf(-x)); }
__device__ __forceinline__ float siluf_(float x) { return x * __builtin_amdgcn_rcpf(1.0f + __expf(-x)); }
__device__ __forceinline__ float softplusf_(float x) { return fmaxf(x, 0.f) + __logf(1.0f + __expf(-fabsf(x))); }
__device__ __forceinline__ float tanhf_(float x) { const float e = __expf(-2.0f * fabsf(x)); return copysignf((1.0f - e) * __builtin_amdgcn_rcpf(1.0f + e), x); }

__device__ __forceinline__ void transpose_item(const float* W, int K, int N, bf16_t* WT, const float* scale, bool remap, LAS float* scr, int item, int nblk, int lane) {
    const int kb = item / nblk, nb = item % nblk, k0 = 64 * kb, n0 = 32 * nb;
    int np = n0 + (lane & 31), oc;
    if (!remap) oc = np;
    else if (np < 4096) oc = np;
    else if (np < 7360) oc = np + 12;
    else if (np < 7372) oc = np - 7360 + 4096;
    else oc = -1;
    float vbuf[32], sbuf[32];
#pragma unroll
    for (int i = 0; i < 32; ++i) { const int kk = 2 * i + (lane >> 5); vbuf[i] = (oc >= 0) ? W[(size_t)(k0 + kk) * N + oc] : 0.f; sbuf[i] = scale ? scale[k0 + kk] : 1.0f; }
#pragma unroll
    for (int i = 0; i < 32; ++i) { const int kk = 2 * i + (lane >> 5); scr[kk * 33 + (lane & 31)] = vbuf[i] * sbuf[i]; }
    __builtin_amdgcn_s_waitcnt(0xc07f); asm volatile("s_waitcnt lgkmcnt(0)" ::: "memory");
    const int c = lane & 7;
#pragma unroll
    for (int j = 0; j < 4; ++j) { const int n = (lane >> 3) + 8 * j; const LAS float* s = scr + (8 * c) * 33 + n;
        u32x4 o; o.x = pk2(s[0 * 33], s[1 * 33]); o.y = pk2(s[2 * 33], s[3 * 33]); o.z = pk2(s[4 * 33], s[5 * 33]); o.w = pk2(s[6 * 33], s[7 * 33]);
        *(u32x4*)(WT + (size_t)(n0 + n) * K + k0 + 8 * c) = o; }
    asm volatile("s_waitcnt lgkmcnt(0)" ::: "memory");
}
__device__ __forceinline__ void phase_convert(const Args& a, LAS unsigned char* lds, int l_lo, int l_hi, int f_lo, int f_hi, int vb, int nvb, int small) {
    size_t wso_ = 0; asm volatile("" : "+s"(wso_)); unsigned char* ws = a.ws + wso_;
    const int tid = tid_l(), wave = __builtin_amdgcn_readfirstlane(tid >> 6), lane = tid & 63;
    LAS float* scr = (LAS float*)(lds + wave * 8448);
    const int gw = vb * 8 + wave, NGW = nvb * 8;
    constexpr int I_IN = (DM / 64) * (NP / 32), I_OUT = (DM / 64) * (DM / 32), PER_L = I_IN + I_OUT;
    const int i_lo = (PER_L / 64) * f_lo, i_hi = (PER_L / 64) * f_hi, span = i_hi - i_lo;
    for (int it = gw; it < (l_hi - l_lo) * span; it += NGW) {
        const int l = l_lo + it / span; int r = i_lo + it % span;
        if (r < I_IN) transpose_item(inp(lds, I_WIN) + (size_t)l * DM * NIN, DM, NIN, (bf16_t*)(ws + WS_WIN) + (size_t)l * NP * DM, inp(lds, I_NORMG) + l * DM, true, scr, r, NP / 32, lane);
        else transpose_item(inp(lds, I_WOUT) + (size_t)l * DM * DM, DM, DM, (bf16_t*)(ws + WS_WOUT) + (size_t)l * DM * DM, nullptr, false, scr, r - I_IN, DM / 32, lane);
    }
    if (small) {
        const int gt = vb * 512 + tid, NT_ = nvb * 512;
        const float* wup = inp(lds, I_RWUP); const float* aup = inp(lds, I_RAUP); bf16_t* WUPT = (bf16_t*)(ws + WS_WUPT); bf16_t* AUPT = (bf16_t*)(ws + WS_AUPT);
        for (int idx = gt; idx < NL * 768 * 96; idx += NT_) { const int i = idx % 96, j = (idx / 96) % 768, l = idx / (96 * 768); const size_t src = ((size_t)l * 96 + i) * 768 + j; WUPT[idx] = f2bf(wup[src]); AUPT[idx] = f2bf(aup[src]); }
        const float* wx = inp(lds, I_LWX); const float* wa = inp(lds, I_LWA); bf16_t* WXT = (bf16_t*)(ws + WS_WXT); bf16_t* WAT = (bf16_t*)(ws + WS_WAT);
        for (int idx = gt; idx < NL * 8 * 64 * 64; idx += NT_) { const int i = idx & 63, j = (idx >> 6) & 63, ln = idx >> 12; const size_t src = ((size_t)ln * 64 + i) * 64 + j; WXT[idx] = f2bf(wx[src]); WAT[idx] = f2bf(wa[src]); }
    }
}
__device__ __forceinline__ void phase_rms(const float* xin, bf16_t* xb) {
    const int tid = tid_l(), wave = tid >> 6, lane = tid & 63;
    const int gw = bid_l() * 8 + wave, NGW = gdim_l() * 8;
    for (int m = gw; m < NTOK; m += NGW) {
        const f32x4* xr = (const f32x4*)(xin + (size_t)m * DM) + lane;
        f32x4 v[8]; float s = 0.f;
#pragma unroll
        for (int j = 0; j < 8; ++j) { v[j] = xr[64 * j]; s += (v[j].x * v[j].x + v[j].y * v[j].y) + (v[j].z * v[j].z + v[j].w * v[j].w); }
        const float rstd = __builtin_amdgcn_rsqf(wave_sum(s) * (1.0f / DM) + 1e-6f);
        u32x2* o = (u32x2*)(xb + (size_t)m * DM) + lane;
#pragma unroll
        for (int j = 0; j < 8; ++j) { u32x2 w; w.x = pk2(v[j].x * rstd, v[j].y * rstd); w.y = pk2(v[j].z * rstd, v[j].w * rstd); o[64 * j] = w; }
    }
}
__device__ __forceinline__ void phase_final(const float* xin, const float* g, float* out) {
    const int tid = tid_l(), wave = tid >> 6, lane = tid & 63;
    const int gw = bid_l() * 8 + wave, NGW = gdim_l() * 8;
    for (int m = gw; m < NTOK; m += NGW) {
        const f32x4* xr = (const f32x4*)(xin + (size_t)m * DM) + lane;
        f32x4 v[8]; float s = 0.f;
#pragma unroll
        for (int j = 0; j < 8; ++j) { v[j] = xr[64 * j]; s += (v[j].x * v[j].x + v[j].y * v[j].y) + (v[j].z * v[j].z + v[j].w * v[j].w); }
        const float rstd = __builtin_amdgcn_rsqf(wave_sum(s) * (1.0f / DM) + 1e-6f);
        f32x4* o = (f32x4*)(out + (size_t)m * DM) + lane; const f32x4* gg = (const f32x4*)g + lane;
#pragma unroll
        for (int j = 0; j < 8; ++j) o[64 * j] = v[j] * rstd * gg[64 * j];
    }
}
struct EpiDual {
    static constexpr bool PERM = true, AFTER_DRAIN = false;
    int mode; bf16_t* O; int ldo; const float* base; float* C; int ldc;
    __device__ __forceinline__ void operator()(const pg8::f32x4 (&acc)[2][2][4][2], const pg8::Unit& u, int wr, int wc, int fr, int fq) const {
        const int row0 = u.pm * 256 + wr * 64 + fr, col0 = u.pn * 256 + wc * 32 + 8 * fq;
        if (mode == 0) {
#pragma unroll
            for (int ai = 0; ai < 2; ++ai)
#pragma unroll
                for (int m = 0; m < 4; ++m) { bf16_t* rowp = O + (size_t)(row0 + ai * 128 + m * 16) * ldo + col0;
#pragma unroll
                    for (int bj = 0; bj < 2; ++bj) { const pg8::f32x4 v0 = acc[ai][bj][m][0], v1 = acc[ai][bj][m][1];
                        pg8::u32x4 w; w.x = cvtpk(v0[0], v0[1]); w.y = cvtpk(v0[2], v0[3]); w.z = cvtpk(v1[0], v1[1]); w.w = cvtpk(v1[2], v1[3]);
                        *(pg8::u32x4*)(rowp + bj * 128) = w; } }
        } else {
#pragma unroll
            for (int ai = 0; ai < 2; ++ai)
#pragma unroll
                for (int m = 0; m < 4; ++m) { const size_t off = (size_t)(row0 + ai * 128 + m * 16) * ldc + col0;
#pragma unroll
                    for (int bj = 0; bj < 2; ++bj)
#pragma unroll
                        for (int n = 0; n < 2; ++n) { const pg8::f32x4 b = *(const pg8::f32x4*)(base + off + bj * 128 + n * 4); *(pg8::f32x4*)(C + off + bj * 128 + n * 4) = acc[ai][bj][m][n] + b; }
                    asm volatile("" ::: "memory"); }
        }
    }
};
constexpr int PT = 32;
typedef short bf16x8 __attribute__((ext_vector_type(8)));
__device__ __forceinline__ float sum16(float v) { v += __shfl_xor(v, 1); v += __shfl_xor(v, 2); v += __shfl_xor(v, 4); v += __shfl_xor(v, 8); return v; }
__device__ __forceinline__ void phase_prep(const Args& a, int l, LAS unsigned char* lds) {
    size_t wso_ = 0; asm volatile("" : "+s"(wso_)); unsigned char* ws = a.ws + wso_;
    const int tid0 = tid_l(), wave = __builtin_amdgcn_readfirstlane(tid0 >> 6);
    const bf16_t* PROJ = (const bf16_t*)(ws + WS_PROJ);
    constexpr int XSR = 200, XLR = 520;
    LAS bf16_t* xsb = (LAS bf16_t*)lds;
    LAS bf16_t* xlb = (LAS bf16_t*)(lds + PT * XSR * 2);
    LAS float* xlf = (LAS float*)(lds + PT * XSR * 2 + PT * XLR * 2);
    float* GQ = (float*)(ws + WS_GQ); float* GK = (float*)(ws + WS_GK); float* GV = (float*)(ws + WS_GV);
    float* GB = (float*)(ws + WS_GB); float* GG = (float*)(ws + WS_GG);
    float* RR = (float*)(ws + WS_RR); float* RWd = (float*)(ws + WS_RW); float* RK = (float*)(ws + WS_RK); float* RV = (float*)(ws + WS_RV);
    float* RKK = (float*)(ws + WS_RKK); float* RB = (float*)(ws + WS_RB);
    float* LA = (float*)(ws + WS_LA); float* LU = (float*)(ws + WS_LU);
    const float* mu = inp(lds, I_RMU) + l * 2496;
    for (int tile = bid_l(); tile < NTOK / PT; tile += gdim_l()) {
        int tid = tid0; asm volatile("" : "+v"(tid)); const int lane = tid & 63, lr = lane & 15, lq = lane >> 4;
        const int t0 = tile * PT, sp = t0 % SEQ;
        { bf16_t curv[12], prevv[12];
#pragma unroll
            for (int q = 0; q < 12; ++q) { const int idx = tid + 512 * q, tt = idx / 192, i = idx % 192; const int col = PC_CIN + 2304 + i;
                curv[q] = PROJ[(size_t)(t0 + tt) * NP + col]; prevv[q] = PROJ[(size_t)(t0 + tt - ((sp + tt > 0) ? 1 : 0)) * NP + col]; }
#pragma unroll
            for (int q = 0; q < 12; ++q) { const int idx = tid + 512 * q, tt = idx / 192, i = idx % 192; const float cur = bf2f(curv[q]), prev = (sp + tt > 0) ? bf2f(prevv[q]) : 0.f;
                float xs = cur + (prev - cur) * mu[2304 + i]; if (i < 96) xs = tanhf_(xs); xsb[tt * XSR + i] = f2bf(xs); } }
        { const int j = tid; const float* cw = inp(lds, I_LCW) + l * 4 * LRUW; const float w0 = cw[j], w1 = cw[LRUW + j], w2 = cw[2 * LRUW + j], w3 = cw[3 * LRUW + j], cb = inp(lds, I_LCB)[l * LRUW + j];
            float xm3 = (sp >= 3) ? bf2f(PROJ[(size_t)(t0 - 3) * NP + PC_AX + j]) : 0.f, xm2 = (sp >= 2) ? bf2f(PROJ[(size_t)(t0 - 2) * NP + PC_AX + j]) : 0.f, xm1 = (sp >= 1) ? bf2f(PROJ[(size_t)(t0 - 1) * NP + PC_AX + j]) : 0.f;
            bf16_t cv[PT];
#pragma unroll
            for (int tt = 0; tt < PT; ++tt) cv[tt] = PROJ[(size_t)(t0 + tt) * NP + PC_AX + j];
#pragma unroll
            for (int tt = 0; tt < PT; ++tt) { const float cur = bf2f(cv[tt]); const float x = w0 * xm3 + w1 * xm2 + w2 * xm1 + w3 * cur + cb; xlf[tt * 512 + j] = x; xlb[tt * XLR + j] = f2bf(x); xm3 = xm2; xm2 = xm1; xm1 = cur; } }
        LBAR();
        for (int u = wave; u < 24; u += 8) { const int h = u % 12, tb = u / 12;
            bf16x8 xw[3], xa[3];
#pragma unroll
            for (int k = 0; k < 3; ++k) { xw[k] = *(const LAS bf16x8*)(xsb + (tb * 16 + lr) * XSR + 32 * k + 8 * lq); xa[k] = *(const LAS bf16x8*)(xsb + (tb * 16 + lr) * XSR + 96 + 32 * k + 8 * lq); }
            f32x4 aw[4], aa[4];
#pragma unroll
            for (int jq = 0; jq < 4; ++jq) { const int jrow = l * 768 + h * 64 + jq * 16 + lr; const bf16_t* pw = (const bf16_t*)(ws + WS_WUPT) + (size_t)jrow * 96 + 8 * lq; const bf16_t* pa = (const bf16_t*)(ws + WS_AUPT) + (size_t)jrow * 96 + 8 * lq;
                aw[jq] = (f32x4){0.f, 0.f, 0.f, 0.f}; aa[jq] = (f32x4){0.f, 0.f, 0.f, 0.f};
#pragma unroll
                for (int k = 0; k < 3; ++k) { aw[jq] = __builtin_amdgcn_mfma_f32_16x16x32_bf16(xw[k], *(const bf16x8*)(pw + 32 * k), aw[jq], 0, 0, 0); aa[jq] = __builtin_amdgcn_mfma_f32_16x16x32_bf16(xa[k], *(const bf16x8*)(pa + 32 * k), aa[jq], 0, 0, 0); } }
            const int tokb = tb * 16 + 4 * lq;
            bf16_t pr_[5][4], pk_[5][4], pv_[5][4];
#pragma unroll
            for (int rr = 0; rr < 5; ++rr) { const int trow = t0 + tokb + rr - ((rr == 0 && sp + tokb == 0) ? 0 : 1);
#pragma unroll
                for (int jq = 0; jq < 4; ++jq) { const bf16_t* p = PROJ + (size_t)trow * NP + PC_CIN + h * 64 + jq * 16 + lr; pr_[rr][jq] = p[0]; pk_[rr][jq] = p[768]; pv_[rr][jq] = p[1536]; } }
            float w0v[4], a0v[4], kkwv[4], kawv[4], murv[4], mukv[4], muvv[4];
#pragma unroll
            for (int jq = 0; jq < 4; ++jq) { const int j = h * 64 + jq * 16 + lr; w0v[jq] = inp(lds, I_RW0)[l * 768 + j]; a0v[jq] = inp(lds, I_RA0)[l * 768 + j]; kkwv[jq] = inp(lds, I_RKK)[l * 768 + j]; kawv[jq] = inp(lds, I_RKA)[l * 768 + j];
                murv[jq] = mu[j]; mukv[jq] = mu[768 + j]; muvv[jq] = mu[1536 + j]; }
#pragma unroll
            for (int r = 0; r < 4; ++r) { const bool first = (sp + tokb + r == 0);
                float kr[4], kv_[4], rv_[4], vv_[4], av_[4]; float ss = 0.f;
#pragma unroll
                for (int jq = 0; jq < 4; ++jq) { const float cr = bf2f(pr_[r + 1][jq]), ck = bf2f(pk_[r + 1][jq]), cvv = bf2f(pv_[r + 1][jq]);
                    const float qr = first ? 0.f : bf2f(pr_[r][jq]), qk = first ? 0.f : bf2f(pk_[r][jq]), qv = first ? 0.f : bf2f(pv_[r][jq]);
                    rv_[jq] = cr + (qr - cr) * murv[jq]; kv_[jq] = ck + (qk - ck) * mukv[jq]; vv_[jq] = cvv + (qv - cvv) * muvv[jq];
                    av_[jq] = sigmoidf_(a0v[jq] + aa[jq][r]); kr[jq] = kv_[jq] * kkwv[jq]; ss += kr[jq] * kr[jq]; }
                ss = sum16(ss); const float rs = __builtin_amdgcn_rsqf(ss + 1e-6f);
#pragma unroll
                for (int jq = 0; jq < 4; ++jq) { const size_t o = (size_t)(t0 + tokb + r) * 768 + h * 64 + jq * 16 + lr;
                    const float wlog = -softplusf_(-(w0v[jq] + aw[jq][r])) - 0.5f; RWd[o] = -__expf(wlog);
                    const float kk = kr[jq] * rs; RR[o] = rv_[jq]; RK[o] = kv_[jq] * (1.0f + (av_[jq] - 1.0f) * kawv[jq]); RV[o] = vv_[jq]; RKK[o] = kk; RB[o] = kk * av_[jq]; } }
        }
        for (int u = wave; u < 16; u += 8) { const int n = u & 7, tb = u >> 3;
            bf16x8 xg[2];
#pragma unroll
            for (int k = 0; k < 2; ++k) xg[k] = *(const LAS bf16x8*)(xlb + (tb * 16 + lr) * XLR + n * 64 + 32 * k + 8 * lq);
            f32x4 ax[4], ag[4];
#pragma unroll
            for (int jq = 0; jq < 4; ++jq) { const size_t jrow = (size_t)(l * 8 + n) * 64 + jq * 16 + lr; const bf16_t* px = (const bf16_t*)(ws + WS_WXT) + jrow * 64 + 8 * lq; const bf16_t* pa = (const bf16_t*)(ws + WS_WAT) + jrow * 64 + 8 * lq;
                ax[jq] = (f32x4){0.f, 0.f, 0.f, 0.f}; ag[jq] = (f32x4){0.f, 0.f, 0.f, 0.f};
#pragma unroll
                for (int k = 0; k < 2; ++k) { ax[jq] = __builtin_amdgcn_mfma_f32_16x16x32_bf16(xg[k], *(const bf16x8*)(px + 32 * k), ax[jq], 0, 0, 0); ag[jq] = __builtin_amdgcn_mfma_f32_16x16x32_bf16(xg[k], *(const bf16x8*)(pa + 32 * k), ag[jq], 0, 0, 0); } }
#pragma unroll
            for (int jq = 0; jq < 4; ++jq) { const int j = n * 64 + jq * 16 + lr; const float bx = inp(lds, I_LBX)[l * 512 + j], ba = inp(lds, I_LBA)[l * 512 + j]; const float spl = softplusf_(-inp(lds, I_LLAM)[l * 512 + j]);
#pragma unroll
                for (int r = 0; r < 4; ++r) { const int tt = tb * 16 + 4 * lq + r; const float gx = sigmoidf_(ax[jq][r] + bx), ga = sigmoidf_(ag[jq][r] + ba);
                    const float loga = -8.0f * ga * spl; const float av = __expf(loga); const float mult = __builtin_amdgcn_sqrtf(fmaxf(1.0f - __expf(2.0f * loga), 0.f));
                    LA[(size_t)(t0 + tt) * 512 + j] = av; LU[(size_t)(t0 + tt) * 512 + j] = mult * gx * xlf[tt * 512 + j]; } } }
        for (int wt = wave; wt < 18; wt += 8) { const int ch0 = 128 * wt + 2 * lane; const float* cw = inp(lds, I_GCW) + (size_t)l * 4 * 2304 + ch0;
            const f32x2 w0 = *(const f32x2*)(cw), w1 = *(const f32x2*)(cw + 2304), w2 = *(const f32x2*)(cw + 2 * 2304), w3 = *(const f32x2*)(cw + 3 * 2304);
            f32x2 xm3 = {0.f, 0.f}, xm2 = {0.f, 0.f}, xm1 = {0.f, 0.f};
            const bf16_t* pc = PROJ + PC_BQKV + ch0;
            if (sp >= 3) { const unsigned q = *(const unsigned*)(pc + (size_t)(t0 - 3) * NP); xm3.x = __uint_as_float(q << 16); xm3.y = __uint_as_float(q & 0xffff0000u); }
            if (sp >= 2) { const unsigned q = *(const unsigned*)(pc + (size_t)(t0 - 2) * NP); xm2.x = __uint_as_float(q << 16); xm2.y = __uint_as_float(q & 0xffff0000u); }
            if (sp >= 1) { const unsigned q = *(const unsigned*)(pc + (size_t)(t0 - 1) * NP); xm1.x = __uint_as_float(q << 16); xm1.y = __uint_as_float(q & 0xffff0000u); }
            float* dst = (wt < 6) ? GQ : (wt < 12 ? GK : GV); const int dch = ch0 % 768;
            unsigned qv[PT];
#pragma unroll
            for (int tt = 0; tt < PT; ++tt) qv[tt] = *(const unsigned*)(pc + (size_t)(t0 + tt) * NP);
#pragma unroll
            for (int tt = 0; tt < PT; ++tt) { const unsigned q = qv[tt]; f32x2 cur; cur.x = __uint_as_float(q << 16); cur.y = __uint_as_float(q & 0xffff0000u);
                f32x2 v = w0 * xm3 + w1 * xm2 + w2 * xm1 + w3 * cur; v.x = siluf_(v.x); v.y = siluf_(v.y);
                if (wt < 12) { const float ss = wave_sum(v.x * v.x + v.y * v.y); float sc = __builtin_amdgcn_rsqf(ss + 1e-6f); if (wt < 6) sc *= 0.08838834764831845f; v = v * sc; }
                *(f32x2*)(dst + (size_t)(t0 + tt) * 768 + dch) = v; xm3 = xm2; xm2 = xm1; xm1 = cur; } }
        if (tid < PT * 6) { const int tt = tid / 6, h = tid % 6; const float bl = bf2f(PROJ[(size_t)(t0 + tt) * NP + PC_BETA + h]), al = bf2f(PROJ[(size_t)(t0 + tt) * NP + PC_BA + h]);
            GB[(size_t)(t0 + tt) * 8 + h] = sigmoidf_(bl); GG[(size_t)(t0 + tt) * 8 + h] = -__expf(inp(lds, I_GALOG)[l * 6 + h]) * softplusf_(al + inp(lds, I_GDT)[l * 6 + h]); }
        LBAR();
    }
}
typedef short bf16x8 __attribute__((ext_vector_type(8)));
struct ScanRec { const bf16_t* M1; const bf16_t* M2; const bf16_t* M3; const bf16_t* M4T; const float* UT; const float* G; const bf16_t* VT; };
template <int D, int KZ, bool EXT>
__device__ __forceinline__ void scan_item(const ScanRec R0, int e0, float* OUT, int out_ld, LAS unsigned char* lds) {
    constexpr int NK1 = D / 32, NK2 = KZ / 32, NT3 = D / 64, SROW = D + 8, ZROW = KZ + 8, HD = EXT ? 64 : 128;
    constexpr bool GS = !EXT;
    const int tid = tid_l(), w = __builtin_amdgcn_readfirstlane(tid >> 6), lane = tid & 63, lr = lane & 15, lq = lane >> 4;
    const bool front = (w < 4); const int cb = w & 3;
    LAS bf16_t* ST = (LAS bf16_t*)lds;
    LAS bf16_t* ZT = (LAS bf16_t*)(lds + 2 * 32 * SROW * 2);
    constexpr int OSROW = 36;
    LAS float* OS = (LAS float*)(lds + 2 * 32 * SROW * 2 + 32 * ZROW * 2);
    for (int i = tid; i < 2 * 32 * SROW / 2; i += 512) ((LAS unsigned*)ST)[i] = 0u;
    struct FS { bf16x8 m1[NK1], m3[NK2]; f32x4 ut[2]; u32x4 vt; };
    struct BS { bf16x8 m4[NT3][NK2]; f32x4 g[GS ? 1 : NT3]; float gs; };
#define SCAN_LOADF(s, n) do { \
        const bf16_t* a1_ = R0.M1 + (size_t)(n) * 64 * D + (cb * 16 + lr) * D + 8 * lq; \
        _Pragma("unroll") for (int k = 0; k < NK1; ++k) s.m1[k] = *(const bf16x8*)(a1_ + 32 * k); \
        const bf16_t* a3_ = R0.M3 + (size_t)(n) * 64 * KZ + (cb * 16 + lr) * KZ + 8 * lq; \
        _Pragma("unroll") for (int k = 0; k < NK2; ++k) s.m3[k] = *(const bf16x8*)(a3_ + 32 * k); \
        _Pragma("unroll") for (int j = 0; j < 2; ++j) s.ut[j] = *(const f32x4*)(R0.UT + (size_t)(n) * HD * 64 + (size_t)(e0 + j * 16 + lr) * 64 + cb * 16 + 4 * lq); \
        if (EXT) s.vt = *(const u32x4*)(R0.VT + (size_t)(n) * 64 * 64 + (size_t)(e0 + (tid >> 3)) * 64 + (tid & 7) * 8); } while (0)
#define SCAN_LOADB(s, n) do { \
        _Pragma("unroll") for (int t = 0; t < NT3; ++t) { const int db = cb + 4 * t; const bf16_t* a4_ = R0.M4T + (size_t)(n) * D * KZ + (db * 16 + lr) * KZ + 8 * lq; \
            _Pragma("unroll") for (int k = 0; k < NK2; ++k) s.m4[t][k] = *(const bf16x8*)(a4_ + 32 * k); \
            if (!GS) s.g[t] = *(const f32x4*)(R0.G + (size_t)(n) * D + db * 16 + 4 * lq); } \
        if (GS) s.gs = R0.G[(size_t)(n) * D]; } while (0)
#define SCAN_OUT(n) do { const f32x4 ov = *(const LAS f32x4*)(OS + (tid >> 3) * OSROW + (tid & 7) * 4); *(f32x4*)(OUT + (size_t)((n) * 64 + (tid >> 3)) * out_ld + e0 + (tid & 7) * 4) = ov; } while (0)
#define SCAN_STEP_F(n, par, fc, fl) do { \
        LAS bf16_t* STo = ST + (par) * 32 * SROW; \
        bf16x8 m2l[NK1]; \
        { const bf16_t* a2_ = R0.M2 + (size_t)(n) * 64 * D + (cb * 16 + lr) * D + 8 * lq; _Pragma("unroll") for (int k = 0; k < NK1; ++k) m2l[k] = *(const bf16x8*)(a2_ + 32 * k); }     \
        if ((n) + 2 < 32) SCAN_LOADF(fl, (n) + 2); \
        _Pragma("unroll") for (int j = 0; j < 2; ++j) { f32x4 a1 = fc.ut[j]; \
            _Pragma("unroll") for (int k = 0; k < NK1; ++k) { const bf16x8 y = *(const LAS bf16x8*)(STo + (j * 16 + lr) * SROW + 32 * k + 8 * lq); a1 = __builtin_amdgcn_mfma_f32_16x16x32_bf16(fc.m1[k], y, a1, 0, 0, 0); } \
            u32x2 zz; zz.x = cvtpk(a1[0], a1[1]); zz.y = cvtpk(a1[2], a1[3]); *(LAS u32x2*)(ZT + (j * 16 + lr) * ZROW + cb * 16 + 4 * lq) = zz; } \
        if (EXT) *(LAS u32x4*)(ZT + (tid >> 3) * ZROW + 64 + (tid & 7) * 8) = fc.vt; \
        LBAR(); \
        _Pragma("unroll") for (int j = 0; j < 2; ++j) { f32x4 a2 = (f32x4){0.f, 0.f, 0.f, 0.f}; \
            _Pragma("unroll") for (int k = 0; k < NK2; ++k) { const bf16x8 z = *(const LAS bf16x8*)(ZT + (j * 16 + lr) * ZROW + 32 * k + 8 * lq); a2 = __builtin_amdgcn_mfma_f32_16x16x32_bf16(fc.m3[k], z, a2, 0, 0, 0); } \
            _Pragma("unroll") for (int k = 0; k < NK1; ++k) { const bf16x8 y = *(const LAS bf16x8*)(STo + (j * 16 + lr) * SROW + 32 * k + 8 * lq); a2 = __builtin_amdgcn_mfma_f32_16x16x32_bf16(m2l[k], y, a2, 0, 0, 0); } \
            _Pragma("unroll") for (int r = 0; r < 4; ++r) OS[(cb * 16 + 4 * lq + r) * OSROW + j * 16 + lr] = a2[r]; } \
        LBAR(); \
        SCAN_OUT(n); } while (0)
#define SCAN_STEP_B(n, par, bc, bl) do { \
        LAS bf16_t* STn = ST + (1 - (par)) * 32 * SROW; \
        if ((n) + 2 < 32) SCAN_LOADB(bl, (n) + 2); \
        LBAR(); \
        _Pragma("unroll") for (int j = 0; j < 2; ++j) { \
            _Pragma("unroll") for (int t = 0; t < NT3; ++t) { if (GS) accs[t][j] = accs[t][j] * bc.gs; else accs[t][j] = accs[t][j] * bc.g[GS ? 0 : t]; } \
            _Pragma("unroll") for (int k = 0; k < NK2; ++k) { const bf16x8 z = *(const LAS bf16x8*)(ZT + (j * 16 + lr) * ZROW + 32 * k + 8 * lq); \
                _Pragma("unroll") for (int t = 0; t < NT3; ++t) accs[t][j] = __builtin_amdgcn_mfma_f32_16x16x32_bf16(bc.m4[t][k], z, accs[t][j], 0, 0, 0); } \
            _Pragma("unroll") for (int t = 0; t < NT3; ++t) { const int db = cb + 4 * t; u32x2 ss; ss.x = cvtpk(accs[t][j][0], accs[t][j][1]); ss.y = cvtpk(accs[t][j][2], accs[t][j][3]); *(LAS u32x2*)(STn + (j * 16 + lr) * SROW + db * 16 + 4 * lq) = ss; } } \
        LBAR(); \
        SCAN_OUT(n); } while (0)
    if (front) {
        FS f0, f1, f2;
        SCAN_LOADF(f0, 0); SCAN_LOADF(f1, 1);
        __builtin_amdgcn_s_waitcnt(0x0F70);
        LBAR();
        for (int n0 = 0; n0 < 30; n0 += 6) {
            SCAN_STEP_F(n0, 0, f0, f2); SCAN_STEP_F(n0 + 1, 1, f1, f0); SCAN_STEP_F(n0 + 2, 0, f2, f1);
            SCAN_STEP_F(n0 + 3, 1, f0, f2); SCAN_STEP_F(n0 + 4, 0, f1, f0); SCAN_STEP_F(n0 + 5, 1, f2, f1);
        }
        SCAN_STEP_F(30, 0, f0, f2); SCAN_STEP_F(31, 1, f1, f0);
    } else {
        BS b0, b1, b2;
        f32x4 accs[NT3][2];
#pragma unroll
        for (int t = 0; t < NT3; ++t) { accs[t][0] = (f32x4){0.f, 0.f, 0.f, 0.f}; accs[t][1] = (f32x4){0.f, 0.f, 0.f, 0.f}; }
        SCAN_LOADB(b0, 0); SCAN_LOADB(b1, 1);
        __builtin_amdgcn_s_waitcnt(0x0F70);
        LBAR();
        for (int n0 = 0; n0 < 30; n0 += 6) {
            SCAN_STEP_B(n0, 0, b0, b2); SCAN_STEP_B(n0 + 1, 1, b1, b0); SCAN_STEP_B(n0 + 2, 0, b2, b1);
            SCAN_STEP_B(n0 + 3, 1, b0, b2); SCAN_STEP_B(n0 + 4, 0, b1, b0); SCAN_STEP_B(n0 + 5, 1, b2, b1);
        }
        SCAN_STEP_B(30, 0, b0, b2); SCAN_STEP_B(31, 1, b1, b0);
    }
#undef SCAN_STEP_F
#undef SCAN_STEP_B
#undef SCAN_OUT
#undef SCAN_LOADF
#undef SCAN_LOADB
}

__device__ __forceinline__ void phase_gdn_chunk(const Args& a, int l, LAS unsigned char* lds) {
    size_t wso_ = 0; asm volatile("" : "+s"(wso_)); unsigned char* ws = a.ws + wso_;
    const int tid0 = tid_l(), w = __builtin_amdgcn_readfirstlane(tid0 >> 6);
    const float* GQ = (const float*)(ws + WS_GQ); const float* GK = (const float*)(ws + WS_GK); const float* GV = (const float*)(ws + WS_GV);
    const float* GB = (const float*)(ws + WS_GB); const float* GG = (const float*)(ws + WS_GG);
    constexpr int KROW = 136;
    LAS bf16_t* Kb = (LAS bf16_t*)lds;
    LAS bf16_t* Qb = (LAS bf16_t*)(lds + 64 * KROW * 2);
    LAS float* Af = (LAS float*)(lds + 2 * 64 * KROW * 2);
    LAS float* dvb = Af + 64 * 64;
    const int first = bid_l(), gstep = gdim_l();
    const int nmine = (first < GCH) ? (GCH - first + gstep - 1) / gstep : 0;
    for (int k = -1; k < nmine; ++k) {
        int tid = tid0; asm volatile("" : "+v"(tid)); const int lane = tid & 63, lr = lane & 15, lq = lane >> 4;
        LBAR();
        if (w < 4) {
            const bool act = (k >= 0); const int item = first + (act ? k : 0) * gstep;
            const int b = item / 192, h = (item / 32) % 6, n = item % 32; const size_t t0 = (size_t)b * SEQ + n * 64;
            LAS float* dv = dvb + (k & 1) * 128; LAS float* bv = dv + 64;
            const int col = tid; const bool isu = (w < 2); const int cc = col & 127;
            float X[64]; int Arow[63];
            if (act) {
                const float* src = (isu ? GV : GK) + t0 * 768 + h * 128 + cc;
#pragma unroll
                for (int c = 0; c < 64; ++c) X[c] = src[(size_t)c * 768];
#pragma unroll
                for (int m = 0; m < 63; ++m) Arow[m] = __float_as_int(Af[m * 64 + lane]);
                if (isu) {
#pragma unroll
                    for (int c = 0; c < 64; ++c) X[c] *= bv[c]; }
                else {
#pragma unroll
                    for (int c = 0; c < 64; ++c) X[c] *= bv[c] * __expf(dv[c]); }
            }
            LBAR();
            if (act) {
#pragma unroll
                for (int m = 0; m < 63; ++m) { const float xm = X[m];
#pragma unroll
                    for (int c = m + 1; c < 64; ++c) X[c] -= __int_as_float(__builtin_amdgcn_readlane(Arow[m], c)) * xm; }
            }
            LBAR();
            if (act) {
                if (isu) { float* UT = (float*)(ws + WS_GU) + (size_t)item * 128 * 64 + (size_t)cc * 64;
#pragma unroll
                    for (int c4 = 0; c4 < 16; ++c4) *(f32x4*)(UT + 4 * c4) = (f32x4){X[4 * c4], X[4 * c4 + 1], X[4 * c4 + 2], X[4 * c4 + 3]}; }
                else { bf16_t* M1 = (bf16_t*)(ws + WS_G1) + (size_t)item * 64 * 128 + cc;
#pragma unroll
                    for (int c = 0; c < 64; ++c) M1[c * 128] = f2bf(-X[c]); }
            }
        } else {
            const bool act = (k + 1 < nmine); const int item = first + (act ? (k + 1) : 0) * gstep;
            const int b = item / 192, h = (item / 32) % 6, n = item % 32; const size_t t0 = (size_t)b * SEQ + n * 64;
            LAS float* dv = dvb + ((k + 1) & 1) * 128; LAS float* bv = dv + 64;
            const int t = tid - 256, wb = w - 4;
            if (act) {
                float gpre = 0.f, bpre = 0.f; if (wb == 0) { gpre = GG[(t0 + lane) * 8 + h]; bpre = GB[(t0 + lane) * 8 + h]; }
#pragma unroll
                for (int hf = 0; hf < 2; ++hf) { f32x4 kv4[4], qv4[4];
#pragma unroll
                    for (int q = 0; q < 4; ++q) { const int idx = t + 256 * (4 * hf + q), c = idx >> 5, d4 = idx & 31; const size_t g = (t0 + c) * 768 + h * 128 + d4 * 4; kv4[q] = *(const f32x4*)(GK + g); qv4[q] = *(const f32x4*)(GQ + g); }
#pragma unroll
                    for (int q = 0; q < 4; ++q) { const int idx = t + 256 * (4 * hf + q), c = idx >> 5, d4 = idx & 31; const f32x4 kv = kv4[q], qv = qv4[q];
                        u32x2 pk; pk.x = cvtpk(kv[0], kv[1]); pk.y = cvtpk(kv[2], kv[3]); *(LAS u32x2*)(Kb + c * KROW + d4 * 4) = pk;
                        u32x2 pq; pq.x = cvtpk(qv[0], qv[1]); pq.y = cvtpk(qv[2], qv[3]); *(LAS u32x2*)(Qb + c * KROW + d4 * 4) = pq; } }
                if (wb == 0) { float g = gpre;
#pragma unroll
                    for (int o = 1; o < 64; o <<= 1) { const float tt = __shfl_up(g, o); if (lane >= o) g += tt; }
                    dv[lane] = g; bv[lane] = bpre; }
            }
            LBAR();
            if (act) {
                const int which = wb >> 1; const LAS bf16_t* X = which ? Qb : Kb;
                bf16_t* M3 = (bf16_t*)(ws + WS_G3) + (size_t)item * 64 * 64;
#pragma unroll
                for (int ci = 0; ci < 2; ++ci) { const int cb = 2 * (wb & 1) + ci;
                    bf16x8 xf[4];
#pragma unroll
                    for (int kk = 0; kk < 4; ++kk) xf[kk] = *(const LAS bf16x8*)(X + (cb * 16 + lr) * KROW + 32 * kk + 8 * lq);
#pragma unroll
                    for (int mb = 0; mb < 4; ++mb) { f32x4 acc = (f32x4){0.f, 0.f, 0.f, 0.f};
#pragma unroll
                        for (int kk = 0; kk < 4; ++kk) { const bf16x8 yf = *(const LAS bf16x8*)(Kb + (mb * 16 + lr) * KROW + 32 * kk + 8 * lq); acc = __builtin_amdgcn_mfma_f32_16x16x32_bf16(xf[kk], yf, acc, 0, 0, 0); }
                        const int m = mb * 16 + lr; const float dm = dv[m];
                        if (which == 0) { f32x4 o;
#pragma unroll
                            for (int r = 0; r < 4; ++r) { const int c = cb * 16 + 4 * lq + r; o[r] = (c > m) ? bv[c] * acc[r] * __expf(dv[c] - dm) : 0.f; }
                            *(LAS f32x4*)(Af + m * 64 + cb * 16 + 4 * lq) = o; }
                        else {
#pragma unroll
                            for (int r = 0; r < 4; ++r) { const int c = cb * 16 + 4 * lq + r; M3[c * 64 + m] = f2bf((c >= m) ? acc[r] * __expf(dv[c] - dm) : 0.f); } } } }
            }
            LBAR();
            if (act) {
                const float dl = dv[63];
                bf16_t* M2 = (bf16_t*)(ws + WS_G2) + (size_t)item * 64 * 128;
#pragma unroll
                for (int q = 0; q < 8; ++q) { const int idx = t + 256 * q, c = idx >> 5, d4 = idx & 31; const u32x2 qq = *(const LAS u32x2*)(Qb + c * KROW + d4 * 4); const float e = __expf(dv[c]);
                    u32x2 p; p.x = cvtpk(__uint_as_float(qq.x << 16) * e, __uint_as_float(qq.x & 0xffff0000u) * e); p.y = cvtpk(__uint_as_float(qq.y << 16) * e, __uint_as_float(qq.y & 0xffff0000u) * e); *(u32x2*)(M2 + c * 128 + d4 * 4) = p; }
                { const int d = t & 127, ch = t >> 7; bf16_t* M4 = (bf16_t*)(ws + WS_G4) + (size_t)item * 128 * 64 + d * 64 + ch * 32;
#pragma unroll
                    for (int q = 0; q < 4; ++q) { float kv[8];
#pragma unroll
                        for (int j = 0; j < 8; ++j) { const int c = ch * 32 + q * 8 + j; kv[j] = bf2f(Kb[c * KROW + d]) * __expf(dl - dv[c]); }
                        u32x4 p; p.x = cvtpk(kv[0], kv[1]); p.y = cvtpk(kv[2], kv[3]); p.z = cvtpk(kv[4], kv[5]); p.w = cvtpk(kv[6], kv[7]); *(u32x4*)(M4 + q * 8) = p; } }
                if (t < 128) ((float*)(ws + WS_GGL))[(size_t)item * 128 + t] = __expf(dl);
            }
        }
    }
    LBAR();
}

__device__ __forceinline__ void phase_rwkv_chunk(const Args& a, int l, LAS unsigned char* lds) {
    size_t wso_ = 0; asm volatile("" : "+s"(wso_)); unsigned char* ws = a.ws + wso_;
    const int tid0 = tid_l(), w = __builtin_amdgcn_readfirstlane(tid0 >> 6);
    const float* RR = (const float*)(ws + WS_RR); const float* RWl = (const float*)(ws + WS_RW); const float* RK = (const float*)(ws + WS_RK); const float* RV = (const float*)(ws + WS_RV);
    const float* RKK = (const float*)(ws + WS_RKK); const float* RB = (const float*)(ws + WS_RB);
    constexpr int OR_ = 72;
    LAS float* cw = (LAS float*)lds;
    LAS bf16_t* M3s = (LAS bf16_t*)lds;
    LAS bf16_t* Al = (LAS bf16_t*)(lds + 16384); LAS bf16_t* Be = Al + 64 * OR_; LAS bf16_t* Ka = Be + 64 * OR_; LAS bf16_t* Rh = Ka + 64 * OR_;
    LAS float* ABf = (LAS float*)(lds + 53248);
    LAS bf16_t* AKb = (LAS bf16_t*)(lds + 69632);
    LAS bf16_t* VTb = (LAS bf16_t*)(lds + 78848);
    LAS float* RH2 = (LAS float*)(lds + 88064);
    LAS bf16_t* M4s = (LAS bf16_t*)(lds + 104448);
    LAS float* segt = (LAS float*)(lds + 121856);
    const int first = bid_l(), gstep = gdim_l();
    const int nmine = (first < RCH) ? (RCH - first + gstep - 1) / gstep : 0;
    if (w < 2) {
    for (int k = -1; k < nmine; ++k) {
        int tid = tid0; asm volatile("" : "+v"(tid)); const int lane = tid & 63, lr = lane & 15, lq = lane >> 4;
            const bool act = (k >= 0); const int item = first + (act ? k : 0) * gstep;
            const bool isom = (w == 0); const int cc = tid & 63;
            float X[64]; int Arow[63];
            if (act) {
                if (isom) {
#pragma unroll
                    for (int c = 0; c < 64; ++c) X[c] = bf2f(Al[c * OR_ + cc]); }
                else {
#pragma unroll
                    for (int c = 0; c < 64; ++c) X[c] = RH2[c * 64 + cc]; }
#pragma unroll
                for (int m = 0; m < 63; ++m) Arow[m] = __float_as_int(ABf[m * 64 + lane]);
            }
            LBAR();
#define RW_SOLVE(m0, m1) do { if (act) { _Pragma("unroll") for (int m = (m0); m < (m1); ++m) { const float xm = X[m]; \
                _Pragma("unroll") for (int c = m + 1; c < 64; ++c) X[c] -= __int_as_float(__builtin_amdgcn_readlane(Arow[m], c)) * xm; } } } while (0)
            RW_SOLVE(0, 30);
            LBAR();
            RW_SOLVE(30, 63);
            LBAR();
#undef RW_SOLVE
            if (act) {
                if (isom) { bf16_t* M1 = (bf16_t*)(ws + WS_R1) + (size_t)item * 4096 + cc;
#pragma unroll
                    for (int c = 0; c < 64; ++c) M1[c * 64] = f2bf(X[c]); }
                else { float* UT = (float*)(ws + WS_RU) + (size_t)item * 4096 + (size_t)cc * 64;
#pragma unroll
                    for (int c4 = 0; c4 < 16; ++c4) *(f32x4*)(UT + 4 * c4) = (f32x4){X[4 * c4], X[4 * c4 + 1], X[4 * c4 + 2], X[4 * c4 + 3]}; }
            }
            LBAR();
    }
    } else {
    float plw[16], pv[11], pkk[12], pbb[12], pk2[12], pr[12];
#define RWB_ISSUE(it) do { const int b_ = (it) / 384, h_ = ((it) / 32) % 12, n_ = (it) % 32; const size_t gb_ = ((size_t)b_ * SEQ + n_ * 64) * 768 + h_ * 64; const int t_ = tidp - 128, wb_ = w - 2; \
        if (wb_ < 4) { _Pragma("unroll") for (int q = 0; q < 16; ++q) plw[q] = RWl[gb_ + (size_t)(wb_ * 16 + q) * 768 + (tidp & 63)]; } \
        _Pragma("unroll") for (int q = 0; q < 11; ++q) { const int idx = t_ + 384 * q; const int c = (idx >> 6) & 63, i = idx & 63; pv[q] = RV[gb_ + (size_t)c * 768 + i]; } \
        _Pragma("unroll") for (int q = 0; q < 12; ++q) { const int idx = t_ + 384 * q; const int c = (idx >> 6) & 63, j = idx & 63; const size_t g = gb_ + (size_t)c * 768 + j; pkk[q] = RKK[g]; pbb[q] = RB[g]; pk2[q] = RK[g]; pr[q] = RR[g]; } } while (0)
    if (nmine > 0) { int tidp = tid0; asm volatile("" : "+v"(tidp)); RWB_ISSUE(first); }
    for (int k = -1; k < nmine; ++k) {
        int tid = tid0; asm volatile("" : "+v"(tid)); const int lane = tid & 63, lr = lane & 15, lq = lane >> 4;
            const bool act = (k + 1 < nmine); const int item = first + (act ? (k + 1) : 0) * gstep;
            const int b = item / 384, h = (item / 32) % 12, n = item % 32; const size_t gb = ((size_t)b * SEQ + n * 64) * 768 + h * 64;
            const int t = tid - 128, wb = w - 2;
            if (act) {
                if (wb < 4) {
                    float acc = 0.f;
#pragma unroll
                    for (int q = 0; q < 8; ++q) { acc += plw[q]; cw[(wb * 16 + q) * 64 + lane] = acc; }
                    segt[(2 * wb) * 64 + lane] = acc; acc = 0.f;
#pragma unroll
                    for (int q = 8; q < 16; ++q) { acc += plw[q]; cw[(wb * 16 + q) * 64 + lane] = acc; }
                    segt[(2 * wb + 1) * 64 + lane] = acc; }
#pragma unroll
                for (int q = 0; q < 11; ++q) { const int idx = t + 384 * q; const int c = idx >> 6, i = idx & 63; if (idx < 4096) VTb[i * OR_ + c] = f2bf(pv[q]); }
            }
            LBAR();
            if (act) {
#pragma unroll
                for (int hf = 0; hf < 2; ++hf) {
#pragma unroll
                    for (int q = 0; q < 6; ++q) { const int idx = t + 384 * (6 * hf + q); const int c = idx >> 6, j = idx & 63;
                        if (idx < 4096) {
                            float off = 0.f, offm = 0.f, tot = 0.f;
#pragma unroll
                            for (int s2 = 0; s2 < 8; ++s2) { const float st = segt[s2 * 64 + j]; if (s2 < (c >> 3)) off += st; if (c > 0 && s2 < ((c - 1) >> 3)) offm += st; tot += st; }
                            const float cwc = cw[c * 64 + j] + off, cwm = c ? cw[(c - 1) * 64 + j] + offm : 0.f, cwl = tot;
                            const float kk = pkk[6 * hf + q], bb = pbb[6 * hf + q], k2 = pk2[6 * hf + q], r = pr[6 * hf + q];
                            const float en = __expf(-cwc);
                            Al[c * OR_ + j] = f2bf(kk * __expf(cwm)); Be[c * OR_ + j] = f2bf(bb * en); Ka[c * OR_ + j] = f2bf(k2 * en); const bf16_t rh = f2bf(r * __expf(cwc)); Rh[c * OR_ + j] = rh;
                            ((bf16_t*)(ws + WS_R2))[(size_t)item * 4096 + c * 64 + j] = rh;
                            const float ed = __expf(cwl - cwc); M4s[j * 136 + c] = f2bf(-bb * ed); M4s[j * 136 + 64 + c] = f2bf(k2 * ed);
                            if (c == 63) ((float*)(ws + WS_RGL))[(size_t)item * 64 + j] = __expf(cwl); } } }
                if (k + 2 < nmine) { const int tidp = tid; RWB_ISSUE(first + (k + 2) * gstep); }
            }
            LBAR();
            if (act) {
                for (int pc = wb; pc < 16; pc += 6) { const int p = pc >> 2, cb = pc & 3; const LAS bf16_t* X = (p < 2) ? Al : Rh; const LAS bf16_t* Y = (p & 1) ? Ka : Be;
                    const bf16x8 x0 = *(const LAS bf16x8*)(X + (cb * 16 + lr) * OR_ + 8 * lq), x1 = *(const LAS bf16x8*)(X + (cb * 16 + lr) * OR_ + 32 + 8 * lq);
#pragma unroll
                    for (int mb = 0; mb < 4; ++mb) { f32x4 acc = (f32x4){0.f, 0.f, 0.f, 0.f};
                        acc = __builtin_amdgcn_mfma_f32_16x16x32_bf16(x0, *(const LAS bf16x8*)(Y + (mb * 16 + lr) * OR_ + 8 * lq), acc, 0, 0, 0);
                        acc = __builtin_amdgcn_mfma_f32_16x16x32_bf16(x1, *(const LAS bf16x8*)(Y + (mb * 16 + lr) * OR_ + 32 + 8 * lq), acc, 0, 0, 0);
                        const int m = mb * 16 + lr;
                        if (p == 0) { f32x4 o;
#pragma unroll
                            for (int r = 0; r < 4; ++r) { const int c = cb * 16 + 4 * lq + r; o[r] = (c > m) ? acc[r] : 0.f; }
                            *(LAS f32x4*)(ABf + m * 64 + cb * 16 + 4 * lq) = o; }
                        else {
#pragma unroll
                            for (int r = 0; r < 4; ++r) { const int c = cb * 16 + 4 * lq + r;
                                if (p == 1) AKb[c * OR_ + m] = f2bf((c > m) ? acc[r] : 0.f);
                                else if (p == 2) M3s[c * 128 + m] = f2bf((c >= m) ? -acc[r] : 0.f);
                                else M3s[c * 128 + 64 + m] = f2bf((c >= m) ? acc[r] : 0.f); } } } }
            }
            LBAR();
            if (act) {
                for (int tl = wb; tl < 16; tl += 6) { const int cb = tl >> 2, ib = tl & 3;
                    const bf16x8 x0 = *(const LAS bf16x8*)(AKb + (cb * 16 + lr) * OR_ + 8 * lq), x1 = *(const LAS bf16x8*)(AKb + (cb * 16 + lr) * OR_ + 32 + 8 * lq);
                    f32x4 acc = (f32x4){0.f, 0.f, 0.f, 0.f};
                    acc = __builtin_amdgcn_mfma_f32_16x16x32_bf16(x0, *(const LAS bf16x8*)(VTb + (ib * 16 + lr) * OR_ + 8 * lq), acc, 0, 0, 0);
                    acc = __builtin_amdgcn_mfma_f32_16x16x32_bf16(x1, *(const LAS bf16x8*)(VTb + (ib * 16 + lr) * OR_ + 32 + 8 * lq), acc, 0, 0, 0);
#pragma unroll
                    for (int r = 0; r < 4; ++r) RH2[(cb * 16 + 4 * lq + r) * 64 + ib * 16 + lr] = acc[r]; }
                u32x4* g3 = (u32x4*)((bf16_t*)(ws + WS_R3) + (size_t)item * 64 * 128);
                for (int q = t; q < 1024; q += 384) g3[q] = *(const LAS u32x4*)(M3s + q * 8);
                u32x4* g4 = (u32x4*)((bf16_t*)(ws + WS_R4) + (size_t)item * 64 * 128);
                for (int q = t; q < 1024; q += 384) g4[q] = *(const LAS u32x4*)(M4s + (q >> 4) * 136 + (q & 15) * 8);
                u32x4* gv = (u32x4*)((bf16_t*)(ws + WS_RVT) + (size_t)item * 64 * 64);
                for (int q = t; q < 512; q += 384) gv[q] = *(const LAS u32x4*)(VTb + (q >> 3) * OR_ + (q & 7) * 8);
            }
            LBAR();
    }
    }
    LBAR();
#undef RWB_ISSUE
}

__device__ __forceinline__ void phase_lru_chunk(const Args& a) {
    size_t wso_ = 0; asm volatile("" : "+s"(wso_)); unsigned char* ws = a.ws + wso_;
    const int tid = tid_l();
    const float* LA = (const float*)(ws + WS_LA); const float* LU = (const float*)(ws + WS_LU); float* LH = (float*)(ws + WS_LH); float* LP = (float*)(ws + WS_LP);
    for (int p = bid_l() * 512 + tid; p < 128 * 512; p += gdim_l() * 512) { const int chunk = p >> 9, c = p & 511; const size_t base = (size_t)chunk * 64 * 512 + c;
        float h = 0.f, cp = 1.f;
        for (int i0 = 0; i0 < 64; i0 += 16) { float av[16], uv[16];
#pragma unroll
            for (int i = 0; i < 16; ++i) { av[i] = LA[base + (size_t)(i0 + i) * 512]; uv[i] = LU[base + (size_t)(i0 + i) * 512]; }
#pragma unroll
            for (int i = 0; i < 16; ++i) { h = av[i] * h + uv[i]; cp *= av[i]; LH[base + (size_t)(i0 + i) * 512] = h; LP[base + (size_t)(i0 + i) * 512] = cp; } } }
}
constexpr int SB = 16;
__device__ __forceinline__ void phase_scan_naive(const Args& a, int l, LAS unsigned char* lds) {
    size_t wso_ = 0; asm volatile("" : "+s"(wso_)); unsigned char* ws = a.ws + wso_;
    const int tid = tid_l(), wave = __builtin_amdgcn_readfirstlane(tid >> 6), lane = tid & 63;
    const int blk = bid_l();
    if (blk < 96) {
        const int xq = blk >> 3, bh = (blk & 7) * 3 + (xq >> 2), es = xq & 3, b = bh / 6, h = bh % 6; const size_t ci = (size_t)bh * 32;
        ScanRec R{(const bf16_t*)(ws + WS_G1) + ci * 64 * 128, (const bf16_t*)(ws + WS_G2) + ci * 64 * 128, (const bf16_t*)(ws + WS_G3) + ci * 64 * 64, (const bf16_t*)(ws + WS_G4) + ci * 128 * 64,
                  (const float*)(ws + WS_GU) + ci * 128 * 64, (const float*)(ws + WS_GGL) + ci * 128, nullptr};
        scan_item<128, 64, false>(R, es * 32, (float*)(ws + WS_GO) + (size_t)b * SEQ * 768 + h * 128, 768, lds);
    } else if (blk < 192) {
        const int it = blk - 96, xq = it >> 3, bh = (it & 7) * 6 + (xq >> 1), es = xq & 1, b = bh / 12, h = bh % 12; const size_t ci = (size_t)bh * 32;
        ScanRec R{(const bf16_t*)(ws + WS_R1) + ci * 4096, (const bf16_t*)(ws + WS_R2) + ci * 4096, (const bf16_t*)(ws + WS_R3) + ci * 8192, (const bf16_t*)(ws + WS_R4) + ci * 8192,
                  (const float*)(ws + WS_RU) + ci * 4096, (const float*)(ws + WS_RGL) + ci * 64, (const bf16_t*)(ws + WS_RVT) + ci * 4096};
        scan_item<64, 128, true>(R, es * 32, (float*)(ws + WS_RY) + (size_t)b * SEQ * 768 + h * 64, 768, lds);
    } else if (blk < 196) {
        const int gidx = (blk - 192) * 512 + tid, b = gidx >> 9, c = gidx & 511;
        const float* LH = (const float*)(ws + WS_LH); const float* LP = (const float*)(ws + WS_LP); float* LC = (float*)(ws + WS_LC);
        float pe[32], he[32];
#pragma unroll
        for (int n = 0; n < 32; ++n) { const size_t o = ((size_t)b * SEQ + n * 64 + 63) * 512 + c; pe[n] = LP[o]; he[n] = LH[o]; }
        float carry = 0.f;
#pragma unroll
        for (int n = 0; n < 32; ++n) { LC[(size_t)(b * 32 + n) * 512 + c] = carry; carry = pe[n] * carry + he[n]; }
    } else if (l + 1 < NL && CONV_SPLIT > 0) {
        phase_convert(a, lds, l + 1, l + 2, 0, CONV_SPLIT, blk - 196, gdim_l() - 196, 0);
    }
}
__device__ __forceinline__ void phase_fin(const Args& a, int l, LAS unsigned char* lds) {
    size_t wso_ = 0; asm volatile("" : "+s"(wso_)); unsigned char* ws = a.ws + wso_;
    const int tid = tid_l(), wave = tid >> 6, lane = tid & 63;
    const int gw = bid_l() * 8 + wave, NGW = gdim_l() * 8;
    const bf16_t* PROJ = (const bf16_t*)(ws + WS_PROJ); bf16_t* Y = (bf16_t*)(ws + WS_Y);
    const float* GO = (const float*)(ws + WS_GO); const float* RY = (const float*)(ws + WS_RY);
    const float* RR = (const float*)(ws + WS_RR); const float* RK = (const float*)(ws + WS_RK); const float* RV = (const float*)(ws + WS_RV);
    const float* LH = (const float*)(ws + WS_LH); const float* LP = (const float*)(ws + WS_LP); const float* LC = (const float*)(ws + WS_LC);
    const f32x2 ng = *(const f32x2*)(inp(lds, I_GNG) + l * 128 + 2 * lane);
    float gnw[12], gnb[12], rkw[12];
#pragma unroll
    for (int h = 0; h < 12; ++h) { gnw[h] = inp(lds, I_RGNW)[l * 768 + h * 64 + lane]; gnb[h] = inp(lds, I_RGNB)[l * 768 + h * 64 + lane]; rkw[h] = inp(lds, I_RRK)[l * 768 + h * 64 + lane]; }
    for (int t = gw; t < NTOK; t += NGW) {
        const f32x4 h0 = *(const f32x4*)(LH + (size_t)t * 512 + 8 * lane), h1 = *(const f32x4*)(LH + (size_t)t * 512 + 8 * lane + 4);
        const f32x4 p0 = *(const f32x4*)(LP + (size_t)t * 512 + 8 * lane), p1 = *(const f32x4*)(LP + (size_t)t * 512 + 8 * lane + 4);
        const f32x4 c0 = *(const f32x4*)(LC + (size_t)(t >> 6) * 512 + 8 * lane), c1 = *(const f32x4*)(LC + (size_t)(t >> 6) * 512 + 8 * lane + 4);
        const u32x4 gq = *(const u32x4*)(PROJ + (size_t)t * NP + PC_AG + 8 * lane);
        f32x2 go[6]; unsigned gg[6];
#pragma unroll
        for (int h = 0; h < 6; ++h) { go[h] = *(const f32x2*)(GO + (size_t)t * 768 + h * 128 + 2 * lane); gg[h] = *(const unsigned*)(PROJ + (size_t)t * NP + PC_BG + h * 128 + 2 * lane); }
        float ry[12], rr[12], rk[12], rv[12]; bf16_t rg[12];
#pragma unroll
        for (int h = 0; h < 12; ++h) { const size_t o = (size_t)t * 768 + h * 64 + lane; ry[h] = RY[o]; rr[h] = RR[o]; rk[h] = RK[o]; rv[h] = RV[o]; rg[h] = PROJ[(size_t)t * NP + PC_CG + h * 64 + lane]; }
        { const f32x4 v0 = h0 + p0 * c0, v1 = h1 + p1 * c1;
            u32x4 o; o.x = cvtpk(v0[0] * siluf_(__uint_as_float(gq.x << 16)), v0[1] * siluf_(__uint_as_float(gq.x & 0xffff0000u)));
            o.y = cvtpk(v0[2] * siluf_(__uint_as_float(gq.y << 16)), v0[3] * siluf_(__uint_as_float(gq.y & 0xffff0000u)));
            o.z = cvtpk(v1[0] * siluf_(__uint_as_float(gq.z << 16)), v1[1] * siluf_(__uint_as_float(gq.z & 0xffff0000u)));
            o.w = cvtpk(v1[2] * siluf_(__uint_as_float(gq.w << 16)), v1[3] * siluf_(__uint_as_float(gq.w & 0xffff0000u)));
            *(u32x4*)(Y + (size_t)t * DM + 8 * lane) = o; }
#pragma unroll
        for (int h = 0; h < 6; ++h) { const f32x2 o = go[h]; const float ss = wave_sum(o.x * o.x + o.y * o.y); const float sc = __builtin_amdgcn_rsqf(ss * (1.0f / 128.f) + 1e-6f);
            const float g0 = __uint_as_float(gg[h] << 16), g1 = __uint_as_float(gg[h] & 0xffff0000u);
            *(unsigned*)(Y + (size_t)t * DM + 512 + h * 128 + 2 * lane) = cvtpk(o.x * sc * ng.x * siluf_(g0), o.y * sc * ng.y * siluf_(g1)); }
#pragma unroll
        for (int h = 0; h < 12; ++h) { const float y = ry[h]; const float mean = wave_sum(y) * (1.0f / 64.f); const float d = y - mean; const float var = wave_sum(d * d) * (1.0f / 64.f);
            float yn = d * (__builtin_amdgcn_rsqf(var + 64e-5f)) * gnw[h] + gnb[h];
            const float sdot = wave_sum(rr[h] * rk[h] * rkw[h]); yn += sdot * rv[h];
            Y[(size_t)t * DM + 1280 + h * 64 + lane] = f2bf(yn * siluf_(bf2f(rg[h]))); }
    }
}
#define XB_TMO      128
#define XB_XCNT(j)  (256  + 64 * (j))
#define XB_XSUB(j)  (1280 + 64 * (j))
#define XB_XGEN(j)  (2304 + 64 * (j))
#define XB_TOP      3328
#define XB_TOPGEN   3392
#define XCD_BAR_WORDS 3456
#define XB_SPIN_CAP (1u << 18)
__device__ __forceinline__ unsigned xb_ld(unsigned* p)              { return __hip_atomic_load(p, __ATOMIC_RELAXED, __HIP_MEMORY_SCOPE_AGENT); }
__device__ __forceinline__ unsigned xb_add(unsigned* p, unsigned v) { return __hip_atomic_fetch_add(p, v, __ATOMIC_RELAXED, __HIP_MEMORY_SCOPE_AGENT); }
__device__ __forceinline__ unsigned xb_xcc_id() { return (unsigned)__builtin_amdgcn_s_getreg((3 << 11) | 20) & 0xFu; }
#define XB_SPIN(cond, bar) do { unsigned _sp = 0; while (cond) { __builtin_amdgcn_s_sleep(1); \
    if ((++_sp & 255u) == 0u) { if (xb_ld(&(bar)[XB_TMO])) break; if (_sp > XB_SPIN_CAP) { atomicAdd(&(bar)[XB_TMO], 1u); break; } } } } while (0)

struct XcdBarrier {
    unsigned* bar; unsigned x;
    volatile LAS unsigned* st;
};

__device__ __forceinline__ XcdBarrier xcd_barrier_post(unsigned* bar, volatile LAS unsigned* st) {
    XcdBarrier b; b.bar = bar; b.x = xb_xcc_id(); b.st = st;
    if (threadIdx.x == 0) (void)xb_add(&bar[XB_XCNT(b.x)], 1u);
    return b;
}
__device__ __forceinline__ void xcd_barrier_complete(unsigned* bar, unsigned x, unsigned& nloc, unsigned& nx) {
    const unsigned G = gridDim.x * gridDim.y * gridDim.z;
    unsigned sum, cnt, mine, sp = 0u;
    for (;;) {
        sum = 0u; cnt = 0u; mine = 0u;
#pragma unroll
        for (unsigned j = 0; j < 16; ++j) { const unsigned c = xb_ld(&bar[XB_XCNT(j)]); sum += c; cnt += (c > 0u) ? 1u : 0u; mine = (j == x) ? c : mine; }
        if (sum == G) break;
        __builtin_amdgcn_s_sleep(1);
        if ((++sp & 255u) == 0u) { if (xb_ld(&bar[XB_TMO])) break; if (sp > XB_SPIN_CAP) { atomicAdd(&bar[XB_TMO], 1u); break; } }
    }
    nloc = mine > 0u ? mine : 1u; nx = cnt > 0u ? cnt : 1u;
}

__device__ __forceinline__ void xcd_barrier(const XcdBarrier& b) {
    asm volatile("s_waitcnt vmcnt(0)" ::: "memory");
    __syncthreads();
    if (threadIdx.x == 0) {
        unsigned* bar = b.bar;
        __builtin_amdgcn_s_waitcnt(0);
        unsigned nloc = b.st[0], nx = b.st[1];
        if (nloc == 0u) { xcd_barrier_complete(bar, b.x, nloc, nx); b.st[0] = nloc; b.st[1] = nx; }
        const unsigned old = xb_add(&bar[XB_XSUB(b.x)], 1u);
        const unsigned gen = old / nloc;
        if (old + 1u == (gen + 1u) * nloc) {
            __builtin_amdgcn_fence(__ATOMIC_RELEASE, "agent");
            asm volatile("s_waitcnt vmcnt(0)" ::: "memory");
            const unsigned og = xb_add(&bar[XB_TOP], 1u);
            const unsigned tg = og / nx;
            if (og + 1u == (tg + 1u) * nx) xb_add(&bar[XB_TOPGEN], 1u);
            else XB_SPIN(xb_ld(&bar[XB_TOPGEN]) == tg, bar);
            __builtin_amdgcn_fence(__ATOMIC_ACQUIRE, "agent");
            xb_add(&bar[XB_XGEN(b.x)], 1u);
            asm volatile("s_waitcnt vmcnt(0)" ::: "memory");
        } else {
            XB_SPIN(xb_ld(&bar[XB_XGEN(b.x)]) == gen, bar);
            __builtin_amdgcn_fence(__ATOMIC_ACQUIRE, "agent");
            asm volatile("s_waitcnt vmcnt(0)" ::: "memory");
        }
    }
    __syncthreads();
}


__global__ void __launch_bounds__(512) mk_fwd(Args a) {
    extern __shared__ __attribute__((aligned(16))) unsigned char lds_raw[];
    LAS unsigned char* lds = (LAS unsigned char*)lds_raw;
    cg::grid_group grid = cg::this_grid();
    const int lo = a.ph_lo, hi = a.ph_hi;
    if (threadIdx.x < 26) { const unsigned long long p = (unsigned long long)a.in[threadIdx.x]; LAS unsigned* t = (LAS unsigned*)(lds + 131072) + 2 * threadIdx.x; t[0] = (unsigned)p; t[1] = (unsigned)(p >> 32); }
    if (threadIdx.x == 0) { LAS unsigned* z = (LAS unsigned*)(lds + 131072 + 256); z[0] = 0u; z[1] = 0u; z[2] = 0u; z[3] = 0u; }
    __syncthreads();
    XcdBarrier xb = xcd_barrier_post((unsigned*)(a.ws + WS_BAR), (volatile LAS unsigned*)(lds + 131072 + 256));
    float* XR = (float*)(a.ws + WS_XR); bf16_t* XB = (bf16_t*)(a.ws + WS_XB); bf16_t* PROJ = (bf16_t*)(a.ws + WS_PROJ); bf16_t* Y = (bf16_t*)(a.ws + WS_Y);
    for (int ph = lo; ph < hi; ++ph) {
      const int nrep = (REPMASK && ph > 0 && ph < NPHASE - 1 && ((REPMASK >> ((ph - 1) % PPL)) & 1)) ? 2 : 1;
      for (int rep = 0; rep < nrep; ++rep) {
        if (ph == 0) { phase_convert(a, lds, 0, 1, 0, 64, bid_l(), gdim_l(), 1); phase_convert(a, lds, 1, NL, CONV_SPLIT2, 64, bid_l(), gdim_l(), 0); }
        else if (ph == NPHASE - 1) phase_final(XR, inp(lds, I_FNG), a.out);
        else { const int l = (ph - 1) / PPL, s = (ph - 1) % PPL; const float* xin = (l == 0) ? inp(lds, I_X) : XR;
            if (s == 0) { if (!(SKIPMASK & 2)) phase_rms(xin, XB); }
            else if (s == 1 || s == 6) { if (!(SKIPMASK & 4)) {
                pg8::Gemm g; EpiDual E;
                if (s == 1) { g = pg8::Gemm{XB, (const bf16_t*)(a.ws + WS_WIN) + (size_t)l * NP * DM, NTOK, NP, DM}; E = EpiDual{0, PROJ, NP, nullptr, nullptr, 0}; }
                else { g = pg8::Gemm{Y, (const bf16_t*)(a.ws + WS_WOUT) + (size_t)l * DM * DM, NTOK, DM, DM}; E = EpiDual{1, nullptr, 0, xin, XR, DM}; }
                pg8::StaticOrder S; S.init(NTOK, g.N, gdim_l(), bid_l());
                pg8::gemm_phase<EpiDual, pg8::StaticOrder>(lds, g, S, E, nullptr);
                if (s == 1 && l + 1 < NL) { const int nfull = (NTOK / 256) * (NP / 256) - 3 * gdim_l();
                    if (nfull > 0 && nfull < gdim_l() && bid_l() >= nfull) phase_convert(a, lds, l + 1, l + 2, CONV_SPLIT, CONV_SPLIT2, bid_l() - nfull, gdim_l() - nfull, 0);
                    else if (nfull <= 0 || nfull >= gdim_l()) phase_convert(a, lds, l + 1, l + 2, CONV_SPLIT, CONV_SPLIT2, bid_l(), gdim_l(), 0); } } }
            else if (s == 2) { if (!(SKIPMASK & 8)) phase_prep(a, l, lds); }
            else if (s == 3) { phase_gdn_chunk(a, l, lds); if (CHUNKREP & 1) phase_gdn_chunk(a, l, lds); phase_rwkv_chunk(a, l, lds); if (CHUNKREP & 2) phase_rwkv_chunk(a, l, lds); phase_lru_chunk(a); if (CHUNKREP & 4) phase_lru_chunk(a); }
            else if (s == 4) { if (!(SKIPMASK & 16)) phase_scan_naive(a, l, lds); }
            else if (s == 5) { if (!(SKIPMASK & 32)) phase_fin(a, l, lds); }
        }
      }
        if (ph + 1 < hi) { if (ph == 0) grid.sync(); else xcd_barrier(xb); }
    }
}

extern "C" void kernel_launch(void* const* d_in, const int* in_sizes, int n_in, void* d_out, int out_size, void* d_ws, size_t ws_size, hipStream_t stream) {
    static int grid = 0;
    if (grid == 0) {
        if (n_in != 26 || ws_size < WS_END) { fprintf(stderr, "kernel_launch: unexpected n_in %d or ws_size %zu < %zu\n", n_in, ws_size, (size_t)WS_END); grid = -1; return; }
        int dev = 0, cus = 0, per_cu = 0;
        hipGetDevice(&dev); hipDeviceGetAttribute(&cus, hipDeviceAttributeMultiprocessorCount, dev);
        if (hipFuncSetAttribute((const void*)mk_fwd, hipFuncAttributeMaxDynamicSharedMemorySize, LDS_BYTES) != hipSuccess) { fprintf(stderr, "hipFuncSetAttribute failed\n"); grid = -1; return; }
        if (hipOccupancyMaxActiveBlocksPerMultiprocessor(&per_cu, (const void*)mk_fwd, 512, LDS_BYTES) != hipSuccess || per_cu < 1) { fprintf(stderr, "occupancy query failed / 0\n"); grid = -1; return; }
        grid = cus;
    }
    if (grid < 0) return;
    if (hipMemsetAsync((char*)d_ws + WS_BAR, 0, 16384, stream) != hipSuccess) { fprintf(stderr, "memset of barrier words failed\n"); return; }
    Args a{};
    for (int i = 0; i < 26; ++i) a.in[i] = (const float*)d_in[i];
    a.out = (float*)d_out; a.ws = (unsigned char*)d_ws;
#if N_LAUNCH_MODE == 1
    a.ph_lo = 0; a.ph_hi = NPHASE;
    void* args[] = {&a};
    hipError_t e = hipLaunchCooperativeKernel((const void*)mk_fwd, dim3(grid), dim3(512), args, LDS_BYTES, stream);
    if (e != hipSuccess) fprintf(stderr, "cooperative launch failed: %s (grid %d)\n", hipGetErrorString(e), grid);
#else
    for (int ph = 0; ph < NPHASE; ++ph) { a.ph_lo = ph; a.ph_hi = ph + 1; hipLaunchKernelGGL(mk_fwd, dim3(grid), dim3(512), LDS_BYTES, stream, a); }
#endif
}
```

```cpp
#include <hip/hip_runtime.h>
#include <hip/hip_cooperative_groups.h>
#include <cstdio>
#include <cstdint>
namespace cg = cooperative_groups;
namespace pg8 {
#define PG8_LAS __attribute__((address_space(3)))
typedef unsigned short bf16_t;
typedef short bf16x8 __attribute__((ext_vector_type(8)));
typedef float f32x4 __attribute__((ext_vector_type(4)));
typedef unsigned u32x4 __attribute__((ext_vector_type(4)));
constexpr int BM = 256, BK = 64, HALF = 128, HTB = HALF * BK * 2  , STAGE_BYTES = 8 * HTB, NXCD = 8, WGM = 8;

__host__ __device__ __forceinline__ int lds_byte(int r, int c) { const int st = (r >> 4) * 2 + (c >> 5), rr = r & 15, cc = c & 31, ob = rr * 64 + cc * 2; return st * 1024 + (ob ^ (((ob >> 9) & 1) << 5)); }
__host__ __device__ __forceinline__ void stage_rc(int b, int& R, int& C) { const int st = b / 1024, sb = b % 1024, swz = sb ^ (((sb >> 9) & 1) << 5); R = (st >> 1) * 16 + swz / 64; C = (st & 1) * 32 + (swz % 64) / 2; }
__host__ __device__ __forceinline__ int perm32(int rho) { const int n = rho >> 4, i = rho & 15; return 8 * (i >> 2) + 4 * n + (i & 3); }

struct Unit { int pm, pn; };
struct Gemm { const bf16_t* A; const bf16_t* Bt; int M, N, K; };

struct StaticOrder {
    int nM, nN, nwg, G, c;
    __host__ __device__ void init(int M, int N, int G_, int c_) { nM = M / BM; nN = N / BM; nwg = nM * nN; G = G_; c = c_; }
    __host__ __device__ bool next(int i, Unit& u) const {
        const long L = (long)i * G + c; if (L >= nwg) return false;
        int wgid = (int)L; { const int q = nwg / NXCD, r = nwg % NXCD, xcd = wgid % NXCD, off = wgid / NXCD; wgid = (xcd < r ? xcd * (q + 1) : r * (q + 1) + (xcd - r) * q) + off; }
        const int nig = WGM * nN, gid = wgid / nig, fm = gid * WGM, gsz = (nM - fm) < WGM ? (nM - fm) : WGM;
        u.pm = fm + ((wgid % nig) % gsz); u.pn = (wgid % nig) / gsz; return true;
    }
    __device__ __forceinline__ void a_ready(const Unit&) const {}
    __device__ __forceinline__ void done(const Unit&) const {}
};
struct CountedOrder : StaticOrder {
    const unsigned* ready; unsigned need; unsigned* tmo;
    __device__ __forceinline__ void a_ready(const Unit& u) const {
        if (threadIdx.x < 64) {
            const unsigned long long t0 = __builtin_amdgcn_s_memrealtime(); unsigned polls = 0;
            while ((unsigned)__builtin_amdgcn_readfirstlane(__hip_atomic_load(ready + 64 * u.pm, __ATOMIC_RELAXED, __HIP_MEMORY_SCOPE_AGENT)) < need) {
                if ((++polls & 255u) == 0u && __builtin_amdgcn_readfirstlane(__hip_atomic_load(tmo, __ATOMIC_RELAXED, __HIP_MEMORY_SCOPE_AGENT)) != 0u) break;
                if (__builtin_amdgcn_s_memrealtime() - t0 > 2000000ull) {
                    if (threadIdx.x == 0) { unsigned expect = 0u; __hip_atomic_compare_exchange_strong(tmo + 1, &expect, 0x600u | (unsigned)(u.pm & 0xff), __ATOMIC_RELAXED, __ATOMIC_RELAXED, __HIP_MEMORY_SCOPE_AGENT); __hip_atomic_store(tmo, 1u, __ATOMIC_RELAXED, __HIP_MEMORY_SCOPE_AGENT); }
                    break; }
                __builtin_amdgcn_s_sleep(2); }
            __builtin_amdgcn_fence(__ATOMIC_ACQUIRE, "agent");
            asm volatile("s_waitcnt vmcnt(0)" ::: "memory");
        }
#if !defined(BROKEN_HOOK_NO_BARRIER)
        asm volatile("" ::: "memory"); __builtin_amdgcn_s_barrier(); asm volatile("" ::: "memory");
#endif
    }
};

__device__ __forceinline__ unsigned cvt_pk_bf16(float lo, float hi) { unsigned r; asm volatile("v_cvt_pk_bf16_f32 %0, %1, %2" : "=v"(r) : "v"(lo), "v"(hi)); return r; }
typedef float f32x2 __attribute__((ext_vector_type(2)));
__device__ __forceinline__ f32x2 gelu_pk(f32x2 v) {
    const f32x2 av = __builtin_elementwise_abs(v), d = av * 0.2316418882f + 1.0f;
    f32x2 t; t.x = __builtin_amdgcn_rcpf(d.x); t.y = __builtin_amdgcn_rcpf(d.y);
    f32x2 q = t * 0.5307027145f + (-0.7265760135f); q = q * t + 0.7107068705f; q = q * t + (-0.142248368f); q = q * t + 0.127414796f; q = q * t;
    const f32x2 s = (v * v) * (-0.72134752044f);
    f32x2 e; e.x = __builtin_amdgcn_exp2f(s.x); e.y = __builtin_amdgcn_exp2f(s.y);
    const f32x2 m = v * (q * e), r = v - m;
    f32x2 o; o.x = v.x < 0.f ? m.x : r.x; o.y = v.y < 0.f ? m.y : r.y; return o;
}

struct EpiF32 {
    static constexpr bool PERM = false, AFTER_DRAIN = false;
    float* C; int ldc; const float* bias;
    __device__ __forceinline__ void operator()(const f32x4 (&acc)[2][2][4][2], const Unit& u, int wr, int wc, int fr, int fq) const {
        const int row0 = u.pm * BM + wr * 64 + fr, col0 = u.pn * BM + wc * 32 + 4 * fq;
        f32x4 bv[2][2];
#pragma unroll
        for (int bj = 0; bj < 2; ++bj)
#pragma unroll
            for (int n = 0; n < 2; ++n) bv[bj][n] = bias ? *(const f32x4*)(bias + col0 + bj * HALF + n * 16) : (f32x4){0.f, 0.f, 0.f, 0.f};
#pragma unroll
        for (int ai = 0; ai < 2; ++ai)
#pragma unroll
            for (int m = 0; m < 4; ++m) { float* rowp = C + (size_t)(row0 + ai * HALF + m * 16) * ldc + col0;
#pragma unroll
                for (int bj = 0; bj < 2; ++bj)
#pragma unroll
                    for (int n = 0; n < 2; ++n) *(f32x4*)(rowp + bj * HALF + n * 16) = acc[ai][bj][m][n] + bv[bj][n]; }
    }
};
template <int ACT  > struct EpiBf16 {
    static constexpr bool PERM = true, AFTER_DRAIN = false;
    bf16_t* O; int ldc; const float* bias; int split_cols; size_t split_stride;
    __device__ __forceinline__ void operator()(const f32x4 (&acc)[2][2][4][2], const Unit& u, int wr, int wc, int fr, int fq) const {
        const int row0 = u.pm * BM + wr * 64 + fr; int colt = u.pn * BM; bf16_t* base = O;
        if (split_cols) { const int t = colt / split_cols; base += (size_t)t * split_stride; colt -= t * split_cols; }
        const int col0 = colt + wc * 32 + 8 * fq, bcol0 = u.pn * BM + wc * 32 + 8 * fq;
        f32x4 bv[2][2];
#pragma unroll
        for (int bj = 0; bj < 2; ++bj)
#pragma unroll
            for (int n = 0; n < 2; ++n) bv[bj][n] = bias ? *(const f32x4*)(bias + bcol0 + bj * HALF + 4 * n) : (f32x4){0.f, 0.f, 0.f, 0.f};
#pragma unroll
        for (int ai = 0; ai < 2; ++ai)
#pragma unroll
            for (int m = 0; m < 4; ++m) { bf16_t* rowp = base + (size_t)(row0 + ai * HALF + m * 16) * ldc + col0;
#pragma unroll
                for (int bj = 0; bj < 2; ++bj) { f32x4 v0 = acc[ai][bj][m][0] + bv[bj][0], v1 = acc[ai][bj][m][1] + bv[bj][1];
                    if (ACT == 1) { f32x2 a = gelu_pk((f32x2){v0[0], v0[1]}), b = gelu_pk((f32x2){v0[2], v0[3]}), c = gelu_pk((f32x2){v1[0], v1[1]}), d = gelu_pk((f32x2){v1[2], v1[3]});
                        v0 = (f32x4){a.x, a.y, b.x, b.y}; v1 = (f32x4){c.x, c.y, d.x, d.y}; }
                    if (ACT == 2) {
#pragma unroll
                        for (int j = 0; j < 4; ++j) { v0[j] = 0.5f * v0[j] * (1.0f + erff(v0[j] * 0.70710678f)); v1[j] = 0.5f * v1[j] * (1.0f + erff(v1[j] * 0.70710678f)); } }
                    u32x4 w; w.x = cvt_pk_bf16(v0[0], v0[1]); w.y = cvt_pk_bf16(v0[2], v0[3]); w.z = cvt_pk_bf16(v1[0], v1[1]); w.w = cvt_pk_bf16(v1[2], v1[3]);
                    *(u32x4*)(rowp + bj * HALF) = w; } }
    }
};

struct PanelStats {
    unsigned* xbuf;
    unsigned* cnt;
    unsigned* tmo;
    int ntn; float eps;
    unsigned code;
    __device__ __forceinline__ bool run(const f32x4 (&v)[2][2][4][2], const Unit& u, int wr, int wc, int fr, int fq, PG8_LAS unsigned char* lds, int wid, int lane) const {
        typedef float f32x2v __attribute__((ext_vector_type(2)));
        PG8_LAS f32x2v* P = (PG8_LAS f32x2v*)lds;
        PG8_LAS f32x2v* S = (PG8_LAS f32x2v*)(lds + 8192);
        PG8_LAS unsigned* flag = (PG8_LAS unsigned*)(lds + 8192 + 2048);
#pragma unroll
        for (int ai = 0; ai < 2; ++ai)
#pragma unroll
            for (int m = 0; m < 4; ++m) {
                float s = 0.f;
#pragma unroll
                for (int bj = 0; bj < 2; ++bj)
#pragma unroll
                    for (int n = 0; n < 2; ++n) { const f32x4 x = v[ai][bj][m][n]; s += (x[0] + x[1]) + (x[2] + x[3]); }
                s += __shfl_xor(s, 16); s += __shfl_xor(s, 32);
                const float mw = s * (1.0f / 64.0f); float q = 0.f;
#pragma unroll
                for (int bj = 0; bj < 2; ++bj)
#pragma unroll
                    for (int n = 0; n < 2; ++n) { const f32x4 d = v[ai][bj][m][n] - mw; q += (d[0] * d[0] + d[1] * d[1]) + (d[2] * d[2] + d[3] * d[3]); }
                q += __shfl_xor(q, 16); q += __shfl_xor(q, 32);
                if (fq == 0) P[(ai * HALF + wr * 64 + m * 16 + fr) * 4 + wc] = (f32x2v){mw, q};
            }
        asm volatile("s_waitcnt lgkmcnt(0)" ::: "memory"); __builtin_amdgcn_s_barrier(); asm volatile("" ::: "memory");
#if defined(BROKEN_NO_WAIT)
        if (blockIdx.x >= 64) { const long long t0 = clock64(); while (clock64() - t0 < 60000) __builtin_amdgcn_s_sleep(8); }
#endif
        const int row = wid * 32 + (lane & 31);
        if (lane < 32) {
            const f32x2v a = P[row * 4 + 0], b = P[row * 4 + 1], c = P[row * 4 + 2], d = P[row * 4 + 3];
            const float mt = (a.x + b.x + c.x + d.x) * 0.25f;
            const float da = a.x - mt, db = b.x - mt, dc = c.x - mt, dd = d.x - mt;
            const float m2 = (a.y + b.y) + (c.y + d.y) + 64.0f * ((da * da + db * db) + (dc * dc + dd * dd));
            unsigned long long* slot = (unsigned long long*)xbuf + ((size_t)(u.pm * BM + row) * 4 + u.pn);
            __hip_atomic_store(slot, ((unsigned long long)__float_as_uint(m2) << 32) | __float_as_uint(mt), __ATOMIC_RELAXED, __HIP_MEMORY_SCOPE_AGENT);
        }
        asm volatile("s_waitcnt vmcnt(0)" ::: "memory");
        if (lane == 0) __hip_atomic_fetch_add(cnt + 64 * u.pm, 1u, __ATOMIC_RELAXED, __HIP_MEMORY_SCOPE_AGENT);
        if (wid == 0) {
            bool dead = false; const unsigned long long t0 = __builtin_amdgcn_s_memrealtime(); const unsigned want = 8u * (unsigned)ntn;
            for (;;) {
#if defined(BROKEN_NO_WAIT)
                break;
#endif
                if ((unsigned)__builtin_amdgcn_readfirstlane(__hip_atomic_load(cnt + 64 * u.pm, __ATOMIC_RELAXED, __HIP_MEMORY_SCOPE_AGENT)) >= want) break;
                if (__builtin_amdgcn_s_memrealtime() - t0 > 2000000ull) {
                    if (lane == 0) { unsigned expect = 0u; __hip_atomic_compare_exchange_strong(tmo + 1, &expect, code | (unsigned)(u.pm & 0xff), __ATOMIC_RELAXED, __ATOMIC_RELAXED, __HIP_MEMORY_SCOPE_AGENT);
                                     __hip_atomic_store(tmo, 1u, __ATOMIC_RELAXED, __HIP_MEMORY_SCOPE_AGENT); }
                    dead = true; break; }
                __builtin_amdgcn_s_sleep(2);
            }
            __builtin_amdgcn_fence(__ATOMIC_ACQUIRE, "agent");
            if (lane == 0) flag[0] = dead ? 1u : 0u;
        }
        asm volatile("s_waitcnt vmcnt(0) lgkmcnt(0)" ::: "memory"); __builtin_amdgcn_s_barrier(); asm volatile("" ::: "memory");
        const bool bad = flag[0] != 0u;
        if (lane < 32) {
            const unsigned long long* slot = (const unsigned long long*)xbuf + (size_t)(u.pm * BM + row) * 4; float mt[4], m2[4]; float ms = 0.f;
#pragma unroll
            for (int t = 0; t < 4; ++t) { if (t < ntn) { const unsigned long long w = __hip_atomic_load(slot + t, __ATOMIC_RELAXED, __HIP_MEMORY_SCOPE_AGENT); mt[t] = __uint_as_float((unsigned)w); m2[t] = __uint_as_float((unsigned)(w >> 32)); } else { mt[t] = 0.f; m2[t] = 0.f; } ms += mt[t]; }
            const float mean = ms / (float)ntn; float q = 0.f;
#pragma unroll
            for (int t = 0; t < 4; ++t) if (t < ntn) { const float dm = mt[t] - mean; q += m2[t] + 256.0f * dm * dm; }
            S[row] = (f32x2v){mean, 1.0f / sqrtf(q / (256.0f * (float)ntn) + eps)};
        }
        asm volatile("s_waitcnt lgkmcnt(0)" ::: "memory"); __builtin_amdgcn_s_barrier(); asm volatile("" ::: "memory");
        return bad;
    }
};
struct EpiLnRes {
    static constexpr bool PERM = false, AFTER_DRAIN = true;
    const float* base; float* out; int ldc; const float* bias; PanelStats st; unsigned poison;
    __device__ __forceinline__ void refuse(size_t i0, size_t stride, int M, int N) const { const float q = __builtin_nanf(""); for (size_t i = i0; i < (size_t)M * N; i += stride) out[(i / N) * ldc + i % N] = q;
        if (i0 == 0) { unsigned expect = 0u; __hip_atomic_compare_exchange_strong(st.tmo + 1, &expect, 0x7f0u, __ATOMIC_RELAXED, __ATOMIC_RELAXED, __HIP_MEMORY_SCOPE_AGENT); __hip_atomic_store(st.tmo, 1u, __ATOMIC_RELAXED, __HIP_MEMORY_SCOPE_AGENT); } }
    __device__ __forceinline__ void fused(f32x4 (&acc)[2][2][4][2], const Unit& u, int wr, int wc, int fr, int fq, PG8_LAS unsigned char* lds, int wid, int lane) const {
        typedef float f32x2v __attribute__((ext_vector_type(2)));
        const PG8_LAS f32x2v* S = (const PG8_LAS f32x2v*)(lds + 8192);
        const int col0 = u.pn * BM + wc * 32 + 4 * fq;
#pragma unroll
        for (int bj = 0; bj < 2; ++bj)
#pragma unroll
            for (int n = 0; n < 2; ++n) { const f32x4 bv = bias ? *(const f32x4*)(bias + col0 + bj * HALF + n * 16) : (f32x4){0.f, 0.f, 0.f, 0.f};
#pragma unroll
                for (int ai = 0; ai < 2; ++ai)
#pragma unroll
                    for (int m = 0; m < 4; ++m) acc[ai][bj][m][n] += bv; }
        const bool bad = st.run(acc, u, wr, wc, fr, fq, lds, wid, lane) || poison != 0u;
        const float qnan = __builtin_nanf("");
#pragma unroll
        for (int ai = 0; ai < 2; ++ai)
#pragma unroll
            for (int m = 0; m < 4; ++m) { const int r = ai * HALF + wr * 64 + m * 16 + fr; const f32x2v sr = S[r]; const size_t off = (size_t)(u.pm * BM + r) * ldc + col0;
#pragma unroll
                for (int bj = 0; bj < 2; ++bj)
#pragma unroll
                    for (int n = 0; n < 2; ++n) { const f32x4 bs = *(const f32x4*)(base + off + bj * HALF + n * 16); f32x4 o = bs + (acc[ai][bj][m][n] - sr.x) * sr.y;
                        if (bad) o = (f32x4){qnan, qnan, qnan, qnan}; *(f32x4*)(out + off + bj * HALF + n * 16) = o; }
                asm volatile("" ::: "memory"); }
    }
};
struct EpiLnResLn {
    static constexpr bool PERM = false, AFTER_DRAIN = true;
    const float* base; float* out; bf16_t* xn; int ldc; const float* bias; PanelStats st1, st2; unsigned poison;
    __device__ __forceinline__ void refuse(size_t i0, size_t stride, int M, int N) const { const float q = __builtin_nanf(""); for (size_t i = i0; i < (size_t)M * N; i += stride) { const size_t o = (i / N) * ldc + i % N; out[o] = q; xn[o] = (bf16_t)0x7fc0u; }
        if (i0 == 0) { unsigned expect = 0u; __hip_atomic_compare_exchange_strong(st1.tmo + 1, &expect, 0x7f0u, __ATOMIC_RELAXED, __ATOMIC_RELAXED, __HIP_MEMORY_SCOPE_AGENT); __hip_atomic_store(st1.tmo, 1u, __ATOMIC_RELAXED, __HIP_MEMORY_SCOPE_AGENT); } }
    __device__ __forceinline__ void fused(f32x4 (&acc)[2][2][4][2], const Unit& u, int wr, int wc, int fr, int fq, PG8_LAS unsigned char* lds, int wid, int lane) const {
        typedef float f32x2v __attribute__((ext_vector_type(2))); typedef unsigned u32x2v __attribute__((ext_vector_type(2)));
        const PG8_LAS f32x2v* S = (const PG8_LAS f32x2v*)(lds + 8192);
        const int col0 = u.pn * BM + wc * 32 + 4 * fq;
#pragma unroll
        for (int bj = 0; bj < 2; ++bj)
#pragma unroll
            for (int n = 0; n < 2; ++n) { const f32x4 bv = bias ? *(const f32x4*)(bias + col0 + bj * HALF + n * 16) : (f32x4){0.f, 0.f, 0.f, 0.f};
#pragma unroll
                for (int ai = 0; ai < 2; ++ai)
#pragma unroll
                    for (int m = 0; m < 4; ++m) acc[ai][bj][m][n] += bv; }
        bool bad = st1.run(acc, u, wr, wc, fr, fq, lds, wid, lane) || poison != 0u;
        const float qnan = __builtin_nanf("");
#pragma unroll
        for (int ai = 0; ai < 2; ++ai)
#pragma unroll
            for (int m = 0; m < 4; ++m) { const int r = ai * HALF + wr * 64 + m * 16 + fr; const f32x2v sr = S[r]; const size_t off = (size_t)(u.pm * BM + r) * ldc + col0;
#pragma unroll
                for (int bj = 0; bj < 2; ++bj)
#pragma unroll
                    for (int n = 0; n < 2; ++n) { const f32x4 bs = *(const f32x4*)(base + off + bj * HALF + n * 16); acc[ai][bj][m][n] = bs + (acc[ai][bj][m][n] - sr.x) * sr.y; }
                asm volatile("" : "+v"(acc[ai][0][m][0]), "+v"(acc[ai][0][m][1]), "+v"(acc[ai][1][m][0]), "+v"(acc[ai][1][m][1]));
                if (m & 1) asm volatile("" ::: "memory"); }
        const bool bad1 = bad;
        bad = st2.run(acc, u, wr, wc, fr, fq, lds, wid, lane) || bad;
#pragma unroll
        for (int ai = 0; ai < 2; ++ai)
#pragma unroll
            for (int m = 0; m < 4; ++m) { const int r = ai * HALF + wr * 64 + m * 16 + fr; const f32x2v sr = S[r]; const size_t off = (size_t)(u.pm * BM + r) * ldc + col0;
#pragma unroll
                for (int bj = 0; bj < 2; ++bj)
#pragma unroll
                    for (int n = 0; n < 2; ++n) { const f32x4 x1 = acc[ai][bj][m][n]; *(f32x4*)(out + off + bj * HALF + n * 16) = bad1 ? (f32x4){qnan, qnan, qnan, qnan} : x1;
                        const f32x4 o = (x1 - sr.x) * sr.y; u32x2v w; w.x = cvt_pk_bf16(o[0], o[1]); w.y = cvt_pk_bf16(o[2], o[3]);
                        if (bad) { w.x = 0x7fc07fc0u; w.y = 0x7fc07fc0u; } *(u32x2v*)(xn + off + bj * HALF + n * 16) = w; }
                asm volatile("" ::: "memory"); }
    }
};

template <class Epi, class Sched, bool STAMP = false>
__device__ __forceinline__ void gemm_phase(PG8_LAS unsigned char* lds, const Gemm g, const Sched& S, const Epi& E, unsigned long long* stamps) {
    int tid_ = threadIdx.x; asm volatile("" : "+v"(tid_)); const int tid = tid_, wid = __builtin_amdgcn_readfirstlane(tid >> 6), lane = tid & 63, wr = wid >> 2, wc = wid & 3, fr = lane & 15, fq = lane >> 4;
    const int K = g.K, nt = K / BK;
    int ts_lo = 0, ts_hi = 0, nts = 0; const unsigned long long rt_entry = STAMP ? (unsigned long long)wall_clock64() : 0ull;
#define PG8_STAMP() do { if (STAMP && wid == 0 && nts < 64) { const unsigned long long _c = (unsigned long long)clock64(); \
        ts_lo = (lane == nts) ? (int)(unsigned)_c : ts_lo; ts_hi = (lane == nts) ? (int)(unsigned)(_c >> 32) : ts_hi; ++nts; } } while (0)
    PG8_STAMP();
    unsigned voffA[2], voffB[2];
#pragma unroll
    for (int i = 0; i < 2; ++i) { int R, C; stage_rc(tid * 16 + i * 8192, R, C); const int Rb = Epi::PERM ? ((R & ~31) + perm32(R & 31)) : R;
        voffA[i] = (unsigned)(R * K + C) * 2u; voffB[i] = (unsigned)(Rb * K + C) * 2u; }
    const size_t kstep = (size_t)(BK * 2);
    const size_t hstep = (size_t)HALF * K * 2;
    const size_t tstep = 2 * hstep;
    const unsigned ldsw = (unsigned)wid * 1024u;
    const int aoff = lds_byte(wr * 64 + fr, fq * 8), boff = lds_byte(wc * 32 + fr, fq * 8);
#define PG8_SA(b, h) (((b) * 2 + (h)) * HTB)
#define PG8_SB(b, h) ((4 + (b) * 2 + (h)) * HTB)
#define PG8_STAGE(bufoff, gbase, voff) do { _Pragma("unroll") for (int _i = 0; _i < 2; ++_i) \
        __builtin_amdgcn_global_load_lds((const unsigned*)((const char*)(gbase) + (voff)[_i]), (PG8_LAS unsigned*)(lds + (bufoff) + ldsw + _i * 8192), 16, 0, 0); } while (0)
#define PG8_LDA(dst, b, h) do { _Pragma("unroll") for (int m = 0; m < 4; ++m) _Pragma("unroll") for (int k = 0; k < 2; ++k) dst[m][k] = *(const PG8_LAS bf16x8*)(lds + PG8_SA(b, h) + aoff + m * 2048 + k * 1024); } while (0)
#define PG8_LDB(dst, b, h) do { _Pragma("unroll") for (int n = 0; n < 2; ++n) _Pragma("unroll") for (int k = 0; k < 2; ++k) dst[n][k] = *(const PG8_LAS bf16x8*)(lds + PG8_SB(b, h) + boff + n * 2048 + k * 1024); } while (0)
#define PG8_MMA(ai, bj, At, Bt) do { __builtin_amdgcn_s_setprio(1); _Pragma("unroll") for (int m = 0; m < 4; ++m) _Pragma("unroll") for (int n = 0; n < 2; ++n) _Pragma("unroll") for (int k = 0; k < 2; ++k) \
        acc[ai][bj][m][n] = __builtin_amdgcn_mfma_f32_16x16x32_bf16(Bt[n][k], At[m][k], acc[ai][bj][m][n], 0, 0, 0); __builtin_amdgcn_s_setprio(0); } while (0)
#define PG8_WAIT_V(n) asm volatile("s_waitcnt vmcnt(" #n ")" ::: "memory")
#define PG8_WAIT_L(n) asm volatile("s_waitcnt lgkmcnt(" #n ")" ::: "memory")
#define PG8_BAR __builtin_amdgcn_s_barrier()
#define PG8_SCHED __builtin_amdgcn_sched_barrier(0)
    Unit cur, nxt; int ui = 0;
    if (!S.next(0, cur)) return;
    f32x4 acc[2][2][4][2];
#pragma unroll
    for (int a = 0; a < 2; ++a)
#pragma unroll
        for (int b = 0; b < 2; ++b)
#pragma unroll
            for (int m = 0; m < 4; ++m)
#pragma unroll
                for (int n = 0; n < 2; ++n) acc[a][b][m][n] = (f32x4){0.f, 0.f, 0.f, 0.f};
    bf16x8 At[4][2], B0[2][2], B1[2][2];
    const char* cA = (const char*)g.A + (size_t)cur.pm * tstep; const char* cB = (const char*)g.Bt + (size_t)cur.pn * tstep;
    S.a_ready(cur);
    PG8_STAGE(PG8_SB(0, 0), cB, voffB); PG8_STAGE(PG8_SA(0, 0), cA, voffA); PG8_STAGE(PG8_SB(0, 1), cB + hstep, voffB); PG8_STAGE(PG8_SA(0, 1), cA + hstep, voffA);
    if (wr == 1) PG8_BAR;
    PG8_WAIT_V(4); PG8_BAR;
    PG8_STAGE(PG8_SB(1, 0), cB + kstep, voffB); PG8_STAGE(PG8_SA(1, 0), cA + kstep, voffA); PG8_STAGE(PG8_SB(1, 1), cB + hstep + kstep, voffB);
    PG8_WAIT_V(6); PG8_BAR;
    PG8_STAMP();
    for (;;) {
        const bool has_next = S.next(ui + 1, nxt);
        const char* nA = has_next ? (const char*)g.A + (size_t)nxt.pm * tstep : cA; const char* nB = has_next ? (const char*)g.Bt + (size_t)nxt.pn * tstep : cB;
        for (int t = 0; t < nt; t += 2) {
            const bool last = (t == nt - 2);
            const char* a1 = cA + (size_t)(t + 1) * kstep;
            const char* a2 = last ? nA : cA + (size_t)(t + 2) * kstep; const char* b2 = last ? nB : cB + (size_t)(t + 2) * kstep;
            const char* a3 = a2 + kstep; const char* b3 = b2 + kstep;
            if (last && has_next) S.a_ready(nxt);
            PG8_LDB(B0, 0, 0); PG8_SCHED; PG8_LDA(At, 0, 0); PG8_STAGE(PG8_SA(1, 1), a1 + hstep, voffA);
            PG8_WAIT_L(8); PG8_BAR; PG8_WAIT_L(0); PG8_MMA(0, 0, At, B0); PG8_BAR; PG8_SCHED;
            PG8_LDB(B1, 0, 1); PG8_STAGE(PG8_SB(0, 0), b2, voffB);
            PG8_BAR; PG8_WAIT_L(0); PG8_MMA(0, 1, At, B1); PG8_BAR;
            PG8_LDA(At, 0, 1); PG8_STAGE(PG8_SA(0, 0), a2, voffA);
            PG8_BAR; PG8_WAIT_L(0); PG8_MMA(1, 0, At, B0); PG8_BAR; PG8_SCHED;
            PG8_STAGE(PG8_SB(0, 1), b2 + hstep, voffB);
            PG8_WAIT_V(6); PG8_BAR; PG8_MMA(1, 1, At, B1); PG8_BAR;
            PG8_LDB(B0, 1, 0); PG8_SCHED; PG8_LDA(At, 1, 0); PG8_STAGE(PG8_SA(0, 1), a2 + hstep, voffA);
            PG8_WAIT_L(8); PG8_BAR; PG8_WAIT_L(0); PG8_MMA(0, 0, At, B0); PG8_BAR; PG8_SCHED;
            PG8_LDB(B1, 1, 1); PG8_STAGE(PG8_SB(1, 0), b3, voffB);
            PG8_BAR; PG8_WAIT_L(0); PG8_MMA(0, 1, At, B1); PG8_BAR;
            PG8_LDA(At, 1, 1); PG8_STAGE(PG8_SA(1, 0), a3, voffA);
            PG8_BAR; PG8_WAIT_L(0); PG8_MMA(1, 0, At, B0); PG8_BAR; PG8_SCHED;
            PG8_STAGE(PG8_SB(1, 1), b3 + hstep, voffB);
            PG8_WAIT_V(6); PG8_BAR; PG8_MMA(1, 1, At, B1); PG8_BAR;
        }
        PG8_STAMP();
        if constexpr (!Epi::AFTER_DRAIN) { E(acc, cur, wr, wc, fr, fq); S.done(cur); }
        PG8_STAMP();
        if (!has_next) break;
#pragma unroll
        for (int a = 0; a < 2; ++a)
#pragma unroll
            for (int b = 0; b < 2; ++b)
#pragma unroll
                for (int m = 0; m < 4; ++m)
#pragma unroll
                    for (int n = 0; n < 2; ++n) acc[a][b][m][n] = (f32x4){0.f, 0.f, 0.f, 0.f};
        cur = nxt; cA = nA; cB = nB; ++ui;
    }
    PG8_WAIT_V(0);
    if (wr == 0) PG8_BAR;
    PG8_BAR;
    if constexpr (Epi::AFTER_DRAIN) { E.fused(acc, cur, wr, wc, fr, fq, lds, wid, lane); S.done(cur); }
    PG8_STAMP();
    if (STAMP && wid == 0) { stamps[lane] = lane < nts ? (((unsigned long long)(unsigned)ts_hi << 32) | (unsigned)ts_lo) : 0ull;
        if (lane == 62) stamps[62] = rt_entry; if (lane == 63) stamps[63] = (unsigned long long)wall_clock64(); }
#undef PG8_STAMP
#undef PG8_SA
#undef PG8_SB
#undef PG8_STAGE
#undef PG8_LDA
#undef PG8_LDB
#undef PG8_MMA
#undef PG8_WAIT_V
#undef PG8_WAIT_L
#undef PG8_BAR
#undef PG8_SCHED
}
}
#define LAS __attribute__((address_space(3)))
typedef unsigned short bf16_t;
typedef float f32x4 __attribute__((ext_vector_type(4)));
typedef float f32x2 __attribute__((ext_vector_type(2)));
typedef unsigned u32x4 __attribute__((ext_vector_type(4)));
typedef unsigned u32x2 __attribute__((ext_vector_type(2)));
constexpr int NTOK = 8192, SEQ = 2048, DM = 2048, NIN = 7372, NP = 7424, NL = 4;
constexpr int LRUW = 512, GW = 768, RW_ = 768;
constexpr int PC_AX = 0, PC_AG = 512, PC_BQKV = 1024, PC_BG = 3328, PC_CIN = 4096, PC_CG = 6592, PC_BETA = 7360, PC_BA = 7366;
constexpr int LDS_BYTES = 131072 + 512;
#ifndef CHUNKREP
#define CHUNKREP 0
#endif
#ifndef CONV_SPLIT2
#define CONV_SPLIT2 52
#endif
#ifndef CONV_SPLIT
#define CONV_SPLIT 24
#endif
#ifndef REPMASK
#define REPMASK 0
#endif
#ifndef SKIPMASK
#define SKIPMASK 0
#endif
#ifndef N_LAUNCH_MODE
#define N_LAUNCH_MODE 1
#endif
constexpr int PPL = 7;
constexpr int NPHASE = 2 + PPL * NL;
constexpr size_t WS_WIN = 0;
constexpr size_t WS_WOUT = WS_WIN + (size_t)NL * NP * DM * 2;
constexpr size_t WS_XB = WS_WOUT + (size_t)NL * DM * DM * 2;
constexpr size_t WS_XR = WS_XB + (size_t)NTOK * DM * 2;
constexpr size_t WS_PROJ = WS_XR + (size_t)NTOK * DM * 4;
constexpr size_t WS_Y = WS_PROJ + (size_t)NTOK * NP * 2;
constexpr size_t SZ768 = (size_t)NTOK * 768 * 4;
constexpr size_t WS_GQ = WS_Y + (size_t)NTOK * DM * 2;
constexpr size_t WS_GK = WS_GQ + SZ768;
constexpr size_t WS_GV = WS_GK + SZ768;
constexpr size_t WS_GO = WS_GV + SZ768;
constexpr size_t WS_RR = WS_GO + SZ768;
constexpr size_t WS_RW = WS_RR + SZ768;
constexpr size_t WS_RK = WS_RW + SZ768;
constexpr size_t WS_RV = WS_RK + SZ768;
constexpr size_t WS_RKK = WS_RV + SZ768;
constexpr size_t WS_RB = WS_RKK + SZ768;
constexpr size_t WS_RY = WS_RB + SZ768;
constexpr size_t WS_GB = WS_RY + SZ768;
constexpr size_t WS_GG = WS_GB + (size_t)NTOK * 8 * 4;
constexpr size_t WS_LA = WS_GG + (size_t)NTOK * 8 * 4;
constexpr size_t WS_LU = WS_LA + (size_t)NTOK * 512 * 4;
constexpr size_t WS_LEND = WS_LU + (size_t)NTOK * 512 * 4;
constexpr int GCH = 768, RCH = 1536;
constexpr size_t WS_G1 = WS_LEND;
constexpr size_t WS_G2 = WS_G1 + (size_t)GCH * 64 * 128 * 2;
constexpr size_t WS_G3 = WS_G2 + (size_t)GCH * 64 * 128 * 2;
constexpr size_t WS_G4 = WS_G3 + (size_t)GCH * 64 * 64 * 2;
constexpr size_t WS_GU = WS_G4 + (size_t)GCH * 128 * 64 * 2;
constexpr size_t WS_GGL = WS_GU + (size_t)GCH * 128 * 64 * 4;
constexpr size_t WS_R1 = WS_GGL + (size_t)GCH * 128 * 4;
constexpr size_t WS_R2 = WS_R1 + (size_t)RCH * 64 * 64 * 2;
constexpr size_t WS_R3 = WS_R2 + (size_t)RCH * 64 * 64 * 2;
constexpr size_t WS_R4 = WS_R3 + (size_t)RCH * 64 * 128 * 2;
constexpr size_t WS_RU = WS_R4 + (size_t)RCH * 64 * 128 * 2;
constexpr size_t WS_RVT = WS_RU + (size_t)RCH * 64 * 64 * 4;
constexpr size_t WS_RGL = WS_RVT + (size_t)RCH * 64 * 64 * 2;
constexpr size_t WS_LH = WS_RGL + (size_t)RCH * 64 * 4;
constexpr size_t WS_LP = WS_LH + (size_t)NTOK * 512 * 4;
constexpr size_t WS_LC = WS_LP + (size_t)NTOK * 512 * 4;
constexpr size_t WS_BAR = WS_LC + (size_t)128 * 512 * 4;
constexpr size_t WS_WUPT = WS_BAR + 16384;
constexpr size_t WS_AUPT = WS_WUPT + (size_t)NL * 768 * 96 * 2;
constexpr size_t WS_WXT = WS_AUPT + (size_t)NL * 768 * 96 * 2;
constexpr size_t WS_WAT = WS_WXT + (size_t)NL * 8 * 64 * 64 * 2;
constexpr size_t WS_END = WS_WAT + (size_t)NL * 8 * 64 * 64 * 2;

struct Args {
    const float* in[26];
    float* out; unsigned char* ws;
    int ph_lo, ph_hi;
};
enum { I_X = 0, I_NORMG, I_WIN, I_WOUT, I_LCW, I_LCB, I_LWX, I_LBX, I_LWA, I_LBA, I_LLAM, I_GCW, I_GALOG, I_GDT, I_GNG,
       I_RMU, I_RW0, I_RWUP, I_RA0, I_RAUP, I_RKK, I_RKA, I_RRK, I_RGNW, I_RGNB, I_FNG };

__device__ __forceinline__ int tid_l() { int t = threadIdx.x; asm volatile("" : "+v"(t)); return t; }
#define LBAR() do { asm volatile("s_waitcnt lgkmcnt(0)" ::: "memory"); __builtin_amdgcn_s_barrier(); asm volatile("" ::: "memory"); } while (0)
__device__ __forceinline__ int bid_l() { int b = blockIdx.x; asm volatile("" : "+s"(b)); return b; }
__device__ __forceinline__ int gdim_l() { int b = gridDim.x; asm volatile("" : "+s"(b)); return b; }
__device__ __forceinline__ const float* inp(LAS unsigned char* lds, int i) {
    const LAS unsigned* t = (const LAS unsigned*)(lds + 131072) + 2 * i;
    const unsigned lo = __builtin_amdgcn_readfirstlane(t[0]), hi = __builtin_amdgcn_readfirstlane(t[1]);
    return (const float*)(const __attribute__((address_space(1))) float*)(((unsigned long long)hi << 32) | lo);
}
__device__ __forceinline__ float bf2f(bf16_t b) { return __uint_as_float(((unsigned)b) << 16); }
typedef __bf16 bf2n_t __attribute__((ext_vector_type(2)));
__device__ __forceinline__ unsigned pk2(float lo, float hi) { const f32x2 v = {lo, hi}; const bf2n_t r = __builtin_convertvector(v, bf2n_t); return __builtin_bit_cast(unsigned, r); }
__device__ __forceinline__ bf16_t f2bf(float f) { return (bf16_t)(pk2(f, f) & 0xffffu); }
template <int CTRL> __device__ __forceinline__ float dpp_f(float v) { return __int_as_float(__builtin_amdgcn_update_dpp(0, __float_as_int(v), CTRL, 0xF, 0xF, true)); }
__device__ __forceinline__ float sum16(float v) { v += dpp_f<0xB1>(v); v += dpp_f<0x4E>(v); v += dpp_f<0x141>(v); v += dpp_f<0x140>(v); return v; }
__device__ __forceinline__ float wave_sum(float v) { v = sum16(v); v += __shfl_xor(v, 16); v += __shfl_xor(v, 32); return v; }
typedef __bf16 bf2_t __attribute__((ext_vector_type(2)));
__device__ __forceinline__ unsigned cvtpk(float lo, float hi) { const f32x2 v = {lo, hi}; const bf2_t r = __builtin_convertvector(v, bf2_t); return __builtin_bit_cast(unsigned, r); }
__device__ __forceinline__ float sigmoidf_(float x) { return __builtin_amdgcn_rcpf(1.0f + __expf(-x)); }
__device__ __forceinline__ float siluf_(float x) { return x * __builtin_amdgcn_rcpf(1.0f + __expf(-x)); }
__device__ __forceinline__ float softplusf_(float x) { return fmaxf(x, 0.f) + __logf(1.0f + __expf(-fabsf(x))); }
__device__ __forceinline__ float tanhf_(float x) { const float e = __expf(-2.0f * fabsf(x)); return copysignf((1.0f - e) * __builtin_amdgcn_rcpf(1.0f + e), x); }

__device__ __forceinline__ void transpose_item(const float* W, int K, int N, bf16_t* WT, const float* scale, bool remap, LAS float* scr, int item, int nblk, int lane) {
    const int kb = item / nblk, nb = item % nblk, k0 = 64 * kb, n0 = 32 * nb;
    int np = n0 + (lane & 31), oc;
    if (!remap) oc = np;
    else if (np < 4096) oc = np;
    else if (np < 7360) oc = np + 12;
    else if (np < 7372) oc = np - 7360 + 4096;
    else oc = -1;
    float vbuf[32], sbuf[32];
#pragma unroll
    for (int i = 0; i < 32; ++i) { const int kk = 2 * i + (lane >> 5); vbuf[i] = (oc >= 0) ? W[(size_t)(k0 + kk) * N + oc] : 0.f; sbuf[i] = scale ? scale[k0 + kk] : 1.0f; }
#pragma unroll
    for (int i = 0; i < 32; ++i) { const int kk = 2 * i + (lane >> 5); scr[kk * 33 + (lane & 31)] = vbuf[i] * sbuf[i]; }
    __builtin_amdgcn_s_waitcnt(0xc07f); asm volatile("s_waitcnt lgkmcnt(0)" ::: "memory");
    const int c = lane & 7;
#pragma unroll
    for (int j = 0; j < 4; ++j) { const int n = (lane >> 3) + 8 * j; const LAS float* s = scr + (8 * c) * 33 + n;
        u32x4 o; o.x = pk2(s[0 * 33], s[1 * 33]); o.y = pk2(s[2 * 33], s[3 * 33]); o.z = pk2(s[4 * 33], s[5 * 33]); o.w = pk2(s[6 * 33], s[7 * 33]);
        *(u32x4*)(WT + (size_t)(n0 + n) * K + k0 + 8 * c) = o; }
    asm volatile("s_waitcnt lgkmcnt(0)" ::: "memory");
}
__device__ __forceinline__ void phase_convert(const Args& a, LAS unsigned char* lds, int l_lo, int l_hi, int f_lo, int f_hi, int vb, int nvb, int small) {
    size_t wso_ = 0; asm volatile("" : "+s"(wso_)); unsigned char* ws = a.ws + wso_;
    const int tid = tid_l(), wave = __builtin_amdgcn_readfirstlane(tid >> 6), lane = tid & 63;
    LAS float* scr = (LAS float*)(lds + wave * 8448);
    const int gw = vb * 8 + wave, NGW = nvb * 8;
    constexpr int I_IN = (DM / 64) * (NP / 32), I_OUT = (DM / 64) * (DM / 32), PER_L = I_IN + I_OUT;
    const int i_lo = (PER_L / 64) * f_lo, i_hi = (PER_L / 64) * f_hi, span = i_hi - i_lo;
    for (int it = gw; it < (l_hi - l_lo) * span; it += NGW) {
        const int l = l_lo + it / span; int r = i_lo + it % span;
        if (r < I_IN) transpose_item(inp(lds, I_WIN) + (size_t)l * DM * NIN, DM, NIN, (bf16_t*)(ws + WS_WIN) + (size_t)l * NP * DM, inp(lds, I_NORMG) + l * DM, true, scr, r, NP / 32, lane);
        else transpose_item(inp(lds, I_WOUT) + (size_t)l * DM * DM, DM, DM, (bf16_t*)(ws + WS_WOUT) + (size_t)l * DM * DM, nullptr, false, scr, r - I_IN, DM / 32, lane);
    }
    if (small) {
        const int gt = vb * 512 + tid, NT_ = nvb * 512;
        const float* wup = inp(lds, I_RWUP); const float* aup = inp(lds, I_RAUP); bf16_t* WUPT = (bf16_t*)(ws + WS_WUPT); bf16_t* AUPT = (bf16_t*)(ws + WS_AUPT);
        for (int idx = gt; idx < NL * 768 * 96; idx += NT_) { const int i = idx % 96, j = (idx / 96) % 768, l = idx / (96 * 768); const size_t src = ((size_t)l * 96 + i) * 768 + j; WUPT[idx] = f2bf(wup[src]); AUPT[idx] = f2bf(aup[src]); }
        const float* wx = inp(lds, I_LWX); const float* wa = inp(lds, I_LWA); bf16_t* WXT = (bf16_t*)(ws + WS_WXT); bf16_t* WAT = (bf16_t*)(ws + WS_WAT);
        for (int idx = gt; idx < NL * 8 * 64 * 64; idx += NT_) { const int i = idx & 63, j = (idx >> 6) & 63, ln = idx >> 12; const size_t src = ((size_t)ln * 64 + i) * 64 + j; WXT[idx] = f2bf(wx[src]); WAT[idx] = f2bf(wa[src]); }
    }
}
__device__ __forceinline__ void phase_rms(const float* xin, bf16_t* xb) {
    const int tid = tid_l(), wave = tid >> 6, lane = tid & 63;
    const int gw = bid_l() * 8 + wave, NGW = gdim_l() * 8;
    for (int m = gw; m < NTOK; m += NGW) {
        const f32x4* xr = (const f32x4*)(xin + (size_t)m * DM) + lane;
        f32x4 v[8]; float s = 0.f;
#pragma unroll
        for (int j = 0; j < 8; ++j) { v[j] = xr[64 * j]; s += (v[j].x * v[j].x + v[j].y * v[j].y) + (v[j].z * v[j].z + v[j].w * v[j].w); }
        const float rstd = __builtin_amdgcn_rsqf(wave_sum(s) * (1.0f / DM) + 1e-6f);
        u32x2* o = (u32x2*)(xb + (size_t)m * DM) + lane;
#pragma unroll
        for (int j = 0; j < 8; ++j) { u32x2 w; w.x = pk2(v[j].x * rstd, v[j].y * rstd); w.y = pk2(v[j].z * rstd, v[j].w * rstd); o[64 * j] = w; }
    }
}
__device__ __forceinline__ void phase_final(const float* xin, const float* g, float* out) {
    const int tid = tid_l(), wave = tid >> 6, lane = tid & 63;
    const int gw = bid_l() * 8 + wave, NGW = gdim_l() * 8;
    for (int m = gw; m < NTOK; m += NGW) {
        const f32x4* xr = (const f32x4*)(xin + (size_t)m * DM) + lane;
        f32x4 v[8]; float s = 0.f;
#pragma unroll
        for (int j = 0; j < 8; ++j) { v[j] = xr[64 * j]; s += (v[j].x * v[j].x + v[j].y * v[j].y) + (v[j].z * v[j].z + v[j].w * v[j].w); }
        const float rstd = __builtin_amdgcn_rsqf(wave_sum(s) * (1.0f / DM) + 1e-6f);
        f32x4* o = (f32x4*)(out + (size_t)m * DM) + lane; const f32x4* gg = (const f32x4*)g + lane;
#pragma unroll
        for (int j = 0; j < 8; ++j) o[64 * j] = v[j] * rstd * gg[64 * j];
    }
}
struct EpiDual {
    static constexpr bool PERM = true, AFTER_DRAIN = false;
    int mode; bf16_t* O; int ldo; const float* base; float* C; int ldc;
    __device__ __forceinline__ void operator()(const pg8::f32x4 (&acc)[2][2][4][2], const pg8::Unit& u, int wr, int wc, int fr, int fq) const {
        const int row0 = u.pm * 256 + wr * 64 + fr, col0 = u.pn * 256 + wc * 32 + 8 * fq;
        if (mode == 0) {
#pragma unroll
            for (int ai = 0; ai < 2; ++ai)
#pragma unroll
                for (int m = 0; m < 4; ++m) { bf16_t* rowp = O + (size_t)(row0 + ai * 128 + m * 16) * ldo + col0;
#pragma unroll
                    for (int bj = 0; bj < 2; ++bj) { const pg8::f32x4 v0 = acc[ai][bj][m][0], v1 = acc[ai][bj][m][1];
                        pg8::u32x4 w; w.x = cvtpk(v0[0], v0[1]); w.y = cvtpk(v0[2], v0[3]); w.z = cvtpk(v1[0], v1[1]); w.w = cvtpk(v1[2], v1[3]);
                        *(pg8::u32x4*)(rowp + bj * 128) = w; } }
        } else {
#pragma unroll
            for (int ai = 0; ai < 2; ++ai)
#pragma unroll
                for (int m = 0; m < 4; ++m) { const size_t off = (size_t)(row0 + ai * 128 + m * 16) * ldc + col0;
#pragma unroll
                    for (int bj = 0; bj < 2; ++bj)
#pragma unroll
                        for (int n = 0; n < 2; ++n) { const pg8::f32x4 b = *(const pg8::f32x4*)(base + off + bj * 128 + n * 4); *(pg8::f32x4*)(C + off + bj * 128 + n * 4) = acc[ai][bj][m][n] + b; }
                    asm volatile("" ::: "memory"); }
        }
    }
};
constexpr int PT = 32;
typedef short bf16x8 __attribute__((ext_vector_type(8)));
__device__ __forceinline__ void phase_prep(const Args& a, int l, LAS unsigned char* lds) {
    size_t wso_ = 0; asm volatile("" : "+s"(wso_)); unsigned char* ws = a.ws + wso_;
    const int tid0 = tid_l(), wave = __builtin_amdgcn_readfirstlane(tid0 >> 6);
    const bf16_t* PROJ = (const bf16_t*)(ws + WS_PROJ);
    constexpr int XSR = 200, XLR = 520;
    LAS bf16_t* xsb = (LAS bf16_t*)lds;
    LAS bf16_t* xlb = (LAS bf16_t*)(lds + PT * XSR * 2);
    LAS float* xlf = (LAS float*)(lds + PT * XSR * 2 + PT * XLR * 2);
    float* GQ = (float*)(ws + WS_GQ); float* GK = (float*)(ws + WS_GK); float* GV = (float*)(ws + WS_GV);
    float* GB = (float*)(ws + WS_GB); float* GG = (float*)(ws + WS_GG);
    float* RR = (float*)(ws + WS_RR); float* RWd = (float*)(ws + WS_RW); float* RK = (float*)(ws + WS_RK); float* RV = (float*)(ws + WS_RV);
    float* RKK = (float*)(ws + WS_RKK); float* RB = (float*)(ws + WS_RB);
    float* LA = (float*)(ws + WS_LA); float* LU = (float*)(ws + WS_LU);
    const float* mu = inp(lds, I_RMU) + l * 2496;
    for (int tile = bid_l(); tile < NTOK / PT; tile += gdim_l()) {
        int tid = tid0; asm volatile("" : "+v"(tid)); const int lane = tid & 63, lr = lane & 15, lq = lane >> 4;
        const int t0 = tile * PT, sp = t0 % SEQ;
        { bf16_t curv[12], prevv[12];
#pragma unroll
            for (int q = 0; q < 12; ++q) { const int idx = tid + 512 * q, tt = idx / 192, i = idx % 192; const int col = PC_CIN + 2304 + i;
                curv[q] = PROJ[(size_t)(t0 + tt) * NP + col]; prevv[q] = PROJ[(size_t)(t0 + tt - ((sp + tt > 0) ? 1 : 0)) * NP + col]; }
#pragma unroll
            for (int q = 0; q < 12; ++q) { const int idx = tid + 512 * q, tt = idx / 192, i = idx % 192; const float cur = bf2f(curv[q]), prev = (sp + tt > 0) ? bf2f(prevv[q]) : 0.f;
                float xs = cur + (prev - cur) * mu[2304 + i]; if (i < 96) xs = tanhf_(xs); xsb[tt * XSR + i] = f2bf(xs); } }
        { const int j = tid; const float* cw = inp(lds, I_LCW) + l * 4 * LRUW; const float w0 = cw[j], w1 = cw[LRUW + j], w2 = cw[2 * LRUW + j], w3 = cw[3 * LRUW + j], cb = inp(lds, I_LCB)[l * LRUW + j];
            float xm3 = (sp >= 3) ? bf2f(PROJ[(size_t)(t0 - 3) * NP + PC_AX + j]) : 0.f, xm2 = (sp >= 2) ? bf2f(PROJ[(size_t)(t0 - 2) * NP + PC_AX + j]) : 0.f, xm1 = (sp >= 1) ? bf2f(PROJ[(size_t)(t0 - 1) * NP + PC_AX + j]) : 0.f;
            bf16_t cv[PT];
#pragma unroll
            for (int tt = 0; tt < PT; ++tt) cv[tt] = PROJ[(size_t)(t0 + tt) * NP + PC_AX + j];
#pragma unroll
            for (int tt = 0; tt < PT; ++tt) { const float cur = bf2f(cv[tt]); const float x = w0 * xm3 + w1 * xm2 + w2 * xm1 + w3 * cur + cb; xlf[tt * 512 + j] = x; xlb[tt * XLR + j] = f2bf(x); xm3 = xm2; xm2 = xm1; xm1 = cur; } }
        LBAR();
        for (int u = wave; u < 24; u += 8) { const int h = u % 12, tb = u / 12;
            bf16x8 xw[3], xa[3];
#pragma unroll
            for (int k = 0; k < 3; ++k) { xw[k] = *(const LAS bf16x8*)(xsb + (tb * 16 + lr) * XSR + 32 * k + 8 * lq); xa[k] = *(const LAS bf16x8*)(xsb + (tb * 16 + lr) * XSR + 96 + 32 * k + 8 * lq); }
            f32x4 aw[4], aa[4];
#pragma unroll
            for (int jq = 0; jq < 4; ++jq) { const int jrow = l * 768 + h * 64 + jq * 16 + lr; const bf16_t* pw = (const bf16_t*)(ws + WS_WUPT) + (size_t)jrow * 96 + 8 * lq; const bf16_t* pa = (const bf16_t*)(ws + WS_AUPT) + (size_t)jrow * 96 + 8 * lq;
                aw[jq] = (f32x4){0.f, 0.f, 0.f, 0.f}; aa[jq] = (f32x4){0.f, 0.f, 0.f, 0.f};
#pragma unroll
                for (int k = 0; k < 3; ++k) { aw[jq] = __builtin_amdgcn_mfma_f32_16x16x32_bf16(xw[k], *(const bf16x8*)(pw + 32 * k), aw[jq], 0, 0, 0); aa[jq] = __builtin_amdgcn_mfma_f32_16x16x32_bf16(xa[k], *(const bf16x8*)(pa + 32 * k), aa[jq], 0, 0, 0); } }
            const int tokb = tb * 16 + 4 * lq;
            bf16_t pr_[5][4], pk_[5][4], pv_[5][4];
#pragma unroll
            for (int rr = 0; rr < 5; ++rr) { const int trow = t0 + tokb + rr - ((rr == 0 && sp + tokb == 0) ? 0 : 1);
#pragma unroll
                for (int jq = 0; jq < 4; ++jq) { const bf16_t* p = PROJ + (size_t)trow * NP + PC_CIN + h * 64 + jq * 16 + lr; pr_[rr][jq] = p[0]; pk_[rr][jq] = p[768]; pv_[rr][jq] = p[1536]; } }
            float w0v[4], a0v[4], kkwv[4], kawv[4], murv[4], mukv[4], muvv[4];
#pragma unroll
            for (int jq = 0; jq < 4; ++jq) { const int j = h * 64 + jq * 16 + lr; w0v[jq] = inp(lds, I_RW0)[l * 768 + j]; a0v[jq] = inp(lds, I_RA0)[l * 768 + j]; kkwv[jq] = inp(lds, I_RKK)[l * 768 + j]; kawv[jq] = inp(lds, I_RKA)[l * 768 + j];
                murv[jq] = mu[j]; mukv[jq] = mu[768 + j]; muvv[jq] = mu[1536 + j]; }
#pragma unroll
            for (int r = 0; r < 4; ++r) { const bool first = (sp + tokb + r == 0);
                float kr[4], kv_[4], rv_[4], vv_[4], av_[4]; float ss = 0.f;
#pragma unroll
                for (int jq = 0; jq < 4; ++jq) { const float cr = bf2f(pr_[r + 1][jq]), ck = bf2f(pk_[r + 1][jq]), cvv = bf2f(pv_[r + 1][jq]);
                    const float qr = first ? 0.f : bf2f(pr_[r][jq]), qk = first ? 0.f : bf2f(pk_[r][jq]), qv = first ? 0.f : bf2f(pv_[r][jq]);
                    rv_[jq] = cr + (qr - cr) * murv[jq]; kv_[jq] = ck + (qk - ck) * mukv[jq]; vv_[jq] = cvv + (qv - cvv) * muvv[jq];
                    av_[jq] = sigmoidf_(a0v[jq] + aa[jq][r]); kr[jq] = kv_[jq] * kkwv[jq]; ss += kr[jq] * kr[jq]; }
                ss = sum16(ss); const float rs = __builtin_amdgcn_rsqf(ss + 1e-6f);
#pragma unroll
                for (int jq = 0; jq < 4; ++jq) { const size_t o = (size_t)(t0 + tokb + r) * 768 + h * 64 + jq * 16 + lr;
                    const float wlog = -softplusf_(-(w0v[jq] + aw[jq][r])) - 0.5f; RWd[o] = -__expf(wlog);
                    const float kk = kr[jq] * rs; RR[o] = rv_[jq]; RK[o] = kv_[jq] * (1.0f + (av_[jq] - 1.0f) * kawv[jq]); RV[o] = vv_[jq]; RKK[o] = kk; RB[o] = kk * av_[jq]; } }
        }
        for (int u = wave; u < 16; u += 8) { const int n = u & 7, tb = u >> 3;
            bf16x8 xg[2];
#pragma unroll
            for (int k = 0; k < 2; ++k) xg[k] = *(const LAS bf16x8*)(xlb + (tb * 16 + lr) * XLR + n * 64 + 32 * k + 8 * lq);
            f32x4 ax[4], ag[4];
#pragma unroll
            for (int jq = 0; jq < 4; ++jq) { const size_t jrow = (size_t)(l * 8 + n) * 64 + jq * 16 + lr; const bf16_t* px = (const bf16_t*)(ws + WS_WXT) + jrow * 64 + 8 * lq; const bf16_t* pa = (const bf16_t*)(ws + WS_WAT) + jrow * 64 + 8 * lq;
                ax[jq] = (f32x4){0.f, 0.f, 0.f, 0.f}; ag[jq] = (f32x4){0.f, 0.f, 0.f, 0.f};
#pragma unroll
                for (int k = 0; k < 2; ++k) { ax[jq] = __builtin_amdgcn_mfma_f32_16x16x32_bf16(xg[k], *(const bf16x8*)(px + 32 * k), ax[jq], 0, 0, 0); ag[jq] = __builtin_amdgcn_mfma_f32_16x16x32_bf16(xg[k], *(const bf16x8*)(pa + 32 * k), ag[jq], 0, 0, 0); } }
#pragma unroll
            for (int jq = 0; jq < 4; ++jq) { const int j = n * 64 + jq * 16 + lr; const float bx = inp(lds, I_LBX)[l * 512 + j], ba = inp(lds, I_LBA)[l * 512 + j]; const float spl = softplusf_(-inp(lds, I_LLAM)[l * 512 + j]);
#pragma unroll
                for (int r = 0; r < 4; ++r) { const int tt = tb * 16 + 4 * lq + r; const float gx = sigmoidf_(ax[jq][r] + bx), ga = sigmoidf_(ag[jq][r] + ba);
                    const float loga = -8.0f * ga * spl; const float av = __expf(loga); const float mult = __builtin_amdgcn_sqrtf(fmaxf(1.0f - __expf(2.0f * loga), 0.f));
                    LA[(size_t)(t0 + tt) * 512 + j] = av; LU[(size_t)(t0 + tt) * 512 + j] = mult * gx * xlf[tt * 512 + j]; } } }
        for (int wt = wave; wt < 18; wt += 8) { const int ch0 = 128 * wt + 2 * lane; const float* cw = inp(lds, I_GCW) + (size_t)l * 4 * 2304 + ch0;
            const f32x2 w0 = *(const f32x2*)(cw), w1 = *(const f32x2*)(cw + 2304), w2 = *(const f32x2*)(cw + 2 * 2304), w3 = *(const f32x2*)(cw + 3 * 2304);
            f32x2 xm3 = {0.f, 0.f}, xm2 = {0.f, 0.f}, xm1 = {0.f, 0.f};
            const bf16_t* pc = PROJ + PC_BQKV + ch0;
            if (sp >= 3) { const unsigned q = *(const unsigned*)(pc + (size_t)(t0 - 3) * NP); xm3.x = __uint_as_float(q << 16); xm3.y = __uint_as_float(q & 0xffff0000u); }
            if (sp >= 2) { const unsigned q = *(const unsigned*)(pc + (size_t)(t0 - 2) * NP); xm2.x = __uint_as_float(q << 16); xm2.y = __uint_as_float(q & 0xffff0000u); }
            if (sp >= 1) { const unsigned q = *(const unsigned*)(pc + (size_t)(t0 - 1) * NP); xm1.x = __uint_as_float(q << 16); xm1.y = __uint_as_float(q & 0xffff0000u); }
            float* dst = (wt < 6) ? GQ : (wt < 12 ? GK : GV); const int dch = ch0 % 768;
            unsigned qv[PT];
#pragma unroll
            for (int tt = 0; tt < PT; ++tt) qv[tt] = *(const unsigned*)(pc + (size_t)(t0 + tt) * NP);
#pragma unroll
            for (int tt = 0; tt < PT; ++tt) { const unsigned q = qv[tt]; f32x2 cur; cur.x = __uint_as_float(q << 16); cur.y = __uint_as_float(q & 0xffff0000u);
                f32x2 v = w0 * xm3 + w1 * xm2 + w2 * xm1 + w3 * cur; v.x = siluf_(v.x); v.y = siluf_(v.y);
                if (wt < 12) { const float ss = wave_sum(v.x * v.x + v.y * v.y); float sc = __builtin_amdgcn_rsqf(ss + 1e-6f); if (wt < 6) sc *= 0.08838834764831845f; v = v * sc; }
                *(f32x2*)(dst + (size_t)(t0 + tt) * 768 + dch) = v; xm3 = xm2; xm2 = xm1; xm1 = cur; } }
        if (tid < PT * 6) { const int tt = tid / 6, h = tid % 6; const float bl = bf2f(PROJ[(size_t)(t0 + tt) * NP + PC_BETA + h]), al = bf2f(PROJ[(size_t)(t0 + tt) * NP + PC_BA + h]);
            GB[(size_t)(t0 + tt) * 8 + h] = sigmoidf_(bl); GG[(size_t)(t0 + tt) * 8 + h] = -__expf(inp(lds, I_GALOG)[l * 6 + h]) * softplusf_(al + inp(lds, I_GDT)[l * 6 + h]); }
        LBAR();
    }
}
typedef short bf16x8 __attribute__((ext_vector_type(8)));
struct ScanRec { const bf16_t* M1; const bf16_t* M2; const bf16_t* M3; const bf16_t* M4T; const float* UT; const float* G; const bf16_t* VT; };
template <int D, int KZ, bool EXT>
__device__ __forceinline__ void scan_item(const ScanRec R0, int e0, float* OUT, int out_ld, LAS unsigned char* lds) {
    constexpr int NK1 = D / 32, NK2 = KZ / 32, NT3 = D / 64, SROW = D + 8, ZROW = KZ + 8, HD = EXT ? 64 : 128;
    constexpr bool GS = !EXT;
    const int tid = tid_l(), w = __builtin_amdgcn_readfirstlane(tid >> 6), lane = tid & 63, lr = lane & 15, lq = lane >> 4;
    const bool front = (w < 4); const int cb = w & 3;
    LAS bf16_t* ST = (LAS bf16_t*)lds;
    LAS bf16_t* ZT = (LAS bf16_t*)(lds + 2 * 32 * SROW * 2);
    constexpr int OSROW = 36;
    LAS float* OS = (LAS float*)(lds + 2 * 32 * SROW * 2 + 32 * ZROW * 2);
    for (int i = tid; i < 2 * 32 * SROW / 2; i += 512) ((LAS unsigned*)ST)[i] = 0u;
    struct FS { bf16x8 m1[NK1], m3[NK2]; f32x4 ut[2]; u32x4 vt; };
    struct BS { bf16x8 m4[NT3][NK2]; f32x4 g[GS ? 1 : NT3]; float gs; };
#define SCAN_LOADF(s, n) do { \
        const bf16_t* a1_ = R0.M1 + (size_t)(n) * 64 * D + (cb * 16 + lr) * D + 8 * lq; \
        _Pragma("unroll") for (int k = 0; k < NK1; ++k) s.m1[k] = *(const bf16x8*)(a1_ + 32 * k); \
        const bf16_t* a3_ = R0.M3 + (size_t)(n) * 64 * KZ + (cb * 16 + lr) * KZ + 8 * lq; \
        _Pragma("unroll") for (int k = 0; k < NK2; ++k) s.m3[k] = *(const bf16x8*)(a3_ + 32 * k); \
        _Pragma("unroll") for (int j = 0; j < 2; ++j) s.ut[j] = *(const f32x4*)(R0.UT + (size_t)(n) * HD * 64 + (size_t)(e0 + j * 16 + lr) * 64 + cb * 16 + 4 * lq); \
        if (EXT) s.vt = *(const u32x4*)(R0.VT + (size_t)(n) * 64 * 64 + (size_t)(e0 + (tid >> 3)) * 64 + (tid & 7) * 8); } while (0)
#define SCAN_LOADB(s, n) do { \
        _Pragma("unroll") for (int t = 0; t < NT3; ++t) { const int db = cb + 4 * t; const bf16_t* a4_ = R0.M4T + (size_t)(n) * D * KZ + (db * 16 + lr) * KZ + 8 * lq; \
            _Pragma("unroll") for (int k = 0; k < NK2; ++k) s.m4[t][k] = *(const bf16x8*)(a4_ + 32 * k); \
            if (!GS) s.g[t] = *(const f32x4*)(R0.G + (size_t)(n) * D + db * 16 + 4 * lq); } \
        if (GS) s.gs = R0.G[(size_t)(n) * D]; } while (0)
#define SCAN_OUT(n) do { const f32x4 ov = *(const LAS f32x4*)(OS + (tid >> 3) * OSROW + (tid & 7) * 4); *(f32x4*)(OUT + (size_t)((n) * 64 + (tid >> 3)) * out_ld + e0 + (tid & 7) * 4) = ov; } while (0)
#define SCAN_STEP_F(n, par, fc, fl) do { \
        LAS bf16_t* STo = ST + (par) * 32 * SROW; \
        bf16x8 m2l[NK1]; \
        { const bf16_t* a2_ = R0.M2 + (size_t)(n) * 64 * D + (cb * 16 + lr) * D + 8 * lq; _Pragma("unroll") for (int k = 0; k < NK1; ++k) m2l[k] = *(const bf16x8*)(a2_ + 32 * k); }     \
        if ((n) + 2 < 32) SCAN_LOADF(fl, (n) + 2); \
        _Pragma("unroll") for (int j = 0; j < 2; ++j) { f32x4 a1 = fc.ut[j]; \
            _Pragma("unroll") for (int k = 0; k < NK1; ++k) { const bf16x8 y = *(const LAS bf16x8*)(STo + (j * 16 + lr) * SROW + 32 * k + 8 * lq); a1 = __builtin_amdgcn_mfma_f32_16x16x32_bf16(fc.m1[k], y, a1, 0, 0, 0); } \
            u32x2 zz; zz.x = cvtpk(a1[0], a1[1]); zz.y = cvtpk(a1[2], a1[3]); *(LAS u32x2*)(ZT + (j * 16 + lr) * ZROW + cb * 16 + 4 * lq) = zz; } \
        if (EXT) *(LAS u32x4*)(ZT + (tid >> 3) * ZROW + 64 + (tid & 7) * 8) = fc.vt; \
        LBAR(); \
        _Pragma("unroll") for (int j = 0; j < 2; ++j) { f32x4 a2 = (f32x4){0.f, 0.f, 0.f, 0.f}; \
            _Pragma("unroll") for (int k = 0; k < NK2; ++k) { const bf16x8 z = *(const LAS bf16x8*)(ZT + (j * 16 + lr) * ZROW + 32 * k + 8 * lq); a2 = __builtin_amdgcn_mfma_f32_16x16x32_bf16(fc.m3[k], z, a2, 0, 0, 0); } \
            _Pragma("unroll") for (int k = 0; k < NK1; ++k) { const bf16x8 y = *(const LAS bf16x8*)(STo + (j * 16 + lr) * SROW + 32 * k + 8 * lq); a2 = __builtin_amdgcn_mfma_f32_16x16x32_bf16(m2l[k], y, a2, 0, 0, 0); } \
            _Pragma("unroll") for (int r = 0; r < 4; ++r) OS[(cb * 16 + 4 * lq + r) * OSROW + j * 16 + lr] = a2[r]; } \
        LBAR(); \
        SCAN_OUT(n); } while (0)
#define SCAN_STEP_B(n, par, bc, bl) do { \
        LAS bf16_t* STn = ST + (1 - (par)) * 32 * SROW; \
        if ((n) + 2 < 32) SCAN_LOADB(bl, (n) + 2); \
        LBAR(); \
        _Pragma("unroll") for (int j = 0; j < 2; ++j) { \
            _Pragma("unroll") for (int t = 0; t < NT3; ++t) { if (GS) accs[t][j] = accs[t][j] * bc.gs; else accs[t][j] = accs[t][j] * bc.g[GS ? 0 : t]; } \
            _Pragma("unroll") for (int k = 0; k < NK2; ++k) { const bf16x8 z = *(const LAS bf16x8*)(ZT + (j * 16 + lr) * ZROW + 32 * k + 8 * lq); \
                _Pragma("unroll") for (int t = 0; t < NT3; ++t) accs[t][j] = __builtin_amdgcn_mfma_f32_16x16x32_bf16(bc.m4[t][k], z, accs[t][j], 0, 0, 0); } \
            _Pragma("unroll") for (int t = 0; t < NT3; ++t) { const int db = cb + 4 * t; u32x2 ss; ss.x = cvtpk(accs[t][j][0], accs[t][j][1]); ss.y = cvtpk(accs[t][j][2], accs[t][j][3]); *(LAS u32x2*)(STn + (j * 16 + lr) * SROW + db * 16 + 4 * lq) = ss; } } \
        LBAR(); \
        SCAN_OUT(n); } while (0)
    if (front) {
        FS f0, f1, f2;
        SCAN_LOADF(f0, 0); SCAN_LOADF(f1, 1);
        __builtin_amdgcn_s_waitcnt(0x0F70);
        LBAR();
        for (int n0 = 0; n0 < 30; n0 += 6) {
            SCAN_STEP_F(n0, 0, f0, f2); SCAN_STEP_F(n0 + 1, 1, f1, f0); SCAN_STEP_F(n0 + 2, 0, f2, f1);
            SCAN_STEP_F(n0 + 3, 1, f0, f2); SCAN_STEP_F(n0 + 4, 0, f1, f0); SCAN_STEP_F(n0 + 5, 1, f2, f1);
        }
        SCAN_STEP_F(30, 0, f0, f2); SCAN_STEP_F(31, 1, f1, f0);
    } else {
        BS b0, b1, b2;
        f32x4 accs[NT3][2];
#pragma unroll
        for (int t = 0; t < NT3; ++t) { accs[t][0] = (f32x4){0.f, 0.f, 0.f, 0.f}; accs[t][1] = (f32x4){0.f, 0.f, 0.f, 0.f}; }
        SCAN_LOADB(b0, 0); SCAN_LOADB(b1, 1);
        __builtin_amdgcn_s_waitcnt(0x0F70);
        LBAR();
        for (int n0 = 0; n0 < 30; n0 += 6) {
            SCAN_STEP_B(n0, 0, b0, b2); SCAN_STEP_B(n0 + 1, 1, b1, b0); SCAN_STEP_B(n0 + 2, 0, b2, b1);
            SCAN_STEP_B(n0 + 3, 1, b0, b2); SCAN_STEP_B(n0 + 4, 0, b1, b0); SCAN_STEP_B(n0 + 5, 1, b2, b1);
        }
        SCAN_STEP_B(30, 0, b0, b2); SCAN_STEP_B(31, 1, b1, b0);
    }
#undef SCAN_STEP_F
#undef SCAN_STEP_B
#undef SCAN_OUT
#undef SCAN_LOADF
#undef SCAN_LOADB
}

__device__ __forceinline__ void phase_gdn_chunk(const Args& a, int l, LAS unsigned char* lds) {
    size_t wso_ = 0; asm volatile("" : "+s"(wso_)); unsigned char* ws = a.ws + wso_;
    const int tid0 = tid_l(), w = __builtin_amdgcn_readfirstlane(tid0 >> 6);
    const float* GQ = (const float*)(ws + WS_GQ); const float* GK = (const float*)(ws + WS_GK); const float* GV = (const float*)(ws + WS_GV);
    const float* GB = (const float*)(ws + WS_GB); const float* GG = (const float*)(ws + WS_GG);
    constexpr int KROW = 136;
    LAS bf16_t* Kb = (LAS bf16_t*)lds;
    LAS bf16_t* Qb = (LAS bf16_t*)(lds + 64 * KROW * 2);
    LAS float* Af = (LAS float*)(lds + 2 * 64 * KROW * 2);
    LAS float* dvb = Af + 64 * 64;
    const int first = bid_l(), gstep = gdim_l();
    const int nmine = (first < GCH) ? (GCH - first + gstep - 1) / gstep : 0;
    for (int k = -1; k < nmine; ++k) {
        int tid = tid0; asm volatile("" : "+v"(tid)); const int lane = tid & 63, lr = lane & 15, lq = lane >> 4;
        LBAR();
        if (w < 4) {
            const bool act = (k >= 0); const int item = first + (act ? k : 0) * gstep;
            const int b = item / 192, h = (item / 32) % 6, n = item % 32; const size_t t0 = (size_t)b * SEQ + n * 64;
            LAS float* dv = dvb + (k & 1) * 128; LAS float* bv = dv + 64;
            const int col = tid; const bool isu = (w < 2); const int cc = col & 127;
            float X[64]; int Arow[63];
            if (act) {
                const float* src = (isu ? GV : GK) + t0 * 768 + h * 128 + cc;
#pragma unroll
                for (int c = 0; c < 64; ++c) X[c] = src[(size_t)c * 768];
#pragma unroll
                for (int m = 0; m < 63; ++m) Arow[m] = __float_as_int(Af[m * 64 + lane]);
                if (isu) {
#pragma unroll
                    for (int c = 0; c < 64; ++c) X[c] *= bv[c]; }
                else {
#pragma unroll
                    for (int c = 0; c < 64; ++c) X[c] *= bv[c] * __expf(dv[c]); }
            }
            LBAR();
            if (act) {
#pragma unroll
                for (int m = 0; m < 63; ++m) { const float xm = X[m];
#pragma unroll
                    for (int c = m + 1; c < 64; ++c) X[c] -= __int_as_float(__builtin_amdgcn_readlane(Arow[m], c)) * xm; }
            }
            LBAR();
            if (act) {
                if (isu) { float* UT = (float*)(ws + WS_GU) + (size_t)item * 128 * 64 + (size_t)cc * 64;
#pragma unroll
                    for (int c4 = 0; c4 < 16; ++c4) *(f32x4*)(UT + 4 * c4) = (f32x4){X[4 * c4], X[4 * c4 + 1], X[4 * c4 + 2], X[4 * c4 + 3]}; }
                else { bf16_t* M1 = (bf16_t*)(ws + WS_G1) + (size_t)item * 64 * 128 + cc;
#pragma unroll
                    for (int c = 0; c < 64; ++c) M1[c * 128] = f2bf(-X[c]); }
            }
        } else {
            const bool act = (k + 1 < nmine); const int item = first + (act ? (k + 1) : 0) * gstep;
            const int b = item / 192, h = (item / 32) % 6, n = item % 32; const size_t t0 = (size_t)b * SEQ + n * 64;
            LAS float* dv = dvb + ((k + 1) & 1) * 128; LAS float* bv = dv + 64;
            const int t = tid - 256, wb = w - 4;
            if (act) {
                float gpre = 0.f, bpre = 0.f; if (wb == 0) { gpre = GG[(t0 + lane) * 8 + h]; bpre = GB[(t0 + lane) * 8 + h]; }
#pragma unroll
                for (int hf = 0; hf < 2; ++hf) { f32x4 kv4[4], qv4[4];
#pragma unroll
                    for (int q = 0; q < 4; ++q) { const int idx = t + 256 * (4 * hf + q), c = idx >> 5, d4 = idx & 31; const size_t g = (t0 + c) * 768 + h * 128 + d4 * 4; kv4[q] = *(const f32x4*)(GK + g); qv4[q] = *(const f32x4*)(GQ + g); }
#pragma unroll
                    for (int q = 0; q < 4; ++q) { const int idx = t + 256 * (4 * hf + q), c = idx >> 5, d4 = idx & 31; const f32x4 kv = kv4[q], qv = qv4[q];
                        u32x2 pk; pk.x = cvtpk(kv[0], kv[1]); pk.y = cvtpk(kv[2], kv[3]); *(LAS u32x2*)(Kb + c * KROW + d4 * 4) = pk;
                        u32x2 pq; pq.x = cvtpk(qv[0], qv[1]); pq.y = cvtpk(qv[2], qv[3]); *(LAS u32x2*)(Qb + c * KROW + d4 * 4) = pq; } }
                if (wb == 0) { float g = gpre;
#pragma unroll
                    for (int o = 1; o < 64; o <<= 1) { const float tt = __shfl_up(g, o); if (lane >= o) g += tt; }
                    dv[lane] = g; bv[lane] = bpre; }
            }
            LBAR();
            if (act) {
                const int which = wb >> 1; const LAS bf16_t* X = which ? Qb : Kb;
                bf16_t* M3 = (bf16_t*)(ws + WS_G3) + (size_t)item * 64 * 64;
#pragma unroll
                for (int ci = 0; ci < 2; ++ci) { const int cb = 2 * (wb & 1) + ci;
                    bf16x8 xf[4];
#pragma unroll
                    for (int kk = 0; kk < 4; ++kk) xf[kk] = *(const LAS bf16x8*)(X + (cb * 16 + lr) * KROW + 32 * kk + 8 * lq);
#pragma unroll
                    for (int mb = 0; mb < 4; ++mb) { f32x4 acc = (f32x4){0.f, 0.f, 0.f, 0.f};
#pragma unroll
                        for (int kk = 0; kk < 4; ++kk) { const bf16x8 yf = *(const LAS bf16x8*)(Kb + (mb * 16 + lr) * KROW + 32 * kk + 8 * lq); acc = __builtin_amdgcn_mfma_f32_16x16x32_bf16(xf[kk], yf, acc, 0, 0, 0); }
                        const int m = mb * 16 + lr; const float dm = dv[m];
                        if (which == 0) { f32x4 o;
#pragma unroll
                            for (int r = 0; r < 4; ++r) { const int c = cb * 16 + 4 * lq + r; o[r] = (c > m) ? bv[c] * acc[r] * __expf(dv[c] - dm) : 0.f; }
                            *(LAS f32x4*)(Af + m * 64 + cb * 16 + 4 * lq) = o; }
                        else {
#pragma unroll
                            for (int r = 0; r < 4; ++r) { const int c = cb * 16 + 4 * lq + r; M3[c * 64 + m] = f2bf((c >= m) ? acc[r] * __expf(dv[c] - dm) : 0.f); } } } }
            }
            LBAR();
            if (act) {
                const float dl = dv[63];
                bf16_t* M2 = (bf16_t*)(ws + WS_G2) + (size_t)item * 64 * 128;
#pragma unroll
                for (int q = 0; q < 8; ++q) { const int idx = t + 256 * q, c = idx >> 5, d4 = idx & 31; const u32x2 qq = *(const LAS u32x2*)(Qb + c * KROW + d4 * 4); const float e = __expf(dv[c]);
                    u32x2 p; p.x = cvtpk(__uint_as_float(qq.x << 16) * e, __uint_as_float(qq.x & 0xffff0000u) * e); p.y = cvtpk(__uint_as_float(qq.y << 16) * e, __uint_as_float(qq.y & 0xffff0000u) * e); *(u32x2*)(M2 + c * 128 + d4 * 4) = p; }
                { const int d = t & 127, ch = t >> 7; bf16_t* M4 = (bf16_t*)(ws + WS_G4) + (size_t)item * 128 * 64 + d * 64 + ch * 32;
#pragma unroll
                    for (int q = 0; q < 4; ++q) { float kv[8];
#pragma unroll
                        for (int j = 0; j < 8; ++j) { const int c = ch * 32 + q * 8 + j; kv[j] = bf2f(Kb[c * KROW + d]) * __expf(dl - dv[c]); }
                        u32x4 p; p.x = cvtpk(kv[0], kv[1]); p.y = cvtpk(kv[2], kv[3]); p.z = cvtpk(kv[4], kv[5]); p.w = cvtpk(kv[6], kv[7]); *(u32x4*)(M4 + q * 8) = p; } }
                if (t < 128) ((float*)(ws + WS_GGL))[(size_t)item * 128 + t] = __expf(dl);
            }
        }
    }
    LBAR();
}

__device__ __forceinline__ void phase_rwkv_chunk(const Args& a, int l, LAS unsigned char* lds) {
    size_t wso_ = 0; asm volatile("" : "+s"(wso_)); unsigned char* ws = a.ws + wso_;
    const int tid0 = tid_l(), w = __builtin_amdgcn_readfirstlane(tid0 >> 6);
    const float* RR = (const float*)(ws + WS_RR); const float* RWl = (const float*)(ws + WS_RW); const float* RK = (const float*)(ws + WS_RK); const float* RV = (const float*)(ws + WS_RV);
    const float* RKK = (const float*)(ws + WS_RKK); const float* RB = (const float*)(ws + WS_RB);
    constexpr int OR_ = 72;
    LAS float* cw = (LAS float*)lds;
    LAS bf16_t* M3s = (LAS bf16_t*)lds;
    LAS bf16_t* Al = (LAS bf16_t*)(lds + 16384); LAS bf16_t* Be = Al + 64 * OR_; LAS bf16_t* Ka = Be + 64 * OR_; LAS bf16_t* Rh = Ka + 64 * OR_;
    LAS float* ABf = (LAS float*)(lds + 53248);
    LAS bf16_t* AKb = (LAS bf16_t*)(lds + 69632);
    LAS bf16_t* VTb = (LAS bf16_t*)(lds + 78848);
    LAS float* RH2 = (LAS float*)(lds + 88064);
    LAS bf16_t* M4s = (LAS bf16_t*)(lds + 104448);
    LAS float* segt = (LAS float*)(lds + 121856);
    const int first = bid_l(), gstep = gdim_l();
    const int nmine = (first < RCH) ? (RCH - first + gstep - 1) / gstep : 0;
    if (w < 2) {
    for (int k = -1; k < nmine; ++k) {
        int tid = tid0; asm volatile("" : "+v"(tid)); const int lane = tid & 63, lr = lane & 15, lq = lane >> 4;
            const bool act = (k >= 0); const int item = first + (act ? k : 0) * gstep;
            const bool isom = (w == 0); const int cc = tid & 63;
            float X[64]; int Arow[63];
            if (act) {
                if (isom) {
#pragma unroll
                    for (int c = 0; c < 64; ++c) X[c] = bf2f(Al[c * OR_ + cc]); }
                else {
#pragma unroll
                    for (int c = 0; c < 64; ++c) X[c] = RH2[c * 64 + cc]; }
#pragma unroll
                for (int m = 0; m < 63; ++m) Arow[m] = __float_as_int(ABf[m * 64 + lane]);
            }
            LBAR();
#define RW_SOLVE(m0, m1) do { if (act) { _Pragma("unroll") for (int m = (m0); m < (m1); ++m) { const float xm = X[m]; \
                _Pragma("unroll") for (int c = m + 1; c < 64; ++c) X[c] -= __int_as_float(__builtin_amdgcn_readlane(Arow[m], c)) * xm; } } } while (0)
            RW_SOLVE(0, 30);
            LBAR();
            RW_SOLVE(30, 63);
            LBAR();
#undef RW_SOLVE
            if (act) {
                if (isom) { bf16_t* M1 = (bf16_t*)(ws + WS_R1) + (size_t)item * 4096 + cc;
#pragma unroll
                    for (int c = 0; c < 64; ++c) M1[c * 64] = f2bf(X[c]); }
                else { float* UT = (float*)(ws + WS_RU) + (size_t)item * 4096 + (size_t)cc * 64;
#pragma unroll
                    for (int c4 = 0; c4 < 16; ++c4) *(f32x4*)(UT + 4 * c4) = (f32x4){X[4 * c4], X[4 * c4 + 1], X[4 * c4 + 2], X[4 * c4 + 3]}; }
            }
            LBAR();
    }
    } else {
    float plw[16], pv[11], pkk[12], pbb[12], pk2[12], pr[12];
#define RWB_ISSUE(it) do { const int b_ = (it) / 384, h_ = ((it) / 32) % 12, n_ = (it) % 32; const size_t gb_ = ((size_t)b_ * SEQ + n_ * 64) * 768 + h_ * 64; const int t_ = tidp - 128, wb_ = w - 2; \
        if (wb_ < 4) { _Pragma("unroll") for (int q = 0; q < 16; ++q) plw[q] = RWl[gb_ + (size_t)(wb_ * 16 + q) * 768 + (tidp & 63)]; } \
        _Pragma("unroll") for (int q = 0; q < 11; ++q) { const int idx = t_ + 384 * q; const int c = (idx >> 6) & 63, i = idx & 63; pv[q] = RV[gb_ + (size_t)c * 768 + i]; } \
        _Pragma("unroll") for (int q = 0; q < 12; ++q) { const int idx = t_ + 384 * q; const int c = (idx >> 6) & 63, j = idx & 63; const size_t g = gb_ + (size_t)c * 768 + j; pkk[q] = RKK[g]; pbb[q] = RB[g]; pk2[q] = RK[g]; pr[q] = RR[g]; } } while (0)
    if (nmine > 0) { int tidp = tid0; asm volatile("" : "+v"(tidp)); RWB_ISSUE(first); }
    for (int k = -1; k < nmine; ++k) {
        int tid = tid0; asm volatile("" : "+v"(tid)); const int lane = tid & 63, lr = lane & 15, lq = lane >> 4;
            const bool act = (k + 1 < nmine); const int item = first + (act ? (k + 1) : 0) * gstep;
            const int b = item / 384, h = (item / 32) % 12, n = item % 32; const size_t gb = ((size_t)b * SEQ + n * 64) * 768 + h * 64;
            const int t = tid - 128, wb = w - 2;
            if (act) {
                if (wb < 4) {
                    float acc = 0.f;
#pragma unroll
                    for (int q = 0; q < 8; ++q) { acc += plw[q]; cw[(wb * 16 + q) * 64 + lane] = acc; }
                    segt[(2 * wb) * 64 + lane] = acc; acc = 0.f;
#pragma unroll
                    for (int q = 8; q < 16; ++q) { acc += plw[q]; cw[(wb * 16 + q) * 64 + lane] = acc; }
                    segt[(2 * wb + 1) * 64 + lane] = acc; }
#pragma unroll
                for (int q = 0; q < 11; ++q) { const int idx = t + 384 * q; const int c = idx >> 6, i = idx & 63; if (idx < 4096) VTb[i * OR_ + c] = f2bf(pv[q]); }
            }
            LBAR();
            if (act) {
#pragma unroll
                for (int hf = 0; hf < 2; ++hf) {
#pragma unroll
                    for (int q = 0; q < 6; ++q) { const int idx = t + 384 * (6 * hf + q); const int c = idx >> 6, j = idx & 63;
                        if (idx < 4096) {
                            float off = 0.f, offm = 0.f, tot = 0.f;
#pragma unroll
                            for (int s2 = 0; s2 < 8; ++s2) { const float st = segt[s2 * 64 + j]; if (s2 < (c >> 3)) off += st; if (c > 0 && s2 < ((c - 1) >> 3)) offm += st; tot += st; }
                            const float cwc = cw[c * 64 + j] + off, cwm = c ? cw[(c - 1) * 64 + j] + offm : 0.f, cwl = tot;
                            const float kk = pkk[6 * hf + q], bb = pbb[6 * hf + q], k2 = pk2[6 * hf + q], r = pr[6 * hf + q];
                            const float en = __expf(-cwc);
                            Al[c * OR_ + j] = f2bf(kk * __expf(cwm)); Be[c * OR_ + j] = f2bf(bb * en); Ka[c * OR_ + j] = f2bf(k2 * en); const bf16_t rh = f2bf(r * __expf(cwc)); Rh[c * OR_ + j] = rh;
                            ((bf16_t*)(ws + WS_R2))[(size_t)item * 4096 + c * 64 + j] = rh;
                            const float ed = __expf(cwl - cwc); M4s[j * 136 + c] = f2bf(-bb * ed); M4s[j * 136 + 64 + c] = f2bf(k2 * ed);
                            if (c == 63) ((float*)(ws + WS_RGL))[(size_t)item * 64 + j] = __expf(cwl); } } }
                if (k + 2 < nmine) { const int tidp = tid; RWB_ISSUE(first + (k + 2) * gstep); }
            }
            LBAR();
            if (act) {
                for (int pc = wb; pc < 16; pc += 6) { const int p = pc >> 2, cb = pc & 3; const LAS bf16_t* X = (p < 2) ? Al : Rh; const LAS bf16_t* Y = (p & 1) ? Ka : Be;
                    const bf16x8 x0 = *(const LAS bf16x8*)(X + (cb * 16 + lr) * OR_ + 8 * lq), x1 = *(const LAS bf16x8*)(X + (cb * 16 + lr) * OR_ + 32 + 8 * lq);
#pragma unroll
                    for (int mb = 0; mb < 4; ++mb) { f32x4 acc = (f32x4){0.f, 0.f, 0.f, 0.f};
                        acc = __builtin_amdgcn_mfma_f32_16x16x32_bf16(x0, *(const LAS bf16x8*)(Y + (mb * 16 + lr) * OR_ + 8 * lq), acc, 0, 0, 0);
                        acc = __builtin_amdgcn_mfma_f32_16x16x32_bf16(x1, *(const LAS bf16x8*)(Y + (mb * 16 + lr) * OR_ + 32 + 8 * lq), acc, 0, 0, 0);
                        const int m = mb * 16 + lr;
                        if (p == 0) { f32x4 o;
#pragma unroll
                            for (int r = 0; r < 4; ++r) { const int c = cb * 16 + 4 * lq + r; o[r] = (c > m) ? acc[r] : 0.f; }
                            *(LAS f32x4*)(ABf + m * 64 + cb * 16 + 4 * lq) = o; }
                        else {
#pragma unroll
                            for (int r = 0; r < 4; ++r) { const int c = cb * 16 + 4 * lq + r;
                                if (p == 1) AKb[c * OR_ + m] = f2bf((c > m) ? acc[r] : 0.f);
                                else if (p == 2) M3s[c * 128 + m] = f2bf((c >= m) ? -acc[r] : 0.f);
                                else M3s[c * 128 + 64 + m] = f2bf((c >= m) ? acc[r] : 0.f); } } } }
            }
            LBAR();
            if (act) {
                for (int tl = wb; tl < 16; tl += 6) { const int cb = tl >> 2, ib = tl & 3;
                    const bf16x8 x0 = *(const LAS bf16x8*)(AKb + (cb * 16 + lr) * OR_ + 8 * lq), x1 = *(const LAS bf16x8*)(AKb + (cb * 16 + lr) * OR_ + 32 + 8 * lq);
                    f32x4 acc = (f32x4){0.f, 0.f, 0.f, 0.f};
                    acc = __builtin_amdgcn_mfma_f32_16x16x32_bf16(x0, *(const LAS bf16x8*)(VTb + (ib * 16 + lr) * OR_ + 8 * lq), acc, 0, 0, 0);
                    acc = __builtin_amdgcn_mfma_f32_16x16x32_bf16(x1, *(const LAS bf16x8*)(VTb + (ib * 16 + lr) * OR_ + 32 + 8 * lq), acc, 0, 0, 0);
#pragma unroll
                    for (int r = 0; r < 4; ++r) RH2[(cb * 16 + 4 * lq + r) * 64 + ib * 16 + lr] = acc[r]; }
                u32x4* g3 = (u32x4*)((bf16_t*)(ws + WS_R3) + (size_t)item * 64 * 128);
                for (int q = t; q < 1024; q += 384) g3[q] = *(const LAS u32x4*)(M3s + q * 8);
                u32x4* g4 = (u32x4*)((bf16_t*)(ws + WS_R4) + (size_t)item * 64 * 128);
                for (int q = t; q < 1024; q += 384) g4[q] = *(const LAS u32x4*)(M4s + (q >> 4) * 136 + (q & 15) * 8);
                u32x4* gv = (u32x4*)((bf16_t*)(ws + WS_RVT) + (size_t)item * 64 * 64);
                for (int q = t; q < 512; q += 384) gv[q] = *(const LAS u32x4*)(VTb + (q >> 3) * OR_ + (q & 7) * 8);
            }
            LBAR();
    }
    }
    LBAR();
#undef RWB_ISSUE
}

__device__ __forceinline__ void phase_lru_chunk(const Args& a) {
    size_t wso_ = 0; asm volatile("" : "+s"(wso_)); unsigned char* ws = a.ws + wso_;
    const int tid = tid_l();
    const float* LA = (const float*)(ws + WS_LA); const float* LU = (const float*)(ws + WS_LU); float* LH = (float*)(ws + WS_LH); float* LP = (float*)(ws + WS_LP);
    for (int p = bid_l() * 512 + tid; p < 128 * 512; p += gdim_l() * 512) { const int chunk = p >> 9, c = p & 511; const size_t base = (size_t)chunk * 64 * 512 + c;
        float h = 0.f, cp = 1.f;
        for (int i0 = 0; i0 < 64; i0 += 16) { float av[16], uv[16];
#pragma unroll
            for (int i = 0; i < 16; ++i) { av[i] = LA[base + (size_t)(i0 + i) * 512]; uv[i] = LU[base + (size_t)(i0 + i) * 512]; }
#pragma unroll
            for (int i = 0; i < 16; ++i) { h = av[i] * h + uv[i]; cp *= av[i]; LH[base + (size_t)(i0 + i) * 512] = h; LP[base + (size_t)(i0 + i) * 512] = cp; } } }
}
constexpr int SB = 16;
__device__ __forceinline__ void phase_scan_naive(const Args& a, int l, LAS unsigned char* lds) {
    size_t wso_ = 0; asm volatile("" : "+s"(wso_)); unsigned char* ws = a.ws + wso_;
    const int tid = tid_l(), wave = __builtin_amdgcn_readfirstlane(tid >> 6), lane = tid & 63;
    const int blk = bid_l();
    if (blk < 96) {
        const int xq = blk >> 3, bh = (blk & 7) * 3 + (xq >> 2), es = xq & 3, b = bh / 6, h = bh % 6; const size_t ci = (size_t)bh * 32;
        ScanRec R{(const bf16_t*)(ws + WS_G1) + ci * 64 * 128, (const bf16_t*)(ws + WS_G2) + ci * 64 * 128, (const bf16_t*)(ws + WS_G3) + ci * 64 * 64, (const bf16_t*)(ws + WS_G4) + ci * 128 * 64,
                  (const float*)(ws + WS_GU) + ci * 128 * 64, (const float*)(ws + WS_GGL) + ci * 128, nullptr};
        scan_item<128, 64, false>(R, es * 32, (float*)(ws + WS_GO) + (size_t)b * SEQ * 768 + h * 128, 768, lds);
    } else if (blk < 192) {
        const int it = blk - 96, xq = it >> 3, bh = (it & 7) * 6 + (xq >> 1), es = xq & 1, b = bh / 12, h = bh % 12; const size_t ci = (size_t)bh * 32;
        ScanRec R{(const bf16_t*)(ws + WS_R1) + ci * 4096, (const bf16_t*)(ws + WS_R2) + ci * 4096, (const bf16_t*)(ws + WS_R3) + ci * 8192, (const bf16_t*)(ws + WS_R4) + ci * 8192,
                  (const float*)(ws + WS_RU) + ci * 4096, (const float*)(ws + WS_RGL) + ci * 64, (const bf16_t*)(ws + WS_RVT) + ci * 4096};
        scan_item<64, 128, true>(R, es * 32, (float*)(ws + WS_RY) + (size_t)b * SEQ * 768 + h * 64, 768, lds);
    } else if (blk < 196) {
        const int gidx = (blk - 192) * 512 + tid, b = gidx >> 9, c = gidx & 511;
        const float* LH = (const float*)(ws + WS_LH); const float* LP = (const float*)(ws + WS_LP); float* LC = (float*)(ws + WS_LC);
        float pe[32], he[32];
#pragma unroll
        for (int n = 0; n < 32; ++n) { const size_t o = ((size_t)b * SEQ + n * 64 + 63) * 512 + c; pe[n] = LP[o]; he[n] = LH[o]; }
        float carry = 0.f;
#pragma unroll
        for (int n = 0; n < 32; ++n) { LC[(size_t)(b * 32 + n) * 512 + c] = carry; carry = pe[n] * carry + he[n]; }
    } else if (l + 1 < NL && CONV_SPLIT > 0) {
        phase_convert(a, lds, l + 1, l + 2, 0, CONV_SPLIT, blk - 196, gdim_l() - 196, 0);
    }
}
__device__ __forceinline__ void phase_fin(const Args& a, int l, LAS unsigned char* lds) {
    size_t wso_ = 0; asm volatile("" : "+s"(wso_)); unsigned char* ws = a.ws + wso_;
    const int tid = tid_l(), wave = tid >> 6, lane = tid & 63;
    const int gw = bid_l() * 8 + wave, NGW = gdim_l() * 8;
    const bf16_t* PROJ = (const bf16_t*)(ws + WS_PROJ); bf16_t* Y = (bf16_t*)(ws + WS_Y);
    const float* GO = (const float*)(ws + WS_GO); const float* RY = (const float*)(ws + WS_RY);
    const float* RR = (const float*)(ws + WS_RR); const float* RK = (const float*)(ws + WS_RK); const float* RV = (const float*)(ws + WS_RV);
    const float* LH = (const float*)(ws + WS_LH); const float* LP = (const float*)(ws + WS_LP); const float* LC = (const float*)(ws + WS_LC);
    const f32x2 ng = *(const f32x2*)(inp(lds, I_GNG) + l * 128 + 2 * lane);
    float gnw[12], gnb[12], rkw[12];
#pragma unroll
    for (int h = 0; h < 12; ++h) { gnw[h] = inp(lds, I_RGNW)[l * 768 + h * 64 + lane]; gnb[h] = inp(lds, I_RGNB)[l * 768 + h * 64 + lane]; rkw[h] = inp(lds, I_RRK)[l * 768 + h * 64 + lane]; }
    for (int t = gw; t < NTOK; t += NGW) {
        const f32x4 h0 = *(const f32x4*)(LH + (size_t)t * 512 + 8 * lane), h1 = *(const f32x4*)(LH + (size_t)t * 512 + 8 * lane + 4);
        const f32x4 p0 = *(const f32x4*)(LP + (size_t)t * 512 + 8 * lane), p1 = *(const f32x4*)(LP + (size_t)t * 512 + 8 * lane + 4);
        const f32x4 c0 = *(const f32x4*)(LC + (size_t)(t >> 6) * 512 + 8 * lane), c1 = *(const f32x4*)(LC + (size_t)(t >> 6) * 512 + 8 * lane + 4);
        const u32x4 gq = *(const u32x4*)(PROJ + (size_t)t * NP + PC_AG + 8 * lane);
        f32x2 go[6]; unsigned gg[6];
#pragma unroll
        for (int h = 0; h < 6; ++h) { go[h] = *(const f32x2*)(GO + (size_t)t * 768 + h * 128 + 2 * lane); gg[h] = *(const unsigned*)(PROJ + (size_t)t * NP + PC_BG + h * 128 + 2 * lane); }
        float ry[12], rr[12], rk[12], rv[12]; bf16_t rg[12];
#pragma unroll
        for (int h = 0; h < 12; ++h) { const size_t o = (size_t)t * 768 + h * 64 + lane; ry[h] = RY[o]; rr[h] = RR[o]; rk[h] = RK[o]; rv[h] = RV[o]; rg[h] = PROJ[(size_t)t * NP + PC_CG + h * 64 + lane]; }
        { const f32x4 v0 = h0 + p0 * c0, v1 = h1 + p1 * c1;
            u32x4 o; o.x = cvtpk(v0[0] * siluf_(__uint_as_float(gq.x << 16)), v0[1] * siluf_(__uint_as_float(gq.x & 0xffff0000u)));
            o.y = cvtpk(v0[2] * siluf_(__uint_as_float(gq.y << 16)), v0[3] * siluf_(__uint_as_float(gq.y & 0xffff0000u)));
            o.z = cvtpk(v1[0] * siluf_(__uint_as_float(gq.z << 16)), v1[1] * siluf_(__uint_as_float(gq.z & 0xffff0000u)));
            o.w = cvtpk(v1[2] * siluf_(__uint_as_float(gq.w << 16)), v1[3] * siluf_(__uint_as_float(gq.w & 0xffff0000u)));
            *(u32x4*)(Y + (size_t)t * DM + 8 * lane) = o; }
#pragma unroll
        for (int h = 0; h < 6; ++h) { const f32x2 o = go[h]; const float ss = wave_sum(o.x * o.x + o.y * o.y); const float sc = __builtin_amdgcn_rsqf(ss * (1.0f / 128.f) + 1e-6f);
            const float g0 = __uint_as_float(gg[h] << 16), g1 = __uint_as_float(gg[h] & 0xffff0000u);
            *(unsigned*)(Y + (size_t)t * DM + 512 + h * 128 + 2 * lane) = cvtpk(o.x * sc * ng.x * siluf_(g0), o.y * sc * ng.y * siluf_(g1)); }
#pragma unroll
        for (int h = 0; h < 12; ++h) { const float y = ry[h]; const float mean = wave_sum(y) * (1.0f / 64.f); const float d = y - mean; const float var = wave_sum(d * d) * (1.0f / 64.f);
            float yn = d * (__builtin_amdgcn_rsqf(var + 64e-5f)) * gnw[h] + gnb[h];
            const float sdot = wave_sum(rr[h] * rk[h] * rkw[h]); yn += sdot * rv[h];
            Y[(size_t)t * DM + 1280 + h * 64 + lane] = f2bf(yn * siluf_(bf2f(rg[h]))); }
    }
}
#define XB_TMO      128
#define XB_XCNT(j)  (256  + 64 * (j))
#define XB_XSUB(j)  (1280 + 64 * (j))
#define XB_XGEN(j)  (2304 + 64 * (j))
#define XB_TOP      3328
#define XB_TOPGEN   3392
#define XCD_BAR_WORDS 3456
#define XB_SPIN_CAP (1u << 18)
__device__ __forceinline__ unsigned xb_ld(unsigned* p)              { return __hip_atomic_load(p, __ATOMIC_RELAXED, __HIP_MEMORY_SCOPE_AGENT); }
__device__ __forceinline__ unsigned xb_add(unsigned* p, unsigned v) { return __hip_atomic_fetch_add(p, v, __ATOMIC_RELAXED, __HIP_MEMORY_SCOPE_AGENT); }
__device__ __forceinline__ unsigned xb_xcc_id() { return (unsigned)__builtin_amdgcn_s_getreg((3 << 11) | 20) & 0xFu; }
#define XB_SPIN(cond, bar) do { unsigned _sp = 0; while (cond) { __builtin_amdgcn_s_sleep(1); \
    if ((++_sp & 255u) == 0u) { if (xb_ld(&(bar)[XB_TMO])) break; if (_sp > XB_SPIN_CAP) { atomicAdd(&(bar)[XB_TMO], 1u); break; } } } } while (0)

struct XcdBarrier {
    unsigned* bar; unsigned x;
    volatile LAS unsigned* st;
};

__device__ __forceinline__ XcdBarrier xcd_barrier_post(unsigned* bar, volatile LAS unsigned* st) {
    XcdBarrier b; b.bar = bar; b.x = xb_xcc_id(); b.st = st;
    if (threadIdx.x == 0) (void)xb_add(&bar[XB_XCNT(b.x)], 1u);
    return b;
}
__device__ __forceinline__ void xcd_barrier_complete(unsigned* bar, unsigned x, unsigned& nloc, unsigned& nx) {
    const unsigned G = gridDim.x * gridDim.y * gridDim.z;
    unsigned sum, cnt, mine, sp = 0u;
    for (;;) {
        sum = 0u; cnt = 0u; mine = 0u;
#pragma unroll
        for (unsigned j = 0; j < 16; ++j) { const unsigned c = xb_ld(&bar[XB_XCNT(j)]); sum += c; cnt += (c > 0u) ? 1u : 0u; mine = (j == x) ? c : mine; }
        if (sum == G) break;
        __builtin_amdgcn_s_sleep(1);
        if ((++sp & 255u) == 0u) { if (xb_ld(&bar[XB_TMO])) break; if (sp > XB_SPIN_CAP) { atomicAdd(&bar[XB_TMO], 1u); break; } }
    }
    nloc = mine > 0u ? mine : 1u; nx = cnt > 0u ? cnt : 1u;
}

__device__ __forceinline__ void xcd_barrier(const XcdBarrier& b) {
    asm volatile("s_waitcnt vmcnt(0)" ::: "memory");
    __syncthreads();
    if (threadIdx.x == 0) {
        unsigned* bar = b.bar;
        __builtin_amdgcn_s_waitcnt(0);
        unsigned nloc = b.st[0], nx = b.st[1];
        if (nloc == 0u) { xcd_barrier_complete(bar, b.x, nloc, nx); b.st[0] = nloc; b.st[1] = nx; }
        const unsigned old = xb_add(&bar[XB_XSUB(b.x)], 1u);
        const unsigned gen = old / nloc;
        if (old + 1u == (gen + 1u) * nloc) {
            __builtin_amdgcn_fence(__ATOMIC_RELEASE, "agent");
            asm volatile("s_waitcnt vmcnt(0)" ::: "memory");
            const unsigned og = xb_add(&bar[XB_TOP], 1u);
            const unsigned tg = og / nx;
            if (og + 1u == (tg + 1u) * nx) xb_add(&bar[XB_TOPGEN], 1u);
            else XB_SPIN(xb_ld(&bar[XB_TOPGEN]) == tg, bar);
            __builtin_amdgcn_fence(__ATOMIC_ACQUIRE, "agent");
            xb_add(&bar[XB_XGEN(b.x)], 1u);
            asm volatile("s_waitcnt vmcnt(0)" ::: "memory");
        } else {
            XB_SPIN(xb_ld(&bar[XB_XGEN(b.x)]) == gen, bar);
            __builtin_amdgcn_fence(__ATOMIC_ACQUIRE, "agent");
            asm volatile("s_waitcnt vmcnt(0)" ::: "memory");
        }
    }
    __syncthreads();
}


__global__ void __launch_bounds__(512) mk_fwd(Args a) {
    extern __shared__ __attribute__((aligned(16))) unsigned char lds_raw[];
    LAS unsigned char* lds = (LAS unsigned char*)lds_raw;
    cg::grid_group grid = cg::this_grid();
    const int lo = a.ph_lo, hi = a.ph_hi;
    if (threadIdx.x < 26) { const unsigned long long p = (unsigned long long)a.in[threadIdx.x]; LAS unsigned* t = (LAS unsigned*)(lds + 131072) + 2 * threadIdx.x; t[0] = (unsigned)p; t[1] = (unsigned)(p >> 32); }
    if (threadIdx.x == 0) { LAS unsigned* z = (LAS unsigned*)(lds + 131072 + 256); z[0] = 0u; z[1] = 0u; z[2] = 0u; z[3] = 0u; }
    __syncthreads();
    XcdBarrier xb = xcd_barrier_post((unsigned*)(a.ws + WS_BAR), (volatile LAS unsigned*)(lds + 131072 + 256));
    float* XR = (float*)(a.ws + WS_XR); bf16_t* XB = (bf16_t*)(a.ws + WS_XB); bf16_t* PROJ = (bf16_t*)(a.ws + WS_PROJ); bf16_t* Y = (bf16_t*)(a.ws + WS_Y);
    for (int ph = lo; ph < hi; ++ph) {
      const int nrep = (REPMASK && ph > 0 && ph < NPHASE - 1 && ((REPMASK >> ((ph - 1) % PPL)) & 1)) ? 2 : 1;
      for (int rep = 0; rep < nrep; ++rep) {
        if (ph == 0) { phase_convert(a, lds, 0, 1, 0, 64, bid_l(), gdim_l(), 1); phase_convert(a, lds, 1, NL, CONV_SPLIT2, 64, bid_l(), gdim_l(), 0); }
        else if (ph == NPHASE - 1) phase_final(XR, inp(lds, I_FNG), a.out);
        else { const int l = (ph - 1) / PPL, s = (ph - 1) % PPL; const float* xin = (l == 0) ? inp(lds, I_X) : XR;
            if (s == 0) { if (!(SKIPMASK & 2)) phase_rms(xin, XB); }
            else if (s == 1 || s == 6) { if (!(SKIPMASK & 4)) {
                pg8::Gemm g; EpiDual E;
                if (s == 1) { g = pg8::Gemm{XB, (const bf16_t*)(a.ws + WS_WIN) + (size_t)l * NP * DM, NTOK, NP, DM}; E = EpiDual{0, PROJ, NP, nullptr, nullptr, 0}; }
                else { g = pg8::Gemm{Y, (const bf16_t*)(a.ws + WS_WOUT) + (size_t)l * DM * DM, NTOK, DM, DM}; E = EpiDual{1, nullptr, 0, xin, XR, DM}; }
                pg8::StaticOrder S; S.init(NTOK, g.N, gdim_l(), bid_l());
                pg8::gemm_phase<EpiDual, pg8::StaticOrder>(lds, g, S, E, nullptr);
                if (s == 1 && l + 1 < NL) { const int nfull = (NTOK / 256) * (NP / 256) - 3 * gdim_l();
                    if (nfull > 0 && nfull < gdim_l() && bid_l() >= nfull) phase_convert(a, lds, l + 1, l + 2, CONV_SPLIT, CONV_SPLIT2, bid_l() - nfull, gdim_l() - nfull, 0);
                    else if (nfull <= 0 || nfull >= gdim_l()) phase_convert(a, lds, l + 1, l + 2, CONV_SPLIT, CONV_SPLIT2, bid_l(), gdim_l(), 0); } } }
            else if (s == 2) { if (!(SKIPMASK & 8)) phase_prep(a, l, lds); }
            else if (s == 3) { phase_gdn_chunk(a, l, lds); if (CHUNKREP & 1) phase_gdn_chunk(a, l, lds); phase_rwkv_chunk(a, l, lds); if (CHUNKREP & 2) phase_rwkv_chunk(a, l, lds); phase_lru_chunk(a); if (CHUNKREP & 4) phase_lru_chunk(a); }
            else if (s == 4) { if (!(SKIPMASK & 16)) phase_scan_naive(a, l, lds); }
            else if (s == 5) { if (!(SKIPMASK & 32)) phase_fin(a, l, lds); }
        }
      }
        if (ph + 1 < hi) { if (ph == 0) grid.sync(); else xcd_barrier(xb); }
    }
}

extern "C" void kernel_launch(void* const* d_in, const int* in_sizes, int n_in, void* d_out, int out_size, void* d_ws, size_t ws_size, hipStream_t stream) {
    static int grid = 0;
    if (grid == 0) {
        if (n_in != 26 || ws_size < WS_END) { fprintf(stderr, "kernel_launch: unexpected n_in %d or ws_size %zu < %zu\n", n_in, ws_size, (size_t)WS_END); grid = -1; return; }
        int dev = 0, cus = 0, per_cu = 0;
        hipGetDevice(&dev); hipDeviceGetAttribute(&cus, hipDeviceAttributeMultiprocessorCount, dev);
        if (hipFuncSetAttribute((const void*)mk_fwd, hipFuncAttributeMaxDynamicSharedMemorySize, LDS_BYTES) != hipSuccess) { fprintf(stderr, "hipFuncSetAttribute failed\n"); grid = -1; return; }
        if (hipOccupancyMaxActiveBlocksPerMultiprocessor(&per_cu, (const void*)mk_fwd, 512, LDS_BYTES) != hipSuccess || per_cu < 1) { fprintf(stderr, "occupancy query failed / 0\n"); grid = -1; return; }
        grid = cus;
    }
    if (grid < 0) return;
    if (hipMemsetAsync((char*)d_ws + WS_BAR, 0, 16384, stream) != hipSuccess) { fprintf(stderr, "memset of barrier words failed\n"); return; }
    Args a{};
    for (int i = 0; i < 26; ++i) a.in[i] = (const float*)d_in[i];
    a.out = (float*)d_out; a.ws = (unsigned char*)d_ws;
#if N_LAUNCH_MODE == 1
    a.ph_lo = 0; a.ph_hi = NPHASE;
    void* args[] = {&a};
    hipError_t e = hipLaunchCooperativeKernel((const void*)mk_fwd, dim3(grid), dim3(512), args, LDS_BYTES, stream);
    if (e != hipSuccess) fprintf(stderr, "cooperative launch failed: %s (grid %d)\n", hipGetErrorString(e), grid);
#else
    for (int ph = 0; ph < NPHASE; ++ph) { a.ph_lo = ph; a.ph_hi = ph + 1; hipLaunchKernelGGL(mk_fwd, dim3(grid), dim3(512), LDS_BYTES, stream, a); }
#endif
}
```

```cpp
#include <hip/hip_runtime.h>
#include <hip/hip_cooperative_groups.h>
#include <cstdio>
#include <cstdint>
namespace cg = cooperative_groups;
namespace pg8 {
#define PG8_LAS __attribute__((address_space(3)))
typedef unsigned short bf16_t;
typedef short bf16x8 __attribute__((ext_vector_type(8)));
typedef float f32x4 __attribute__((ext_vector_type(4)));
typedef unsigned u32x4 __attribute__((ext_vector_type(4)));
constexpr int BM = 256, BK = 64, HALF = 128, HTB = HALF * BK * 2  , STAGE_BYTES = 8 * HTB, NXCD = 8, WGM = 8;

__host__ __device__ __forceinline__ int lds_byte(int r, int c) { const int st = (r >> 4) * 2 + (c >> 5), rr = r & 15, cc = c & 31, ob = rr * 64 + cc * 2; return st * 1024 + (ob ^ (((ob >> 9) & 1) << 5)); }
__host__ __device__ __forceinline__ void stage_rc(int b, int& R, int& C) { const int st = b / 1024, sb = b % 1024, swz = sb ^ (((sb >> 9) & 1) << 5); R = (st >> 1) * 16 + swz / 64; C = (st & 1) * 32 + (swz % 64) / 2; }
__host__ __device__ __forceinline__ int perm32(int rho) { const int n = rho >> 4, i = rho & 15; return 8 * (i >> 2) + 4 * n + (i & 3); }

struct Unit { int pm, pn; };
struct Gemm { const bf16_t* A; const bf16_t* Bt; int M, N, K; };

struct StaticOrder {
    int nM, nN, nwg, G, c;
    __host__ __device__ void init(int M, int N, int G_, int c_) { nM = M / BM; nN = N / BM; nwg = nM * nN; G = G_; c = c_; }
    __host__ __device__ bool next(int i, Unit& u) const {
        const long L = (long)i * G + c; if (L >= nwg) return false;
        int wgid = (int)L; { const int q = nwg / NXCD, r = nwg % NXCD, xcd = wgid % NXCD, off = wgid / NXCD; wgid = (xcd < r ? xcd * (q + 1) : r * (q + 1) + (xcd - r) * q) + off; }
        const int nig = WGM * nN, gid = wgid / nig, fm = gid * WGM, gsz = (nM - fm) < WGM ? (nM - fm) : WGM;
        u.pm = fm + ((wgid % nig) % gsz); u.pn = (wgid % nig) / gsz; return true;
    }
    __device__ __forceinline__ void a_ready(const Unit&) const {}
    __device__ __forceinline__ void done(const Unit&) const {}
};
struct CountedOrder : StaticOrder {
    const unsigned* ready; unsigned need; unsigned* tmo;
    __device__ __forceinline__ void a_ready(const Unit& u) const {
        if (threadIdx.x < 64) {
            const unsigned long long t0 = __builtin_amdgcn_s_memrealtime(); unsigned polls = 0;
            while ((unsigned)__builtin_amdgcn_readfirstlane(__hip_atomic_load(ready + 64 * u.pm, __ATOMIC_RELAXED, __HIP_MEMORY_SCOPE_AGENT)) < need) {
                if ((++polls & 255u) == 0u && __builtin_amdgcn_readfirstlane(__hip_atomic_load(tmo, __ATOMIC_RELAXED, __HIP_MEMORY_SCOPE_AGENT)) != 0u) break;
                if (__builtin_amdgcn_s_memrealtime() - t0 > 2000000ull) {
                    if (threadIdx.x == 0) { unsigned expect = 0u; __hip_atomic_compare_exchange_strong(tmo + 1, &expect, 0x600u | (unsigned)(u.pm & 0xff), __ATOMIC_RELAXED, __ATOMIC_RELAXED, __HIP_MEMORY_SCOPE_AGENT); __hip_atomic_store(tmo, 1u, __ATOMIC_RELAXED, __HIP_MEMORY_SCOPE_AGENT); }
                    break; }
                __builtin_amdgcn_s_sleep(2); }
            __builtin_amdgcn_fence(__ATOMIC_ACQUIRE, "agent");
            asm volatile("s_waitcnt vmcnt(0)" ::: "memory");
        }
#if !defined(BROKEN_HOOK_NO_BARRIER)
        asm volatile("" ::: "memory"); __builtin_amdgcn_s_barrier(); asm volatile("" ::: "memory");
#endif
    }
};

__device__ __forceinline__ unsigned cvt_pk_bf16(float lo, float hi) { unsigned r; asm volatile("v_cvt_pk_bf16_f32 %0, %1, %2" : "=v"(r) : "v"(lo), "v"(hi)); return r; }
typedef float f32x2 __attribute__((ext_vector_type(2)));
__device__ __forceinline__ f32x2 gelu_pk(f32x2 v) {
    const f32x2 av = __builtin_elementwise_abs(v), d = av * 0.2316418882f + 1.0f;
    f32x2 t; t.x = __builtin_amdgcn_rcpf(d.x); t.y = __builtin_amdgcn_rcpf(d.y);
    f32x2 q = t * 0.5307027145f + (-0.7265760135f); q = q * t + 0.7107068705f; q = q * t + (-0.142248368f); q = q * t + 0.127414796f; q = q * t;
    const f32x2 s = (v * v) * (-0.72134752044f);
    f32x2 e; e.x = __builtin_amdgcn_exp2f(s.x); e.y = __builtin_amdgcn_exp2f(s.y);
    const f32x2 m = v * (q * e), r = v - m;
    f32x2 o; o.x = v.x < 0.f ? m.x : r.x; o.y = v.y < 0.f ? m.y : r.y; return o;
}

struct EpiF32 {
    static constexpr bool PERM = false, AFTER_DRAIN = false;
    float* C; int ldc; const float* bias;
    __device__ __forceinline__ void operator()(const f32x4 (&acc)[2][2][4][2], const Unit& u, int wr, int wc, int fr, int fq) const {
        const int row0 = u.pm * BM + wr * 64 + fr, col0 = u.pn * BM + wc * 32 + 4 * fq;
        f32x4 bv[2][2];
#pragma unroll
        for (int bj = 0; bj < 2; ++bj)
#pragma unroll
            for (int n = 0; n < 2; ++n) bv[bj][n] = bias ? *(const f32x4*)(bias + col0 + bj * HALF + n * 16) : (f32x4){0.f, 0.f, 0.f, 0.f};
#pragma unroll
        for (int ai = 0; ai < 2; ++ai)
#pragma unroll
            for (int m = 0; m < 4; ++m) { float* rowp = C + (size_t)(row0 + ai * HALF + m * 16) * ldc + col0;
#pragma unroll
                for (int bj = 0; bj < 2; ++bj)
#pragma unroll
                    for (int n = 0; n < 2; ++n) *(f32x4*)(rowp + bj * HALF + n * 16) = acc[ai][bj][m][n] + bv[bj][n]; }
    }
};
template <int ACT  > struct EpiBf16 {
    static constexpr bool PERM = true, AFTER_DRAIN = false;
    bf16_t* O; int ldc; const float* bias; int split_cols; size_t split_stride;
    __device__ __forceinline__ void operator()(const f32x4 (&acc)[2][2][4][2], const Unit& u, int wr, int wc, int fr, int fq) const {
        const int row0 = u.pm * BM + wr * 64 + fr; int colt = u.pn * BM; bf16_t* base = O;
        if (split_cols) { const int t = colt / split_cols; base += (size_t)t * split_stride; colt -= t * split_cols; }
        const int col0 = colt + wc * 32 + 8 * fq, bcol0 = u.pn * BM + wc * 32 + 8 * fq;
        f32x4 bv[2][2];
#pragma unroll
        for (int bj = 0; bj < 2; ++bj)
#pragma unroll
            for (int n = 0; n < 2; ++n) bv[bj][n] = bias ? *(const f32x4*)(bias + bcol0 + bj * HALF + 4 * n) : (f32x4){0.f, 0.f, 0.f, 0.f};
#pragma unroll
        for (int ai = 0; ai < 2; ++ai)
#pragma unroll
            for (int m = 0; m < 4; ++m) { bf16_t* rowp = base + (size_t)(row0 + ai * HALF + m * 16) * ldc + col0;
#pragma unroll
                for (int bj = 0; bj < 2; ++bj) { f32x4 v0 = acc[ai][bj][m][0] + bv[bj][0], v1 = acc[ai][bj][m][1] + bv[bj][1];
                    if (ACT == 1) { f32x2 a = gelu_pk((f32x2){v0[0], v0[1]}), b = gelu_pk((f32x2){v0[2], v0[3]}), c = gelu_pk((f32x2){v1[0], v1[1]}), d = gelu_pk((f32x2){v1[2], v1[3]});
                        v0 = (f32x4){a.x, a.y, b.x, b.y}; v1 = (f32x4){c.x, c.y, d.x, d.y}; }
                    if (ACT == 2) {
#pragma unroll
                        for (int j = 0; j < 4; ++j) { v0[j] = 0.5f * v0[j] * (1.0f + erff(v0[j] * 0.70710678f)); v1[j] = 0.5f * v1[j] * (1.0f + erff(v1[j] * 0.70710678f)); } }
                    u32x4 w; w.x = cvt_pk_bf16(v0[0], v0[1]); w.y = cvt_pk_bf16(v0[2], v0[3]); w.z = cvt_pk_bf16(v1[0], v1[1]); w.w = cvt_pk_bf16(v1[2], v1[3]);
                    *(u32x4*)(rowp + bj * HALF) = w; } }
    }
};

struct PanelStats {
    unsigned* xbuf;
    unsigned* cnt;
    unsigned* tmo;
    int ntn; float eps;
    unsigned code;
    __device__ __forceinline__ bool run(const f32x4 (&v)[2][2][4][2], const Unit& u, int wr, int wc, int fr, int fq, PG8_LAS unsigned char* lds, int wid, int lane) const {
        typedef float f32x2v __attribute__((ext_vector_type(2)));
        PG8_LAS f32x2v* P = (PG8_LAS f32x2v*)lds;
        PG8_LAS f32x2v* S = (PG8_LAS f32x2v*)(lds + 8192);
        PG8_LAS unsigned* flag = (PG8_LAS unsigned*)(lds + 8192 + 2048);
#pragma unroll
        for (int ai = 0; ai < 2; ++ai)
#pragma unroll
            for (int m = 0; m < 4; ++m) {
                float s = 0.f;
#pragma unroll
                for (int bj = 0; bj < 2; ++bj)
#pragma unroll
                    for (int n = 0; n < 2; ++n) { const f32x4 x = v[ai][bj][m][n]; s += (x[0] + x[1]) + (x[2] + x[3]); }
                s += __shfl_xor(s, 16); s += __shfl_xor(s, 32);
                const float mw = s * (1.0f / 64.0f); float q = 0.f;
#pragma unroll
                for (int bj = 0; bj < 2; ++bj)
#pragma unroll
                    for (int n = 0; n < 2; ++n) { const f32x4 d = v[ai][bj][m][n] - mw; q += (d[0] * d[0] + d[1] * d[1]) + (d[2] * d[2] + d[3] * d[3]); }
                q += __shfl_xor(q, 16); q += __shfl_xor(q, 32);
                if (fq == 0) P[(ai * HALF + wr * 64 + m * 16 + fr) * 4 + wc] = (f32x2v){mw, q};
            }
        asm volatile("s_waitcnt lgkmcnt(0)" ::: "memory"); __builtin_amdgcn_s_barrier(); asm volatile("" ::: "memory");
#if defined(BROKEN_NO_WAIT)
        if (blockIdx.x >= 64) { const long long t0 = clock64(); while (clock64() - t0 < 60000) __builtin_amdgcn_s_sleep(8); }
#endif
        const int row = wid * 32 + (lane & 31);
        if (lane < 32) {
            const f32x2v a = P[row * 4 + 0], b = P[row * 4 + 1], c = P[row * 4 + 2], d = P[row * 4 + 3];
            const float mt = (a.x + b.x + c.x + d.x) * 0.25f;
            const float da = a.x - mt, db = b.x - mt, dc = c.x - mt, dd = d.x - mt;
            const float m2 = (a.y + b.y) + (c.y + d.y) + 64.0f * ((da * da + db * db) + (dc * dc + dd * dd));
            unsigned long long* slot = (unsigned long long*)xbuf + ((size_t)(u.pm * BM + row) * 4 + u.pn);
            __hip_atomic_store(slot, ((unsigned long long)__float_as_uint(m2) << 32) | __float_as_uint(mt), __ATOMIC_RELAXED, __HIP_MEMORY_SCOPE_AGENT);
        }
        asm volatile("s_waitcnt vmcnt(0)" ::: "memory");
        if (lane == 0) __hip_atomic_fetch_add(cnt + 64 * u.pm, 1u, __ATOMIC_RELAXED, __HIP_MEMORY_SCOPE_AGENT);
        if (wid == 0) {
            bool dead = false; const unsigned long long t0 = __builtin_amdgcn_s_memrealtime(); const unsigned want = 8u * (unsigned)ntn;
            for (;;) {
#if defined(BROKEN_NO_WAIT)
                break;
#endif
                if ((unsigned)__builtin_amdgcn_readfirstlane(__hip_atomic_load(cnt + 64 * u.pm, __ATOMIC_RELAXED, __HIP_MEMORY_SCOPE_AGENT)) >= want) break;
                if (__builtin_amdgcn_s_memrealtime() - t0 > 2000000ull) {
                    if (lane == 0) { unsigned expect = 0u; __hip_atomic_compare_exchange_strong(tmo + 1, &expect, code | (unsigned)(u.pm & 0xff), __ATOMIC_RELAXED, __ATOMIC_RELAXED, __HIP_MEMORY_SCOPE_AGENT);
                                     __hip_atomic_store(tmo, 1u, __ATOMIC_RELAXED, __HIP_MEMORY_SCOPE_AGENT); }
                    dead = true; break; }
                __builtin_amdgcn_s_sleep(2);
            }
            __builtin_amdgcn_fence(__ATOMIC_ACQUIRE, "agent");
            if (lane == 0) flag[0] = dead ? 1u : 0u;
        }
        asm volatile("s_waitcnt vmcnt(0) lgkmcnt(0)" ::: "memory"); __builtin_amdgcn_s_barrier(); asm volatile("" ::: "memory");
        const bool bad = flag[0] != 0u;
        if (lane < 32) {
            const unsigned long long* slot = (const unsigned long long*)xbuf + (size_t)(u.pm * BM + row) * 4; float mt[4], m2[4]; float ms = 0.f;
#pragma unroll
            for (int t = 0; t < 4; ++t) { if (t < ntn) { const unsigned long long w = __hip_atomic_load(slot + t, __ATOMIC_RELAXED, __HIP_MEMORY_SCOPE_AGENT); mt[t] = __uint_as_float((unsigned)w); m2[t] = __uint_as_float((unsigned)(w >> 32)); } else { mt[t] = 0.f; m2[t] = 0.f; } ms += mt[t]; }
            const float mean = ms / (float)ntn; float q = 0.f;
#pragma unroll
            for (int t = 0; t < 4; ++t) if (t < ntn) { const float dm = mt[t] - mean; q += m2[t] + 256.0f * dm * dm; }
            S[row] = (f32x2v){mean, 1.0f / sqrtf(q / (256.0f * (float)ntn) + eps)};
        }
        asm volatile("s_waitcnt lgkmcnt(0)" ::: "memory"); __builtin_amdgcn_s_barrier(); asm volatile("" ::: "memory");
        return bad;
    }
};
struct EpiLnRes {
    static constexpr bool PERM = false, AFTER_DRAIN = true;
    const float* base; float* out; int ldc; const float* bias; PanelStats st; unsigned poison;
    __device__ __forceinline__ void refuse(size_t i0, size_t stride, int M, int N) const { const float q = __builtin_nanf(""); for (size_t i = i0; i < (size_t)M * N; i += stride) out[(i / N) * ldc + i % N] = q;
        if (i0 == 0) { unsigned expect = 0u; __hip_atomic_compare_exchange_strong(st.tmo + 1, &expect, 0x7f0u, __ATOMIC_RELAXED, __ATOMIC_RELAXED, __HIP_MEMORY_SCOPE_AGENT); __hip_atomic_store(st.tmo, 1u, __ATOMIC_RELAXED, __HIP_MEMORY_SCOPE_AGENT); } }
    __device__ __forceinline__ void fused(f32x4 (&acc)[2][2][4][2], const Unit& u, int wr, int wc, int fr, int fq, PG8_LAS unsigned char* lds, int wid, int lane) const {
        typedef float f32x2v __attribute__((ext_vector_type(2)));
        const PG8_LAS f32x2v* S = (const PG8_LAS f32x2v*)(lds + 8192);
        const int col0 = u.pn * BM + wc * 32 + 4 * fq;
#pragma unroll
        for (int bj = 0; bj < 2; ++bj)
#pragma unroll
            for (int n = 0; n < 2; ++n) { const f32x4 bv = bias ? *(const f32x4*)(bias + col0 + bj * HALF + n * 16) : (f32x4){0.f, 0.f, 0.f, 0.f};
#pragma unroll
                for (int ai = 0; ai < 2; ++ai)
#pragma unroll
                    for (int m = 0; m < 4; ++m) acc[ai][bj][m][n] += bv; }
        const bool bad = st.run(acc, u, wr, wc, fr, fq, lds, wid, lane) || poison != 0u;
        const float qnan = __builtin_nanf("");
#pragma unroll
        for (int ai = 0; ai < 2; ++ai)
#pragma unroll
            for (int m = 0; m < 4; ++m) { const int r = ai * HALF + wr * 64 + m * 16 + fr; const f32x2v sr = S[r]; const size_t off = (size_t)(u.pm * BM + r) * ldc + col0;
#pragma unroll
                for (int bj = 0; bj < 2; ++bj)
#pragma unroll
                    for (int n = 0; n < 2; ++n) { const f32x4 bs = *(const f32x4*)(base + off + bj * HALF + n * 16); f32x4 o = bs + (acc[ai][bj][m][n] - sr.x) * sr.y;
                        if (bad) o = (f32x4){qnan, qnan, qnan, qnan}; *(f32x4*)(out + off + bj * HALF + n * 16) = o; }
                asm volatile("" ::: "memory"); }
    }
};
struct EpiLnResLn {
    static constexpr bool PERM = false, AFTER_DRAIN = true;
    const float* base; float* out; bf16_t* xn; int ldc; const float* bias; PanelStats st1, st2; unsigned poison;
    __device__ __forceinline__ void refuse(size_t i0, size_t stride, int M, int N) const { const float q = __builtin_nanf(""); for (size_t i = i0; i < (size_t)M * N; i += stride) { const size_t o = (i / N) * ldc + i % N; out[o] = q; xn[o] = (bf16_t)0x7fc0u; }
        if (i0 == 0) { unsigned expect = 0u; __hip_atomic_compare_exchange_strong(st1.tmo + 1, &expect, 0x7f0u, __ATOMIC_RELAXED, __ATOMIC_RELAXED, __HIP_MEMORY_SCOPE_AGENT); __hip_atomic_store(st1.tmo, 1u, __ATOMIC_RELAXED, __HIP_MEMORY_SCOPE_AGENT); } }
    __device__ __forceinline__ void fused(f32x4 (&acc)[2][2][4][2], const Unit& u, int wr, int wc, int fr, int fq, PG8_LAS unsigned char* lds, int wid, int lane) const {
        typedef float f32x2v __attribute__((ext_vector_type(2))); typedef unsigned u32x2v __attribute__((ext_vector_type(2)));
        const PG8_LAS f32x2v* S = (const PG8_LAS f32x2v*)(lds + 8192);
        const int col0 = u.pn * BM + wc * 32 + 4 * fq;
#pragma unroll
        for (int bj = 0; bj < 2; ++bj)
#pragma unroll
            for (int n = 0; n < 2; ++n) { const f32x4 bv = bias ? *(const f32x4*)(bias + col0 + bj * HALF + n * 16) : (f32x4){0.f, 0.f, 0.f, 0.f};
#pragma unroll
                for (int ai = 0; ai < 2; ++ai)
#pragma unroll
                    for (int m = 0; m < 4; ++m) acc[ai][bj][m][n] += bv; }
        bool bad = st1.run(acc, u, wr, wc, fr, fq, lds, wid, lane) || poison != 0u;
        const float qnan = __builtin_nanf("");
#pragma unroll
        for (int ai = 0; ai < 2; ++ai)
#pragma unroll
            for (int m = 0; m < 4; ++m) { const int r = ai * HALF + wr * 64 + m * 16 + fr; const f32x2v sr = S[r]; const size_t off = (size_t)(u.pm * BM + r) * ldc + col0;
#pragma unroll
                for (int bj = 0; bj < 2; ++bj)
#pragma unroll
                    for (int n = 0; n < 2; ++n) { const f32x4 bs = *(const f32x4*)(base + off + bj * HALF + n * 16); acc[ai][bj][m][n] = bs + (acc[ai][bj][m][n] - sr.x) * sr.y; }
                asm volatile("" : "+v"(acc[ai][0][m][0]), "+v"(acc[ai][0][m][1]), "+v"(acc[ai][1][m][0]), "+v"(acc[ai][1][m][1]));
                if (m & 1) asm volatile("" ::: "memory"); }
        const bool bad1 = bad;
        bad = st2.run(acc, u, wr, wc, fr, fq, lds, wid, lane) || bad;
#pragma unroll
        for (int ai = 0; ai < 2; ++ai)
#pragma unroll
            for (int m = 0; m < 4; ++m) { const int r = ai * HALF + wr * 64 + m * 16 + fr; const f32x2v sr = S[r]; const size_t off = (size_t)(u.pm * BM + r) * ldc + col0;
#pragma unroll
                for (int bj = 0; bj < 2; ++bj)
#pragma unroll
                    for (int n = 0; n < 2; ++n) { const f32x4 x1 = acc[ai][bj][m][n]; *(f32x4*)(out + off + bj * HALF + n * 16) = bad1 ? (f32x4){qnan, qnan, qnan, qnan} : x1;
                        const f32x4 o = (x1 - sr.x) * sr.y; u32x2v w; w.x = cvt_pk_bf16(o[0], o[1]); w.y = cvt_pk_bf16(o[2], o[3]);
                        if (bad) { w.x = 0x7fc07fc0u; w.y = 0x7fc07fc0u; } *(u32x2v*)(xn + off + bj * HALF + n * 16) = w; }
                asm volatile("" ::: "memory"); }
    }
};

template <class Epi, class Sched, bool STAMP = false>
__device__ __forceinline__ void gemm_phase(PG8_LAS unsigned char* lds, const Gemm g, const Sched& S, const Epi& E, unsigned long long* stamps) {
    int tid_ = threadIdx.x; asm volatile("" : "+v"(tid_)); const int tid = tid_, wid = __builtin_amdgcn_readfirstlane(tid >> 6), lane = tid & 63, wr = wid >> 2, wc = wid & 3, fr = lane & 15, fq = lane >> 4;
    const int K = g.K, nt = K / BK;
    int ts_lo = 0, ts_hi = 0, nts = 0; const unsigned long long rt_entry = STAMP ? (unsigned long long)wall_clock64() : 0ull;
#define PG8_STAMP() do { if (STAMP && wid == 0 && nts < 64) { const unsigned long long _c = (unsigned long long)clock64(); \
        ts_lo = (lane == nts) ? (int)(unsigned)_c : ts_lo; ts_hi = (lane == nts) ? (int)(unsigned)(_c >> 32) : ts_hi; ++nts; } } while (0)
    PG8_STAMP();
    unsigned voffA[2], voffB[2];
#pragma unroll
    for (int i = 0; i < 2; ++i) { int R, C; stage_rc(tid * 16 + i * 8192, R, C); const int Rb = Epi::PERM ? ((R & ~31) + perm32(R & 31)) : R;
        voffA[i] = (unsigned)(R * K + C) * 2u; voffB[i] = (unsigned)(Rb * K + C) * 2u; }
    const size_t kstep = (size_t)(BK * 2);
    const size_t hstep = (size_t)HALF * K * 2;
    const size_t tstep = 2 * hstep;
    const unsigned ldsw = (unsigned)wid * 1024u;
    const int aoff = lds_byte(wr * 64 + fr, fq * 8), boff = lds_byte(wc * 32 + fr, fq * 8);
#define PG8_SA(b, h) (((b) * 2 + (h)) * HTB)
#define PG8_SB(b, h) ((4 + (b) * 2 + (h)) * HTB)
#define PG8_STAGE(bufoff, gbase, voff) do { _Pragma("unroll") for (int _i = 0; _i < 2; ++_i) \
        __builtin_amdgcn_global_load_lds((const unsigned*)((const char*)(gbase) + (voff)[_i]), (PG8_LAS unsigned*)(lds + (bufoff) + ldsw + _i * 8192), 16, 0, 0); } while (0)
#define PG8_LDA(dst, b, h) do { _Pragma("unroll") for (int m = 0; m < 4; ++m) _Pragma("unroll") for (int k = 0; k < 2; ++k) dst[m][k] = *(const PG8_LAS bf16x8*)(lds + PG8_SA(b, h) + aoff + m * 2048 + k * 1024); } while (0)
#define PG8_LDB(dst, b, h) do { _Pragma("unroll") for (int n = 0; n < 2; ++n) _Pragma("unroll") for (int k = 0; k < 2; ++k) dst[n][k] = *(const PG8_LAS bf16x8*)(lds + PG8_SB(b, h) + boff + n * 2048 + k * 1024); } while (0)
#define PG8_MMA(ai, bj, At, Bt) do { __builtin_amdgcn_s_setprio(1); _Pragma("unroll") for (int m = 0; m < 4; ++m) _Pragma("unroll") for (int n = 0; n < 2; ++n) _Pragma("unroll") for (int k = 0; k < 2; ++k) \
        acc[ai][bj][m][n] = __builtin_amdgcn_mfma_f32_16x16x32_bf16(Bt[n][k], At[m][k], acc[ai][bj][m][n], 0, 0, 0); __builtin_amdgcn_s_setprio(0); } while (0)
#define PG8_WAIT_V(n) asm volatile("s_waitcnt vmcnt(" #n ")" ::: "memory")
#define PG8_WAIT_L(n) asm volatile("s_waitcnt lgkmcnt(" #n ")" ::: "memory")
#define PG8_BAR __builtin_amdgcn_s_barrier()
#define PG8_SCHED __builtin_amdgcn_sched_barrier(0)
    Unit cur, nxt; int ui = 0;
    if (!S.next(0, cur)) return;
    f32x4 acc[2][2][4][2];
#pragma unroll
    for (int a = 0; a < 2; ++a)
#pragma unroll
        for (int b = 0; b < 2; ++b)
#pragma unroll
            for (int m = 0; m < 4; ++m)
#pragma unroll
                for (int n = 0; n < 2; ++n) acc[a][b][m][n] = (f32x4){0.f, 0.f, 0.f, 0.f};
    bf16x8 At[4][2], B0[2][2], B1[2][2];
    const char* cA = (const char*)g.A + (size_t)cur.pm * tstep; const char* cB = (const char*)g.Bt + (size_t)cur.pn * tstep;
    S.a_ready(cur);
    PG8_STAGE(PG8_SB(0, 0), cB, voffB); PG8_STAGE(PG8_SA(0, 0), cA, voffA); PG8_STAGE(PG8_SB(0, 1), cB + hstep, voffB); PG8_STAGE(PG8_SA(0, 1), cA + hstep, voffA);
    if (wr == 1) PG8_BAR;
    PG8_WAIT_V(4); PG8_BAR;
    PG8_STAGE(PG8_SB(1, 0), cB + kstep, voffB); PG8_STAGE(PG8_SA(1, 0), cA + kstep, voffA); PG8_STAGE(PG8_SB(1, 1), cB + hstep + kstep, voffB);
    PG8_WAIT_V(6); PG8_BAR;
    PG8_STAMP();
    for (;;) {
        const bool has_next = S.next(ui + 1, nxt);
        const char* nA = has_next ? (const char*)g.A + (size_t)nxt.pm * tstep : cA; const char* nB = has_next ? (const char*)g.Bt + (size_t)nxt.pn * tstep : cB;
        for (int t = 0; t < nt; t += 2) {
            const bool last = (t == nt - 2);
            const char* a1 = cA + (size_t)(t + 1) * kstep;
            const char* a2 = last ? nA : cA + (size_t)(t + 2) * kstep; const char* b2 = last ? nB : cB + (size_t)(t + 2) * kstep;
            const char* a3 = a2 + kstep; const char* b3 = b2 + kstep;
            if (last && has_next) S.a_ready(nxt);
            PG8_LDB(B0, 0, 0); PG8_SCHED; PG8_LDA(At, 0, 0); PG8_STAGE(PG8_SA(1, 1), a1 + hstep, voffA);
            PG8_WAIT_L(8); PG8_BAR; PG8_WAIT_L(0); PG8_MMA(0, 0, At, B0); PG8_BAR; PG8_SCHED;
            PG8_LDB(B1, 0, 1); PG8_STAGE(PG8_SB(0, 0), b2, voffB);
            PG8_BAR; PG8_WAIT_L(0); PG8_MMA(0, 1, At, B1); PG8_BAR;
            PG8_LDA(At, 0, 1); PG8_STAGE(PG8_SA(0, 0), a2, voffA);
            PG8_BAR; PG8_WAIT_L(0); PG8_MMA(1, 0, At, B0); PG8_BAR; PG8_SCHED;
            PG8_STAGE(PG8_SB(0, 1), b2 + hstep, voffB);
            PG8_WAIT_V(6); PG8_BAR; PG8_MMA(1, 1, At, B1); PG8_BAR;
            PG8_LDB(B0, 1, 0); PG8_SCHED; PG8_LDA(At, 1, 0); PG8_STAGE(PG8_SA(0, 1), a2 + hstep, voffA);
            PG8_WAIT_L(8); PG8_BAR; PG8_WAIT_L(0); PG8_MMA(0, 0, At, B0); PG8_BAR; PG8_SCHED;
            PG8_LDB(B1, 1, 1); PG8_STAGE(PG8_SB(1, 0), b3, voffB);
            PG8_BAR; PG8_WAIT_L(0); PG8_MMA(0, 1, At, B1); PG8_BAR;
            PG8_LDA(At, 1, 1); PG8_STAGE(PG8_SA(1, 0), a3, voffA);
            PG8_BAR; PG8_WAIT_L(0); PG8_MMA(1, 0, At, B0); PG8_BAR; PG8_SCHED;
            PG8_STAGE(PG8_SB(1, 1), b3 + hstep, voffB);
            PG8_WAIT_V(6); PG8_BAR; PG8_MMA(1, 1, At, B1); PG8_BAR;
        }
        PG8_STAMP();
        if constexpr (!Epi::AFTER_DRAIN) { E(acc, cur, wr, wc, fr, fq); S.done(cur); }
        PG8_STAMP();
        if (!has_next) break;
#pragma unroll
        for (int a = 0; a < 2; ++a)
#pragma unroll
            for (int b = 0; b < 2; ++b)
#pragma unroll
                for (int m = 0; m < 4; ++m)
#pragma unroll
                    for (int n = 0; n < 2; ++n) acc[a][b][m][n] = (f32x4){0.f, 0.f, 0.f, 0.f};
        cur = nxt; cA = nA; cB = nB; ++ui;
    }
    PG8_WAIT_V(0);
    if (wr == 0) PG8_BAR;
    PG8_BAR;
    if constexpr (Epi::AFTER_DRAIN) { E.fused(acc, cur, wr, wc, fr, fq, lds, wid, lane); S.done(cur); }
    PG8_STAMP();
    if (STAMP && wid == 0) { stamps[lane] = lane < nts ? (((unsigned long long)(unsigned)ts_hi << 32) | (unsigned)ts_lo) : 0ull;
        if (lane == 62) stamps[62] = rt_entry; if (lane == 63) stamps[63] = (unsigned long long)wall_clock64(); }
#undef PG8_STAMP
#undef PG8_SA
#undef PG8_SB
#undef PG8_STAGE
#undef PG8_LDA
#undef PG8_LDB
#undef PG8_MMA
#undef PG8_WAIT_V
#undef PG8_WAIT_L
#undef PG8_BAR
#undef PG8_SCHED
}
}
#define LAS __attribute__((address_space(3)))
typedef unsigned short bf16_t;
typedef float f32x4 __attribute__((ext_vector_type(4)));
typedef float f32x2 __attribute__((ext_vector_type(2)));
typedef unsigned u32x4 __attribute__((ext_vector_type(4)));
typedef unsigned u32x2 __attribute__((ext_vector_type(2)));
constexpr int NTOK = 8192, SEQ = 2048, DM = 2048, NIN = 7372, NP = 7424, NL = 4;
constexpr int LRUW = 512, GW = 768, RW_ = 768;
constexpr int PC_AX = 0, PC_AG = 512, PC_BQKV = 1024, PC_BG = 3328, PC_CIN = 4096, PC_CG = 6592, PC_BETA = 7360, PC_BA = 7366;
constexpr int LDS_BYTES = 131072 + 512;
#ifndef CHUNKREP
#define CHUNKREP 0
#endif
#ifndef CONV_SPLIT2
#define CONV_SPLIT2 52
#endif
#ifndef CONV_SPLIT
#define CONV_SPLIT 24
#endif
#ifndef REPMASK
#define REPMASK 0
#endif
#ifndef SKIPMASK
#define SKIPMASK 0
#endif
#ifndef N_LAUNCH_MODE
#define N_LAUNCH_MODE 1
#endif
constexpr int PPL = 7;
constexpr int NPHASE = 2 + PPL * NL;
constexpr size_t WS_WIN = 0;
constexpr size_t WS_WOUT = WS_WIN + (size_t)NL * NP * DM * 2;
constexpr size_t WS_XB = WS_WOUT + (size_t)NL * DM * DM * 2;
constexpr size_t WS_XR = WS_XB + (size_t)NTOK * DM * 2;
constexpr size_t WS_PROJ = WS_XR + (size_t)NTOK * DM * 4;
constexpr size_t WS_Y = WS_PROJ + (size_t)NTOK * NP * 2;
constexpr size_t SZ768 = (size_t)NTOK * 768 * 4;
constexpr size_t WS_GQ = WS_Y + (size_t)NTOK * DM * 2;
constexpr size_t WS_GK = WS_GQ + SZ768;
constexpr size_t WS_GV = WS_GK + SZ768;
constexpr size_t WS_GO = WS_GV + SZ768;
constexpr size_t WS_RR = WS_GO + SZ768;
constexpr size_t WS_RW = WS_RR + SZ768;
constexpr size_t WS_RK = WS_RW + SZ768;
constexpr size_t WS_RV = WS_RK + SZ768;
constexpr size_t WS_RKK = WS_RV + SZ768;
constexpr size_t WS_RB = WS_RKK + SZ768;
constexpr size_t WS_RY = WS_RB + SZ768;
constexpr size_t WS_GB = WS_RY + SZ768;
constexpr size_t WS_GG = WS_GB + (size_t)NTOK * 8 * 4;
constexpr size_t WS_LA = WS_GG + (size_t)NTOK * 8 * 4;
constexpr size_t WS_LU = WS_LA + (size_t)NTOK * 512 * 4;
constexpr size_t WS_LEND = WS_LU + (size_t)NTOK * 512 * 4;
constexpr int GCH = 768, RCH = 1536;
constexpr size_t WS_G1 = WS_LEND;
constexpr size_t WS_G2 = WS_G1 + (size_t)GCH * 64 * 128 * 2;
constexpr size_t WS_G3 = WS_G2 + (size_t)GCH * 64 * 128 * 2;
constexpr size_t WS_G4 = WS_G3 + (size_t)GCH * 64 * 64 * 2;
constexpr size_t WS_GU = WS_G4 + (size_t)GCH * 128 * 64 * 2;
constexpr size_t WS_GGL = WS_GU + (size_t)GCH * 128 * 64 * 4;
constexpr size_t WS_R1 = WS_GGL + (size_t)GCH * 128 * 4;
constexpr size_t WS_R2 = WS_R1 + (size_t)RCH * 64 * 64 * 2;
constexpr size_t WS_R3 = WS_R2 + (size_t)RCH * 64 * 64 * 2;
constexpr size_t WS_R4 = WS_R3 + (size_t)RCH * 64 * 128 * 2;
constexpr size_t WS_RU = WS_R4 + (size_t)RCH * 64 * 128 * 2;
constexpr size_t WS_RVT = WS_RU + (size_t)RCH * 64 * 64 * 4;
constexpr size_t WS_RGL = WS_RVT + (size_t)RCH * 64 * 64 * 2;
constexpr size_t WS_LH = WS_RGL + (size_t)RCH * 64 * 4;
constexpr size_t WS_LP = WS_LH + (size_t)NTOK * 512 * 4;
constexpr size_t WS_LC = WS_LP + (size_t)NTOK * 512 * 4;
constexpr size_t WS_BAR = WS_LC + (size_t)128 * 512 * 4;
constexpr size_t WS_WUPT = WS_BAR + 16384;
constexpr size_t WS_AUPT = WS_WUPT + (size_t)NL * 768 * 96 * 2;
constexpr size_t WS_WXT = WS_AUPT + (size_t)NL * 768 * 96 * 2;
constexpr size_t WS_WAT = WS_WXT + (size_t)NL * 8 * 64 * 64 * 2;
constexpr size_t WS_END = WS_WAT + (size_t)NL * 8 * 64 * 64 * 2;

struct Args {
    const float* in[26];
    float* out; unsigned char* ws;
    int ph_lo, ph_hi;
};
enum { I_X = 0, I_NORMG, I_WIN, I_WOUT, I_LCW, I_LCB, I_LWX, I_LBX, I_LWA, I_LBA, I_LLAM, I_GCW, I_GALOG, I_GDT, I_GNG,
       I_RMU, I_RW0, I_RWUP, I_RA0, I_RAUP, I_RKK, I_RKA, I_RRK, I_RGNW, I_RGNB, I_FNG };

__device__ __forceinline__ int tid_l() { int t = threadIdx.x; asm volatile("" : "+v"(t)); return t; }
#define LBAR() do { asm volatile("s_waitcnt lgkmcnt(0)" ::: "memory"); __builtin_amdgcn_s_barrier(); asm volatile("" ::: "memory"); } while (0)
__device__ __forceinline__ int bid_l() { int b = blockIdx.x; asm volatile("" : "+s"(b)); return b; }
__device__ __forceinline__ int gdim_l() { int b = gridDim.x; asm volatile("" : "+s"(b)); return b; }
__device__ __forceinline__ const float* inp(LAS unsigned char* lds, int i) {
    const LAS unsigned* t = (const LAS unsigned*)(lds + 131072) + 2 * i;
    const unsigned lo = __builtin_amdgcn_readfirstlane(t[0]), hi = __builtin_amdgcn_readfirstlane(t[1]);
    return (const float*)(const __attribute__((address_space(1))) float*)(((unsigned long long)hi << 32) | lo);
}
__device__ __forceinline__ float bf2f(bf16_t b) { return __uint_as_float(((unsigned)b) << 16); }
typedef __bf16 bf2n_t __attribute__((ext_vector_type(2)));
__device__ __forceinline__ unsigned pk2(float lo, float hi) { const f32x2 v = {lo, hi}; const bf2n_t r = __builtin_convertvector(v, bf2n_t); return __builtin_bit_cast(unsigned, r); }
__device__ __forceinline__ bf16_t f2bf(float f) { return (bf16_t)(pk2(f, f) & 0xffffu); }
template <int CTRL> __device__ __forceinline__ float dpp_f(float v) { return __int_as_float(__builtin_amdgcn_update_dpp(0, __float_as_int(v), CTRL, 0xF, 0xF, true)); }
__device__ __forceinline__ float sum16(float v) { v += dpp_f<0xB1>(v); v += dpp_f<0x4E>(v); v += dpp_f<0x141>(v); v += dpp_f<0x140>(v); return v; }
__device__ __forceinline__ float wave_sum(float v) { v = sum16(v);
    v += __int_as_float(__builtin_amdgcn_update_dpp(0, __float_as_int(v), 0x142, 0xA, 0xF, false));
    v += __int_as_float(__builtin_amdgcn_update_dpp(0, __float_as_int(v), 0x143, 0xC, 0xF, false));
    return __int_as_float(__builtin_amdgcn_readlane(__float_as_int(v), 63)); }
typedef __bf16 bf2_t __attribute__((ext_vector_type(2)));
__device__ __forceinline__ unsigned cvtpk(float lo, float hi) { const f32x2 v = {lo, hi}; const bf2_t r = __builtin_convertvector(v, bf2_t); return __builtin_bit_cast(unsigned, r); }
__device__ __forceinline__ float sigmoidf_(float x) { return __builtin_amdgcn_rcpf(1.0f + __expf(-x)); }
__device__ __forceinline__ float siluf_(float x) { return x * __builtin_amdgcn_rcpf(1.0f + __expf(-x)); }
__device__ __forceinline__ float softplusf_(float x) { return fmaxf(x, 0.f) + __logf(1.0f + __expf(-fabsf(x))); }
__device__ __forceinline__ float tanhf_(float x) { const float e = __expf(-2.0f * fabsf(x)); return copysignf((1.0f - e) * __builtin_amdgcn_rcpf(1.0f + e), x); }

__device__ __forceinline__ void transpose_item(const float* W, int K, int N, bf16_t* WT, const float* scale, bool remap, LAS float* scr, int item, int nblk, int lane) {
    const int kb = item / nblk, nb = item % nblk, k0 = 64 * kb, n0 = 32 * nb;
    int np = n0 + (lane & 31), oc;
    if (!remap) oc = np;
    else if (np < 4096) oc = np;
    else if (np < 7360) oc = np + 12;
    else if (np < 7372) oc = np - 7360 + 4096;
    else oc = -1;
    float vbuf[32], sbuf[32];
#pragma unroll
    for (int i = 0; i < 32; ++i) { const int kk = 2 * i + (lane >> 5); vbuf[i] = (oc >= 0) ? W[(size_t)(k0 + kk) * N + oc] : 0.f; sbuf[i] = scale ? scale[k0 + kk] : 1.0f; }
#pragma unroll
    for (int i = 0; i < 32; ++i) { const int kk = 2 * i + (lane >> 5); scr[kk * 33 + (lane & 31)] = vbuf[i] * sbuf[i]; }
    __builtin_amdgcn_s_waitcnt(0xc07f); asm volatile("s_waitcnt lgkmcnt(0)" ::: "memory");
    const int c = lane & 7;
#pragma unroll
    for (int j = 0; j < 4; ++j) { const int n = (lane >> 3) + 8 * j; const LAS float* s = scr + (8 * c) * 33 + n;
        u32x4 o; o.x = pk2(s[0 * 33], s[1 * 33]); o.y = pk2(s[2 * 33], s[3 * 33]); o.z = pk2(s[4 * 33], s[5 * 33]); o.w = pk2(s[6 * 33], s[7 * 33]);
        *(u32x4*)(WT + (size_t)(n0 + n) * K + k0 + 8 * c) = o; }
    asm volatile("s_waitcnt lgkmcnt(0)" ::: "memory");
}
__device__ __forceinline__ void phase_convert(const Args& a, LAS unsigned char* lds, int l_lo, int l_hi, int f_lo, int f_hi, int vb, int nvb, int small) {
    size_t wso_ = 0; asm volatile("" : "+s"(wso_)); unsigned char* ws = a.ws + wso_;
    const int tid = tid_l(), wave = __builtin_amdgcn_readfirstlane(tid >> 6), lane = tid & 63;
    LAS float* scr = (LAS float*)(lds + wave * 8448);
    const int gw = vb * 8 + wave, NGW = nvb * 8;
    constexpr int I_IN = (DM / 64) * (NP / 32), I_OUT = (DM / 64) * (DM / 32), PER_L = I_IN + I_OUT;
    const int i_lo = (PER_L / 64) * f_lo, i_hi = (PER_L / 64) * f_hi, span = i_hi - i_lo;
    for (int it = gw; it < (l_hi - l_lo) * span; it += NGW) {
        const int l = l_lo + it / span; int r = i_lo + it % span;
        if (r < I_IN) transpose_item(inp(lds, I_WIN) + (size_t)l * DM * NIN, DM, NIN, (bf16_t*)(ws + WS_WIN) + (size_t)l * NP * DM, inp(lds, I_NORMG) + l * DM, true, scr, r, NP / 32, lane);
        else transpose_item(inp(lds, I_WOUT) + (size_t)l * DM * DM, DM, DM, (bf16_t*)(ws + WS_WOUT) + (size_t)l * DM * DM, nullptr, false, scr, r - I_IN, DM / 32, lane);
    }
    if (small) {
        const int gt = vb * 512 + tid, NT_ = nvb * 512;
        const float* wup = inp(lds, I_RWUP); const float* aup = inp(lds, I_RAUP); bf16_t* WUPT = (bf16_t*)(ws + WS_WUPT); bf16_t* AUPT = (bf16_t*)(ws + WS_AUPT);
        for (int idx = gt; idx < NL * 768 * 96; idx += NT_) { const int i = idx % 96, j = (idx / 96) % 768, l = idx / (96 * 768); const size_t src = ((size_t)l * 96 + i) * 768 + j; WUPT[idx] = f2bf(wup[src]); AUPT[idx] = f2bf(aup[src]); }
        const float* wx = inp(lds, I_LWX); const float* wa = inp(lds, I_LWA); bf16_t* WXT = (bf16_t*)(ws + WS_WXT); bf16_t* WAT = (bf16_t*)(ws + WS_WAT);
        for (int idx = gt; idx < NL * 8 * 64 * 64; idx += NT_) { const int i = idx & 63, j = (idx >> 6) & 63, ln = idx >> 12; const size_t src = ((size_t)ln * 64 + i) * 64 + j; WXT[idx] = f2bf(wx[src]); WAT[idx] = f2bf(wa[src]); }
    }
}
__device__ __forceinline__ void phase_rms(const float* xin, bf16_t* xb) {
    const int tid = tid_l(), wave = tid >> 6, lane = tid & 63;
    const int gw = bid_l() * 8 + wave, NGW = gdim_l() * 8;
    for (int m = gw; m < NTOK; m += NGW) {
        const f32x4* xr = (const f32x4*)(xin + (size_t)m * DM) + lane;
        f32x4 v[8]; float s = 0.f;
#pragma unroll
        for (int j = 0; j < 8; ++j) { v[j] = xr[64 * j]; s += (v[j].x * v[j].x + v[j].y * v[j].y) + (v[j].z * v[j].z + v[j].w * v[j].w); }
        const float rstd = __builtin_amdgcn_rsqf(wave_sum(s) * (1.0f / DM) + 1e-6f);
        u32x2* o = (u32x2*)(xb + (size_t)m * DM) + lane;
#pragma unroll
        for (int j = 0; j < 8; ++j) { u32x2 w; w.x = pk2(v[j].x * rstd, v[j].y * rstd); w.y = pk2(v[j].z * rstd, v[j].w * rstd); o[64 * j] = w; }
    }
}
__device__ __forceinline__ void phase_final(const float* xin, const float* g, float* out) {
    const int tid = tid_l(), wave = tid >> 6, lane = tid & 63;
    const int gw = bid_l() * 8 + wave, NGW = gdim_l() * 8;
    for (int m = gw; m < NTOK; m += NGW) {
        const f32x4* xr = (const f32x4*)(xin + (size_t)m * DM) + lane;
        f32x4 v[8]; float s = 0.f;
#pragma unroll
        for (int j = 0; j < 8; ++j) { v[j] = xr[64 * j]; s += (v[j].x * v[j].x + v[j].y * v[j].y) + (v[j].z * v[j].z + v[j].w * v[j].w); }
        const float rstd = __builtin_amdgcn_rsqf(wave_sum(s) * (1.0f / DM) + 1e-6f);
        f32x4* o = (f32x4*)(out + (size_t)m * DM) + lane; const f32x4* gg = (const f32x4*)g + lane;
#pragma unroll
        for (int j = 0; j < 8; ++j) o[64 * j] = v[j] * rstd * gg[64 * j];
    }
}
struct EpiDual {
    static constexpr bool PERM = true, AFTER_DRAIN = false;
    int mode; bf16_t* O; int ldo; const float* base; float* C; int ldc;
    __device__ __forceinline__ void operator()(const pg8::f32x4 (&acc)[2][2][4][2], const pg8::Unit& u, int wr, int wc, int fr, int fq) const {
        const int row0 = u.pm * 256 + wr * 64 + fr, col0 = u.pn * 256 + wc * 32 + 8 * fq;
        if (mode == 0) {
#pragma unroll
            for (int ai = 0; ai < 2; ++ai)
#pragma unroll
                for (int m = 0; m < 4; ++m) { bf16_t* rowp = O + (size_t)(row0 + ai * 128 + m * 16) * ldo + col0;
#pragma unroll
                    for (int bj = 0; bj < 2; ++bj) { const pg8::f32x4 v0 = acc[ai][bj][m][0], v1 = acc[ai][bj][m][1];
                        pg8::u32x4 w; w.x = cvtpk(v0[0], v0[1]); w.y = cvtpk(v0[2], v0[3]); w.z = cvtpk(v1[0], v1[1]); w.w = cvtpk(v1[2], v1[3]);
                        *(pg8::u32x4*)(rowp + bj * 128) = w; } }
        } else {
#pragma unroll
            for (int ai = 0; ai < 2; ++ai)
#pragma unroll
                for (int m = 0; m < 4; ++m) { const size_t off = (size_t)(row0 + ai * 128 + m * 16) * ldc + col0;
#pragma unroll
                    for (int bj = 0; bj < 2; ++bj)
#pragma unroll
                        for (int n = 0; n < 2; ++n) { const pg8::f32x4 b = *(const pg8::f32x4*)(base + off + bj * 128 + n * 4); *(pg8::f32x4*)(C + off + bj * 128 + n * 4) = acc[ai][bj][m][n] + b; }
                    asm volatile("" ::: "memory"); }
        }
    }
};
constexpr int PT = 32;
typedef short bf16x8 __attribute__((ext_vector_type(8)));
__device__ __forceinline__ void phase_prep(const Args& a, int l, LAS unsigned char* lds) {
    size_t wso_ = 0; asm volatile("" : "+s"(wso_)); unsigned char* ws = a.ws + wso_;
    const int tid0 = tid_l(), wave = __builtin_amdgcn_readfirstlane(tid0 >> 6);
    const bf16_t* PROJ = (const bf16_t*)(ws + WS_PROJ);
    constexpr int XSR = 200, XLR = 520;
    LAS bf16_t* xsb = (LAS bf16_t*)lds;
    LAS bf16_t* xlb = (LAS bf16_t*)(lds + PT * XSR * 2);
    LAS float* xlf = (LAS float*)(lds + PT * XSR * 2 + PT * XLR * 2);
    float* GQ = (float*)(ws + WS_GQ); float* GK = (float*)(ws + WS_GK); float* GV = (float*)(ws + WS_GV);
    float* GB = (float*)(ws + WS_GB); float* GG = (float*)(ws + WS_GG);
    float* RR = (float*)(ws + WS_RR); float* RWd = (float*)(ws + WS_RW); float* RK = (float*)(ws + WS_RK); float* RV = (float*)(ws + WS_RV);
    float* RKK = (float*)(ws + WS_RKK); float* RB = (float*)(ws + WS_RB);
    float* LA = (float*)(ws + WS_LA); float* LU = (float*)(ws + WS_LU);
    const float* mu = inp(lds, I_RMU) + l * 2496;
    for (int tile = bid_l(); tile < NTOK / PT; tile += gdim_l()) {
        int tid = tid0; asm volatile("" : "+v"(tid)); const int lane = tid & 63, lr = lane & 15, lq = lane >> 4;
        const int t0 = tile * PT, sp = t0 % SEQ;
        { bf16_t curv[12], prevv[12];
#pragma unroll
            for (int q = 0; q < 12; ++q) { const int idx = tid + 512 * q, tt = idx / 192, i = idx % 192; const int col = PC_CIN + 2304 + i;
                curv[q] = PROJ[(size_t)(t0 + tt) * NP + col]; prevv[q] = PROJ[(size_t)(t0 + tt - ((sp + tt > 0) ? 1 : 0)) * NP + col]; }
#pragma unroll
            for (int q = 0; q < 12; ++q) { const int idx = tid + 512 * q, tt = idx / 192, i = idx % 192; const float cur = bf2f(curv[q]), prev = (sp + tt > 0) ? bf2f(prevv[q]) : 0.f;
                float xs = cur + (prev - cur) * mu[2304 + i]; if (i < 96) xs = tanhf_(xs); xsb[tt * XSR + i] = f2bf(xs); } }
        { const int j = tid; const float* cw = inp(lds, I_LCW) + l * 4 * LRUW; const float w0 = cw[j], w1 = cw[LRUW + j], w2 = cw[2 * LRUW + j], w3 = cw[3 * LRUW + j], cb = inp(lds, I_LCB)[l * LRUW + j];
            float xm3 = (sp >= 3) ? bf2f(PROJ[(size_t)(t0 - 3) * NP + PC_AX + j]) : 0.f, xm2 = (sp >= 2) ? bf2f(PROJ[(size_t)(t0 - 2) * NP + PC_AX + j]) : 0.f, xm1 = (sp >= 1) ? bf2f(PROJ[(size_t)(t0 - 1) * NP + PC_AX + j]) : 0.f;
            bf16_t cv[PT];
#pragma unroll
            for (int tt = 0; tt < PT; ++tt) cv[tt] = PROJ[(size_t)(t0 + tt) * NP + PC_AX + j];
#pragma unroll
            for (int tt = 0; tt < PT; ++tt) { const float cur = bf2f(cv[tt]); const float x = w0 * xm3 + w1 * xm2 + w2 * xm1 + w3 * cur + cb; xlf[tt * 512 + j] = x; xlb[tt * XLR + j] = f2bf(x); xm3 = xm2; xm2 = xm1; xm1 = cur; } }
        LBAR();
        for (int u = wave; u < 24; u += 8) { const int h = u % 12, tb = u / 12;
            bf16x8 xw[3], xa[3];
#pragma unroll
            for (int k = 0; k < 3; ++k) { xw[k] = *(const LAS bf16x8*)(xsb + (tb * 16 + lr) * XSR + 32 * k + 8 * lq); xa[k] = *(const LAS bf16x8*)(xsb + (tb * 16 + lr) * XSR + 96 + 32 * k + 8 * lq); }
            f32x4 aw[4], aa[4];
#pragma unroll
            for (int jq = 0; jq < 4; ++jq) { const int jrow = l * 768 + h * 64 + jq * 16 + lr; const bf16_t* pw = (const bf16_t*)(ws + WS_WUPT) + (size_t)jrow * 96 + 8 * lq; const bf16_t* pa = (const bf16_t*)(ws + WS_AUPT) + (size_t)jrow * 96 + 8 * lq;
                aw[jq] = (f32x4){0.f, 0.f, 0.f, 0.f}; aa[jq] = (f32x4){0.f, 0.f, 0.f, 0.f};
#pragma unroll
                for (int k = 0; k < 3; ++k) { aw[jq] = __builtin_amdgcn_mfma_f32_16x16x32_bf16(xw[k], *(const bf16x8*)(pw + 32 * k), aw[jq], 0, 0, 0); aa[jq] = __builtin_amdgcn_mfma_f32_16x16x32_bf16(xa[k], *(const bf16x8*)(pa + 32 * k), aa[jq], 0, 0, 0); } }
            const int tokb = tb * 16 + 4 * lq;
            bf16_t pr_[5][4], pk_[5][4], pv_[5][4];
#pragma unroll
            for (int rr = 0; rr < 5; ++rr) { const int trow = t0 + tokb + rr - ((rr == 0 && sp + tokb == 0) ? 0 : 1);
#pragma unroll
                for (int jq = 0; jq < 4; ++jq) { const bf16_t* p = PROJ + (size_t)trow * NP + PC_CIN + h * 64 + jq * 16 + lr; pr_[rr][jq] = p[0]; pk_[rr][jq] = p[768]; pv_[rr][jq] = p[1536]; } }
            float w0v[4], a0v[4], kkwv[4], kawv[4], murv[4], mukv[4], muvv[4];
#pragma unroll
            for (int jq = 0; jq < 4; ++jq) { const int j = h * 64 + jq * 16 + lr; w0v[jq] = inp(lds, I_RW0)[l * 768 + j]; a0v[jq] = inp(lds, I_RA0)[l * 768 + j]; kkwv[jq] = inp(lds, I_RKK)[l * 768 + j]; kawv[jq] = inp(lds, I_RKA)[l * 768 + j];
                murv[jq] = mu[j]; mukv[jq] = mu[768 + j]; muvv[jq] = mu[1536 + j]; }
#pragma unroll
            for (int r = 0; r < 4; ++r) { const bool first = (sp + tokb + r == 0);
                float kr[4], kv_[4], rv_[4], vv_[4], av_[4]; float ss = 0.f;
#pragma unroll
                for (int jq = 0; jq < 4; ++jq) { const float cr = bf2f(pr_[r + 1][jq]), ck = bf2f(pk_[r + 1][jq]), cvv = bf2f(pv_[r + 1][jq]);
                    const float qr = first ? 0.f : bf2f(pr_[r][jq]), qk = first ? 0.f : bf2f(pk_[r][jq]), qv = first ? 0.f : bf2f(pv_[r][jq]);
                    rv_[jq] = cr + (qr - cr) * murv[jq]; kv_[jq] = ck + (qk - ck) * mukv[jq]; vv_[jq] = cvv + (qv - cvv) * muvv[jq];
                    av_[jq] = sigmoidf_(a0v[jq] + aa[jq][r]); kr[jq] = kv_[jq] * kkwv[jq]; ss += kr[jq] * kr[jq]; }
                ss = sum16(ss); const float rs = __builtin_amdgcn_rsqf(ss + 1e-6f);
#pragma unroll
                for (int jq = 0; jq < 4; ++jq) { const size_t o = (size_t)(t0 + tokb + r) * 768 + h * 64 + jq * 16 + lr;
                    const float wlog = -softplusf_(-(w0v[jq] + aw[jq][r])) - 0.5f; RWd[o] = -__expf(wlog);
                    const float kk = kr[jq] * rs; RR[o] = rv_[jq]; RK[o] = kv_[jq] * (1.0f + (av_[jq] - 1.0f) * kawv[jq]); RV[o] = vv_[jq]; RKK[o] = kk; RB[o] = kk * av_[jq]; } }
        }
        for (int u = wave; u < 16; u += 8) { const int n = u & 7, tb = u >> 3;
            bf16x8 xg[2];
#pragma unroll
            for (int k = 0; k < 2; ++k) xg[k] = *(const LAS bf16x8*)(xlb + (tb * 16 + lr) * XLR + n * 64 + 32 * k + 8 * lq);
            f32x4 ax[4], ag[4];
#pragma unroll
            for (int jq = 0; jq < 4; ++jq) { const size_t jrow = (size_t)(l * 8 + n) * 64 + jq * 16 + lr; const bf16_t* px = (const bf16_t*)(ws + WS_WXT) + jrow * 64 + 8 * lq; const bf16_t* pa = (const bf16_t*)(ws + WS_WAT) + jrow * 64 + 8 * lq;
                ax[jq] = (f32x4){0.f, 0.f, 0.f, 0.f}; ag[jq] = (f32x4){0.f, 0.f, 0.f, 0.f};
#pragma unroll
                for (int k = 0; k < 2; ++k) { ax[jq] = __builtin_amdgcn_mfma_f32_16x16x32_bf16(xg[k], *(const bf16x8*)(px + 32 * k), ax[jq], 0, 0, 0); ag[jq] = __builtin_amdgcn_mfma_f32_16x16x32_bf16(xg[k], *(const bf16x8*)(pa + 32 * k), ag[jq], 0, 0, 0); } }
#pragma unroll
            for (int jq = 0; jq < 4; ++jq) { const int j = n * 64 + jq * 16 + lr; const float bx = inp(lds, I_LBX)[l * 512 + j], ba = inp(lds, I_LBA)[l * 512 + j]; const float spl = softplusf_(-inp(lds, I_LLAM)[l * 512 + j]);
#pragma unroll
                for (int r = 0; r < 4; ++r) { const int tt = tb * 16 + 4 * lq + r; const float gx = sigmoidf_(ax[jq][r] + bx), ga = sigmoidf_(ag[jq][r] + ba);
                    const float loga = -8.0f * ga * spl; const float av = __expf(loga); const float mult = __builtin_amdgcn_sqrtf(fmaxf(1.0f - __expf(2.0f * loga), 0.f));
                    LA[(size_t)(t0 + tt) * 512 + j] = av; LU[(size_t)(t0 + tt) * 512 + j] = mult * gx * xlf[tt * 512 + j]; } } }
        for (int wt = wave; wt < 18; wt += 8) { const int ch0 = 128 * wt + 2 * lane; const float* cw = inp(lds, I_GCW) + (size_t)l * 4 * 2304 + ch0;
            const f32x2 w0 = *(const f32x2*)(cw), w1 = *(const f32x2*)(cw + 2304), w2 = *(const f32x2*)(cw + 2 * 2304), w3 = *(const f32x2*)(cw + 3 * 2304);
            f32x2 xm3 = {0.f, 0.f}, xm2 = {0.f, 0.f}, xm1 = {0.f, 0.f};
            const bf16_t* pc = PROJ + PC_BQKV + ch0;
            if (sp >= 3) { const unsigned q = *(const unsigned*)(pc + (size_t)(t0 - 3) * NP); xm3.x = __uint_as_float(q << 16); xm3.y = __uint_as_float(q & 0xffff0000u); }
            if (sp >= 2) { const unsigned q = *(const unsigned*)(pc + (size_t)(t0 - 2) * NP); xm2.x = __uint_as_float(q << 16); xm2.y = __uint_as_float(q & 0xffff0000u); }
            if (sp >= 1) { const unsigned q = *(const unsigned*)(pc + (size_t)(t0 - 1) * NP); xm1.x = __uint_as_float(q << 16); xm1.y = __uint_as_float(q & 0xffff0000u); }
            float* dst = (wt < 6) ? GQ : (wt < 12 ? GK : GV); const int dch = ch0 % 768;
            unsigned qv[PT];
#pragma unroll
            for (int tt = 0; tt < PT; ++tt) qv[tt] = *(const unsigned*)(pc + (size_t)(t0 + tt) * NP);
#pragma unroll
            for (int tt = 0; tt < PT; ++tt) { const unsigned q = qv[tt]; f32x2 cur; cur.x = __uint_as_float(q << 16); cur.y = __uint_as_float(q & 0xffff0000u);
                f32x2 v = w0 * xm3 + w1 * xm2 + w2 * xm1 + w3 * cur; v.x = siluf_(v.x); v.y = siluf_(v.y);
                if (wt < 12) { const float ss = wave_sum(v.x * v.x + v.y * v.y); float sc = __builtin_amdgcn_rsqf(ss + 1e-6f); if (wt < 6) sc *= 0.08838834764831845f; v = v * sc; }
                *(f32x2*)(dst + (size_t)(t0 + tt) * 768 + dch) = v; xm3 = xm2; xm2 = xm1; xm1 = cur; } }
        if (tid < PT * 6) { const int tt = tid / 6, h = tid % 6; const float bl = bf2f(PROJ[(size_t)(t0 + tt) * NP + PC_BETA + h]), al = bf2f(PROJ[(size_t)(t0 + tt) * NP + PC_BA + h]);
            GB[(size_t)(t0 + tt) * 8 + h] = sigmoidf_(bl); GG[(size_t)(t0 + tt) * 8 + h] = -__expf(inp(lds, I_GALOG)[l * 6 + h]) * softplusf_(al + inp(lds, I_GDT)[l * 6 + h]); }
        LBAR();
    }
}
typedef short bf16x8 __attribute__((ext_vector_type(8)));
struct ScanRec { const bf16_t* M1; const bf16_t* M2; const bf16_t* M3; const bf16_t* M4T; const float* UT; const float* G; const bf16_t* VT; };
template <int D, int KZ, bool EXT>
__device__ __forceinline__ void scan_item(const ScanRec R0, int e0, float* OUT, int out_ld, LAS unsigned char* lds) {
    constexpr int NK1 = D / 32, NK2 = KZ / 32, NT3 = D / 64, SROW = D + 8, ZROW = KZ + 8, HD = EXT ? 64 : 128;
    constexpr bool GS = !EXT;
    const int tid = tid_l(), w = __builtin_amdgcn_readfirstlane(tid >> 6), lane = tid & 63, lr = lane & 15, lq = lane >> 4;
    const bool front = (w < 4); const int cb = w & 3;
    LAS bf16_t* ST = (LAS bf16_t*)lds;
    LAS bf16_t* ZT = (LAS bf16_t*)(lds + 2 * 32 * SROW * 2);
    constexpr int OSROW = 36;
    LAS float* OS = (LAS float*)(lds + 2 * 32 * SROW * 2 + 32 * ZROW * 2);
    for (int i = tid; i < 2 * 32 * SROW / 2; i += 512) ((LAS unsigned*)ST)[i] = 0u;
    struct FS { bf16x8 m1[NK1], m3[NK2]; f32x4 ut[2]; u32x4 vt; };
    struct BS { bf16x8 m4[NT3][NK2]; f32x4 g[GS ? 1 : NT3]; float gs; };
#define SCAN_LOADF(s, n) do { \
        const bf16_t* a1_ = R0.M1 + (size_t)(n) * 64 * D + (cb * 16 + lr) * D + 8 * lq; \
        _Pragma("unroll") for (int k = 0; k < NK1; ++k) s.m1[k] = *(const bf16x8*)(a1_ + 32 * k); \
        const bf16_t* a3_ = R0.M3 + (size_t)(n) * 64 * KZ + (cb * 16 + lr) * KZ + 8 * lq; \
        _Pragma("unroll") for (int k = 0; k < NK2; ++k) s.m3[k] = *(const bf16x8*)(a3_ + 32 * k); \
        _Pragma("unroll") for (int j = 0; j < 2; ++j) s.ut[j] = *(const f32x4*)(R0.UT + (size_t)(n) * HD * 64 + (size_t)(e0 + j * 16 + lr) * 64 + cb * 16 + 4 * lq); \
        if (EXT) s.vt = *(const u32x4*)(R0.VT + (size_t)(n) * 64 * 64 + (size_t)(e0 + (tid >> 3)) * 64 + (tid & 7) * 8); } while (0)
#define SCAN_LOADB(s, n) do { \
        _Pragma("unroll") for (int t = 0; t < NT3; ++t) { const int db = cb + 4 * t; const bf16_t* a4_ = R0.M4T + (size_t)(n) * D * KZ + (db * 16 + lr) * KZ + 8 * lq; \
            _Pragma("unroll") for (int k = 0; k < NK2; ++k) s.m4[t][k] = *(const bf16x8*)(a4_ + 32 * k); \
            if (!GS) s.g[t] = *(const f32x4*)(R0.G + (size_t)(n) * D + db * 16 + 4 * lq); } \
        if (GS) s.gs = R0.G[(size_t)(n) * D]; } while (0)
#define SCAN_OUT(n) do { const f32x4 ov = *(const LAS f32x4*)(OS + (tid >> 3) * OSROW + (tid & 7) * 4); *(f32x4*)(OUT + (size_t)((n) * 64 + (tid >> 3)) * out_ld + e0 + (tid & 7) * 4) = ov; } while (0)
#define SCAN_STEP_F(n, par, fc, fl) do { \
        LAS bf16_t* STo = ST + (par) * 32 * SROW; \
        bf16x8 m2l[NK1]; \
        { const bf16_t* a2_ = R0.M2 + (size_t)(n) * 64 * D + (cb * 16 + lr) * D + 8 * lq; _Pragma("unroll") for (int k = 0; k < NK1; ++k) m2l[k] = *(const bf16x8*)(a2_ + 32 * k); }     \
        if ((n) + 2 < 32) SCAN_LOADF(fl, (n) + 2); \
        _Pragma("unroll") for (int j = 0; j < 2; ++j) { f32x4 a1 = fc.ut[j]; \
            _Pragma("unroll") for (int k = 0; k < NK1; ++k) { const bf16x8 y = *(const LAS bf16x8*)(STo + (j * 16 + lr) * SROW + 32 * k + 8 * lq); a1 = __builtin_amdgcn_mfma_f32_16x16x32_bf16(fc.m1[k], y, a1, 0, 0, 0); } \
            u32x2 zz; zz.x = cvtpk(a1[0], a1[1]); zz.y = cvtpk(a1[2], a1[3]); *(LAS u32x2*)(ZT + (j * 16 + lr) * ZROW + cb * 16 + 4 * lq) = zz; } \
        if (EXT) *(LAS u32x4*)(ZT + (tid >> 3) * ZROW + 64 + (tid & 7) * 8) = fc.vt; \
        LBAR(); \
        _Pragma("unroll") for (int j = 0; j < 2; ++j) { f32x4 a2 = (f32x4){0.f, 0.f, 0.f, 0.f}; \
            _Pragma("unroll") for (int k = 0; k < NK2; ++k) { const bf16x8 z = *(const LAS bf16x8*)(ZT + (j * 16 + lr) * ZROW + 32 * k + 8 * lq); a2 = __builtin_amdgcn_mfma_f32_16x16x32_bf16(fc.m3[k], z, a2, 0, 0, 0); } \
            _Pragma("unroll") for (int k = 0; k < NK1; ++k) { const bf16x8 y = *(const LAS bf16x8*)(STo + (j * 16 + lr) * SROW + 32 * k + 8 * lq); a2 = __builtin_amdgcn_mfma_f32_16x16x32_bf16(m2l[k], y, a2, 0, 0, 0); } \
            _Pragma("unroll") for (int r = 0; r < 4; ++r) OS[(cb * 16 + 4 * lq + r) * OSROW + j * 16 + lr] = a2[r]; } \
        LBAR(); \
        SCAN_OUT(n); } while (0)
#define SCAN_STEP_B(n, par, bc, bl) do { \
        LAS bf16_t* STn = ST + (1 - (par)) * 32 * SROW; \
        if ((n) + 2 < 32) SCAN_LOADB(bl, (n) + 2); \
        LBAR(); \
        _Pragma("unroll") for (int j = 0; j < 2; ++j) { \
            _Pragma("unroll") for (int t = 0; t < NT3; ++t) { if (GS) accs[t][j] = accs[t][j] * bc.gs; else accs[t][j] = accs[t][j] * bc.g[GS ? 0 : t]; } \
            _Pragma("unroll") for (int k = 0; k < NK2; ++k) { const bf16x8 z = *(const LAS bf16x8*)(ZT + (j * 16 + lr) * ZROW + 32 * k + 8 * lq); \
                _Pragma("unroll") for (int t = 0; t < NT3; ++t) accs[t][j] = __builtin_amdgcn_mfma_f32_16x16x32_bf16(bc.m4[t][k], z, accs[t][j], 0, 0, 0); } \
            _Pragma("unroll") for (int t = 0; t < NT3; ++t) { const int db = cb + 4 * t; u32x2 ss; ss.x = cvtpk(accs[t][j][0], accs[t][j][1]); ss.y = cvtpk(accs[t][j][2], accs[t][j][3]); *(LAS u32x2*)(STn + (j * 16 + lr) * SROW + db * 16 + 4 * lq) = ss; } } \
        LBAR(); \
        SCAN_OUT(n); } while (0)
    if (front) {
        FS f0, f1, f2;
        SCAN_LOADF(f0, 0); SCAN_LOADF(f1, 1);
        __builtin_amdgcn_s_waitcnt(0x0F70);
        LBAR();
        for (int n0 = 0; n0 < 30; n0 += 6) {
            SCAN_STEP_F(n0, 0, f0, f2); SCAN_STEP_F(n0 + 1, 1, f1, f0); SCAN_STEP_F(n0 + 2, 0, f2, f1);
            SCAN_STEP_F(n0 + 3, 1, f0, f2); SCAN_STEP_F(n0 + 4, 0, f1, f0); SCAN_STEP_F(n0 + 5, 1, f2, f1);
        }
        SCAN_STEP_F(30, 0, f0, f2); SCAN_STEP_F(31, 1, f1, f0);
    } else {
        BS b0, b1, b2;
        f32x4 accs[NT3][2];
#pragma unroll
        for (int t = 0; t < NT3; ++t) { accs[t][0] = (f32x4){0.f, 0.f, 0.f, 0.f}; accs[t][1] = (f32x4){0.f, 0.f, 0.f, 0.f}; }
        SCAN_LOADB(b0, 0); SCAN_LOADB(b1, 1);
        __builtin_amdgcn_s_waitcnt(0x0F70);
        LBAR();
        for (int n0 = 0; n0 < 30; n0 += 6) {
            SCAN_STEP_B(n0, 0, b0, b2); SCAN_STEP_B(n0 + 1, 1, b1, b0); SCAN_STEP_B(n0 + 2, 0, b2, b1);
            SCAN_STEP_B(n0 + 3, 1, b0, b2); SCAN_STEP_B(n0 + 4, 0, b1, b0); SCAN_STEP_B(n0 + 5, 1, b2, b1);
        }
        SCAN_STEP_B(30, 0, b0, b2); SCAN_STEP_B(31, 1, b1, b0);
    }
#undef SCAN_STEP_F
#undef SCAN_STEP_B
#undef SCAN_OUT
#undef SCAN_LOADF
#undef SCAN_LOADB
}

__device__ __forceinline__ void phase_gdn_chunk(const Args& a, int l, LAS unsigned char* lds) {
    size_t wso_ = 0; asm volatile("" : "+s"(wso_)); unsigned char* ws = a.ws + wso_;
    const int tid0 = tid_l(), w = __builtin_amdgcn_readfirstlane(tid0 >> 6);
    const float* GQ = (const float*)(ws + WS_GQ); const float* GK = (const float*)(ws + WS_GK); const float* GV = (const float*)(ws + WS_GV);
    const float* GB = (const float*)(ws + WS_GB); const float* GG = (const float*)(ws + WS_GG);
    constexpr int KROW = 136;
    LAS bf16_t* Kb = (LAS bf16_t*)lds;
    LAS bf16_t* Qb = (LAS bf16_t*)(lds + 64 * KROW * 2);
    LAS float* Af = (LAS float*)(lds + 2 * 64 * KROW * 2);
    LAS float* dvb = Af + 64 * 64;
    const int first = bid_l(), gstep = gdim_l();
    const int nmine = (first < GCH) ? (GCH - first + gstep - 1) / gstep : 0;
    for (int k = -1; k < nmine; ++k) {
        int tid = tid0; asm volatile("" : "+v"(tid)); const int lane = tid & 63, lr = lane & 15, lq = lane >> 4;
        LBAR();
        if (w < 4) {
            const bool act = (k >= 0); const int item = first + (act ? k : 0) * gstep;
            const int b = item / 192, h = (item / 32) % 6, n = item % 32; const size_t t0 = (size_t)b * SEQ + n * 64;
            LAS float* dv = dvb + (k & 1) * 128; LAS float* bv = dv + 64;
            const int col = tid; const bool isu = (w < 2); const int cc = col & 127;
            float X[64]; int Arow[63];
            if (act) {
                const float* src = (isu ? GV : GK) + t0 * 768 + h * 128 + cc;
#pragma unroll
                for (int c = 0; c < 64; ++c) X[c] = src[(size_t)c * 768];
#pragma unroll
                for (int m = 0; m < 63; ++m) Arow[m] = __float_as_int(Af[m * 64 + lane]);
                if (isu) {
#pragma unroll
                    for (int c = 0; c < 64; ++c) X[c] *= bv[c]; }
                else {
#pragma unroll
                    for (int c = 0; c < 64; ++c) X[c] *= bv[c] * __expf(dv[c]); }
            }
            LBAR();
            if (act) {
#pragma unroll
                for (int m = 0; m < 63; ++m) { const float xm = X[m];
#pragma unroll
                    for (int c = m + 1; c < 64; ++c) X[c] -= __int_as_float(__builtin_amdgcn_readlane(Arow[m], c)) * xm; }
            }
            LBAR();
            if (act) {
                if (isu) { float* UT = (float*)(ws + WS_GU) + (size_t)item * 128 * 64 + (size_t)cc * 64;
#pragma unroll
                    for (int c4 = 0; c4 < 16; ++c4) *(f32x4*)(UT + 4 * c4) = (f32x4){X[4 * c4], X[4 * c4 + 1], X[4 * c4 + 2], X[4 * c4 + 3]}; }
                else { bf16_t* M1 = (bf16_t*)(ws + WS_G1) + (size_t)item * 64 * 128 + cc;
#pragma unroll
                    for (int c = 0; c < 64; ++c) M1[c * 128] = f2bf(-X[c]); }
            }
        } else {
            const bool act = (k + 1 < nmine); const int item = first + (act ? (k + 1) : 0) * gstep;
            const int b = item / 192, h = (item / 32) % 6, n = item % 32; const size_t t0 = (size_t)b * SEQ + n * 64;
            LAS float* dv = dvb + ((k + 1) & 1) * 128; LAS float* bv = dv + 64;
            const int t = tid - 256, wb = w - 4;
            if (act) {
                float gpre = 0.f, bpre = 0.f; if (wb == 0) { gpre = GG[(t0 + lane) * 8 + h]; bpre = GB[(t0 + lane) * 8 + h]; }
#pragma unroll
                for (int hf = 0; hf < 2; ++hf) { f32x4 kv4[4], qv4[4];
#pragma unroll
                    for (int q = 0; q < 4; ++q) { const int idx = t + 256 * (4 * hf + q), c = idx >> 5, d4 = idx & 31; const size_t g = (t0 + c) * 768 + h * 128 + d4 * 4; kv4[q] = *(const f32x4*)(GK + g); qv4[q] = *(const f32x4*)(GQ + g); }
#pragma unroll
                    for (int q = 0; q < 4; ++q) { const int idx = t + 256 * (4 * hf + q), c = idx >> 5, d4 = idx & 31; const f32x4 kv = kv4[q], qv = qv4[q];
                        u32x2 pk; pk.x = cvtpk(kv[0], kv[1]); pk.y = cvtpk(kv[2], kv[3]); *(LAS u32x2*)(Kb + c * KROW + d4 * 4) = pk;
                        u32x2 pq; pq.x = cvtpk(qv[0], qv[1]); pq.y = cvtpk(qv[2], qv[3]); *(LAS u32x2*)(Qb + c * KROW + d4 * 4) = pq; } }
                if (wb == 0) { float g = gpre;
#pragma unroll
                    for (int o = 1; o < 64; o <<= 1) { const float tt = __shfl_up(g, o); if (lane >= o) g += tt; }
                    dv[lane] = g; bv[lane] = bpre; }
            }
            LBAR();
            if (act) {
                const int which = wb >> 1; const LAS bf16_t* X = which ? Qb : Kb;
                bf16_t* M3 = (bf16_t*)(ws + WS_G3) + (size_t)item * 64 * 64;
#pragma unroll
                for (int ci = 0; ci < 2; ++ci) { const int cb = 2 * (wb & 1) + ci;
                    bf16x8 xf[4];
#pragma unroll
                    for (int kk = 0; kk < 4; ++kk) xf[kk] = *(const LAS bf16x8*)(X + (cb * 16 + lr) * KROW + 32 * kk + 8 * lq);
#pragma unroll
                    for (int mb = 0; mb < 4; ++mb) { f32x4 acc = (f32x4){0.f, 0.f, 0.f, 0.f};
#pragma unroll
                        for (int kk = 0; kk < 4; ++kk) { const bf16x8 yf = *(const LAS bf16x8*)(Kb + (mb * 16 + lr) * KROW + 32 * kk + 8 * lq); acc = __builtin_amdgcn_mfma_f32_16x16x32_bf16(xf[kk], yf, acc, 0, 0, 0); }
                        const int m = mb * 16 + lr; const float dm = dv[m];
                        if (which == 0) { f32x4 o;
#pragma unroll
                            for (int r = 0; r < 4; ++r) { const int c = cb * 16 + 4 * lq + r; o[r] = (c > m) ? bv[c] * acc[r] * __expf(dv[c] - dm) : 0.f; }
                            *(LAS f32x4*)(Af + m * 64 + cb * 16 + 4 * lq) = o; }
                        else {
#pragma unroll
                            for (int r = 0; r < 4; ++r) { const int c = cb * 16 + 4 * lq + r; M3[c * 64 + m] = f2bf((c >= m) ? acc[r] * __expf(dv[c] - dm) : 0.f); } } } }
            }
            LBAR();
            if (act) {
                const float dl = dv[63];
                bf16_t* M2 = (bf16_t*)(ws + WS_G2) + (size_t)item * 64 * 128;
#pragma unroll
                for (int q = 0; q < 8; ++q) { const int idx = t + 256 * q, c = idx >> 5, d4 = idx & 31; const u32x2 qq = *(const LAS u32x2*)(Qb + c * KROW + d4 * 4); const float e = __expf(dv[c]);
                    u32x2 p; p.x = cvtpk(__uint_as_float(qq.x << 16) * e, __uint_as_float(qq.x & 0xffff0000u) * e); p.y = cvtpk(__uint_as_float(qq.y << 16) * e, __uint_as_float(qq.y & 0xffff0000u) * e); *(u32x2*)(M2 + c * 128 + d4 * 4) = p; }
                { const int d = t & 127, ch = t >> 7; bf16_t* M4 = (bf16_t*)(ws + WS_G4) + (size_t)item * 128 * 64 + d * 64 + ch * 32;
#pragma unroll
                    for (int q = 0; q < 4; ++q) { float kv[8];
#pragma unroll
                        for (int j = 0; j < 8; ++j) { const int c = ch * 32 + q * 8 + j; kv[j] = bf2f(Kb[c * KROW + d]) * __expf(dl - dv[c]); }
                        u32x4 p; p.x = cvtpk(kv[0], kv[1]); p.y = cvtpk(kv[2], kv[3]); p.z = cvtpk(kv[4], kv[5]); p.w = cvtpk(kv[6], kv[7]); *(u32x4*)(M4 + q * 8) = p; } }
                if (t < 128) ((float*)(ws + WS_GGL))[(size_t)item * 128 + t] = __expf(dl);
            }
        }
    }
    LBAR();
}

__device__ __forceinline__ void phase_rwkv_chunk(const Args& a, int l, LAS unsigned char* lds) {
    size_t wso_ = 0; asm volatile("" : "+s"(wso_)); unsigned char* ws = a.ws + wso_;
    const int tid0 = tid_l(), w = __builtin_amdgcn_readfirstlane(tid0 >> 6);
    const float* RR = (const float*)(ws + WS_RR); const float* RWl = (const float*)(ws + WS_RW); const float* RK = (const float*)(ws + WS_RK); const float* RV = (const float*)(ws + WS_RV);
    const float* RKK = (const float*)(ws + WS_RKK); const float* RB = (const float*)(ws + WS_RB);
    constexpr int OR_ = 72;
    LAS float* cw = (LAS float*)lds;
    LAS bf16_t* M3s = (LAS bf16_t*)lds;
    LAS bf16_t* Al = (LAS bf16_t*)(lds + 16384); LAS bf16_t* Be = Al + 64 * OR_; LAS bf16_t* Ka = Be + 64 * OR_; LAS bf16_t* Rh = Ka + 64 * OR_;
    LAS float* ABf = (LAS float*)(lds + 53248);
    LAS bf16_t* AKb = (LAS bf16_t*)(lds + 69632);
    LAS bf16_t* VTb = (LAS bf16_t*)(lds + 78848);
    LAS float* RH2 = (LAS float*)(lds + 88064);
    LAS bf16_t* M4s = (LAS bf16_t*)(lds + 104448);
    LAS float* segt = (LAS float*)(lds + 121856);
    const int first = bid_l(), gstep = gdim_l();
    const int nmine = (first < RCH) ? (RCH - first + gstep - 1) / gstep : 0;
    if (w < 2) {
    for (int k = -1; k < nmine; ++k) {
        int tid = tid0; asm volatile("" : "+v"(tid)); const int lane = tid & 63, lr = lane & 15, lq = lane >> 4;
            const bool act = (k >= 0); const int item = first + (act ? k : 0) * gstep;
            const bool isom = (w == 0); const int cc = tid & 63;
            float X[64]; int Arow[63];
            if (act) {
                if (isom) {
#pragma unroll
                    for (int c = 0; c < 64; ++c) X[c] = bf2f(Al[c * OR_ + cc]); }
                else {
#pragma unroll
                    for (int c = 0; c < 64; ++c) X[c] = RH2[c * 64 + cc]; }
#pragma unroll
                for (int m = 0; m < 63; ++m) Arow[m] = __float_as_int(ABf[m * 64 + lane]);
            }
            LBAR();
#define RW_SOLVE(m0, m1) do { if (act) { _Pragma("unroll") for (int m = (m0); m < (m1); ++m) { const float xm = X[m]; \
                _Pragma("unroll") for (int c = m + 1; c < 64; ++c) X[c] -= __int_as_float(__builtin_amdgcn_readlane(Arow[m], c)) * xm; } } } while (0)
            RW_SOLVE(0, 30);
            LBAR();
            RW_SOLVE(30, 63);
            LBAR();
#undef RW_SOLVE
            if (act) {
                if (isom) { bf16_t* M1 = (bf16_t*)(ws + WS_R1) + (size_t)item * 4096 + cc;
#pragma unroll
                    for (int c = 0; c < 64; ++c) M1[c * 64] = f2bf(X[c]); }
                else { float* UT = (float*)(ws + WS_RU) + (size_t)item * 4096 + (size_t)cc * 64;
#pragma unroll
                    for (int c4 = 0; c4 < 16; ++c4) *(f32x4*)(UT + 4 * c4) = (f32x4){X[4 * c4], X[4 * c4 + 1], X[4 * c4 + 2], X[4 * c4 + 3]}; }
            }
            LBAR();
    }
    } else {
    float plw[16], pv[11], pkk[12], pbb[12], pk2[12], pr[12];
#define RWB_ISSUE(it) do { const int b_ = (it) / 384, h_ = ((it) / 32) % 12, n_ = (it) % 32; const size_t gb_ = ((size_t)b_ * SEQ + n_ * 64) * 768 + h_ * 64; const int t_ = tidp - 128, wb_ = w - 2; \
        if (wb_ < 4) { _Pragma("unroll") for (int q = 0; q < 16; ++q) plw[q] = RWl[gb_ + (size_t)(wb_ * 16 + q) * 768 + (tidp & 63)]; } \
        _Pragma("unroll") for (int q = 0; q < 11; ++q) { const int idx = t_ + 384 * q; const int c = (idx >> 6) & 63, i = idx & 63; pv[q] = RV[gb_ + (size_t)c * 768 + i]; } \
        _Pragma("unroll") for (int q = 0; q < 12; ++q) { const int idx = t_ + 384 * q; const int c = (idx >> 6) & 63, j = idx & 63; const size_t g = gb_ + (size_t)c * 768 + j; pkk[q] = RKK[g]; pbb[q] = RB[g]; pk2[q] = RK[g]; pr[q] = RR[g]; } } while (0)
    if (nmine > 0) { int tidp = tid0; asm volatile("" : "+v"(tidp)); RWB_ISSUE(first); }
    for (int k = -1; k < nmine; ++k) {
        int tid = tid0; asm volatile("" : "+v"(tid)); const int lane = tid & 63, lr = lane & 15, lq = lane >> 4;
            const bool act = (k + 1 < nmine); const int item = first + (act ? (k + 1) : 0) * gstep;
            const int b = item / 384, h = (item / 32) % 12, n = item % 32; const size_t gb = ((size_t)b * SEQ + n * 64) * 768 + h * 64;
            const int t = tid - 128, wb = w - 2;
            if (act) {
                if (wb < 4) {
                    float acc = 0.f;
#pragma unroll
                    for (int q = 0; q < 8; ++q) { acc += plw[q]; cw[(wb * 16 + q) * 64 + lane] = acc; }
                    segt[(2 * wb) * 64 + lane] = acc; acc = 0.f;
#pragma unroll
                    for (int q = 8; q < 16; ++q) { acc += plw[q]; cw[(wb * 16 + q) * 64 + lane] = acc; }
                    segt[(2 * wb + 1) * 64 + lane] = acc; }
#pragma unroll
                for (int q = 0; q < 11; ++q) { const int idx = t + 384 * q; const int c = idx >> 6, i = idx & 63; if (idx < 4096) VTb[i * OR_ + c] = f2bf(pv[q]); }
            }
            LBAR();
            if (act) {
#pragma unroll
                for (int hf = 0; hf < 2; ++hf) {
#pragma unroll
                    for (int q = 0; q < 6; ++q) { const int idx = t + 384 * (6 * hf + q); const int c = idx >> 6, j = idx & 63;
                        if (idx < 4096) {
                            float off = 0.f, offm = 0.f, tot = 0.f;
#pragma unroll
                            for (int s2 = 0; s2 < 8; ++s2) { const float st = segt[s2 * 64 + j]; if (s2 < (c >> 3)) off += st; if (c > 0 && s2 < ((c - 1) >> 3)) offm += st; tot += st; }
                            const float cwc = cw[c * 64 + j] + off, cwm = c ? cw[(c - 1) * 64 + j] + offm : 0.f, cwl = tot;
                            const float kk = pkk[6 * hf + q], bb = pbb[6 * hf + q], k2 = pk2[6 * hf + q], r = pr[6 * hf + q];
                            const float en = __expf(-cwc);
                            Al[c * OR_ + j] = f2bf(kk * __expf(cwm)); Be[c * OR_ + j] = f2bf(bb * en); Ka[c * OR_ + j] = f2bf(k2 * en); const bf16_t rh = f2bf(r * __expf(cwc)); Rh[c * OR_ + j] = rh;
                            ((bf16_t*)(ws + WS_R2))[(size_t)item * 4096 + c * 64 + j] = rh;
                            const float ed = __expf(cwl - cwc); M4s[j * 136 + c] = f2bf(-bb * ed); M4s[j * 136 + 64 + c] = f2bf(k2 * ed);
                            if (c == 63) ((float*)(ws + WS_RGL))[(size_t)item * 64 + j] = __expf(cwl); } } }
                if (k + 2 < nmine) { const int tidp = tid; RWB_ISSUE(first + (k + 2) * gstep); }
            }
            LBAR();
            if (act) {
                for (int pc = wb; pc < 16; pc += 6) { const int p = pc >> 2, cb = pc & 3; const LAS bf16_t* X = (p < 2) ? Al : Rh; const LAS bf16_t* Y = (p & 1) ? Ka : Be;
                    const bf16x8 x0 = *(const LAS bf16x8*)(X + (cb * 16 + lr) * OR_ + 8 * lq), x1 = *(const LAS bf16x8*)(X + (cb * 16 + lr) * OR_ + 32 + 8 * lq);
#pragma unroll
                    for (int mb = 0; mb < 4; ++mb) { f32x4 acc = (f32x4){0.f, 0.f, 0.f, 0.f};
                        acc = __builtin_amdgcn_mfma_f32_16x16x32_bf16(x0, *(const LAS bf16x8*)(Y + (mb * 16 + lr) * OR_ + 8 * lq), acc, 0, 0, 0);
                        acc = __builtin_amdgcn_mfma_f32_16x16x32_bf16(x1, *(const LAS bf16x8*)(Y + (mb * 16 + lr) * OR_ + 32 + 8 * lq), acc, 0, 0, 0);
                        const int m = mb * 16 + lr;
                        if (p == 0) { f32x4 o;
#pragma unroll
                            for (int r = 0; r < 4; ++r) { const int c = cb * 16 + 4 * lq + r; o[r] = (c > m) ? acc[r] : 0.f; }
                            *(LAS f32x4*)(ABf + m * 64 + cb * 16 + 4 * lq) = o; }
                        else {
#pragma unroll
                            for (int r = 0; r < 4; ++r) { const int c = cb * 16 + 4 * lq + r;
                                if (p == 1) AKb[c * OR_ + m] = f2bf((c > m) ? acc[r] : 0.f);
                                else if (p == 2) M3s[c * 128 + m] = f2bf((c >= m) ? -acc[r] : 0.f);
                                else M3s[c * 128 + 64 + m] = f2bf((c >= m) ? acc[r] : 0.f); } } } }
            }
            LBAR();
            if (act) {
                for (int tl = wb; tl < 16; tl += 6) { const int cb = tl >> 2, ib = tl & 3;
                    const bf16x8 x0 = *(const LAS bf16x8*)(AKb + (cb * 16 + lr) * OR_ + 8 * lq), x1 = *(const LAS bf16x8*)(AKb + (cb * 16 + lr) * OR_ + 32 + 8 * lq);
                    f32x4 acc = (f32x4){0.f, 0.f, 0.f, 0.f};
                    acc = __builtin_amdgcn_mfma_f32_16x16x32_bf16(x0, *(const LAS bf16x8*)(VTb + (ib * 16 + lr) * OR_ + 8 * lq), acc, 0, 0, 0);
                    acc = __builtin_amdgcn_mfma_f32_16x16x32_bf16(x1, *(const LAS bf16x8*)(VTb + (ib * 16 + lr) * OR_ + 32 + 8 * lq), acc, 0, 0, 0);
#pragma unroll
                    for (int r = 0; r < 4; ++r) RH2[(cb * 16 + 4 * lq + r) * 64 + ib * 16 + lr] = acc[r]; }
                u32x4* g3 = (u32x4*)((bf16_t*)(ws + WS_R3) + (size_t)item * 64 * 128);
                for (int q = t; q < 1024; q += 384) g3[q] = *(const LAS u32x4*)(M3s + q * 8);
                u32x4* g4 = (u32x4*)((bf16_t*)(ws + WS_R4) + (size_t)item * 64 * 128);
                for (int q = t; q < 1024; q += 384) g4[q] = *(const LAS u32x4*)(M4s + (q >> 4) * 136 + (q & 15) * 8);
                u32x4* gv = (u32x4*)((bf16_t*)(ws + WS_RVT) + (size_t)item * 64 * 64);
                for (int q = t; q < 512; q += 384) gv[q] = *(const LAS u32x4*)(VTb + (q >> 3) * OR_ + (q & 7) * 8);
            }
            LBAR();
    }
    }
    LBAR();
#undef RWB_ISSUE
}

__device__ __forceinline__ void phase_lru_chunk(const Args& a) {
    size_t wso_ = 0; asm volatile("" : "+s"(wso_)); unsigned char* ws = a.ws + wso_;
    const int tid = tid_l();
    const float* LA = (const float*)(ws + WS_LA); const float* LU = (const float*)(ws + WS_LU); float* LH = (float*)(ws + WS_LH); float* LP = (float*)(ws + WS_LP);
    for (int p = bid_l() * 512 + tid; p < 128 * 512; p += gdim_l() * 512) { const int chunk = p >> 9, c = p & 511; const size_t base = (size_t)chunk * 64 * 512 + c;
        float h = 0.f, cp = 1.f;
        for (int i0 = 0; i0 < 64; i0 += 16) { float av[16], uv[16];
#pragma unroll
            for (int i = 0; i < 16; ++i) { av[i] = LA[base + (size_t)(i0 + i) * 512]; uv[i] = LU[base + (size_t)(i0 + i) * 512]; }
#pragma unroll
            for (int i = 0; i < 16; ++i) { h = av[i] * h + uv[i]; cp *= av[i]; LH[base + (size_t)(i0 + i) * 512] = h; LP[base + (size_t)(i0 + i) * 512] = cp; } } }
}
constexpr int SB = 16;
__device__ __forceinline__ void phase_scan_naive(const Args& a, int l, LAS unsigned char* lds) {
    size_t wso_ = 0; asm volatile("" : "+s"(wso_)); unsigned char* ws = a.ws + wso_;
    const int tid = tid_l(), wave = __builtin_amdgcn_readfirstlane(tid >> 6), lane = tid & 63;
    const int blk = bid_l();
    if (blk < 96) {
        const int xq = blk >> 3, bh = (blk & 7) * 3 + (xq >> 2), es = xq & 3, b = bh / 6, h = bh % 6; const size_t ci = (size_t)bh * 32;
        ScanRec R{(const bf16_t*)(ws + WS_G1) + ci * 64 * 128, (const bf16_t*)(ws + WS_G2) + ci * 64 * 128, (const bf16_t*)(ws + WS_G3) + ci * 64 * 64, (const bf16_t*)(ws + WS_G4) + ci * 128 * 64,
                  (const float*)(ws + WS_GU) + ci * 128 * 64, (const float*)(ws + WS_GGL) + ci * 128, nullptr};
        scan_item<128, 64, false>(R, es * 32, (float*)(ws + WS_GO) + (size_t)b * SEQ * 768 + h * 128, 768, lds);
    } else if (blk < 192) {
        const int it = blk - 96, xq = it >> 3, bh = (it & 7) * 6 + (xq >> 1), es = xq & 1, b = bh / 12, h = bh % 12; const size_t ci = (size_t)bh * 32;
        ScanRec R{(const bf16_t*)(ws + WS_R1) + ci * 4096, (const bf16_t*)(ws + WS_R2) + ci * 4096, (const bf16_t*)(ws + WS_R3) + ci * 8192, (const bf16_t*)(ws + WS_R4) + ci * 8192,
                  (const float*)(ws + WS_RU) + ci * 4096, (const float*)(ws + WS_RGL) + ci * 64, (const bf16_t*)(ws + WS_RVT) + ci * 4096};
        scan_item<64, 128, true>(R, es * 32, (float*)(ws + WS_RY) + (size_t)b * SEQ * 768 + h * 64, 768, lds);
    } else if (blk < 196) {
        const int gidx = (blk - 192) * 512 + tid, b = gidx >> 9, c = gidx & 511;
        const float* LH = (const float*)(ws + WS_LH); const float* LP = (const float*)(ws + WS_LP); float* LC = (float*)(ws + WS_LC);
        float pe[32], he[32];
#pragma unroll
        for (int n = 0; n < 32; ++n) { const size_t o = ((size_t)b * SEQ + n * 64 + 63) * 512 + c; pe[n] = LP[o]; he[n] = LH[o]; }
        float carry = 0.f;
#pragma unroll
        for (int n = 0; n < 32; ++n) { LC[(size_t)(b * 32 + n) * 512 + c] = carry; carry = pe[n] * carry + he[n]; }
    } else if (l + 1 < NL && CONV_SPLIT > 0) {
        phase_convert(a, lds, l + 1, l + 2, 0, CONV_SPLIT, blk - 196, gdim_l() - 196, 0);
    }
}
__device__ __forceinline__ void phase_fin(const Args& a, int l, LAS unsigned char* lds) {
    size_t wso_ = 0; asm volatile("" : "+s"(wso_)); unsigned char* ws = a.ws + wso_;
    const int tid = tid_l(), wave = tid >> 6, lane = tid & 63;
    const int gw = bid_l() * 8 + wave, NGW = gdim_l() * 8;
    const bf16_t* PROJ = (const bf16_t*)(ws + WS_PROJ); bf16_t* Y = (bf16_t*)(ws + WS_Y);
    const float* GO = (const float*)(ws + WS_GO); const float* RY = (const float*)(ws + WS_RY);
    const float* RR = (const float*)(ws + WS_RR); const float* RK = (const float*)(ws + WS_RK); const float* RV = (const float*)(ws + WS_RV);
    const float* LH = (const float*)(ws + WS_LH); const float* LP = (const float*)(ws + WS_LP); const float* LC = (const float*)(ws + WS_LC);
    const f32x2 ng = *(const f32x2*)(inp(lds, I_GNG) + l * 128 + 2 * lane);
    float gnw[12], gnb[12], rkw[12];
#pragma unroll
    for (int h = 0; h < 12; ++h) { gnw[h] = inp(lds, I_RGNW)[l * 768 + h * 64 + lane]; gnb[h] = inp(lds, I_RGNB)[l * 768 + h * 64 + lane]; rkw[h] = inp(lds, I_RRK)[l * 768 + h * 64 + lane]; }
    for (int t = gw; t < NTOK; t += NGW) {
        const f32x4 h0 = *(const f32x4*)(LH + (size_t)t * 512 + 8 * lane), h1 = *(const f32x4*)(LH + (size_t)t * 512 + 8 * lane + 4);
        const f32x4 p0 = *(const f32x4*)(LP + (size_t)t * 512 + 8 * lane), p1 = *(const f32x4*)(LP + (size_t)t * 512 + 8 * lane + 4);
        const f32x4 c0 = *(const f32x4*)(LC + (size_t)(t >> 6) * 512 + 8 * lane), c1 = *(const f32x4*)(LC + (size_t)(t >> 6) * 512 + 8 * lane + 4);
        const u32x4 gq = *(const u32x4*)(PROJ + (size_t)t * NP + PC_AG + 8 * lane);
        f32x2 go[6]; unsigned gg[6];
#pragma unroll
        for (int h = 0; h < 6; ++h) { go[h] = *(const f32x2*)(GO + (size_t)t * 768 + h * 128 + 2 * lane); gg[h] = *(const unsigned*)(PROJ + (size_t)t * NP + PC_BG + h * 128 + 2 * lane); }
        float ry[12], rr[12], rk[12], rv[12]; bf16_t rg[12];
#pragma unroll
        for (int h = 0; h < 12; ++h) { const size_t o = (size_t)t * 768 + h * 64 + lane; ry[h] = RY[o]; rr[h] = RR[o]; rk[h] = RK[o]; rv[h] = RV[o]; rg[h] = PROJ[(size_t)t * NP + PC_CG + h * 64 + lane]; }
        { const f32x4 v0 = h0 + p0 * c0, v1 = h1 + p1 * c1;
            u32x4 o; o.x = cvtpk(v0[0] * siluf_(__uint_as_float(gq.x << 16)), v0[1] * siluf_(__uint_as_float(gq.x & 0xffff0000u)));
            o.y = cvtpk(v0[2] * siluf_(__uint_as_float(gq.y << 16)), v0[3] * siluf_(__uint_as_float(gq.y & 0xffff0000u)));
            o.z = cvtpk(v1[0] * siluf_(__uint_as_float(gq.z << 16)), v1[1] * siluf_(__uint_as_float(gq.z & 0xffff0000u)));
            o.w = cvtpk(v1[2] * siluf_(__uint_as_float(gq.w << 16)), v1[3] * siluf_(__uint_as_float(gq.w & 0xffff0000u)));
            *(u32x4*)(Y + (size_t)t * DM + 8 * lane) = o; }
#pragma unroll
        for (int h = 0; h < 6; ++h) { const f32x2 o = go[h]; const float ss = wave_sum(o.x * o.x + o.y * o.y); const float sc = __builtin_amdgcn_rsqf(ss * (1.0f / 128.f) + 1e-6f);
            const float g0 = __uint_as_float(gg[h] << 16), g1 = __uint_as_float(gg[h] & 0xffff0000u);
            *(unsigned*)(Y + (size_t)t * DM + 512 + h * 128 + 2 * lane) = cvtpk(o.x * sc * ng.x * siluf_(g0), o.y * sc * ng.y * siluf_(g1)); }
#pragma unroll
        for (int h = 0; h < 12; ++h) { const float y = ry[h]; const float mean = wave_sum(y) * (1.0f / 64.f); const float d = y - mean; const float var = wave_sum(d * d) * (1.0f / 64.f);
            float yn = d * (__builtin_amdgcn_rsqf(var + 64e-5f)) * gnw[h] + gnb[h];
            const float sdot = wave_sum(rr[h] * rk[h] * rkw[h]); yn += sdot * rv[h];
            Y[(size_t)t * DM + 1280 + h * 64 + lane] = f2bf(yn * siluf_(bf2f(rg[h]))); }
    }
}
#define XB_TMO      128
#define XB_XCNT(j)  (256  + 64 * (j))
#define XB_XSUB(j)  (1280 + 64 * (j))
#define XB_XGEN(j)  (2304 + 64 * (j))
#define XB_TOP      3328
#define XB_TOPGEN   3392
#define XCD_BAR_WORDS 3456
#define XB_SPIN_CAP (1u << 18)
__device__ __forceinline__ unsigned xb_ld(unsigned* p)              { return __hip_atomic_load(p, __ATOMIC_RELAXED, __HIP_MEMORY_SCOPE_AGENT); }
__device__ __forceinline__ unsigned xb_add(unsigned* p, unsigned v) { return __hip_atomic_fetch_add(p, v, __ATOMIC_RELAXED, __HIP_MEMORY_SCOPE_AGENT); }
__device__ __forceinline__ unsigned xb_xcc_id() { return (unsigned)__builtin_amdgcn_s_getreg((3 << 11) | 20) & 0xFu; }
#define XB_SPIN(cond, bar) do { unsigned _sp = 0; while (cond) { __builtin_amdgcn_s_sleep(1); \
    if ((++_sp & 255u) == 0u) { if (xb_ld(&(bar)[XB_TMO])) break; if (_sp > XB_SPIN_CAP) { atomicAdd(&(bar)[XB_TMO], 1u); break; } } } } while (0)

struct XcdBarrier {
    unsigned* bar; unsigned x;
    volatile LAS unsigned* st;
};

__device__ __forceinline__ XcdBarrier xcd_barrier_post(unsigned* bar, volatile LAS unsigned* st) {
    XcdBarrier b; b.bar = bar; b.x = xb_xcc_id(); b.st = st;
    if (threadIdx.x == 0) (void)xb_add(&bar[XB_XCNT(b.x)], 1u);
    return b;
}
__device__ __forceinline__ void xcd_barrier_complete(unsigned* bar, unsigned x, unsigned& nloc, unsigned& nx) {
    const unsigned G = gridDim.x * gridDim.y * gridDim.z;
    unsigned sum, cnt, mine, sp = 0u;
    for (;;) {
        sum = 0u; cnt = 0u; mine = 0u;
#pragma unroll
        for (unsigned j = 0; j < 16; ++j) { const unsigned c = xb_ld(&bar[XB_XCNT(j)]); sum += c; cnt += (c > 0u) ? 1u : 0u; mine = (j == x) ? c : mine; }
        if (sum == G) break;
        __builtin_amdgcn_s_sleep(1);
        if ((++sp & 255u) == 0u) { if (xb_ld(&bar[XB_TMO])) break; if (sp > XB_SPIN_CAP) { atomicAdd(&bar[XB_TMO], 1u); break; } }
    }
    nloc = mine > 0u ? mine : 1u; nx = cnt > 0u ? cnt : 1u;
}

__device__ __forceinline__ void xcd_barrier(const XcdBarrier& b) {
    asm volatile("s_waitcnt vmcnt(0)" ::: "memory");
    __syncthreads();
    if (threadIdx.x == 0) {
        unsigned* bar = b.bar;
        __builtin_amdgcn_s_waitcnt(0);
        unsigned nloc = b.st[0], nx = b.st[1];
        if (nloc == 0u) { xcd_barrier_complete(bar, b.x, nloc, nx); b.st[0] = nloc; b.st[1] = nx; }
        const unsigned old = xb_add(&bar[XB_XSUB(b.x)], 1u);
        const unsigned gen = old / nloc;
        if (old + 1u == (gen + 1u) * nloc) {
            __builtin_amdgcn_fence(__ATOMIC_RELEASE, "agent");
            asm volatile("s_waitcnt vmcnt(0)" ::: "memory");
            const unsigned og = xb_add(&bar[XB_TOP], 1u);
            const unsigned tg = og / nx;
            if (og + 1u == (tg + 1u) * nx) xb_add(&bar[XB_TOPGEN], 1u);
            else XB_SPIN(xb_ld(&bar[XB_TOPGEN]) == tg, bar);
            __builtin_amdgcn_fence(__ATOMIC_ACQUIRE, "agent");
            xb_add(&bar[XB_XGEN(b.x)], 1u);
            asm volatile("s_waitcnt vmcnt(0)" ::: "memory");
        } else {
            XB_SPIN(xb_ld(&bar[XB_XGEN(b.x)]) == gen, bar);
            __builtin_amdgcn_fence(__ATOMIC_ACQUIRE, "agent");
            asm volatile("s_waitcnt vmcnt(0)" ::: "memory");
        }
    }
    __syncthreads();
}


__global__ void __launch_bounds__(512) mk_fwd(Args a) {
    extern __shared__ __attribute__((aligned(16))) unsigned char lds_raw[];
    LAS unsigned char* lds = (LAS unsigned char*)lds_raw;
    cg::grid_group grid = cg::this_grid();
    const int lo = a.ph_lo, hi = a.ph_hi;
    if (threadIdx.x < 26) { const unsigned long long p = (unsigned long long)a.in[threadIdx.x]; LAS unsigned* t = (LAS unsigned*)(lds + 131072) + 2 * threadIdx.x; t[0] = (unsigned)p; t[1] = (unsigned)(p >> 32); }
    if (threadIdx.x == 0) { LAS unsigned* z = (LAS unsigned*)(lds + 131072 + 256); z[0] = 0u; z[1] = 0u; z[2] = 0u; z[3] = 0u; }
    __syncthreads();
    XcdBarrier xb = xcd_barrier_post((unsigned*)(a.ws + WS_BAR), (volatile LAS unsigned*)(lds + 131072 + 256));
    float* XR = (float*)(a.ws + WS_XR); bf16_t* XB = (bf16_t*)(a.ws + WS_XB); bf16_t* PROJ = (bf16_t*)(a.ws + WS_PROJ); bf16_t* Y = (bf16_t*)(a.ws + WS_Y);
    for (int ph = lo; ph < hi; ++ph) {
      const int nrep = (REPMASK && ph > 0 && ph < NPHASE - 1 && ((REPMASK >> ((ph - 1) % PPL)) & 1)) ? 2 : 1;
      for (int rep = 0; rep < nrep; ++rep) {
        if (ph == 0) { phase_convert(a, lds, 0, 1, 0, 64, bid_l(), gdim_l(), 1); phase_convert(a, lds, 1, NL, CONV_SPLIT2, 64, bid_l(), gdim_l(), 0); }
        else if (ph == NPHASE - 1) phase_final(XR, inp(lds, I_FNG), a.out);
        else { const int l = (ph - 1) / PPL, s = (ph - 1) % PPL; const float* xin = (l == 0) ? inp(lds, I_X) : XR;
            if (s == 0) { if (!(SKIPMASK & 2)) phase_rms(xin, XB); }
            else if (s == 1 || s == 6) { if (!(SKIPMASK & 4)) {
                pg8::Gemm g; EpiDual E;
                if (s == 1) { g = pg8::Gemm{XB, (const bf16_t*)(a.ws + WS_WIN) + (size_t)l * NP * DM, NTOK, NP, DM}; E = EpiDual{0, PROJ, NP, nullptr, nullptr, 0}; }
                else { g = pg8::Gemm{Y, (const bf16_t*)(a.ws + WS_WOUT) + (size_t)l * DM * DM, NTOK, DM, DM}; E = EpiDual{1, nullptr, 0, xin, XR, DM}; }
                pg8::StaticOrder S; S.init(NTOK, g.N, gdim_l(), bid_l());
                pg8::gemm_phase<EpiDual, pg8::StaticOrder>(lds, g, S, E, nullptr);
                if (s == 1 && l + 1 < NL) { const int nfull = (NTOK / 256) * (NP / 256) - 3 * gdim_l();
                    if (nfull > 0 && nfull < gdim_l() && bid_l() >= nfull) phase_convert(a, lds, l + 1, l + 2, CONV_SPLIT, CONV_SPLIT2, bid_l() - nfull, gdim_l() - nfull, 0);
                    else if (nfull <= 0 || nfull >= gdim_l()) phase_convert(a, lds, l + 1, l + 2, CONV_SPLIT, CONV_SPLIT2, bid_l(), gdim_l(), 0); } } }
            else if (s == 2) { if (!(SKIPMASK & 8)) phase_prep(a, l, lds); }
            else if (s == 3) { phase_gdn_chunk(a, l, lds); if (CHUNKREP & 1) phase_gdn_chunk(a, l, lds); phase_rwkv_chunk(a, l, lds); if (CHUNKREP & 2) phase_rwkv_chunk(a, l, lds); phase_lru_chunk(a); if (CHUNKREP & 4) phase_lru_chunk(a); }
            else if (s == 4) { if (!(SKIPMASK & 16)) phase_scan_naive(a, l, lds); }
            else if (s == 5) { if (!(SKIPMASK & 32)) phase_fin(a, l, lds); }
        }
      }
        if (ph + 1 < hi) { if (ph == 0) grid.sync(); else xcd_barrier(xb); }
    }
}

extern "C" void kernel_launch(void* const* d_in, const int* in_sizes, int n_in, void* d_out, int out_size, void* d_ws, size_t ws_size, hipStream_t stream) {
    static int grid = 0;
    if (grid == 0) {
        if (n_in != 26 || ws_size < WS_END) { fprintf(stderr, "kernel_launch: unexpected n_in %d or ws_size %zu < %zu\n", n_in, ws_size, (size_t)WS_END); grid = -1; return; }
        int dev = 0, cus = 0, per_cu = 0;
        hipGetDevice(&dev); hipDeviceGetAttribute(&cus, hipDeviceAttributeMultiprocessorCount, dev);
        if (hipFuncSetAttribute((const void*)mk_fwd, hipFuncAttributeMaxDynamicSharedMemorySize, LDS_BYTES) != hipSuccess) { fprintf(stderr, "hipFuncSetAttribute failed\n"); grid = -1; return; }
        if (hipOccupancyMaxActiveBlocksPerMultiprocessor(&per_cu, (const void*)mk_fwd, 512, LDS_BYTES) != hipSuccess || per_cu < 1) { fprintf(stderr, "occupancy query failed / 0\n"); grid = -1; return; }
        grid = cus;
    }
    if (grid < 0) return;
    if (hipMemsetAsync((char*)d_ws + WS_BAR, 0, 16384, stream) != hipSuccess) { fprintf(stderr, "memset of barrier words failed\n"); return; }
    Args a{};
    for (int i = 0; i < 26; ++i) a.in[i] = (const float*)d_in[i];
    a.out = (float*)d_out; a.ws = (unsigned char*)d_ws;
#if N_LAUNCH_MODE == 1
    a.ph_lo = 0; a.ph_hi = NPHASE;
    void* args[] = {&a};
    hipError_t e = hipLaunchCooperativeKernel((const void*)mk_fwd, dim3(grid), dim3(512), args, LDS_BYTES, stream);
    if (e != hipSuccess) fprintf(stderr, "cooperative launch failed: %s (grid %d)\n", hipGetErrorString(e), grid);
#else
    for (int ph = 0; ph < NPHASE; ++ph) { a.ph_lo = ph; a.ph_hi = ph + 1; hipLaunchKernelGGL(mk_fwd, dim3(grid), dim3(512), LDS_BYTES, stream, a); }
#endif
}
```
